# Optimizing an MI355X kernel written in HIP

```python
import math
import jax, jax.numpy as jnp
from jax import lax
import numpy as np

D_MODEL = 2048
BATCH = 1
SEQ = 8192
DEPTH = 4

N_MIXERS = 2
N_ATTN_LAYERS = (DEPTH + 1) // 2
N_REC_LAYERS = DEPTH // 2
N_HEADS = 16
HEAD_DIM = D_MODEL // N_HEADS
MOBA_BLOCK = 256
MOBA_TOPK = 3
Q_CHUNK = 32
NUM_BUCKETS = 32
MAX_DISTANCE = 4096
D_RNN = D_MODEL
N_GATE_BLOCKS = 16
GATE_BLOCK = D_RNN // N_GATE_BLOCKS
CONV_WIDTH = 4
LRU_C = 8.0
D_FF = 4 * D_MODEL
EPS = 1e-6

kernel_name = "moba_rglru_interleaved_trunk"


def rms_norm(x, g):
    xf = x.astype(jnp.float32)
    y = xf * lax.rsqrt(jnp.mean(xf * xf, axis=-1, keepdims=True) + EPS)
    return (y * g.astype(jnp.float32)).astype(x.dtype)


def t5_bucket(dist):
    n = jnp.maximum(dist, 0)
    max_exact = NUM_BUCKETS // 2
    nf = jnp.maximum(n, max_exact).astype(jnp.float32)
    large = max_exact + (jnp.log(nf / max_exact) / math.log(MAX_DISTANCE / max_exact)
                         * (NUM_BUCKETS - max_exact)).astype(jnp.int32)
    large = jnp.minimum(large, NUM_BUCKETS - 1)
    return jnp.where(n < max_exact, n, large)


def moba_attention(x, w_qkv, w_o, rel_bias):
    B, S, _ = x.shape
    n_blocks = -(-S // MOBA_BLOCK)
    s_pad = n_blocks * MOBA_BLOCK
    qkv = (x @ w_qkv).reshape(B, S, 3, N_HEADS, HEAD_DIM)
    qkv = jnp.pad(qkv, ((0, 0), (0, s_pad - S), (0, 0), (0, 0), (0, 0)))
    q, k, v = qkv[:, :, 0], qkv[:, :, 1], qkv[:, :, 2]
    kb = k.reshape(B, n_blocks, MOBA_BLOCK, N_HEADS, HEAD_DIM).transpose(0, 3, 1, 2, 4)
    vb = v.reshape(B, n_blocks, MOBA_BLOCK, N_HEADS, HEAD_DIM).transpose(0, 3, 1, 2, 4)
    k_mean = jnp.mean(kb, axis=3)
    bias_hb = rel_bias.T.astype(jnp.float32)
    n_sel = min(MOBA_TOPK, n_blocks - 1)
    scale = HEAD_DIM ** -0.5
    b_idx = jnp.arange(B)[:, None, None, None]
    h_idx = jnp.arange(N_HEADS)[None, None, :, None]
    blk_ids = jnp.arange(n_blocks)
    offs = jnp.arange(MOBA_BLOCK)

    def chunk(ci):
        start = ci * Q_CHUNK
        cur = start // MOBA_BLOCK
        qc = lax.dynamic_slice_in_dim(q, start, Q_CHUNK, axis=1)
        q_pos = start + jnp.arange(Q_CHUNK)
        k_own = lax.dynamic_index_in_dim(kb, cur, axis=2, keepdims=False)
        v_own = lax.dynamic_index_in_dim(vb, cur, axis=2, keepdims=False)
        s_own = jnp.einsum('bqhd,bhjd->bqhj', qc, k_own).astype(jnp.float32) * scale
        dist_own = q_pos[:, None] - (cur * MOBA_BLOCK + offs)[None, :]
        s_own = s_own + bias_hb[:, t5_bucket(dist_own)].transpose(1, 0, 2)[None]
        s_own = jnp.where((dist_own >= 0)[None, :, None, :], s_own, -jnp.inf)
        if n_sel == 0:
            p = jax.nn.softmax(s_own, axis=-1)
            return jnp.einsum('bqhj,bhjd->bqhd', p.astype(v.dtype), v_own)
        gate = jnp.einsum('bqhd,bhnd->bqhn', qc, k_mean).astype(jnp.float32)
        gate = jnp.where(blk_ids < cur, gate, -jnp.inf)
        _, sel = lax.top_k(gate, n_sel)
        sel_valid = sel < cur
        k_sel = kb[b_idx, h_idx, sel]
        v_sel = vb[b_idx, h_idx, sel]
        s_sel = jnp.einsum('bqhd,bqhkjd->bqhkj', qc, k_sel).astype(jnp.float32) * scale
        dist_sel = q_pos[None, :, None, None, None] - (sel[..., None] * MOBA_BLOCK + offs)
        s_sel = s_sel + bias_hb[h_idx[..., None], t5_bucket(dist_sel)]
        s_sel = jnp.where(sel_valid[..., None], s_sel, -jnp.inf)
        logits = jnp.concatenate([s_own, s_sel.reshape(B, Q_CHUNK, N_HEADS, n_sel * MOBA_BLOCK)], axis=-1)
        p = jax.nn.softmax(logits, axis=-1).astype(v.dtype)
        p_own = p[..., :MOBA_BLOCK]
        p_sel = p[..., MOBA_BLOCK:].reshape(B, Q_CHUNK, N_HEADS, n_sel, MOBA_BLOCK)
        return (jnp.einsum('bqhj,bhjd->bqhd', p_own, v_own)
                + jnp.einsum('bqhkj,bqhkjd->bqhd', p_sel, v_sel))

    out = lax.map(chunk, jnp.arange(s_pad // Q_CHUNK))
    out = out.transpose(1, 0, 2, 3, 4).reshape(B, s_pad, N_HEADS * HEAD_DIM)[:, :S]
    return out @ w_o


def _lin_rec_combine(c1, c2):
    a1, b1 = c1
    a2, b2 = c2
    return a1 * a2, a2 * b1 + b2


def rglru_block(x, w_in, conv_w, conv_b, w_rg, b_rg, w_ig, b_ig, lam, w_out):
    B, S, _ = x.shape
    xz = x @ w_in
    xr, gate = xz[..., :D_RNN], xz[..., D_RNN:]
    xp = jnp.pad(xr, ((0, 0), (CONV_WIDTH - 1, 0), (0, 0)))
    xc = conv_b + sum(xp[:, j:j + S] * conv_w[j] for j in range(CONV_WIDTH))
    xb = xc.reshape(B, S, N_GATE_BLOCKS, GATE_BLOCK)
    r = jax.nn.sigmoid(jnp.einsum('bsnc,ncd->bsnd', xb, w_rg).reshape(B, S, D_RNN) + b_rg)
    i = jax.nn.sigmoid(jnp.einsum('bsnc,ncd->bsnd', xb, w_ig).reshape(B, S, D_RNN) + b_ig)
    log_a = (LRU_C * r.astype(jnp.float32)) * jax.nn.log_sigmoid(lam.astype(jnp.float32))
    a = jnp.exp(log_a)
    b_in = jnp.sqrt(-jnp.expm1(2.0 * log_a)) * (i * xc).astype(jnp.float32)
    _, h = lax.associative_scan(_lin_rec_combine, (a, b_in), axis=1)
    y = h.astype(x.dtype) * jax.nn.gelu(gate)
    return y @ w_out


def squared_relu_mlp(x, w1, w2):
    return jnp.square(jax.nn.relu(x @ w1)) @ w2


def setup_inputs(seed: int = 0) -> dict:
    key = jax.random.key(seed)
    ks = jax.random.split(key, 20)
    f32 = jnp.float32
    nrm = lambda k, shape, s: jax.random.normal(k, shape, f32) * s
    u = jax.random.uniform(ks[13], (N_REC_LAYERS, D_RNN), f32, 0.9, 0.999)
    a0 = u ** (1.0 / LRU_C)
    lam = jnp.log(a0) - jnp.log1p(-a0)
    return {
        "x": nrm(ks[0], (BATCH, SEQ, D_MODEL), 1.0),
        "rel_bias": nrm(ks[1], (NUM_BUCKETS, N_HEADS), 0.5),
        "mix_norm": 1.0 + nrm(ks[2], (DEPTH, D_MODEL), 0.02),
        "mlp_norm": 1.0 + nrm(ks[3], (DEPTH, D_MODEL), 0.02),
        "final_norm": 1.0 + nrm(ks[4], (D_MODEL,), 0.02),
        "attn_w_qkv": nrm(ks[5], (N_ATTN_LAYERS, D_MODEL, 3 * N_HEADS * HEAD_DIM), D_MODEL ** -0.5),
        "attn_w_o": nrm(ks[6], (N_ATTN_LAYERS, N_HEADS * HEAD_DIM, D_MODEL), D_MODEL ** -0.5),
        "rec_w_in": nrm(ks[7], (N_REC_LAYERS, D_MODEL, 2 * D_RNN), D_MODEL ** -0.5),
        "rec_conv_w": nrm(ks[8], (N_REC_LAYERS, CONV_WIDTH, D_RNN), CONV_WIDTH ** -0.5),
        "rec_conv_b": nrm(ks[9], (N_REC_LAYERS, D_RNN), 0.01),
        "rec_w_rg": nrm(ks[10], (N_REC_LAYERS, N_GATE_BLOCKS, GATE_BLOCK, GATE_BLOCK), GATE_BLOCK ** -0.5),
        "rec_b_rg": nrm(ks[11], (N_REC_LAYERS, D_RNN), 0.01),
        "rec_w_ig": nrm(ks[12], (N_REC_LAYERS, N_GATE_BLOCKS, GATE_BLOCK, GATE_BLOCK), GATE_BLOCK ** -0.5),
        "rec_b_ig": nrm(ks[14], (N_REC_LAYERS, D_RNN), 0.01),
        "rec_lambda": lam,
        "rec_w_out": nrm(ks[15], (N_REC_LAYERS, D_RNN, D_MODEL), D_RNN ** -0.5),
        "mlp_w1": nrm(ks[16], (DEPTH, D_MODEL, D_FF), D_MODEL ** -0.5),
        "mlp_w2": nrm(ks[17], (DEPTH, D_FF, D_MODEL), D_FF ** -0.5),
    }


def reference(x, rel_bias, mix_norm, mlp_norm, final_norm, attn_w_qkv, attn_w_o,
              rec_w_in, rec_conv_w, rec_conv_b, rec_w_rg, rec_b_rg, rec_w_ig, rec_b_ig,
              rec_lambda, rec_w_out, mlp_w1, mlp_w2):
    for layer in range(DEPTH):
        h = rms_norm(x, mix_norm[layer])
        j = layer // N_MIXERS
        if layer % N_MIXERS == 0:
            h = moba_attention(h, attn_w_qkv[j], attn_w_o[j], rel_bias)
        else:
            h = rglru_block(h, rec_w_in[j], rec_conv_w[j], rec_conv_b[j], rec_w_rg[j], rec_b_rg[j],
                            rec_w_ig[j], rec_b_ig[j], rec_lambda[j], rec_w_out[j])
        x = x + h
        x = x + squared_relu_mlp(rms_norm(x, mlp_norm[layer]), mlp_w1[layer], mlp_w2[layer])
    return rms_norm(x, final_norm)
```

```cpp
#include <hip/hip_runtime.h>
#include <cstdio>
#include <cstdint>
#include <cmath>
namespace pg8 {
#define PG8_LAS __attribute__((address_space(3)))
typedef unsigned short bf16_t;
typedef short bf16x8 __attribute__((ext_vector_type(8)));
typedef float f32x4 __attribute__((ext_vector_type(4)));
typedef unsigned u32x4 __attribute__((ext_vector_type(4)));
constexpr int BM = 256, BK = 64, HALF = 128, HTB = HALF * BK * 2  , STAGE_BYTES = 8 * HTB, NXCD = 8, WGM = 8;

__host__ __device__ __forceinline__ int lds_byte(int r, int c) { const int st = (r >> 4) * 2 + (c >> 5), rr = r & 15, cc = c & 31, ob = rr * 64 + cc * 2; return st * 1024 + (ob ^ (((ob >> 9) & 1) << 5)); }
__host__ __device__ __forceinline__ void stage_rc(int b, int& R, int& C) { const int st = b / 1024, sb = b % 1024, swz = sb ^ (((sb >> 9) & 1) << 5); R = (st >> 1) * 16 + swz / 64; C = (st & 1) * 32 + (swz % 64) / 2; }
__host__ __device__ __forceinline__ int perm32(int rho) { const int n = rho >> 4, i = rho & 15; return 8 * (i >> 2) + 4 * n + (i & 3); }

struct Unit { int pm, pn; };
struct Gemm { const bf16_t* A; const bf16_t* Bt; int M, N, K; };

struct StaticOrder {
    int nM, nN, nwg, G, c;
    __host__ __device__ void init(int M, int N, int G_, int c_) { nM = M / BM; nN = N / BM; nwg = nM * nN; G = G_; c = c_; }
    __host__ __device__ bool next(int i, Unit& u) const {
        const long L = (long)i * G + c; if (L >= nwg) return false;
        int wgid = (int)L; { const int q = nwg / NXCD, r = nwg % NXCD, xcd = wgid % NXCD, off = wgid / NXCD; wgid = (xcd < r ? xcd * (q + 1) : r * (q + 1) + (xcd - r) * q) + off; }
        const int nig = WGM * nN, gid = wgid / nig, fm = gid * WGM, gsz = (nM - fm) < WGM ? (nM - fm) : WGM;
        u.pm = fm + ((wgid % nig) % gsz); u.pn = (wgid % nig) / gsz; return true;
    }
    __device__ __forceinline__ void a_ready(const Unit&) const {}
    __device__ __forceinline__ void done(const Unit&) const {}
};

__device__ __forceinline__ unsigned cvt_pk_bf16(float lo, float hi) { unsigned r; asm volatile("v_cvt_pk_bf16_f32 %0, %1, %2" : "=v"(r) : "v"(lo), "v"(hi)); return r; }
constexpr float RMS_EPS = 1e-6f;
__device__ __forceinline__ void load_rstd(const float* ssq, int row0, int fq, float (&rs)[2][4]) {
    asm volatile("" ::: "memory"); __builtin_amdgcn_sched_barrier(0);
#pragma unroll
    for (int ai = 0; ai < 2; ++ai) {
        f32x4 a[4][2];
#pragma unroll
        for (int m = 0; m < 4; ++m) { const f32x4* p = (const f32x4*)(ssq + (size_t)(row0 + ai * HALF + m * 16) * 32 + fq * 8); a[m][0] = p[0]; a[m][1] = p[1]; }
#pragma unroll
        for (int m = 0; m < 4; ++m) { const f32x4 x = a[m][0], y = a[m][1]; float s = ((x[0] + x[1]) + (x[2] + x[3])) + ((y[0] + y[1]) + (y[2] + y[3]));
            s += __shfl_xor(s, 16); s += __shfl_xor(s, 32); rs[ai][m] = __builtin_amdgcn_rsqf(s * (1.0f / 2048.0f) + RMS_EPS); }
        asm volatile("" ::: "memory"); __builtin_amdgcn_sched_barrier(0);
    }
}
__device__ __forceinline__ float gelu_tanh(float x) {
    const float u = 0.7978845608028654f * (x + 0.044715f * x * x * x);
    const float e = __builtin_amdgcn_exp2f(-2.0f * 1.4426950408889634f * u);
    return x * __builtin_amdgcn_rcpf(1.0f + e);
}
struct EpiScale {
    static constexpr bool PERM = true, AFTER_DRAIN = false;
    bf16_t* O; int ldc; const float* ssq; float* kmp; bf16_t* O2; int mode;
    __device__ __forceinline__ void operator()(const f32x4 (&acc)[2][2][4][2], const Unit& u, int wr, int wc, int fr, int fq) const {
        const int row0 = u.pm * BM + wr * 64 + fr;
        float rs[2][4]; load_rstd(ssq, row0, fq, rs);
        int colt = u.pn * BM; bf16_t* base = O; int am = mode == 2 ? 2 : 0;
        if (mode == 1 && colt >= 2048) { colt -= 2048; base = O2; am = 1; }
        const int col0 = colt + wc * 32 + 8 * fq;
#pragma unroll
        for (int ai = 0; ai < 2; ++ai)
#pragma unroll
            for (int m = 0; m < 4; ++m) { bf16_t* rowp = base + (size_t)(row0 + ai * HALF + m * 16) * ldc + col0; const float r = rs[ai][m];
#pragma unroll
                for (int bj = 0; bj < 2; ++bj) { f32x4 v0 = acc[ai][bj][m][0] * r, v1 = acc[ai][bj][m][1] * r;
                    if (am == 1) {
#pragma unroll
                        for (int e = 0; e < 4; ++e) { v0[e] = gelu_tanh(v0[e]); v1[e] = gelu_tanh(v1[e]); } }
                    else if (am == 2) {
#pragma unroll
                        for (int e = 0; e < 4; ++e) { const float a0 = fmaxf(v0[e], 0.f), a1 = fmaxf(v1[e], 0.f); v0[e] = a0 * a0; v1[e] = a1 * a1; } }
                    u32x4 w; w.x = cvt_pk_bf16(v0[0], v0[1]); w.y = cvt_pk_bf16(v0[2], v0[3]); w.z = cvt_pk_bf16(v1[0], v1[1]); w.w = cvt_pk_bf16(v1[2], v1[3]);
                    *(u32x4*)(rowp + bj * HALF) = w; } }
        if (mode == 0 && u.pn >= 8 && u.pn < 16) {
            float* kp = kmp + ((size_t)wr * 32 + u.pm) * 2048 + (u.pn - 8) * BM + wc * 32 + 8 * fq;
#pragma unroll
            for (int bj = 0; bj < 2; ++bj)
#pragma unroll
                for (int n = 0; n < 2; ++n) { f32x4 s = (f32x4){0.f, 0.f, 0.f, 0.f};
#pragma unroll
                    for (int ai = 0; ai < 2; ++ai)
#pragma unroll
                        for (int m = 0; m < 4; ++m) s += acc[ai][bj][m][n] * rs[ai][m];
#pragma unroll
                    for (int e = 0; e < 4; ++e) { float t = s[e]; t += __shfl_xor(t, 1); t += __shfl_xor(t, 2); t += __shfl_xor(t, 4); t += __shfl_xor(t, 8); s[e] = t; }
                    if (fr == 0) *(f32x4*)(kp + bj * HALF + 4 * n) = s; } }
    }
};
struct EpiRes {
    static constexpr bool PERM = true, AFTER_DRAIN = false;
    float* X; bf16_t* XB; float* ssq;
    __device__ __forceinline__ void operator()(const f32x4 (&acc)[2][2][4][2], const Unit& u, int wr, int wc, int fr, int fq) const {
        const int row0 = u.pm * BM + wr * 64 + fr, col0 = u.pn * BM + wc * 32 + 8 * fq;
#pragma unroll
        for (int ai = 0; ai < 2; ++ai)
#pragma unroll
            for (int m = 0; m < 4; ++m) { const int r = row0 + ai * HALF + m * 16; float s = 0.f;
#pragma unroll
                for (int bj = 0; bj < 2; ++bj) { float* xp = X + (size_t)r * 2048 + col0 + bj * HALF;
                    f32x4 x0 = *(const f32x4*)xp + acc[ai][bj][m][0], x1 = *(const f32x4*)(xp + 4) + acc[ai][bj][m][1];
                    *(f32x4*)xp = x0; *(f32x4*)(xp + 4) = x1;
                    s += ((x0[0] * x0[0] + x0[1] * x0[1]) + (x0[2] * x0[2] + x0[3] * x0[3])) + ((x1[0] * x1[0] + x1[1] * x1[1]) + (x1[2] * x1[2] + x1[3] * x1[3]));
                    u32x4 w; w.x = cvt_pk_bf16(x0[0], x0[1]); w.y = cvt_pk_bf16(x0[2], x0[3]); w.z = cvt_pk_bf16(x1[0], x1[1]); w.w = cvt_pk_bf16(x1[2], x1[3]);
                    *(u32x4*)(XB + (size_t)r * 2048 + col0 + bj * HALF) = w; }
                s += __shfl_xor(s, 16); s += __shfl_xor(s, 32);
                if (fq == 0) ssq[(size_t)r * 32 + u.pn * 4 + wc] = s; }
    }
};
template <class Epi, class Sched, bool ALIGN_EPI = false, bool SP2 = false>
__device__ __forceinline__ void gemm_phase(PG8_LAS unsigned char* lds, const Gemm g, const Sched& S, const Epi& E) {
    int tid_ = threadIdx.x; asm volatile("" : "+v"(tid_));
    const int tid = tid_, wid = __builtin_amdgcn_readfirstlane(tid >> 6), lane = tid & 63, wr = wid >> 2, wc = wid & 3, fr = lane & 15, fq = lane >> 4;
    const int K = g.K, nt = K / BK;
    unsigned voffA[2], voffB[2];
#pragma unroll
    for (int i = 0; i < 2; ++i) { int R, C; stage_rc(tid * 16 + i * 8192, R, C); const int Rb = Epi::PERM ? ((R & ~31) + perm32(R & 31)) : R;
        voffA[i] = (unsigned)(R * K + C) * 2u; voffB[i] = (unsigned)(Rb * K + C) * 2u; }
    const size_t kstep = (size_t)(BK * 2);
    const size_t hstep = (size_t)HALF * K * 2;
    const size_t tstep = 2 * hstep;
    const unsigned ldsw = (unsigned)wid * 1024u;
    const int aoff = lds_byte(wr * 64 + fr, fq * 8), boff = lds_byte(wc * 32 + fr, fq * 8);
#define PG8_SA(b, h) (((b) * 2 + (h)) * HTB)
#define PG8_SB(b, h) ((4 + (b) * 2 + (h)) * HTB)
#define PG8_STAGE(bufoff, gbase, voff) do { _Pragma("unroll") for (int _i = 0; _i < 2; ++_i) \
        __builtin_amdgcn_global_load_lds((const unsigned*)((const char*)(gbase) + (voff)[_i]), (PG8_LAS unsigned*)(lds + (bufoff) + ldsw + _i * 8192), 16, 0, 0); } while (0)
#define PG8_LDA(dst, b, h) do { _Pragma("unroll") for (int m = 0; m < 4; ++m) _Pragma("unroll") for (int k = 0; k < 2; ++k) dst[m][k] = *(const PG8_LAS bf16x8*)(lds + PG8_SA(b, h) + aoff + m * 2048 + k * 1024); } while (0)
#define PG8_LDB(dst, b, h) do { _Pragma("unroll") for (int n = 0; n < 2; ++n) _Pragma("unroll") for (int k = 0; k < 2; ++k) dst[n][k] = *(const PG8_LAS bf16x8*)(lds + PG8_SB(b, h) + boff + n * 2048 + k * 1024); } while (0)
#define PG8_MMA(ai, bj, At, Bt) do { __builtin_amdgcn_s_setprio(1); _Pragma("unroll") for (int m = 0; m < 4; ++m) _Pragma("unroll") for (int n = 0; n < 2; ++n) _Pragma("unroll") for (int k = 0; k < 2; ++k) \
        acc[ai][bj][m][n] = __builtin_amdgcn_mfma_f32_16x16x32_bf16(Bt[n][k], At[m][k], acc[ai][bj][m][n], 0, 0, 0); __builtin_amdgcn_s_setprio(0); } while (0)
#define PG8_WAIT_V(n) asm volatile("s_waitcnt vmcnt(" #n ")" ::: "memory")
#define PG8_WAIT_L(n) asm volatile("s_waitcnt lgkmcnt(" #n ")" ::: "memory")
#define PG8_BAR __builtin_amdgcn_s_barrier()
#define PG8_SCHED __builtin_amdgcn_sched_barrier(0)
    Unit cur, nxt; int ui = 0;
    if (!S.next(0, cur)) return;
    f32x4 acc[2][2][4][2];
#pragma unroll
    for (int a = 0; a < 2; ++a)
#pragma unroll
        for (int b = 0; b < 2; ++b)
#pragma unroll
            for (int m = 0; m < 4; ++m)
#pragma unroll
                for (int n = 0; n < 2; ++n) acc[a][b][m][n] = (f32x4){0.f, 0.f, 0.f, 0.f};
    bf16x8 At[4][2], B0[2][2], B1[2][2];
    const char* cA = (const char*)g.A + (size_t)cur.pm * tstep; const char* cB = (const char*)g.Bt + (size_t)cur.pn * tstep;
    S.a_ready(cur);
    if constexpr (SP2) {
        PG8_STAGE(PG8_SB(0, 0), cB, voffB); PG8_STAGE(PG8_SB(0, 1), cB + hstep, voffB); PG8_STAGE(PG8_SA(0, 0), cA, voffA); PG8_STAGE(PG8_SA(0, 1), cA + hstep, voffA);
        if (wr == 1) PG8_BAR;
        PG8_WAIT_V(2); PG8_BAR;
        PG8_STAGE(PG8_SB(1, 0), cB + kstep, voffB); PG8_STAGE(PG8_SA(1, 0), cA + kstep, voffA); PG8_STAGE(PG8_SB(1, 1), cB + hstep + kstep, voffB);
        PG8_WAIT_V(6); PG8_BAR;
    } else {
        PG8_STAGE(PG8_SB(0, 0), cB, voffB); PG8_STAGE(PG8_SA(0, 0), cA, voffA); PG8_STAGE(PG8_SB(0, 1), cB + hstep, voffB); PG8_STAGE(PG8_SA(0, 1), cA + hstep, voffA);
        if (wr == 1) PG8_BAR;
        PG8_WAIT_V(4); PG8_BAR;
        PG8_STAGE(PG8_SB(1, 0), cB + kstep, voffB); PG8_STAGE(PG8_SA(1, 0), cA + kstep, voffA); PG8_STAGE(PG8_SB(1, 1), cB + hstep + kstep, voffB);
        PG8_WAIT_V(6); PG8_BAR;
    }
    for (;;) {
        const bool has_next = S.next(ui + 1, nxt);
        const char* nA = has_next ? (const char*)g.A + (size_t)nxt.pm * tstep : cA; const char* nB = has_next ? (const char*)g.Bt + (size_t)nxt.pn * tstep : cB;
        for (int t = 0; t < nt; t += 2) {
            const bool last = (t == nt - 2);
            const char* a1 = cA + (size_t)(t + 1) * kstep;
            const char* a2 = last ? nA : cA + (size_t)(t + 2) * kstep; const char* b2 = last ? nB : cB + (size_t)(t + 2) * kstep;
            const char* a3 = a2 + kstep; const char* b3 = b2 + kstep;
            if (last && has_next) S.a_ready(nxt);
            if constexpr (SP2) {
            PG8_LDB(B0, 0, 0); PG8_LDB(B1, 0, 1); PG8_SCHED; PG8_LDA(At, 0, 0); PG8_STAGE(PG8_SA(1, 1), a1 + hstep, voffA);
            PG8_WAIT_V(8); PG8_WAIT_L(0); PG8_BAR; PG8_MMA(0, 0, At, B0); PG8_MMA(0, 1, At, B1); PG8_BAR; PG8_SCHED;
            PG8_LDA(At, 0, 1); PG8_STAGE(PG8_SB(0, 0), b2, voffB); PG8_STAGE(PG8_SB(0, 1), b2 + hstep, voffB); PG8_STAGE(PG8_SA(0, 0), a2, voffA);
            PG8_WAIT_V(8); PG8_WAIT_L(0); PG8_BAR; PG8_MMA(1, 0, At, B0); PG8_MMA(1, 1, At, B1); PG8_BAR; PG8_SCHED;
            PG8_LDB(B0, 1, 0); PG8_LDB(B1, 1, 1); PG8_SCHED; PG8_LDA(At, 1, 0); PG8_STAGE(PG8_SA(0, 1), a2 + hstep, voffA);
            PG8_WAIT_V(8); PG8_WAIT_L(0); PG8_BAR; PG8_MMA(0, 0, At, B0); PG8_MMA(0, 1, At, B1); PG8_BAR; PG8_SCHED;
            PG8_LDA(At, 1, 1); PG8_STAGE(PG8_SB(1, 0), b3, voffB); PG8_STAGE(PG8_SB(1, 1), b3 + hstep, voffB); PG8_STAGE(PG8_SA(1, 0), a3, voffA);
            PG8_WAIT_V(8); PG8_WAIT_L(0); PG8_BAR; PG8_MMA(1, 0, At, B0); PG8_MMA(1, 1, At, B1); PG8_BAR; PG8_SCHED;
            } else {
            PG8_LDB(B0, 0, 0); PG8_SCHED; PG8_LDA(At, 0, 0); PG8_STAGE(PG8_SA(1, 1), a1 + hstep, voffA);
            PG8_WAIT_L(8); PG8_BAR; PG8_WAIT_L(0); PG8_MMA(0, 0, At, B0); PG8_BAR; PG8_SCHED;
            PG8_LDB(B1, 0, 1); PG8_STAGE(PG8_SB(0, 0), b2, voffB);
            PG8_BAR; PG8_WAIT_L(0); PG8_MMA(0, 1, At, B1); PG8_BAR;
            PG8_LDA(At, 0, 1); PG8_STAGE(PG8_SA(0, 0), a2, voffA);
            PG8_BAR; PG8_WAIT_L(0); PG8_MMA(1, 0, At, B0); PG8_BAR; PG8_SCHED;
            PG8_STAGE(PG8_SB(0, 1), b2 + hstep, voffB);
            PG8_WAIT_V(6); PG8_BAR; PG8_MMA(1, 1, At, B1); PG8_BAR;
            PG8_LDB(B0, 1, 0); PG8_SCHED; PG8_LDA(At, 1, 0); PG8_STAGE(PG8_SA(0, 1), a2 + hstep, voffA);
            PG8_WAIT_L(8); PG8_BAR; PG8_WAIT_L(0); PG8_MMA(0, 0, At, B0); PG8_BAR; PG8_SCHED;
            PG8_LDB(B1, 1, 1); PG8_STAGE(PG8_SB(1, 0), b3, voffB);
            PG8_BAR; PG8_WAIT_L(0); PG8_MMA(0, 1, At, B1); PG8_BAR;
            PG8_LDA(At, 1, 1); PG8_STAGE(PG8_SA(1, 0), a3, voffA);
            PG8_BAR; PG8_WAIT_L(0); PG8_MMA(1, 0, At, B0); PG8_BAR; PG8_SCHED;
            PG8_STAGE(PG8_SB(1, 1), b3 + hstep, voffB);
            PG8_WAIT_V(6); PG8_BAR; PG8_MMA(1, 1, At, B1); PG8_BAR;
            }
        }
        if constexpr (ALIGN_EPI) { if (wr == 0) PG8_BAR; }
        if constexpr (!Epi::AFTER_DRAIN) { E(acc, cur, wr, wc, fr, fq); S.done(cur); }
        if (!has_next) break;
#pragma unroll
        for (int a = 0; a < 2; ++a)
#pragma unroll
            for (int b = 0; b < 2; ++b)
#pragma unroll
                for (int m = 0; m < 4; ++m)
#pragma unroll
                    for (int n = 0; n < 2; ++n) acc[a][b][m][n] = (f32x4){0.f, 0.f, 0.f, 0.f};
        cur = nxt; cA = nA; cB = nB; ++ui;
        if constexpr (ALIGN_EPI) { if (wr == 1) PG8_BAR; }
    }
    PG8_WAIT_V(0);
    if constexpr (!ALIGN_EPI) { if (wr == 0) PG8_BAR; }
    PG8_BAR;
    if constexpr (Epi::AFTER_DRAIN) { E.fused(acc, cur, wr, wc, fr, fq, lds, wid, lane); S.done(cur); }
#undef PG8_SA
#undef PG8_SB
#undef PG8_STAGE
#undef PG8_LDA
#undef PG8_LDB
#undef PG8_MMA
#undef PG8_WAIT_V
#undef PG8_WAIT_L
#undef PG8_BAR
#undef PG8_SCHED
}
}
constexpr int NWAVES = 8;
constexpr int S = 8192, DM = 2048, NH = 16, HD = 128, FF = 8192, NBLK = 32, BLK = 256, DEPTH = 4;
constexpr int NQKV = 3 * DM;
constexpr int BIAS_LD = 8448;
constexpr int NPHASE = 30;
#ifndef DBG_MASK
#define DBG_MASK 0xffff
#endif
#define DBG(b) ((DBG_MASK >> (b)) & 1)
#ifndef MK_PER_PHASE
#define MK_PER_PHASE 0
#endif
constexpr size_t MiB = 1u << 20;
constexpr size_t WS_CTL = 0, CTL_ZERO_BYTES = 1 * MiB;
constexpr size_t WS_WQKV = 2 * MiB;
constexpr size_t WS_WO   = WS_WQKV + 48 * MiB;
constexpr size_t WS_WIN  = WS_WO + 16 * MiB;
constexpr size_t WS_WOUT = WS_WIN + 32 * MiB;
constexpr size_t WS_W1   = WS_WOUT + 16 * MiB;
constexpr size_t WS_W2   = WS_W1 + 128 * MiB;
constexpr size_t WS_X    = WS_W2 + 128 * MiB;
constexpr size_t WS_XB   = WS_X + 64 * MiB;
constexpr size_t WS_QKV  = WS_XB + 32 * MiB;
constexpr size_t WS_AO   = WS_QKV + 96 * MiB;
constexpr size_t WS_HID  = WS_AO + 32 * MiB;
constexpr size_t WS_SSQ  = WS_HID + 128 * MiB;
constexpr size_t WS_KMP  = WS_SSQ + 9 * MiB;
constexpr size_t WS_LSE  = WS_KMP + 1 * MiB;
constexpr size_t WS_LIST = WS_LSE + 2 * MiB;
constexpr size_t WS_BIAS = WS_LIST + 16 * MiB;
constexpr size_t WS_CARRY = WS_BIAS + 1 * MiB;
constexpr size_t WS_END  = WS_CARRY + 2 * MiB;
constexpr int CW_TMO = 0, CW_CODE = 1;
constexpr int CW_BAR = 4096;
constexpr int CW_CNT = 16384;
constexpr int RING_OFF = 0, RING_BYTES = 135168;
constexpr int LDSCTL_OFF = RING_BYTES, MISC_OFF = LDSCTL_OFF + 320;
constexpr int LDS_BYTES = 147456;
#define GAS __attribute__((address_space(1)))
#define LAS __attribute__((address_space(3)))
typedef unsigned short bf16;
typedef unsigned v4u __attribute__((ext_vector_type(4)));
typedef float f32x4 __attribute__((ext_vector_type(4)));
typedef short bf16x8 __attribute__((ext_vector_type(8)));
typedef GAS unsigned gu32;
typedef GAS unsigned long long gu64;
#define RLX_AGENT __ATOMIC_RELAXED, __HIP_MEMORY_SCOPE_AGENT
#define LDS_WAIT() asm volatile("s_waitcnt lgkmcnt(0)" ::: "memory")
#define VM_WAIT() asm volatile("s_waitcnt vmcnt(0)" ::: "memory")
__device__ __forceinline__ unsigned long long rt() { return __builtin_amdgcn_s_memrealtime(); }
__device__ __forceinline__ unsigned f2bf(float f) { unsigned u = __builtin_bit_cast(unsigned, f); return (u + 0x7fffu + ((u >> 16) & 1u)) >> 16; }
__device__ __forceinline__ unsigned pk2(float lo, float hi) { return f2bf(lo) | (f2bf(hi) << 16); }

#define XB_TMO      128
#define XB_XCNT(j)  (256  + 64 * (j))
#define XB_XSUB(j)  (1280 + 64 * (j))
#define XB_XGEN(j)  (2304 + 64 * (j))
#define XB_TOP      3328
#define XB_TOPGEN   3392
#define XCD_BAR_WORDS 3456
#define XB_SPIN_CAP (1u << 22)

__device__ __forceinline__ unsigned xb_ld(unsigned* p)              { return __hip_atomic_load(p, __ATOMIC_RELAXED, __HIP_MEMORY_SCOPE_AGENT); }
__device__ __forceinline__ unsigned xb_add(unsigned* p, unsigned v) { return __hip_atomic_fetch_add(p, v, __ATOMIC_RELAXED, __HIP_MEMORY_SCOPE_AGENT); }
__device__ __forceinline__ unsigned xb_xcc_id() { return (unsigned)__builtin_amdgcn_s_getreg((3 << 11) | 20) & 0xFu; }
#define XB_SPIN(cond, bar) do { unsigned _sp = 0; while (cond) { __builtin_amdgcn_s_sleep(1); \
    if ((++_sp & 255u) == 0u) { if (xb_ld(&(bar)[XB_TMO])) break; if (_sp > XB_SPIN_CAP) { atomicAdd(&(bar)[XB_TMO], 1u); break; } } } } while (0)

struct XcdBarrier {
    unsigned* bar; unsigned x;
    volatile LAS unsigned* st;
};

__device__ __forceinline__ XcdBarrier xcd_barrier_post(unsigned* bar, volatile LAS unsigned* st) {
    XcdBarrier b; b.bar = bar; b.x = xb_xcc_id(); b.st = st;
    if (threadIdx.x == 0) (void)xb_add(&bar[XB_XCNT(b.x)], 1u);
    return b;
}
__device__ __forceinline__ void xcd_barrier_complete(unsigned* bar, unsigned x, unsigned& nloc, unsigned& nx) {
    const unsigned G = gridDim.x * gridDim.y * gridDim.z;
    unsigned sum, cnt, mine, sp = 0u;
    for (;;) {
        sum = 0u; cnt = 0u; mine = 0u;
#pragma unroll
        for (unsigned j = 0; j < 16; ++j) { const unsigned c = xb_ld(&bar[XB_XCNT(j)]); sum += c; cnt += (c > 0u) ? 1u : 0u; mine = (j == x) ? c : mine; }
        if (sum == G) break;
        __builtin_amdgcn_s_sleep(1);
        if ((++sp & 255u) == 0u) { if (xb_ld(&bar[XB_TMO])) break; if (sp > XB_SPIN_CAP) { atomicAdd(&bar[XB_TMO], 1u); break; } }
    }
    nloc = mine > 0u ? mine : 1u; nx = cnt > 0u ? cnt : 1u;
}

__device__ __forceinline__ void xcd_barrier(const XcdBarrier& b) {
    asm volatile("s_waitcnt vmcnt(0)" ::: "memory");
    __syncthreads();
    if (threadIdx.x == 0) {
        unsigned* bar = b.bar;
        __builtin_amdgcn_s_waitcnt(0);
        unsigned nloc = b.st[0], nx = b.st[1];
        if (nloc == 0u) { xcd_barrier_complete(bar, b.x, nloc, nx); b.st[0] = nloc; b.st[1] = nx; }
        const unsigned old = xb_add(&bar[XB_XSUB(b.x)], 1u);
        const unsigned gen = old / nloc;
        if (old + 1u == (gen + 1u) * nloc) {
            __builtin_amdgcn_fence(__ATOMIC_RELEASE, "agent");
            asm volatile("s_waitcnt vmcnt(0)" ::: "memory");
            const unsigned og = xb_add(&bar[XB_TOP], 1u);
            const unsigned tg = og / nx;
            if (og + 1u == (tg + 1u) * nx) xb_add(&bar[XB_TOPGEN], 1u);
            else XB_SPIN(xb_ld(&bar[XB_TOPGEN]) == tg, bar);
            __builtin_amdgcn_fence(__ATOMIC_ACQUIRE, "agent");
            xb_add(&bar[XB_XGEN(b.x)], 1u);
            asm volatile("s_waitcnt vmcnt(0)" ::: "memory");
        } else {
            XB_SPIN(xb_ld(&bar[XB_XGEN(b.x)]) == gen, bar);
            __builtin_amdgcn_fence(__ATOMIC_ACQUIRE, "agent");
            asm volatile("s_waitcnt vmcnt(0)" ::: "memory");
        }
    }
    __syncthreads();
}
typedef unsigned short bf16;
typedef unsigned v4u __attribute__((ext_vector_type(4)));
typedef unsigned v2u __attribute__((ext_vector_type(2)));
typedef float f32x2 __attribute__((ext_vector_type(2)));
__device__ __forceinline__ float bf2f(unsigned short b) { return __builtin_bit_cast(float, (unsigned)b << 16); }
__device__ __forceinline__ float bflo(unsigned u) { return __builtin_bit_cast(float, u << 16); }
__device__ __forceinline__ float bfhi(unsigned u) { return __builtin_bit_cast(float, u & 0xffff0000u); }
__device__ __forceinline__ float wave_sum(float v) {
#pragma unroll
    for (int o = 1; o < 64; o <<= 1) v += __shfl_xor(v, o);
    return v;
}
__device__ __forceinline__ float wave_max(float v) {
#pragma unroll
    for (int o = 1; o < 64; o <<= 1) v = fmaxf(v, __shfl_xor(v, o));
    return v;
}
struct Args { const float* in[18]; float* out; unsigned char* ws; int ph_lo, ph_hi; };
struct Frame {
    LAS unsigned char* lds; unsigned char* ldsg;
    volatile LAS unsigned* MISC;
    gu32* ctl;
    int tid, lane, wave, G, bid;
    unsigned char* ws;
};
__device__ __forceinline__ void tr_item(const float* W, int K, int N, bf16* WT, const float* gain, LAS float* scr, int item, int lane) {
    const int nb = N >> 6, kb = item / nb, nbi = item - kb * nb, k0 = kb * 64, n0 = nbi * 64;
    f32x4 v[16];
#pragma unroll
    for (int i = 0; i < 16; ++i) v[i] = *(const f32x4*)(W + (size_t)(k0 + 4 * i + (lane >> 4)) * N + n0 + (lane & 15) * 4);
#pragma unroll
    for (int i = 0; i < 16; ++i) { LAS float* s = scr + (4 * i + (lane >> 4)) * 65 + (lane & 15) * 4; s[0] = v[i][0]; s[1] = v[i][1]; s[2] = v[i][2]; s[3] = v[i][3]; }
    LDS_WAIT(); asm volatile("" ::: "memory");
    const int c = lane & 7;
    float g[8];
#pragma unroll
    for (int i = 0; i < 8; ++i) g[i] = gain ? gain[k0 + 8 * c + i] : 1.0f;
#pragma unroll
    for (int j = 0; j < 8; ++j) { const int n = (lane >> 3) + 8 * j; const LAS float* s = scr + (8 * c) * 65 + n;
        v4u o; o.x = pk2(s[0 * 65] * g[0], s[1 * 65] * g[1]); o.y = pk2(s[2 * 65] * g[2], s[3 * 65] * g[3]); o.z = pk2(s[4 * 65] * g[4], s[5 * 65] * g[5]); o.w = pk2(s[6 * 65] * g[6], s[7 * 65] * g[7]);
        *(GAS v4u*)(WT + (size_t)(n0 + n) * K + k0 + 8 * c) = o; }
    LDS_WAIT(); asm volatile("" ::: "memory");
}
__device__ __forceinline__ int t5_bucket(int d) {
    if (d < 16) return d;
    const unsigned d2 = (unsigned)d * (unsigned)d; const int msb = 31 - __builtin_clz(d2);
    const int b = 16 + msb - 8; return b > 31 ? 31 : b;
}
__device__ __forceinline__ void p0_prologue(const Args& A, Frame& F) {
    int tid = threadIdx.x; asm volatile("" : "+v"(tid)); const int lane = tid & 63, wave = __builtin_amdgcn_readfirstlane(tid >> 6); (void)lane; (void)wave;
    LAS float* scr = (LAS float*)(F.lds + RING_OFF + wave * 16640);
    const int gw = F.bid * NWAVES + wave, NGW = F.G * NWAVES;
    const float* mixn = A.in[2]; const float* mlpn = A.in[3];
    constexpr int T_QKV = 32 * 96, T_O = 32 * 32, T_IN = 32 * 64, T_1 = 32 * 128, T_2 = 128 * 32;
    constexpr int T_MIX = T_QKV + T_O + T_IN + T_O;
    constexpr int NITEMS = 2 * T_MIX + 4 * (T_1 + T_2);
    for (int it = gw; it < NITEMS; it += NGW) {
        int r = it;
        if (r < 2 * T_MIX) { const int j = r / T_MIX; r -= j * T_MIX;
            if (r < T_QKV) { tr_item(A.in[5] + (size_t)j * DM * NQKV, DM, NQKV, (bf16*)(F.ws + WS_WQKV) + (size_t)j * NQKV * DM, mixn + (2 * j) * DM, scr, r, lane); continue; } r -= T_QKV;
            if (r < T_O)   { tr_item(A.in[6] + (size_t)j * DM * DM, DM, DM, (bf16*)(F.ws + WS_WO) + (size_t)j * DM * DM, nullptr, scr, r, lane); continue; } r -= T_O;
            if (r < T_IN)  { tr_item(A.in[7] + (size_t)j * DM * 2 * DM, DM, 2 * DM, (bf16*)(F.ws + WS_WIN) + (size_t)j * 2 * DM * DM, mixn + (2 * j + 1) * DM, scr, r, lane); continue; } r -= T_IN;
            tr_item(A.in[15] + (size_t)j * DM * DM, DM, DM, (bf16*)(F.ws + WS_WOUT) + (size_t)j * DM * DM, nullptr, scr, r, lane); continue; }
        r -= 2 * T_MIX;
        { const int l = r / (T_1 + T_2); r -= l * (T_1 + T_2);
            if (r < T_1) { tr_item(A.in[16] + (size_t)l * DM * FF, DM, FF, (bf16*)(F.ws + WS_W1) + (size_t)l * FF * DM, mlpn + l * DM, scr, r, lane); continue; } r -= T_1;
            tr_item(A.in[17] + (size_t)l * FF * DM, FF, DM, (bf16*)(F.ws + WS_W2) + (size_t)l * DM * FF, nullptr, scr, r, lane); }
    }
    { const float* x = A.in[0]; float* X = (float*)(F.ws + WS_X); bf16* XB = (bf16*)(F.ws + WS_XB); float* ssq = (float*)(F.ws + WS_SSQ);
      for (int m = gw; m < S; m += NGW) { const GAS f32x4* xr = (const GAS f32x4*)(x + (size_t)m * DM) + lane; GAS f32x4* xo = (GAS f32x4*)(X + (size_t)m * DM) + lane;
          GAS v2u* xb = (GAS v2u*)(XB + (size_t)m * DM) + lane; float s = 0.f;
#pragma unroll
          for (int j = 0; j < 8; ++j) { const f32x4 v = xr[64 * j]; xo[64 * j] = v; s += (v.x * v.x + v.y * v.y) + (v.z * v.z + v.w * v.w); v2u o; o.x = pk2(v.x, v.y); o.y = pk2(v.z, v.w); xb[64 * j] = o; }
          s = wave_sum(s) * (1.0f / 32.0f);
          if (lane < 32) ssq[(size_t)m * 32 + lane] = s; } }
    { const float* rb = A.in[1]; float* bt = (float*)(F.ws + WS_BIAS);
      for (int i = F.bid * (NWAVES * 64) + tid; i < NH * BIAS_LD; i += F.G * NWAVES * 64) { const int h = i / BIAS_LD, d = i - h * BIAS_LD - 256;
          bt[i] = d < 0 ? -INFINITY : rb[t5_bucket(d) * NH + h] * 1.4426950408889634f; } }
}
#define TOP3_INS(x_, j_) do { const float x__ = (x_); const int j__ = (j_); const bool b0 = x__ > v0, b1 = x__ > v1, b2 = x__ > v2; \
    v2 = b1 ? v1 : (b2 ? x__ : v2); i2 = b1 ? i1 : (b2 ? j__ : i2); v1 = b0 ? v0 : (b1 ? x__ : v1); i1 = b0 ? i0 : (b1 ? j__ : i1); v0 = b0 ? x__ : v0; i0 = b0 ? j__ : i0; } while (0)
__device__ __forceinline__ void phase_gate(const Args& A, Frame& F, int ja) {
    int tid = threadIdx.x; asm volatile("" : "+v"(tid)); const int lane = tid & 63, wave = __builtin_amdgcn_readfirstlane(tid >> 6); (void)lane; (void)wave;
    const bf16* QKV = (const bf16*)(F.ws + WS_QKV); const float* KMP = (const float*)(F.ws + WS_KMP);
    unsigned* cnt = (unsigned*)(F.ctl + CW_CNT + ja * 512); unsigned* list = (unsigned*)(F.ws + WS_LIST); float* LSE = (float*)(F.ws + WS_LSE);
    LAS float* km = (LAS float*)(F.lds + RING_OFF);
    LAS float* cv = km + 32 * 128;
    LAS int* ci = (LAS int*)(cv + 256 * 3);
    for (int item = F.bid; item < 512; item += F.G) {
        const int h = item & 15, c = item >> 4;
        for (int i = tid; i < 32 * 128; i += NWAVES * 64) { const int jb = i >> 7, d = i & 127;
            km[i] = (KMP[(size_t)jb * 2048 + h * 128 + d] + KMP[(size_t)(32 + jb) * 2048 + h * 128 + d]) * (1.0f / 256.0f); }
        __syncthreads();
        const int t = tid & 255, half = tid >> 8, q = c * 256 + t;
        float g[16];
#pragma unroll
        for (int jb = 0; jb < 16; ++jb) g[jb] = 0.f;
        const bf16* qp = QKV + (size_t)q * NQKV + h * HD;
        const LAS float* kmh = km + half * 16 * 128;
#pragma unroll 1
        for (int d0 = 0; d0 < 128; d0 += 8) {
            const v4u qv = *(const v4u*)(qp + d0);
            const float q0 = bflo(qv.x), q1 = bfhi(qv.x), q2 = bflo(qv.y), q3 = bfhi(qv.y), q4 = bflo(qv.z), q5 = bfhi(qv.z), q6 = bflo(qv.w), q7 = bfhi(qv.w);
#pragma unroll
            for (int jb = 0; jb < 16; ++jb) { const f32x4 k0 = *(const LAS f32x4*)(kmh + jb * 128 + d0), k1 = *(const LAS f32x4*)(kmh + jb * 128 + d0 + 4);
                g[jb] += (q0 * k0[0] + q1 * k0[1]) + (q2 * k0[2] + q3 * k0[3]) + (q4 * k1[0] + q5 * k1[1]) + (q6 * k1[2] + q7 * k1[3]);
                if ((jb & 3) == 3) __builtin_amdgcn_sched_barrier(0); }
        }
        float v0 = -INFINITY, v1 = -INFINITY, v2 = -INFINITY; int i0 = -1, i1 = -1, i2 = -1;
#pragma unroll
        for (int jb = 0; jb < 16; ++jb) { const int j = half * 16 + jb; if (j < c) TOP3_INS(g[jb], j); }
        if (half == 1) { cv[t * 3 + 0] = v0; cv[t * 3 + 1] = v1; cv[t * 3 + 2] = v2; ci[t * 3 + 0] = i0; ci[t * 3 + 1] = i1; ci[t * 3 + 2] = i2; }
        __syncthreads();
        if (half == 0) {
            { const int j = ci[t * 3 + 0]; if (j >= 0) TOP3_INS(cv[t * 3 + 0], j); }
            { const int j = ci[t * 3 + 1]; if (j >= 0) TOP3_INS(cv[t * 3 + 1], j); }
            { const int j = ci[t * 3 + 2]; if (j >= 0) TOP3_INS(cv[t * 3 + 2], j); }
#define EMIT_PICK(k_, sj_) do { if ((sj_) >= 0) { const unsigned pos = atomicAdd(&cnt[h * 32 + (sj_)], 1u); list[(size_t)(h * 32 + (sj_)) * 8192 + pos] = ((unsigned)q << 2) | (unsigned)(k_); } \
                else LSE[((size_t)q * NH + h) * 4 + (k_)] = -INFINITY; } while (0)
            EMIT_PICK(0, i0); EMIT_PICK(1, i1); EMIT_PICK(2, i2);
#undef EMIT_PICK
        }
        __syncthreads();
    }
}
__device__ __forceinline__ void attn_entry(const Args& A, Frame& F, int q, int h, int jb, int slot) {
    int tid = threadIdx.x; asm volatile("" : "+v"(tid)); const int lane = tid & 63, wave = __builtin_amdgcn_readfirstlane(tid >> 6); (void)lane; (void)wave;
    const bf16* QKV = (const bf16*)(F.ws + WS_QKV); const int l = lane;
    const bf16* qp = QKV + (size_t)q * NQKV + h * HD;
    const bf16* Kb = QKV + (size_t)(jb * BLK) * NQKV + DM + h * HD; const bf16* Vb = Kb + DM;
    float s[4] = {0.f, 0.f, 0.f, 0.f};
    for (int d0 = 0; d0 < 128; d0 += 8) {
        const v4u qv = *(const v4u*)(qp + d0);
        const float q0 = bflo(qv.x), q1 = bfhi(qv.x), q2 = bflo(qv.y), q3 = bfhi(qv.y), q4 = bflo(qv.z), q5 = bfhi(qv.z), q6 = bflo(qv.w), q7 = bfhi(qv.w);
#pragma unroll
        for (int kk = 0; kk < 4; ++kk) { const v4u kv = *(const v4u*)(Kb + (size_t)(l + 64 * kk) * NQKV + d0);
            s[kk] += (q0 * bflo(kv.x) + q1 * bfhi(kv.x)) + (q2 * bflo(kv.y) + q3 * bfhi(kv.y)) + (q4 * bflo(kv.z) + q5 * bfhi(kv.z)) + (q6 * bflo(kv.w) + q7 * bfhi(kv.w)); }
    }
    const float C = 0.088388347648318440f * 1.4426950408889634f;
    const float* bt = (const float*)(F.ws + WS_BIAS) + h * BIAS_LD + 256;
    float t[4], m = -INFINITY;
#pragma unroll
    for (int kk = 0; kk < 4; ++kk) { const int d = q - (jb * BLK + l + 64 * kk); t[kk] = s[kk] * C + bt[d]; m = fmaxf(m, t[kk]); }
    m = wave_max(m);
    float p[4], ls = 0.f;
#pragma unroll
    for (int kk = 0; kk < 4; ++kk) { p[kk] = __builtin_amdgcn_exp2f(t[kk] - m); ls += p[kk]; }
    ls = wave_sum(ls);
    const int c0 = 64 * (l >> 5) + (l & 31);
    float o0 = 0.f, o1 = 0.f;
#pragma unroll
    for (int kk = 0; kk < 4; ++kk)
        for (int src = 0; src < 64; ++src) { const float pk = __shfl(p[kk], src); const bf16* vr = Vb + (size_t)(src + 64 * kk) * NQKV;
            o0 += pk * bf2f(vr[c0]); o1 += pk * bf2f(vr[c0 + 32]); }
    const float inv = 1.0f / ls;
    unsigned* PART = (unsigned*)(F.ws + WS_HID); float* LSE = (float*)(F.ws + WS_LSE);
    const size_t e = ((size_t)q * NH + h) * 4 + slot;
    PART[e * 64 + l] = pk2(o0 * inv, o1 * inv);
    if (l == 0) LSE[e] = m + __builtin_amdgcn_logf(ls);
}
__device__ __forceinline__ void phase_attn(const Args& A, Frame& F, int ja) {
    int tid = threadIdx.x; asm volatile("" : "+v"(tid)); const int lane = tid & 63, wave = __builtin_amdgcn_readfirstlane(tid >> 6); (void)lane; (void)wave;
    const unsigned* cnt = (const unsigned*)(F.ctl + CW_CNT + ja * 512); const unsigned* list = (const unsigned*)(F.ws + WS_LIST);
    LAS unsigned* pre = (LAS unsigned*)(F.lds + RING_OFF);
    LAS unsigned* cl = pre + 520;
    for (int i = tid; i < 512; i += NWAVES * 64) cl[i] = __hip_atomic_load(cnt + i, RLX_AGENT);
    __syncthreads();
    if (tid == 0) { unsigned a = 0; for (int i = 0; i < 512; ++i) { pre[i] = a; a += (cl[i] + 7u) >> 3; } pre[512] = a; }
    __syncthreads();
    const int total = (int)pre[512];
    for (int tile = F.bid; tile < total + S * NH / 8; tile += F.G) {
        if (tile < total) {
            int lo = 0, hi = 512;
            while (hi - lo > 1) { const int mid = (lo + hi) >> 1; if ((int)pre[mid] <= tile) lo = mid; else hi = mid; }
            const int e = (tile - (int)pre[lo]) * 8 + wave;
            if (e < (int)cl[lo]) { const unsigned ent = list[(size_t)lo * 8192 + e]; attn_entry(A, F, (int)(ent >> 2), lo >> 5, lo & 31, (int)(ent & 3u)); }
        } else { const int e = (tile - total) * 8 + wave; const int q = e >> 4, h = e & 15; attn_entry(A, F, q, h, q >> 8, 3); }
    }
}
__device__ __forceinline__ void phase_combine(const Args& A, Frame& F) {
    int tid = threadIdx.x; asm volatile("" : "+v"(tid)); const int lane = tid & 63, wave = __builtin_amdgcn_readfirstlane(tid >> 6); (void)lane; (void)wave;
    const unsigned* PART = (const unsigned*)(F.ws + WS_HID); const float* LSE = (const float*)(F.ws + WS_LSE); bf16* AO = (bf16*)(F.ws + WS_AO);
    const int gw = F.bid * NWAVES + wave, NGW = F.G * NWAVES, l = lane;
    for (int e = gw; e < S * NH; e += NGW) {
        const f32x4 ls = *(const f32x4*)(LSE + (size_t)e * 4);
        const float M = fmaxf(fmaxf(ls[0], ls[1]), fmaxf(ls[2], ls[3]));
        float o0 = 0.f, o1 = 0.f, W = 0.f;
#pragma unroll
        for (int k = 0; k < 4; ++k) { const float w = __builtin_amdgcn_exp2f(ls[k] - M);
            if (w > 0.f) { const unsigned u = PART[((size_t)e * 4 + k) * 64 + l]; o0 += w * bflo(u); o1 += w * bfhi(u); W += w; } }
        const float inv = 1.0f / W; const int q = e >> 4, h = e & 15, c0 = 64 * (l >> 5) + (l & 31);
        bf16* op = AO + (size_t)q * DM + h * HD;
        op[c0] = (bf16)f2bf(o0 * inv); op[c0 + 32] = (bf16)f2bf(o1 * inv);
    }
}
__device__ __forceinline__ float sigmoidf_(float x) { return 1.0f / (1.0f + __expf(-x)); }
__device__ __forceinline__ void phase_rec_ab(const Args& A, Frame& F, int jr) {
    int tid = threadIdx.x; asm volatile("" : "+v"(tid)); const int lane = tid & 63, wave = __builtin_amdgcn_readfirstlane(tid >> 6); (void)lane; (void)wave;
    const bf16* XR = (const bf16*)(F.ws + WS_QKV);
    const float* cw = A.in[8] + (size_t)jr * 4 * DM; const float* cb = A.in[9] + (size_t)jr * DM;
    const float* wrg = A.in[10] + (size_t)jr * 16 * 128 * 128; const float* brg = A.in[11] + (size_t)jr * DM;
    const float* wig = A.in[12] + (size_t)jr * 16 * 128 * 128; const float* big = A.in[13] + (size_t)jr * DM; const float* lam = A.in[14] + (size_t)jr * DM;
    float* SA = (float*)(F.ws + WS_HID); float* SB = SA + (size_t)S * DM;
    LAS float* xc = (LAS float*)(F.lds + RING_OFF);
    for (int item = F.bid; item < 256 * 16; item += F.G) {
        const int tt = item >> 4, n = item & 15;
        for (int i = tid; i < 4096; i += NWAVES * 64) { const int r = i >> 7, cc = i & 127, t = tt * 32 + r, c = n * 128 + cc;
            float a = cb[c];
#pragma unroll
            for (int jj = 0; jj < 4; ++jj) { const int ts = t - 3 + jj; if (ts >= 0) a += bf2f(XR[(size_t)ts * DM + c]) * cw[jj * DM + c]; }
            xc[i] = a; }
        __syncthreads();
        const int cc = tid & 127, rg = tid >> 7, c = n * 128 + cc;
        float ar[8], ai[8];
#pragma unroll
        for (int i = 0; i < 8; ++i) { ar[i] = 0.f; ai[i] = 0.f; }
        const float* wr_ = wrg + (size_t)n * 128 * 128 + cc; const float* wi_ = wig + (size_t)n * 128 * 128 + cc;
        for (int k = 0; k < 128; ++k) { const float a = wr_[k * 128], b = wi_[k * 128];
#pragma unroll
            for (int i = 0; i < 8; ++i) { const float x = xc[(rg + 4 * i) * 128 + k]; ar[i] += x * a; ai[i] += x * b; } }
        const float lm = lam[c]; const float lsg = (fminf(lm, 0.f) - log1pf(__expf(-fabsf(lm)))) * 8.0f;
        const float b_r = brg[c], b_i = big[c];
#pragma unroll
        for (int i = 0; i < 8; ++i) { const int r = rg + 4 * i; const size_t o = (size_t)(tt * 32 + r) * DM + c;
            const float rr = sigmoidf_(ar[i] + b_r), ii = sigmoidf_(ai[i] + b_i), la = rr * lsg;
            SA[o] = __expf(la); SB[o] = sqrtf(-expm1f(2.0f * la)) * (ii * xc[r * 128 + cc]); }
        __syncthreads();
    }
}
__device__ __forceinline__ void phase_rec_tot(const Args& A, Frame& F) {
    int tid = threadIdx.x; asm volatile("" : "+v"(tid)); const int lane = tid & 63, wave = __builtin_amdgcn_readfirstlane(tid >> 6); (void)lane; (void)wave;
    const float* SA = (const float*)(F.ws + WS_HID); const float* SB = SA + (size_t)S * DM; float* CA = (float*)(F.ws + WS_CARRY); float* CH = CA + 128 * DM;
    for (int i = F.bid * (NWAVES * 64) + tid; i < 128 * 1024; i += F.G * NWAVES * 64) { const int ch = i >> 10, c = (i & 1023) * 2;
        f32x2 A = (f32x2){1.f, 1.f}, H = (f32x2){0.f, 0.f};
#pragma unroll 8
        for (int r = 0; r < 64; ++r) { const size_t o = (size_t)(ch * 64 + r) * DM + c; const f32x2 a = *(const f32x2*)(SA + o), b = *(const f32x2*)(SB + o); H = a * H + b; A = A * a; }
        *(f32x2*)(CA + ch * DM + c) = A; *(f32x2*)(CH + ch * DM + c) = H; }
}
__device__ __forceinline__ void phase_rec_scan(const Args& A, Frame& F) {
    int tid = threadIdx.x; asm volatile("" : "+v"(tid)); const int lane = tid & 63, wave = __builtin_amdgcn_readfirstlane(tid >> 6); (void)lane; (void)wave;
    const float* SA = (const float*)(F.ws + WS_HID); const float* SB = SA + (size_t)S * DM; const float* CA = (const float*)(F.ws + WS_CARRY); const float* CH = CA + 128 * DM;
    const bf16* GG = (const bf16*)(F.ws + WS_QKV + 32 * MiB); bf16* AO = (bf16*)(F.ws + WS_AO);
    for (int i = F.bid * (NWAVES * 64) + tid; i < 128 * 1024; i += F.G * NWAVES * 64) { const int ch = i >> 10, c = (i & 1023) * 2;
        f32x2 H = (f32x2){0.f, 0.f};
#pragma unroll 4
        for (int k = 0; k < ch; ++k) { const f32x2 a = *(const f32x2*)(CA + k * DM + c), b = *(const f32x2*)(CH + k * DM + c); H = a * H + b; }
#pragma unroll 8
        for (int r = 0; r < 64; ++r) { const size_t o = (size_t)(ch * 64 + r) * DM + c; const f32x2 a = *(const f32x2*)(SA + o), b = *(const f32x2*)(SB + o); H = a * H + b;
            const unsigned g = *(const unsigned*)(GG + o); *(unsigned*)(AO + o) = pk2(H.x * bflo(g), H.y * bfhi(g)); } }
}
__device__ __forceinline__ void phase_final(const Args& A, Frame& F) {
    int tid = threadIdx.x; asm volatile("" : "+v"(tid)); const int lane = tid & 63, wave = __builtin_amdgcn_readfirstlane(tid >> 6); (void)lane; (void)wave;
    const float* X = (const float*)(F.ws + WS_X); const float* ssq = (const float*)(F.ws + WS_SSQ) + (size_t)8 * S * 32; const float* gf = A.in[4];
    const int gw = F.bid * NWAVES + wave, NGW = F.G * NWAVES;
    for (int m = gw; m < S; m += NGW) { float s = lane < 32 ? ssq[(size_t)m * 32 + lane] : 0.f; s = wave_sum(s);
        const float rstd = 1.0f / sqrtf(s * (1.0f / 2048.0f) + 1e-6f);
        const GAS f32x4* xr = (const GAS f32x4*)(X + (size_t)m * DM) + lane; const GAS f32x4* gr = (const GAS f32x4*)gf + lane; GAS f32x4* o = (GAS f32x4*)(A.out + (size_t)m * DM) + lane;
#pragma unroll
        for (int j = 0; j < 8; ++j) o[64 * j] = xr[64 * j] * rstd * gr[64 * j]; }
}
__global__ void __launch_bounds__(NWAVES * 64, 2) mega_fwd(Args A) {
    extern __shared__ __attribute__((aligned(16))) unsigned char lds[];
    Frame F;
    F.lds = (LAS unsigned char*)lds; F.ldsg = lds;
    F.MISC = (volatile LAS unsigned*)(F.lds + MISC_OFF);
    F.tid = threadIdx.x; F.lane = F.tid & 63; F.wave = __builtin_amdgcn_readfirstlane(F.tid >> 6);
    F.G = gridDim.x; F.bid = blockIdx.x;
    F.ws = A.ws; F.ctl = (gu32*)(A.ws + WS_CTL);
    for (int u = F.tid; u < (LDS_BYTES - LDSCTL_OFF) / 4; u += NWAVES * 64) ((LAS unsigned*)(F.lds + LDSCTL_OFF))[u] = 0u;
    __syncthreads();
    XcdBarrier bar; bar.bar = (unsigned*)(F.ctl + CW_BAR); bar.x = 0; bar.st = nullptr;
    if (!MK_PER_PHASE) bar = xcd_barrier_post((unsigned*)(F.ctl + CW_BAR), F.MISC + 8);
    const int lo = A.ph_lo, hi = A.ph_hi;
#define IN(k) (lo <= (k) && (k) < hi)
#define SEAM(k) do { if (IN(k) && IN((k) + 1)) xcd_barrier(bar); } while (0)

    if (IN(0) && DBG(0)) { p0_prologue(A, F); } SEAM(0);
    for (int ls = 0; ls < 2 * DEPTH; ++ls) {
        const int l = ls >> 1, st = ls & 1, jm = l >> 1, rec = l & 1;
        const int p1 = 1 + 7 * l + (st ? 5 : 0), p2 = p1 + (st ? 1 : 4);
        if (IN(p1) && DBG(1)) {
            const bf16* Bt; int N, mode; bf16* O; int ldc;
            if (st) { Bt = (const bf16*)(F.ws + WS_W1) + (size_t)l * FF * DM; N = FF; mode = 2; O = (bf16*)(F.ws + WS_HID); ldc = FF; }
            else if (rec) { Bt = (const bf16*)(F.ws + WS_WIN) + (size_t)jm * 2 * DM * DM; N = 2 * DM; mode = 1; O = (bf16*)(F.ws + WS_QKV); ldc = DM; }
            else { Bt = (const bf16*)(F.ws + WS_WQKV) + (size_t)jm * NQKV * DM; N = NQKV; mode = 0; O = (bf16*)(F.ws + WS_QKV); ldc = NQKV; }
            pg8::Gemm g{(const bf16*)(F.ws + WS_XB), Bt, S, N, DM}; pg8::StaticOrder So; So.init(S, N, F.G, F.bid);
            pg8::EpiScale E{O, ldc, (const float*)(F.ws + WS_SSQ) + (size_t)ls * S * 32, (float*)(F.ws + WS_KMP), (bf16*)(F.ws + WS_QKV + 32 * MiB), mode};
            pg8::gemm_phase<pg8::EpiScale, pg8::StaticOrder, true, true>(F.lds + RING_OFF, g, So, E); }
        SEAM(p1);
        if (!st) {
            if (!rec) {
                if (IN(p1 + 1) && DBG(2)) phase_gate(A, F, jm);
                SEAM(p1 + 1);
                if (IN(p1 + 2) && DBG(3)) phase_attn(A, F, jm);
                SEAM(p1 + 2);
                if (IN(p1 + 3) && DBG(4)) phase_combine(A, F);
                SEAM(p1 + 3);
            } else {
                if (IN(p1 + 1) && DBG(6)) phase_rec_ab(A, F, jm);
                SEAM(p1 + 1);
                if (IN(p1 + 2) && DBG(7)) phase_rec_tot(A, F);
                SEAM(p1 + 2);
                if (IN(p1 + 3) && DBG(8)) phase_rec_scan(A, F);
                SEAM(p1 + 3);
            }
        }
        if (IN(p2) && DBG(9)) {
            const bf16* Ap; const bf16* Bt; int K;
            if (st) { Ap = (const bf16*)(F.ws + WS_HID); Bt = (const bf16*)(F.ws + WS_W2) + (size_t)l * DM * FF; K = FF; }
            else { Ap = (const bf16*)(F.ws + WS_AO); Bt = (const bf16*)(F.ws + (rec ? WS_WOUT : WS_WO)) + (size_t)jm * DM * DM; K = DM; }
            pg8::Gemm g{Ap, Bt, S, DM, K}; pg8::StaticOrder So; So.init(S, DM, F.G, F.bid);
            pg8::EpiRes E{(float*)(F.ws + WS_X), (bf16*)(F.ws + WS_XB), (float*)(F.ws + WS_SSQ) + (size_t)(ls + 1) * S * 32};
            pg8::gemm_phase<pg8::EpiRes, pg8::StaticOrder, true, true>(F.lds + RING_OFF, g, So, E); }
        SEAM(p2);
    }
    if (IN(NPHASE - 1) && DBG(12)) phase_final(A, F);
#undef IN
#undef SEAM
}

extern "C" void kernel_launch(void* const* d_in, const int* in_sizes, int n_in, void* d_out, int out_size, void* d_ws, size_t ws_size, hipStream_t stream) {
    static int grid = 0;
    if (grid == 0) {
        if (n_in != 18 || in_sizes[0] != S * DM || out_size != S * DM || ws_size < WS_END) { fprintf(stderr, "kernel_launch: shape mismatch n_in %d in0 %d out %d ws %zu (need %zu)\n", n_in, n_in > 0 ? in_sizes[0] : -1, out_size, ws_size, (size_t)WS_END); grid = -1; return; }
        int dev = 0, cus = 0, per_cu = 0;
        if (hipGetDevice(&dev) != hipSuccess || hipDeviceGetAttribute(&cus, hipDeviceAttributeMultiprocessorCount, dev) != hipSuccess) { grid = -1; return; }
        if (hipFuncSetAttribute((const void*)mega_fwd, hipFuncAttributeMaxDynamicSharedMemorySize, LDS_BYTES) != hipSuccess) { fprintf(stderr, "kernel_launch: hipFuncSetAttribute failed\n"); grid = -1; return; }
        if (hipOccupancyMaxActiveBlocksPerMultiprocessor(&per_cu, (const void*)mega_fwd, NWAVES * 64, LDS_BYTES) != hipSuccess || per_cu < 1) fprintf(stderr, "kernel_launch: occupancy query says %d\n", per_cu);
        (void)hipGetLastError();
        grid = cus;
    }
    if (grid < 0) return;
    if (hipMemsetAsync((char*)d_ws + WS_CTL, 0, CTL_ZERO_BYTES, stream) != hipSuccess) { fprintf(stderr, "kernel_launch: memset failed\n"); return; }
    Args a{};
    for (int i = 0; i < 18; ++i) a.in[i] = (const float*)d_in[i];
    a.out = (float*)d_out; a.ws = (unsigned char*)d_ws;
#if MK_PER_PHASE
    for (int p = 0; p < NPHASE; ++p) { a.ph_lo = p; a.ph_hi = p + 1; hipLaunchKernelGGL(mega_fwd, dim3(grid), dim3(NWAVES * 64), LDS_BYTES, stream, a); }
#else
    a.ph_lo = 0; a.ph_hi = NPHASE; hipLaunchKernelGGL(mega_fwd, dim3(grid), dim3(NWAVES * 64), LDS_BYTES, stream, a);
#endif
    const hipError_t le = hipPeekAtLastError();
    if (le != hipSuccess) fprintf(stderr, "kernel_launch: launch failed: %s\n", hipGetErrorName(le));
}
```

```cpp
#include <hip/hip_runtime.h>
#include <cstdio>
#include <cstdint>
#include <cmath>
__device__ __forceinline__ int lane_id_v() { int l; asm volatile("v_mbcnt_lo_u32_b32 %0, -1, 0\n\tv_mbcnt_hi_u32_b32 %0, -1, %0" : "=v"(l)); return l; }
namespace pg8 {
#define PG8_LAS __attribute__((address_space(3)))
typedef unsigned short bf16_t;
typedef short bf16x8 __attribute__((ext_vector_type(8)));
typedef float f32x4 __attribute__((ext_vector_type(4)));
typedef unsigned u32x4 __attribute__((ext_vector_type(4)));
typedef int i32x4 __attribute__((ext_vector_type(4)));
template <bool I8> struct AccT { typedef f32x4 type; };
template <> struct AccT<true> { typedef i32x4 type; };
__device__ __forceinline__ f32x4 mma_op(bf16x8 a, bf16x8 b, f32x4 c) { return __builtin_amdgcn_mfma_f32_16x16x32_bf16(a, b, c, 0, 0, 0); }
__device__ __forceinline__ i32x4 mma_op(bf16x8 a, bf16x8 b, i32x4 c) { return __builtin_amdgcn_mfma_i32_16x16x64_i8(__builtin_bit_cast(i32x4, a), __builtin_bit_cast(i32x4, b), c, 0, 0, 0); }
constexpr int BM = 256, BK = 64, HALF = 128, HTB = HALF * BK * 2  , STAGE_BYTES = 8 * HTB, NXCD = 8, WGM = 8;

__host__ __device__ __forceinline__ int lds_byte(int r, int c) { const int st = (r >> 4) * 2 + (c >> 5), rr = r & 15, cc = c & 31, ob = rr * 64 + cc * 2; return st * 1024 + (ob ^ (((ob >> 9) & 1) << 5)); }
__host__ __device__ __forceinline__ void stage_rc(int b, int& R, int& C) { const int st = b / 1024, sb = b % 1024, swz = sb ^ (((sb >> 9) & 1) << 5); R = (st >> 1) * 16 + swz / 64; C = (st & 1) * 32 + (swz % 64) / 2; }
__host__ __device__ __forceinline__ int perm32(int rho) { const int n = rho >> 4, i = rho & 15; return 8 * (i >> 2) + 4 * n + (i & 3); }

struct Unit { int pm, pn, seq; };
struct Gemm { const bf16_t* A; const bf16_t* Bt; int M, N, K; int wave; };

struct StaticOrder {
    int nM, nN, nwg, G, c;
    __host__ __device__ void init(int M, int N, int G_, int c_) { nM = M / BM; nN = N / BM; nwg = nM * nN; G = G_; c = c_; }
    __host__ __device__ bool next(int i, Unit& u) const {
        const long L = (long)i * G + c; if (L >= nwg) return false;
        int wgid = (int)L; { const int q = nwg / NXCD, r = nwg % NXCD, xcd = wgid % NXCD, off = wgid / NXCD; wgid = (xcd < r ? xcd * (q + 1) : r * (q + 1) + (xcd - r) * q) + off; }
        const int nig = WGM * nN, gid = wgid / nig, fm = gid * WGM, gsz = (nM - fm) < WGM ? (nM - fm) : WGM;
        u.pm = fm + ((wgid % nig) % gsz); u.pn = (wgid % nig) / gsz; u.seq = i; return true;
    }
    __device__ __forceinline__ void a_ready(const Unit&) const {}
    __device__ __forceinline__ void done(const Unit&) const {}
};

__device__ __forceinline__ unsigned cvt_pk_bf16(float lo, float hi) { unsigned r; asm volatile("v_cvt_pk_bf16_f32 %0, %1, %2" : "=v"(r) : "v"(lo), "v"(hi)); return r; }
struct FrowOrder : StaticOrder {
    const float* frow; PG8_LAS unsigned char* tab;
    __device__ __forceinline__ void a_ready(const Unit& u) const {
        const int lane = lane_id_v();
        __builtin_amdgcn_global_load_lds((const unsigned*)(frow + (size_t)u.pm * BM + lane * 4), (PG8_LAS unsigned*)(tab + (u.seq & 1) * 1024), 16, 0, 0);
    }
};
constexpr float RMS_EPS = 1e-6f;
typedef float f32x2_ __attribute__((ext_vector_type(2)));
__device__ __forceinline__ float gelu_tanh(float x) {
    const float u = 0.7978845608028654f * (x + 0.044715f * x * x * x);
    const float e = __builtin_amdgcn_exp2f(-2.0f * 1.4426950408889634f * u);
    return x * __builtin_amdgcn_rcpf(1.0f + e);
}
template <bool I8>
struct EpiScaleT {
    static constexpr bool PERM = true, AFTER_DRAIN = false;
    bf16_t* O; int ldc; const PG8_LAS unsigned char* tab; float* kmp; bf16_t* O2; int mode; const float* scol; const float* hq;
    __device__ __forceinline__ void operator()(const typename AccT<I8>::type (&acc)[2][2][4][2], const Unit& u, int wr, int wc, int fr, int fq) const {
        const int row0 = u.pm * BM + wr * 64 + fr;
        f32x4 sc[2][2];
#pragma unroll
        for (int bj = 0; bj < 2; ++bj)
#pragma unroll
            for (int n = 0; n < 2; ++n) { if constexpr (I8) sc[bj][n] = *(const f32x4*)(scol + u.pn * BM + bj * HALF + wc * 32 + 8 * fq + 4 * n); else sc[bj][n] = (f32x4){1.f, 1.f, 1.f, 1.f}; }
        float rs[2][4];
#pragma unroll
        for (int ai = 0; ai < 2; ++ai)
#pragma unroll
            for (int m = 0; m < 4; ++m) rs[ai][m] = *(const PG8_LAS float*)(tab + (u.seq & 1) * 1024 + (wr * 64 + fr + ai * HALF + m * 16) * 4);
        int colt = u.pn * BM; bf16_t* base = O; int am = mode >= 2 ? 2 : 0; const float hqi = mode == 3 ? hq[0] : 0.f;
        if (mode == 1 && colt >= 2048) { colt -= 2048; base = O2; am = 1; }
        const int col0 = colt + wc * 32 + 8 * fq;
#pragma unroll
        for (int ai = 0; ai < 2; ++ai)
#pragma unroll
            for (int m = 0; m < 4; ++m) { bf16_t* rowp = base + (size_t)(row0 + ai * HALF + m * 16) * ldc + col0; const float r = rs[ai][m];
#pragma unroll
                for (int bj = 0; bj < 2; ++bj) { f32x4 v0 = __builtin_convertvector(acc[ai][bj][m][0], f32x4) * (sc[bj][0] * r), v1 = __builtin_convertvector(acc[ai][bj][m][1], f32x4) * (sc[bj][1] * r);
                    if (am == 1) {
#pragma unroll
                        for (int e = 0; e < 4; ++e) { v0[e] = gelu_tanh(v0[e]); v1[e] = gelu_tanh(v1[e]); } }
                    else if (am == 2) {
#pragma unroll
                        for (int e = 0; e < 4; ++e) { const float a0 = fmaxf(v0[e], 0.f), a1 = fmaxf(v1[e], 0.f); v0[e] = a0 * a0; v1[e] = a1 * a1; } }
                    u32x4 w; w.x = cvt_pk_bf16(v0[0], v0[1]); w.y = cvt_pk_bf16(v0[2], v0[3]); w.z = cvt_pk_bf16(v1[0], v1[1]); w.w = cvt_pk_bf16(v1[2], v1[3]);
                    if (mode == 3) {
                        int q[8];
#pragma unroll
                        for (int e = 0; e < 4; ++e) { q[e] = (int)__builtin_rintf(fminf(v0[e] * hqi, 254.0f)) - 127; q[4 + e] = (int)__builtin_rintf(fminf(v1[e] * hqi, 254.0f)) - 127; }
                        f32x2_ wq; wq.x = __builtin_bit_cast(float, ((unsigned)q[0] & 255u) | (((unsigned)q[1] & 255u) << 8) | (((unsigned)q[2] & 255u) << 16) | ((unsigned)q[3] << 24));
                        wq.y = __builtin_bit_cast(float, ((unsigned)q[4] & 255u) | (((unsigned)q[5] & 255u) << 8) | (((unsigned)q[6] & 255u) << 16) | ((unsigned)q[7] << 24));
                        *(f32x2_*)((unsigned char*)O + (size_t)(row0 + ai * HALF + m * 16) * 8192 + col0 + bj * HALF) = wq; }
                    else if (am == 2) __builtin_nontemporal_store(w, (u32x4*)(rowp + bj * HALF)); else *(u32x4*)(rowp + bj * HALF) = w; } }
        if (mode == 0 && u.pn >= 8 && u.pn < 16) {
            float* kp = kmp + ((size_t)wr * 32 + u.pm) * 2048 + (u.pn - 8) * BM + wc * 32 + 8 * fq;
#pragma unroll
            for (int bj = 0; bj < 2; ++bj)
#pragma unroll
                for (int n = 0; n < 2; ++n) { f32x4 s = (f32x4){0.f, 0.f, 0.f, 0.f};
#pragma unroll
                    for (int ai = 0; ai < 2; ++ai)
#pragma unroll
                        for (int m = 0; m < 4; ++m) s += __builtin_convertvector(acc[ai][bj][m][n], f32x4) * rs[ai][m];
                    s *= sc[bj][n];
#pragma unroll
                    for (int e = 0; e < 4; ++e) { float t = s[e]; t += __shfl_xor(t, 1); t += __shfl_xor(t, 2); t += __shfl_xor(t, 4); t += __shfl_xor(t, 8); s[e] = t; }
                    if (fr == 0) *(f32x4*)(kp + bj * HALF + 4 * n) = s; } }
    }
};
struct EpiRes {
    static constexpr bool PERM = true, AFTER_DRAIN = false;
    bf16_t* XB;
    __device__ __forceinline__ void operator()(const f32x4 (&acc)[2][2][4][2], const Unit& u, int wr, int wc, int fr, int fq) const {
        const int row0 = u.pm * BM + wr * 64 + fr, col0 = u.pn * BM + wc * 32 + 8 * fq;
        asm volatile("" ::: "memory"); __builtin_amdgcn_sched_barrier(0);
        u32x4 xin[2][4][2];
#pragma unroll
        for (int ai = 0; ai < 2; ++ai)
#pragma unroll
            for (int m = 0; m < 4; ++m)
#pragma unroll
                for (int bj = 0; bj < 2; ++bj) xin[ai][m][bj] = *(const u32x4*)(XB + (size_t)(row0 + ai * HALF + m * 16) * 2048 + col0 + bj * HALF);
        asm volatile("" ::: "memory"); __builtin_amdgcn_sched_barrier(0);
#pragma unroll
        for (int ai = 0; ai < 2; ++ai)
#pragma unroll
            for (int m = 0; m < 4; ++m) { const int r = row0 + ai * HALF + m * 16;
#pragma unroll
                for (int bj = 0; bj < 2; ++bj) { bf16_t* xp = XB + (size_t)r * 2048 + col0 + bj * HALF; const u32x4 xo = xin[ai][m][bj];
                    f32x4 x0, x1;
                    x0[0] = __builtin_bit_cast(float, xo.x << 16); x0[1] = __builtin_bit_cast(float, xo.x & 0xffff0000u); x0[2] = __builtin_bit_cast(float, xo.y << 16); x0[3] = __builtin_bit_cast(float, xo.y & 0xffff0000u);
                    x1[0] = __builtin_bit_cast(float, xo.z << 16); x1[1] = __builtin_bit_cast(float, xo.z & 0xffff0000u); x1[2] = __builtin_bit_cast(float, xo.w << 16); x1[3] = __builtin_bit_cast(float, xo.w & 0xffff0000u);
                    x0 += acc[ai][bj][m][0]; x1 += acc[ai][bj][m][1];
                    u32x4 w; w.x = cvt_pk_bf16(x0[0], x0[1]); w.y = cvt_pk_bf16(x0[2], x0[3]); w.z = cvt_pk_bf16(x1[0], x1[1]); w.w = cvt_pk_bf16(x1[2], x1[3]);
                    *(u32x4*)xp = w; } }
    }
};
struct EpiResQ8 {
    static constexpr bool PERM = true, AFTER_DRAIN = false;
    bf16_t* XB; const float* t2; const float* cs2; const float* hq;
    __device__ __forceinline__ void operator()(const i32x4 (&acc)[2][2][4][2], const Unit& u, int wr, int wc, int fr, int fq) const {
        const int row0 = u.pm * BM + wr * 64 + fr, col0 = u.pn * BM + wc * 32 + 8 * fq;
        const float step = hq[1];
        f32x4 sc[2][2], cc[2][2];
#pragma unroll
        for (int bj = 0; bj < 2; ++bj)
#pragma unroll
            for (int n = 0; n < 2; ++n) { sc[bj][n] = *(const f32x4*)(t2 + col0 + bj * HALF + 4 * n) * step; cc[bj][n] = *(const f32x4*)(cs2 + col0 + bj * HALF + 4 * n) * 127.0f; }
        asm volatile("" ::: "memory"); __builtin_amdgcn_sched_barrier(0);
#pragma unroll
        for (int ai = 0; ai < 2; ++ai) {
            u32x4 xin[4][2];
#pragma unroll
            for (int m = 0; m < 4; ++m)
#pragma unroll
                for (int bj = 0; bj < 2; ++bj) xin[m][bj] = *(const u32x4*)(XB + (size_t)(row0 + ai * HALF + m * 16) * 2048 + col0 + bj * HALF);
            asm volatile("" ::: "memory"); __builtin_amdgcn_sched_barrier(0);
#pragma unroll
            for (int m = 0; m < 4; ++m) { const int r = row0 + ai * HALF + m * 16;
#pragma unroll
                for (int bj = 0; bj < 2; ++bj) { bf16_t* xp = XB + (size_t)r * 2048 + col0 + bj * HALF; const u32x4 xo = xin[m][bj];
                    f32x4 x0, x1;
                    x0[0] = __builtin_bit_cast(float, xo.x << 16); x0[1] = __builtin_bit_cast(float, xo.x & 0xffff0000u); x0[2] = __builtin_bit_cast(float, xo.y << 16); x0[3] = __builtin_bit_cast(float, xo.y & 0xffff0000u);
                    x1[0] = __builtin_bit_cast(float, xo.z << 16); x1[1] = __builtin_bit_cast(float, xo.z & 0xffff0000u); x1[2] = __builtin_bit_cast(float, xo.w << 16); x1[3] = __builtin_bit_cast(float, xo.w & 0xffff0000u);
                    x0 += (__builtin_convertvector(acc[ai][bj][m][0], f32x4) + cc[bj][0]) * sc[bj][0]; x1 += (__builtin_convertvector(acc[ai][bj][m][1], f32x4) + cc[bj][1]) * sc[bj][1];
                    u32x4 w; w.x = cvt_pk_bf16(x0[0], x0[1]); w.y = cvt_pk_bf16(x0[2], x0[3]); w.z = cvt_pk_bf16(x1[0], x1[1]); w.w = cvt_pk_bf16(x1[2], x1[3]);
                    *(u32x4*)xp = w; } }
            asm volatile("" ::: "memory"); __builtin_amdgcn_sched_barrier(0); }
    }
};
template <class Epi, class Sched, bool ALIGN_EPI = false, bool SP2 = false, bool I8 = false>
__device__ __forceinline__ void gemm_phase(PG8_LAS unsigned char* lds, const Gemm g, const Sched& S, const Epi& E) {
    int tid_ = g.wave * 64 + lane_id_v(); asm volatile("" : "+v"(tid_));
    const int tid = tid_, wid = __builtin_amdgcn_readfirstlane(tid >> 6), lane = tid & 63, wr = wid >> 2, wc = wid & 3, fr = lane & 15, fq = lane >> 4;
    const int K = g.K, nt = K / BK;
    unsigned voffA[2], voffB[2];
#pragma unroll
    for (int i = 0; i < 2; ++i) { int R, C; stage_rc(tid * 16 + i * 8192, R, C); const int Rb = Epi::PERM ? ((R & ~31) + perm32(R & 31)) : R;
        voffA[i] = (unsigned)(R * K + C) * 2u; voffB[i] = (unsigned)(Rb * K + C) * 2u; }
    const size_t kstep = (size_t)(BK * 2);
    const size_t hstep = (size_t)HALF * K * 2;
    const size_t tstep = 2 * hstep;
    const unsigned ldsw = (unsigned)wid * 1024u;
    const int aoff = lds_byte(wr * 64 + fr, fq * 8), boff = lds_byte(wc * 32 + fr, fq * 8);
#define PG8_SA(b, h) (((b) * 2 + (h)) * HTB)
#define PG8_SB(b, h) ((4 + (b) * 2 + (h)) * HTB)
#define PG8_STAGE(bufoff, gbase, voff) do { _Pragma("unroll") for (int _i = 0; _i < 2; ++_i) \
        __builtin_amdgcn_global_load_lds((const unsigned*)((const char*)(gbase) + (voff)[_i]), (PG8_LAS unsigned*)(lds + (bufoff) + ldsw + _i * 8192), 16, 0, 0); } while (0)
#define PG8_LDA(dst, b, h) do { _Pragma("unroll") for (int m = 0; m < 4; ++m) _Pragma("unroll") for (int k = 0; k < 2; ++k) dst[m][k] = *(const PG8_LAS bf16x8*)(lds + PG8_SA(b, h) + aoff + m * 2048 + k * 1024); } while (0)
#define PG8_LDB(dst, b, h) do { _Pragma("unroll") for (int n = 0; n < 2; ++n) _Pragma("unroll") for (int k = 0; k < 2; ++k) dst[n][k] = *(const PG8_LAS bf16x8*)(lds + PG8_SB(b, h) + boff + n * 2048 + k * 1024); } while (0)
#define PG8_MMA(ai, bj, At, Bt) do { __builtin_amdgcn_s_setprio(1); _Pragma("unroll") for (int m = 0; m < 4; ++m) _Pragma("unroll") for (int n = 0; n < 2; ++n) _Pragma("unroll") for (int k = 0; k < 2; ++k) \
        acc[ai][bj][m][n] = mma_op(Bt[n][k], At[m][k], acc[ai][bj][m][n]); __builtin_amdgcn_s_setprio(0); } while (0)
#define PG8_WAIT_V(n) asm volatile("s_waitcnt vmcnt(" #n ")" ::: "memory")
#define PG8_WAIT_L(n) asm volatile("s_waitcnt lgkmcnt(" #n ")" ::: "memory")
#define PG8_BAR __builtin_amdgcn_s_barrier()
#define PG8_SCHED __builtin_amdgcn_sched_barrier(0)
    Unit cur, nxt; int ui = 0;
    if (!S.next(0, cur)) return;
    typedef typename AccT<I8>::type acc_t;
    acc_t acc[2][2][4][2];
#pragma unroll
    for (int a = 0; a < 2; ++a)
#pragma unroll
        for (int b = 0; b < 2; ++b)
#pragma unroll
            for (int m = 0; m < 4; ++m)
#pragma unroll
                for (int n = 0; n < 2; ++n) acc[a][b][m][n] = acc_t{};
    bf16x8 At[4][2], B0[2][2], B1[2][2];
    const char* cA = (const char*)g.A + (size_t)cur.pm * tstep; const char* cB = (const char*)g.Bt + (size_t)cur.pn * tstep;
    S.a_ready(cur);
    if constexpr (SP2) {
        PG8_STAGE(PG8_SB(0, 0), cB, voffB); PG8_STAGE(PG8_SB(0, 1), cB + hstep, voffB); PG8_STAGE(PG8_SA(0, 0), cA, voffA); PG8_STAGE(PG8_SA(0, 1), cA + hstep, voffA);
        if (wr == 1) PG8_BAR;
        PG8_WAIT_V(2); PG8_BAR;
        PG8_STAGE(PG8_SB(1, 0), cB + kstep, voffB); PG8_STAGE(PG8_SB(1, 1), cB + hstep + kstep, voffB);
        PG8_WAIT_V(4); PG8_BAR;
    } else {
        PG8_STAGE(PG8_SB(0, 0), cB, voffB); PG8_STAGE(PG8_SA(0, 0), cA, voffA); PG8_STAGE(PG8_SB(0, 1), cB + hstep, voffB); PG8_STAGE(PG8_SA(0, 1), cA + hstep, voffA);
        if (wr == 1) PG8_BAR;
        PG8_WAIT_V(4); PG8_BAR;
        PG8_STAGE(PG8_SB(1, 0), cB + kstep, voffB); PG8_STAGE(PG8_SA(1, 0), cA + kstep, voffA); PG8_STAGE(PG8_SB(1, 1), cB + hstep + kstep, voffB);
        PG8_WAIT_V(6); PG8_BAR;
    }
    for (;;) {
        const bool has_next = S.next(ui + 1, nxt);
        const char* nA = has_next ? (const char*)g.A + (size_t)nxt.pm * tstep : cA; const char* nB = has_next ? (const char*)g.Bt + (size_t)nxt.pn * tstep : cB;
        for (int t = 0; t < nt; t += 2) {
            const bool last = (t == nt - 2);
            const char* a1 = cA + (size_t)(t + 1) * kstep;
            const char* a2 = last ? nA : cA + (size_t)(t + 2) * kstep; const char* b2 = last ? nB : cB + (size_t)(t + 2) * kstep;
            const char* a3 = a2 + kstep; const char* b3 = b2 + kstep; (void)a3;
            if (last && has_next) S.a_ready(nxt);
            if constexpr (SP2) {
            PG8_LDB(B0, 0, 0); PG8_LDB(B1, 0, 1); PG8_SCHED; PG8_LDA(At, 0, 0); PG8_STAGE(PG8_SA(1, 0), a1, voffA); PG8_STAGE(PG8_SA(1, 1), a1 + hstep, voffA);
            PG8_WAIT_V(8); PG8_WAIT_L(0); PG8_BAR; PG8_MMA(0, 0, At, B0); PG8_MMA(0, 1, At, B1); PG8_BAR; PG8_SCHED;
            PG8_LDA(At, 0, 1); PG8_STAGE(PG8_SB(0, 0), b2, voffB); PG8_STAGE(PG8_SB(0, 1), b2 + hstep, voffB);
            PG8_WAIT_V(6); PG8_WAIT_L(0); PG8_BAR; PG8_MMA(1, 0, At, B0); PG8_MMA(1, 1, At, B1); PG8_BAR; PG8_SCHED;
            PG8_LDB(B0, 1, 0); PG8_LDB(B1, 1, 1); PG8_SCHED; PG8_LDA(At, 1, 0); PG8_STAGE(PG8_SA(0, 0), a2, voffA); PG8_STAGE(PG8_SA(0, 1), a2 + hstep, voffA);
            PG8_WAIT_V(8); PG8_WAIT_L(0); PG8_BAR; PG8_MMA(0, 0, At, B0); PG8_MMA(0, 1, At, B1); PG8_BAR; PG8_SCHED;
            PG8_LDA(At, 1, 1); PG8_STAGE(PG8_SB(1, 0), b3, voffB); PG8_STAGE(PG8_SB(1, 1), b3 + hstep, voffB);
            PG8_WAIT_V(6); PG8_WAIT_L(0); PG8_BAR; PG8_MMA(1, 0, At, B0); PG8_MMA(1, 1, At, B1); PG8_BAR; PG8_SCHED;
            } else {
            PG8_LDB(B0, 0, 0); PG8_SCHED; PG8_LDA(At, 0, 0); PG8_STAGE(PG8_SA(1, 1), a1 + hstep, voffA);
            PG8_WAIT_L(8); PG8_BAR; PG8_WAIT_L(0); PG8_MMA(0, 0, At, B0); PG8_BAR; PG8_SCHED;
            PG8_LDB(B1, 0, 1); PG8_STAGE(PG8_SB(0, 0), b2, voffB);
            PG8_BAR; PG8_WAIT_L(0); PG8_MMA(0, 1, At, B1); PG8_BAR;
            PG8_LDA(At, 0, 1); PG8_STAGE(PG8_SA(0, 0), a2, voffA);
            PG8_BAR; PG8_WAIT_L(0); PG8_MMA(1, 0, At, B0); PG8_BAR; PG8_SCHED;
            PG8_STAGE(PG8_SB(0, 1), b2 + hstep, voffB);
            PG8_WAIT_V(6); PG8_BAR; PG8_MMA(1, 1, At, B1); PG8_BAR;
            PG8_LDB(B0, 1, 0); PG8_SCHED; PG8_LDA(At, 1, 0); PG8_STAGE(PG8_SA(0, 1), a2 + hstep, voffA);
            PG8_WAIT_L(8); PG8_BAR; PG8_WAIT_L(0); PG8_MMA(0, 0, At, B0); PG8_BAR; PG8_SCHED;
            PG8_LDB(B1, 1, 1); PG8_STAGE(PG8_SB(1, 0), b3, voffB);
            PG8_BAR; PG8_WAIT_L(0); PG8_MMA(0, 1, At, B1); PG8_BAR;
            PG8_LDA(At, 1, 1); PG8_STAGE(PG8_SA(1, 0), a3, voffA);
            PG8_BAR; PG8_WAIT_L(0); PG8_MMA(1, 0, At, B0); PG8_BAR; PG8_SCHED;
            PG8_STAGE(PG8_SB(1, 1), b3 + hstep, voffB);
            PG8_WAIT_V(6); PG8_BAR; PG8_MMA(1, 1, At, B1); PG8_BAR;
            }
        }
        if constexpr (ALIGN_EPI) { if (wr == 0) PG8_BAR; }
        if constexpr (!Epi::AFTER_DRAIN) { E(acc, cur, wr, wc, fr, fq); S.done(cur); }
        if (!has_next) break;
#pragma unroll
        for (int a = 0; a < 2; ++a)
#pragma unroll
            for (int b = 0; b < 2; ++b)
#pragma unroll
                for (int m = 0; m < 4; ++m)
#pragma unroll
                    for (int n = 0; n < 2; ++n) acc[a][b][m][n] = acc_t{};
        cur = nxt; cA = nA; cB = nB; ++ui;
        if constexpr (ALIGN_EPI) { if (wr == 1) PG8_BAR; }
    }
    PG8_WAIT_V(0);
    if constexpr (!ALIGN_EPI) { if (wr == 0) PG8_BAR; }
    PG8_BAR;
    if constexpr (Epi::AFTER_DRAIN) { E.fused(acc, cur, wr, wc, fr, fq, lds, wid, lane); S.done(cur); }
#undef PG8_SA
#undef PG8_SB
#undef PG8_STAGE
#undef PG8_LDA
#undef PG8_LDB
#undef PG8_MMA
#undef PG8_WAIT_V
#undef PG8_WAIT_L
#undef PG8_BAR
#undef PG8_SCHED
}
}
constexpr int NWAVES = 8;
constexpr int S = 8192, DM = 2048, NH = 16, HD = 128, FF = 8192, NBLK = 32, BLK = 256, DEPTH = 4;
constexpr int NQKV = 3 * DM;
constexpr int BIAS_LD = 8448;
constexpr int NPHASE = 30;
#ifndef DBG_MASK
#define DBG_MASK 0xffff
#endif
#define DBG(b) ((DBG_MASK >> (b)) & 1)
#ifndef REP_MASK
#define REP_MASK 0
#endif
#define NREP(b) (((REP_MASK >> (b)) & 1) ? 2 : 1)
#ifndef MK_PER_PHASE
#define MK_PER_PHASE 0
#endif
constexpr size_t MiB = 1u << 20;
constexpr size_t WS_CTL = 0, CTL_ZERO_BYTES = 1 * MiB;
constexpr size_t WS_WQKV = 2 * MiB;
constexpr size_t WS_WO   = WS_WQKV + 48 * MiB;
constexpr size_t WS_WIN  = WS_WO + 16 * MiB;
constexpr size_t WS_WOUT = WS_WIN + 32 * MiB;
constexpr size_t WS_W1   = WS_WOUT + 16 * MiB;
constexpr size_t WS_W2   = WS_W1 + 128 * MiB;
constexpr size_t WS_X    = WS_W2 + 128 * MiB;
constexpr size_t WS_XQ   = WS_X;
constexpr size_t WS_FROW = WS_X + 16 * MiB;
constexpr size_t WS_RSTD = WS_FROW + 65536;
constexpr size_t WS_SW   = WS_X + 17 * MiB;
constexpr int SW_QKV = 0, SW_WIN = 2 * 6144, SW_W1 = SW_WIN + 2 * 4096;
constexpr int SW_T2 = 65536, SW_CS2 = SW_T2 + 4 * 2048, SW_SS = SW_CS2 + 4 * 2048, SW_CL = SW_SS + 4 * 8192;
#ifndef DQ_MASK
#define DQ_MASK 12
#endif
static_assert((DQ_MASK & 1) == 0 && DQ_MASK < 16, "layer 0's hidden step would be needed in the phase that computes the column norms");
constexpr size_t WS_W2Q_OFF = 64;
constexpr size_t WS_XB   = WS_X + 64 * MiB;
constexpr size_t WS_QKV  = WS_XB + 32 * MiB;
constexpr size_t WS_AO   = WS_QKV + 96 * MiB;
constexpr size_t WS_HID  = WS_AO + 32 * MiB;
constexpr size_t WS_SSQ  = WS_HID + 128 * MiB;
constexpr size_t WS_KMP  = WS_SSQ + 9 * MiB;
constexpr size_t WS_LSE  = WS_KMP + 1 * MiB;
constexpr size_t WS_LIST = WS_LSE + 2 * MiB;
constexpr size_t WS_BIAS = WS_LIST + 16 * MiB;
constexpr size_t WS_CARRY = WS_BIAS + 1 * MiB;
constexpr size_t WS_WG   = WS_CARRY + 2 * MiB;
constexpr size_t WS_END  = WS_WG + 2 * MiB;
constexpr int CW_TMO = 0, CW_CODE = 1;
constexpr int CW_BAR = 4096;
constexpr int CW_CNT = 16384;
constexpr int RING_OFF = 0, RING_BYTES = 155392;
constexpr int LDSCTL_OFF = RING_BYTES, MISC_OFF = LDSCTL_OFF + 320;
constexpr int LDS_BYTES = 157696;
#define GAS __attribute__((address_space(1)))
#define LAS __attribute__((address_space(3)))
typedef unsigned short bf16;
typedef unsigned v4u __attribute__((ext_vector_type(4)));
typedef float f32x4 __attribute__((ext_vector_type(4)));
typedef short bf16x8 __attribute__((ext_vector_type(8)));
typedef GAS unsigned gu32;
typedef GAS unsigned long long gu64;
#define RLX_AGENT __ATOMIC_RELAXED, __HIP_MEMORY_SCOPE_AGENT
#define LDS_WAIT() asm volatile("s_waitcnt lgkmcnt(0)" ::: "memory")
#define VM_WAIT() asm volatile("s_waitcnt vmcnt(0)" ::: "memory")
__device__ __forceinline__ unsigned long long rt() { return __builtin_amdgcn_s_memrealtime(); }
__device__ __forceinline__ unsigned f2bf(float f) { unsigned u = __builtin_bit_cast(unsigned, f); return (u + 0x7fffu + ((u >> 16) & 1u)) >> 16; }
__device__ __forceinline__ unsigned pk2(float lo, float hi) { return f2bf(lo) | (f2bf(hi) << 16); }

#define XB_TMO      128
#define XB_XCNT(j)  (256  + 64 * (j))
#define XB_XSUB(j)  (1280 + 64 * (j))
#define XB_XGEN(j)  (2304 + 64 * (j))
#define XB_TOP      3328
#define XB_TOPGEN   3392
#define XCD_BAR_WORDS 3456
#define XB_SPIN_CAP (1u << 22)

__device__ __forceinline__ unsigned xb_ld(unsigned* p)              { return __hip_atomic_load(p, __ATOMIC_RELAXED, __HIP_MEMORY_SCOPE_AGENT); }
__device__ __forceinline__ unsigned xb_add(unsigned* p, unsigned v) { return __hip_atomic_fetch_add(p, v, __ATOMIC_RELAXED, __HIP_MEMORY_SCOPE_AGENT); }
__device__ __forceinline__ unsigned xb_xcc_id() { return (unsigned)__builtin_amdgcn_s_getreg((3 << 11) | 20) & 0xFu; }
#define XB_SPIN(cond, bar) do { unsigned _sp = 0; while (cond) { __builtin_amdgcn_s_sleep(1); \
    if ((++_sp & 255u) == 0u) { if (xb_ld(&(bar)[XB_TMO])) break; if (_sp > XB_SPIN_CAP) { atomicAdd(&(bar)[XB_TMO], 1u); break; } } } } while (0)

struct XcdBarrier {
    unsigned* bar; unsigned x;
    volatile LAS unsigned* st;
};

__device__ __forceinline__ XcdBarrier xcd_barrier_post(unsigned* bar, volatile LAS unsigned* st) {
    XcdBarrier b; b.bar = bar; b.x = xb_xcc_id(); b.st = st;
    if (threadIdx.x == 0) (void)xb_add(&bar[XB_XCNT(b.x)], 1u);
    return b;
}
__device__ __forceinline__ void xcd_barrier_complete(unsigned* bar, unsigned x, unsigned& nloc, unsigned& nx) {
    const unsigned G = gridDim.x * gridDim.y * gridDim.z;
    unsigned sum, cnt, mine, sp = 0u;
    for (;;) {
        sum = 0u; cnt = 0u; mine = 0u;
#pragma unroll
        for (unsigned j = 0; j < 16; ++j) { const unsigned c = xb_ld(&bar[XB_XCNT(j)]); sum += c; cnt += (c > 0u) ? 1u : 0u; mine = (j == x) ? c : mine; }
        if (sum == G) break;
        __builtin_amdgcn_s_sleep(1);
        if ((++sp & 255u) == 0u) { if (xb_ld(&bar[XB_TMO])) break; if (sp > XB_SPIN_CAP) { atomicAdd(&bar[XB_TMO], 1u); break; } }
    }
    nloc = mine > 0u ? mine : 1u; nx = cnt > 0u ? cnt : 1u;
}

__device__ __forceinline__ void xcd_barrier(const XcdBarrier& b) {
    asm volatile("s_waitcnt vmcnt(0)" ::: "memory");
    __syncthreads();
    if (threadIdx.x == 0) {
        unsigned* bar = b.bar;
        __builtin_amdgcn_s_waitcnt(0);
        unsigned nloc = b.st[0], nx = b.st[1];
        if (nloc == 0u) { xcd_barrier_complete(bar, b.x, nloc, nx); b.st[0] = nloc; b.st[1] = nx; }
        const unsigned old = xb_add(&bar[XB_XSUB(b.x)], 1u);
        const unsigned gen = old / nloc;
        if (old + 1u == (gen + 1u) * nloc) {
            __builtin_amdgcn_fence(__ATOMIC_RELEASE, "agent");
            asm volatile("s_waitcnt vmcnt(0)" ::: "memory");
            const unsigned og = xb_add(&bar[XB_TOP], 1u);
            const unsigned tg = og / nx;
            if (og + 1u == (tg + 1u) * nx) xb_add(&bar[XB_TOPGEN], 1u);
            else XB_SPIN(xb_ld(&bar[XB_TOPGEN]) == tg, bar);
            __builtin_amdgcn_fence(__ATOMIC_ACQUIRE, "agent");
            xb_add(&bar[XB_XGEN(b.x)], 1u);
            asm volatile("s_waitcnt vmcnt(0)" ::: "memory");
        } else {
            XB_SPIN(xb_ld(&bar[XB_XGEN(b.x)]) == gen, bar);
            __builtin_amdgcn_fence(__ATOMIC_ACQUIRE, "agent");
            asm volatile("s_waitcnt vmcnt(0)" ::: "memory");
        }
    }
    __syncthreads();
}
typedef unsigned short bf16;
typedef unsigned v4u __attribute__((ext_vector_type(4)));
typedef unsigned v2u __attribute__((ext_vector_type(2)));
typedef float f32x2 __attribute__((ext_vector_type(2)));
__device__ __forceinline__ float bf2f(unsigned short b) { return __builtin_bit_cast(float, (unsigned)b << 16); }
__device__ __forceinline__ float bflo(unsigned u) { return __builtin_bit_cast(float, u << 16); }
__device__ __forceinline__ float bfhi(unsigned u) { return __builtin_bit_cast(float, u & 0xffff0000u); }
__device__ __forceinline__ float wave_sum(float v) {
#pragma unroll
    for (int o = 1; o < 64; o <<= 1) v += __shfl_xor(v, o);
    return v;
}
__device__ __forceinline__ float wave_max(float v) {
#pragma unroll
    for (int o = 1; o < 64; o <<= 1) v = fmaxf(v, __shfl_xor(v, o));
    return v;
}
struct Args { const float* in[18]; float* out; unsigned char* ws; int ph_lo, ph_hi; };
struct Frame {
    LAS unsigned char* lds; unsigned char* ldsg;
    volatile LAS unsigned* MISC;
    gu32* ctl;
    int tid, lane, wave, G, bid;
    unsigned char* ws;
};
struct TrItem { const float* W; bf16* WT; const float* gain; int K, N, item; };
__device__ __forceinline__ void tr_load(const TrItem& t, int lane, f32x4 (&v)[16]) {
    const int nb = t.N >> 6, kb = t.item / nb, nbi = t.item - kb * nb, k0 = kb * 64, n0 = nbi * 64;
#pragma unroll
    for (int i = 0; i < 16; ++i) v[i] = __builtin_nontemporal_load((const f32x4*)(t.W + (size_t)(k0 + 4 * i + (lane >> 4)) * t.N + n0 + (lane & 15) * 4));
}
__device__ __forceinline__ void tr_store(const TrItem& t, int lane, const f32x4 (&v)[16], LAS float* scr) {
    const int nb = t.N >> 6, kb = t.item / nb, nbi = t.item - kb * nb, k0 = kb * 64, n0 = nbi * 64;
#pragma unroll
    for (int i = 0; i < 16; ++i) { LAS float* s = scr + (4 * i + (lane >> 4)) * 65 + (lane & 15) * 4; s[0] = v[i][0]; s[1] = v[i][1]; s[2] = v[i][2]; s[3] = v[i][3]; }
    LDS_WAIT(); asm volatile("" ::: "memory");
    const int c = lane & 7;
    float g[8];
#pragma unroll
    for (int i = 0; i < 8; ++i) g[i] = t.gain ? t.gain[k0 + 8 * c + i] : 1.0f;
#pragma unroll
    for (int j = 0; j < 8; ++j) { const int n = (lane >> 3) + 8 * j; const LAS float* s = scr + (8 * c) * 65 + n;
        v4u o; o.x = pk2(s[0 * 65] * g[0], s[1 * 65] * g[1]); o.y = pk2(s[2 * 65] * g[2], s[3 * 65] * g[3]); o.z = pk2(s[4 * 65] * g[4], s[5 * 65] * g[5]); o.w = pk2(s[6 * 65] * g[6], s[7 * 65] * g[7]);
        *(GAS v4u*)(t.WT + (size_t)(n0 + n) * t.K + k0 + 8 * c) = o; }
    LDS_WAIT(); asm volatile("" ::: "memory");
}
__device__ __forceinline__ int t5_bucket(int d) {
    if (d < 16) return d;
    const unsigned d2 = (unsigned)d * (unsigned)d; const int msb = 31 - __builtin_clz(d2);
    const int b = 16 + msb - 8; return b > 31 ? 31 : b;
}
__device__ __forceinline__ unsigned pack_i8x4(float a, float b, float c, float d) {
    const int ia = (int)__builtin_rintf(a), ib = (int)__builtin_rintf(b), ic = (int)__builtin_rintf(c), id = (int)__builtin_rintf(d);
    return ((unsigned)ia & 255u) | (((unsigned)ib & 255u) << 8) | (((unsigned)ic & 255u) << 16) | ((unsigned)id << 24);
}
__device__ __forceinline__ void st_ld(const float* W, int N, int k0, int n0, int lane, f32x4 (&v)[16]) {
    const float* p = W + (size_t)(k0 + (lane >> 4)) * N + n0 + (lane & 15) * 4; asm volatile("" : "+v"(p));
#pragma unroll
    for (int i = 0; i < 16; ++i) { v[i] = __builtin_nontemporal_load((const f32x4*)p); p += (size_t)4 * N; }
}
__device__ __forceinline__ void st_pk(const f32x4 (&v)[16], int k0, const LAS float* gl, int lane, unsigned (&h)[32], f32x4& cm) {
#pragma unroll
    for (int i = 0; i < 16; ++i) { const float g = gl[k0 + 4 * i + (lane >> 4)];
        const unsigned p0 = pg8::cvt_pk_bf16(v[i][0] * g, v[i][1] * g), p1 = pg8::cvt_pk_bf16(v[i][2] * g, v[i][3] * g); h[2 * i] = p0; h[2 * i + 1] = p1;
        cm[0] = fmaxf(cm[0], fabsf(bflo(p0))); cm[1] = fmaxf(cm[1], fabsf(bfhi(p0))); cm[2] = fmaxf(cm[2], fabsf(bflo(p1))); cm[3] = fmaxf(cm[3], fabsf(bfhi(p1))); }
    asm volatile("" ::: "memory"); __builtin_amdgcn_sched_barrier(0);
}
__device__ __forceinline__ void st_quant(const unsigned (&h)[32], f32x4 inv4, int k0, int n0, int lane, LAS float* scr, unsigned char* WQ) {
#pragma unroll
    for (int i = 0; i < 16; ++i) { LAS float* sp = scr + (4 * i + (lane >> 4)) * 65 + (lane & 15) * 4;
        sp[0] = bflo(h[2 * i]) * inv4[0]; sp[1] = bfhi(h[2 * i]) * inv4[1]; sp[2] = bflo(h[2 * i + 1]) * inv4[2]; sp[3] = bfhi(h[2 * i + 1]) * inv4[3]; }
    LDS_WAIT(); asm volatile("" ::: "memory");
    const int c = lane & 7;
#pragma unroll
    for (int j = 0; j < 8; ++j) { const int n = (lane >> 3) + 8 * j; const LAS float* sp = scr + (8 * c) * 65 + n;
        v2u o; o.x = pack_i8x4(sp[0 * 65], sp[1 * 65], sp[2 * 65], sp[3 * 65]); o.y = pack_i8x4(sp[4 * 65], sp[5 * 65], sp[6 * 65], sp[7 * 65]);
        *(GAS v2u*)(WQ + (size_t)(n0 + n) * DM + k0 + 8 * c) = o;
        if (j & 1) { asm volatile("" ::: "memory"); __builtin_amdgcn_sched_barrier(0); } }
    LDS_WAIT(); asm volatile("" ::: "memory");
}
__device__ __forceinline__ void p0_strips(const Args& A, Frame& F) {
    int tid = F.wave * 64 + lane_id_v(); asm volatile("" : "+v"(tid)); const int lane = tid & 63, wave = __builtin_amdgcn_readfirstlane(tid >> 6); (void)lane; (void)wave;
    LAS float* scr = (LAS float*)(F.lds + RING_OFF + wave * 16640);
    LAS float* cmx = (LAS float*)(F.lds + RING_OFF + 133120);
    LAS float* gl = (LAS float*)(F.lds + RING_OFF + 137216);
    const int gw = F.bid * NWAVES + wave, NGW = F.G * NWAVES;
    const float* mixn = A.in[2]; const float* mlpn = A.in[3];
    float* SWb = (float*)(F.ws + WS_SW);
    constexpr int NS_QKV = 2 * 96, NS_1 = 4 * 128, NSTRIP = NS_QKV + NS_1;
    struct SD { const float* W; const float* gain; unsigned char* WQ; float* SW; int N, n0; };
    auto dec = [&](int si) -> SD { SD d;
        if (si < NS_QKV) { const int j = si / 96, c = si - j * 96; d.W = A.in[5] + (size_t)j * DM * NQKV; d.gain = mixn + (2 * j) * DM; d.WQ = F.ws + WS_WQKV + (size_t)j * NQKV * DM; d.SW = SWb + SW_QKV + j * NQKV; d.N = NQKV; d.n0 = c * 64; }
        else { const int r = si - NS_QKV, l = r >> 7, c = r & 127; d.W = A.in[16] + (size_t)l * DM * FF; d.gain = mlpn + l * DM; d.WQ = F.ws + WS_W1 + (size_t)l * FF * DM; d.SW = SWb + SW_W1 + l * FF; d.N = FF; d.n0 = c * 64; }
        return d; };
    const int kb = wave * 256;
    int sp = 0;
    f32x4 v[16];
    if (F.bid < NSTRIP) { const SD d0 = dec(F.bid); st_ld(d0.W, d0.N, kb, d0.n0, lane, v); }
    for (int si = F.bid; si < NSTRIP; si += F.G, sp ^= 1) {
        const SD d = dec(si);
        __syncthreads();
#pragma unroll
        for (int i = 0; i < 4; ++i) gl[tid + 512 * i] = d.gain[tid + 512 * i];
        __syncthreads();
        unsigned hb[4][32]; f32x4 cm = (f32x4){0.f, 0.f, 0.f, 0.f};
        st_pk(v, kb, gl, lane, hb[0], cm);
#pragma unroll
        for (int t = 1; t < 4; ++t) { st_ld(d.W, d.N, kb + 64 * t, d.n0, lane, v); st_pk(v, kb + 64 * t, gl, lane, hb[t], cm); }
#pragma unroll
        for (int e = 0; e < 4; ++e) { float t = cm[e]; t = fmaxf(t, __shfl_xor(t, 16)); t = fmaxf(t, __shfl_xor(t, 32)); cm[e] = t; }
        if (lane < 16) *(LAS f32x4*)(cmx + (sp * 8 + wave) * 64 + lane * 4) = cm;
#pragma unroll
        for (int t = 0; t < 4; ++t)
#pragma unroll
            for (int k = 0; k < 32; ++k) asm volatile("" : "+v"(hb[t][k]));
        __syncthreads();
        f32x4 mx = *(const LAS f32x4*)(cmx + (sp * 8) * 64 + (lane & 15) * 4);
#pragma unroll
        for (int w = 1; w < 8; ++w) { const f32x4 t = *(const LAS f32x4*)(cmx + (sp * 8 + w) * 64 + (lane & 15) * 4);
#pragma unroll
            for (int e = 0; e < 4; ++e) mx[e] = fmaxf(mx[e], t[e]); }
        f32x4 inv4;
#pragma unroll
        for (int e = 0; e < 4; ++e) inv4[e] = mx[e] > 1e-30f ? 127.0f / mx[e] : 0.f;
        if (wave == 0 && lane < 16) *(f32x4*)(d.SW + d.n0 + lane * 4) = mx * (1.0f / 127.0f);
        st_quant(hb[0], inv4, kb, d.n0, lane, scr, d.WQ);
        if (si + F.G < NSTRIP) { const SD dn = dec(si + F.G); st_ld(dn.W, dn.N, kb, dn.n0, lane, v); }
#pragma unroll
        for (int t = 1; t < 4; ++t) st_quant(hb[t], inv4, kb + 64 * t, d.n0, lane, scr, d.WQ);
    }
}
__device__ __forceinline__ void p0_tiles(const Args& A, Frame& F) {
    int tid = F.wave * 64 + lane_id_v(); asm volatile("" : "+v"(tid)); const int lane = tid & 63, wave = __builtin_amdgcn_readfirstlane(tid >> 6); (void)lane; (void)wave;
    LAS float* scr = (LAS float*)(F.lds + RING_OFF + wave * 16640);
    const int gw = F.bid * NWAVES + wave, NGW = F.G * NWAVES; (void)gw; (void)NGW; (void)scr;
    constexpr int NSTRIP = 2 * 96 + 4 * 128;
    constexpr int T_O = 32 * 32, T_2 = 128 * 32, T_IN = 32 * 64;
    constexpr int NB = 4 * T_O + 4 * T_2 + 256 + 2 * T_IN;
    auto decode = [&](int it) -> TrItem {
        int r = it; TrItem t;
        if (r >= 4 * T_O + 4 * T_2 + 256) { r -= 4 * T_O + 4 * T_2 + 256; const int j = r / T_IN; r -= j * T_IN;
            t.W = A.in[7] + (size_t)j * DM * 2 * DM; t.WT = (bf16*)(F.ws + WS_WIN) + (size_t)j * 2 * DM * DM; t.gain = A.in[2] + (2 * j + 1) * DM; t.K = DM; t.N = 2 * DM; t.item = r; return t; }
        if (r >= 4 * T_O + 4 * T_2) { r -= 4 * T_O + 4 * T_2; const int blk = r >> 2, jg = blk >> 4, j = jg >> 1, g = jg & 1, n = blk & 15;
            t.W = A.in[g ? 12 : 10] + ((size_t)j * 16 + n) * 16384; t.WT = (bf16*)(F.ws + WS_WG) + (((size_t)j * 2 + g) * 16 + n) * 16384; t.gain = nullptr; t.K = 128; t.N = 128; t.item = r & 3; return t; }
        if (r < 4 * T_O) { const int jj = r / T_O, j = jj & 1; r -= jj * T_O;
            if (jj < 2) { t.W = A.in[6] + (size_t)j * DM * DM; t.WT = (bf16*)(F.ws + WS_WO) + (size_t)j * DM * DM; }
            else { t.W = A.in[15] + (size_t)j * DM * DM; t.WT = (bf16*)(F.ws + WS_WOUT) + (size_t)j * DM * DM; }
            t.gain = nullptr; t.K = DM; t.N = DM; t.item = r; return t; }
        r -= 4 * T_O;
        const int l = r / T_2; r -= l * T_2;
        t.W = A.in[17] + (size_t)l * FF * DM; t.WT = (bf16*)(F.ws + WS_W2) + (size_t)l * DM * FF; t.gain = nullptr; t.K = FF; t.N = DM; t.item = r; return t;
    };
    {
        constexpr int SW_ = 32;
        const int per = (NSTRIP * SW_ + NB + F.G - 1) / F.G;
        int start = 0, cnt = 0;
        for (int b2 = 0; b2 <= F.bid; ++b2) { const int ns = b2 < NSTRIP ? (NSTRIP - b2 + F.G - 1) / F.G : 0; int q = per - SW_ * ns; q = q < 0 ? 0 : q; if (b2 < F.bid) start += q; else cnt = q; }
        int tot = start;
        for (int b2 = F.bid; b2 < F.G; ++b2) { const int ns = b2 < NSTRIP ? (NSTRIP - b2 + F.G - 1) / F.G : 0; int q = per - SW_ * ns; tot += q < 0 ? 0 : q; }
        int end = start + cnt; if (end > NB) end = NB; if (start > NB) start = NB;
        f32x4 va[16], vb[16];
        for (int pass = 0; pass < 2; ++pass) {
            const int first = pass == 0 ? start + wave : (tot < NB ? tot + gw : NB), lim = pass == 0 ? end : NB, step = pass == 0 ? NWAVES : NGW;
            if (first >= lim) continue;
            TrItem cur = decode(first); tr_load(cur, lane, va);
            for (int it = first; it < lim; it += 2 * step) {
                const bool h1 = it + step < lim; TrItem n1 = cur; if (h1) { n1 = decode(it + step); tr_load(n1, lane, vb); }
                tr_store(cur, lane, va, scr);
                if (!h1) break;
                const bool h2 = it + 2 * step < lim; if (h2) { cur = decode(it + 2 * step); tr_load(cur, lane, va); }
                tr_store(n1, lane, vb, scr);
                if (!h2) break;
            }
        }
    }
}
__device__ __forceinline__ void p0_x(const Args& A, Frame& F) {
    int tid = F.wave * 64 + lane_id_v(); asm volatile("" : "+v"(tid)); const int lane = tid & 63, wave = __builtin_amdgcn_readfirstlane(tid >> 6); (void)lane; (void)wave;
    LAS float* scr = (LAS float*)(F.lds + RING_OFF + wave * 16640);
    const int gw = F.bid * NWAVES + wave, NGW = F.G * NWAVES; (void)gw; (void)NGW; (void)scr;
    { const float* x = A.in[0]; bf16* XB = (bf16*)(F.ws + WS_XB); unsigned char* XQ = F.ws + WS_XQ; float* frow = (float*)(F.ws + WS_FROW);
      for (int m = gw; m < S; m += NGW) { const GAS f32x4* xr = (const GAS f32x4*)(x + (size_t)m * DM) + lane;
          GAS v2u* xb = (GAS v2u*)(XB + (size_t)m * DM) + lane; GAS unsigned* xq = (GAS unsigned*)(XQ + (size_t)m * DM) + lane; float s = 0.f, am = 0.f;
          f32x4 v[8];
#pragma unroll
          for (int j = 0; j < 8; ++j) v[j] = xr[64 * j];
#pragma unroll
          for (int j = 0; j < 8; ++j) { s += (v[j].x * v[j].x + v[j].y * v[j].y) + (v[j].z * v[j].z + v[j].w * v[j].w); am = fmaxf(fmaxf(am, fmaxf(fabsf(v[j].x), fabsf(v[j].y))), fmaxf(fabsf(v[j].z), fabsf(v[j].w)));
              v2u o; o.x = pk2(v[j].x, v[j].y); o.y = pk2(v[j].z, v[j].w); xb[64 * j] = o; }
          s = wave_sum(s); am = wave_max(am);
          const float inv = am > 1e-30f ? 127.0f / am : 0.f;
#pragma unroll
          for (int j = 0; j < 8; ++j) xq[64 * j] = pack_i8x4(v[j].x * inv, v[j].y * inv, v[j].z * inv, v[j].w * inv);
          if (lane == 0) { const float rstd = __builtin_amdgcn_rsqf(s * (1.0f / 2048.0f) + 1e-6f); frow[m] = am * (1.0f / 127.0f) * rstd; ((float*)(F.ws + WS_RSTD))[m] = rstd; } } }
    { const float* rb = A.in[1]; float* bt = (float*)(F.ws + WS_BIAS);
      for (int i = F.bid * (NWAVES * 64) + tid; i < NH * BIAS_LD; i += F.G * NWAVES * 64) { const int h = i / BIAS_LD, d = i - h * BIAS_LD - 256;
          bt[i] = d < 0 ? -INFINITY : rb[t5_bucket(d) * NH + h] * 1.4426950408889634f; } }
}
__device__ __forceinline__ void p0_prologue(const Args& A, Frame& F) { p0_strips(A, F); p0_tiles(A, F); p0_x(A, F); }
#define TOP3_INS(x_, j_) do { const float x__ = (x_); const int j__ = (j_); const bool b0 = x__ > v0, b1 = x__ > v1, b2 = x__ > v2; \
    v2 = b1 ? v1 : (b2 ? x__ : v2); i2 = b1 ? i1 : (b2 ? j__ : i2); v1 = b0 ? v0 : (b1 ? x__ : v1); i1 = b0 ? i0 : (b1 ? j__ : i1); v0 = b0 ? x__ : v0; i0 = b0 ? j__ : i0; } while (0)
__device__ __forceinline__ void phase_gate(const Args& A, Frame& F, int ja) {
    int tid = F.wave * 64 + lane_id_v(); asm volatile("" : "+v"(tid)); const int lane = tid & 63, wave = __builtin_amdgcn_readfirstlane(tid >> 6); (void)lane; (void)wave;
    const bf16* QKV = (const bf16*)(F.ws + WS_QKV); const float* KMP = (const float*)(F.ws + WS_KMP);
    unsigned* cnt = (unsigned*)(F.ctl + CW_CNT + ja * 512); unsigned* list = (unsigned*)(F.ws + WS_LIST); float* LSE = (float*)(F.ws + WS_LSE);
    LAS float* km = (LAS float*)(F.lds + RING_OFF);
    LAS float* cv = km + 32 * 128;
    LAS int* ci = (LAS int*)(cv + 256 * 3);
    for (int item = F.bid; item < 512; item += F.G) {
        const int h = item & 15, c = item >> 4;
        for (int i = tid; i < 32 * 128; i += NWAVES * 64) { const int jb = i >> 7, d = i & 127;
            km[i] = (KMP[(size_t)jb * 2048 + h * 128 + d] + KMP[(size_t)(32 + jb) * 2048 + h * 128 + d]) * (1.0f / 256.0f); }
        __syncthreads();
        const int t = tid & 255, half = tid >> 8, q = c * 256 + t;
        float g[16];
#pragma unroll
        for (int jb = 0; jb < 16; ++jb) g[jb] = 0.f;
        const bf16* qp = QKV + (size_t)q * NQKV + h * HD;
        const LAS float* kmh = km + half * 16 * 128;
#pragma unroll 1
        for (int d0 = 0; d0 < 128; d0 += 8) {
            const v4u qv = *(const v4u*)(qp + d0);
            const float q0 = bflo(qv.x), q1 = bfhi(qv.x), q2 = bflo(qv.y), q3 = bfhi(qv.y), q4 = bflo(qv.z), q5 = bfhi(qv.z), q6 = bflo(qv.w), q7 = bfhi(qv.w);
#pragma unroll
            for (int jb = 0; jb < 16; ++jb) { const f32x4 k0 = *(const LAS f32x4*)(kmh + jb * 128 + d0), k1 = *(const LAS f32x4*)(kmh + jb * 128 + d0 + 4);
                g[jb] += (q0 * k0[0] + q1 * k0[1]) + (q2 * k0[2] + q3 * k0[3]) + (q4 * k1[0] + q5 * k1[1]) + (q6 * k1[2] + q7 * k1[3]);
                if ((jb & 3) == 3) __builtin_amdgcn_sched_barrier(0); }
        }
        float v0 = -INFINITY, v1 = -INFINITY, v2 = -INFINITY; int i0 = -1, i1 = -1, i2 = -1;
#pragma unroll
        for (int jb = 0; jb < 16; ++jb) { const int j = half * 16 + jb; if (j < c) TOP3_INS(g[jb], j); }
        if (half == 1) { cv[t * 3 + 0] = v0; cv[t * 3 + 1] = v1; cv[t * 3 + 2] = v2; ci[t * 3 + 0] = i0; ci[t * 3 + 1] = i1; ci[t * 3 + 2] = i2; }
        __syncthreads();
        if (half == 0) {
            { const int j = ci[t * 3 + 0]; if (j >= 0) TOP3_INS(cv[t * 3 + 0], j); }
            { const int j = ci[t * 3 + 1]; if (j >= 0) TOP3_INS(cv[t * 3 + 1], j); }
            { const int j = ci[t * 3 + 2]; if (j >= 0) TOP3_INS(cv[t * 3 + 2], j); }
#define EMIT_PICK(k_, sj_) do { if ((sj_) >= 0) { const unsigned pos = atomicAdd(&cnt[h * 32 + (sj_)], 1u); list[(size_t)(h * 32 + (sj_)) * 8192 + pos] = ((unsigned)q << 2) | (unsigned)(k_); } \
                else LSE[((size_t)q * NH + h) * 4 + (k_)] = -INFINITY; } while (0)
            EMIT_PICK(0, i0); EMIT_PICK(1, i1); EMIT_PICK(2, i2);
#undef EMIT_PICK
        }
        __syncthreads();
    }
}
__device__ __forceinline__ void attn_entry(const Args& A, Frame& F, int q, int h, int jb, int slot) {
    int tid = F.wave * 64 + lane_id_v(); asm volatile("" : "+v"(tid)); const int lane = tid & 63, wave = __builtin_amdgcn_readfirstlane(tid >> 6); (void)lane; (void)wave;
    const bf16* QKV = (const bf16*)(F.ws + WS_QKV); const int l = lane;
    const bf16* qp = QKV + (size_t)q * NQKV + h * HD;
    const bf16* Kb = QKV + (size_t)(jb * BLK) * NQKV + DM + h * HD; const bf16* Vb = Kb + DM;
    float s[4] = {0.f, 0.f, 0.f, 0.f};
    for (int d0 = 0; d0 < 128; d0 += 8) {
        const v4u qv = *(const v4u*)(qp + d0);
        const float q0 = bflo(qv.x), q1 = bfhi(qv.x), q2 = bflo(qv.y), q3 = bfhi(qv.y), q4 = bflo(qv.z), q5 = bfhi(qv.z), q6 = bflo(qv.w), q7 = bfhi(qv.w);
#pragma unroll
        for (int kk = 0; kk < 4; ++kk) { const v4u kv = *(const v4u*)(Kb + (size_t)(l + 64 * kk) * NQKV + d0);
            s[kk] += (q0 * bflo(kv.x) + q1 * bfhi(kv.x)) + (q2 * bflo(kv.y) + q3 * bfhi(kv.y)) + (q4 * bflo(kv.z) + q5 * bfhi(kv.z)) + (q6 * bflo(kv.w) + q7 * bfhi(kv.w)); }
    }
    const float C = 0.088388347648318440f * 1.4426950408889634f;
    const float* bt = (const float*)(F.ws + WS_BIAS) + h * BIAS_LD + 256;
    float t[4], m = -INFINITY;
#pragma unroll
    for (int kk = 0; kk < 4; ++kk) { const int d = q - (jb * BLK + l + 64 * kk); t[kk] = s[kk] * C + bt[d]; m = fmaxf(m, t[kk]); }
    m = wave_max(m);
    float p[4], ls = 0.f;
#pragma unroll
    for (int kk = 0; kk < 4; ++kk) { p[kk] = __builtin_amdgcn_exp2f(t[kk] - m); ls += p[kk]; }
    ls = wave_sum(ls);
    const int c0 = 64 * (l >> 5) + (l & 31);
    float o0 = 0.f, o1 = 0.f;
#pragma unroll
    for (int kk = 0; kk < 4; ++kk)
        for (int src = 0; src < 64; ++src) { const float pk = __shfl(p[kk], src); const bf16* vr = Vb + (size_t)(src + 64 * kk) * NQKV;
            o0 += pk * bf2f(vr[c0]); o1 += pk * bf2f(vr[c0 + 32]); }
    const float inv = 1.0f / ls;
    unsigned* PART = (unsigned*)(F.ws + WS_HID); float* LSE = (float*)(F.ws + WS_LSE);
    const size_t e = ((size_t)q * NH + h) * 4 + slot;
    PART[e * 64 + l] = pk2(o0 * inv, o1 * inv);
    if (l == 0) LSE[e] = m + __builtin_amdgcn_logf(ls);
}
__device__ __forceinline__ void phase_attn(const Args& A, Frame& F, int ja) {
    int tid = F.wave * 64 + lane_id_v(); asm volatile("" : "+v"(tid)); const int lane = tid & 63, wave = __builtin_amdgcn_readfirstlane(tid >> 6); (void)lane; (void)wave;
    const unsigned* cnt = (const unsigned*)(F.ctl + CW_CNT + ja * 512); const unsigned* list = (const unsigned*)(F.ws + WS_LIST);
    LAS unsigned* pre = (LAS unsigned*)(F.lds + RING_OFF);
    LAS unsigned* cl = pre + 520;
    for (int i = tid; i < 512; i += NWAVES * 64) cl[i] = __hip_atomic_load(cnt + i, RLX_AGENT);
    __syncthreads();
    if (tid == 0) { unsigned a = 0; for (int i = 0; i < 512; ++i) { pre[i] = a; a += (cl[i] + 7u) >> 3; } pre[512] = a; }
    __syncthreads();
    const int total = (int)pre[512];
    for (int tile = F.bid; tile < total + S * NH / 8; tile += F.G) {
        if (tile < total) {
            int lo = 0, hi = 512;
            while (hi - lo > 1) { const int mid = (lo + hi) >> 1; if ((int)pre[mid] <= tile) lo = mid; else hi = mid; }
            const int e = (tile - (int)pre[lo]) * 8 + wave;
            if (e < (int)cl[lo]) { const unsigned ent = list[(size_t)lo * 8192 + e]; attn_entry(A, F, (int)(ent >> 2), lo >> 5, lo & 31, (int)(ent & 3u)); }
        } else { const int e = (tile - total) * 8 + wave; const int q = e >> 4, h = e & 15; attn_entry(A, F, q, h, q >> 8, 3); }
    }
}
namespace at {
using bf16x8 = __attribute__((ext_vector_type(8))) short;
using s16x4  = __attribute__((ext_vector_type(4))) short;
using f32x16 = __attribute__((ext_vector_type(16))) float;
using u32x4  = __attribute__((ext_vector_type(4))) unsigned;
constexpr int KVBLK = 64, LDK = NQKV;
constexpr int SHM_V = KVBLK * 128 * 2, SHM_K = KVBLK * 128 * 2;
constexpr int OFF_V = 0, OFF_K = 2 * SHM_V, OFF_WS = OFF_K + 2 * SHM_K, OFF_DST = OFF_WS + 8 * 256, OFF_BT = OFF_DST + 8 * 128, OFF_PRE = OFF_BT + BIAS_LD * 4, OFF_CL = OFF_PRE + 1032 * 4, OFF_WT = OFF_CL + 512 * 4, OFF_END = OFF_WT + 64;
static_assert(OFF_END <= RING_BYTES, "attention LDS map");
#define KSWZ(row, colB) ((row) * 256 + ((colB) ^ (((row) & 7) << 4)))
#define SBAR() __builtin_amdgcn_sched_barrier(0)
__device__ __forceinline__ int crow(int r, int hi) { return (r & 3) + 8 * (r >> 2) + 4 * hi; }
__device__ __forceinline__ unsigned cvtpk(float lo, float hi) { unsigned r; asm volatile("v_cvt_pk_bf16_f32 %0, %1, %2" : "=v"(r) : "v"(lo), "v"(hi)); return r; }
__device__ __forceinline__ void partialSM(f32x16& p0, f32x16& p1, const LAS float* bp, float& m_reg, float& alpha) {
    constexpr float C = 0.088388347648318440f * 1.4426950408889634f;
#pragma unroll
    for (int r = 0; r < 16; ++r) p0[r] = fmaf(p0[r], C, bp[59 - ((r & 3) + 8 * (r >> 2))]);
#pragma unroll
    for (int r = 0; r < 16; ++r) p1[r] = fmaf(p1[r], C, bp[27 - ((r & 3) + 8 * (r >> 2))]);
    float pmax = p0[0];
#pragma unroll
    for (int r = 1; r < 16; ++r) pmax = fmaxf(pmax, p0[r]);
#pragma unroll
    for (int r = 0; r < 16; ++r) pmax = fmaxf(pmax, p1[r]);
    { auto rr = __builtin_amdgcn_permlane32_swap(__float_as_uint(pmax), __float_as_uint(pmax), false, false); pmax = fmaxf(__uint_as_float(rr[0]), __uint_as_float(rr[1])); }
    float mn = m_reg; alpha = 1.f;
    if (!__all(pmax <= m_reg + 8.0f)) { const bool up = pmax > m_reg + 8.0f;
        mn = up ? pmax : m_reg; alpha = up ? __builtin_amdgcn_exp2f(m_reg - mn) : 1.f; m_reg = mn; }
#pragma unroll
    for (int r = 0; r < 16; ++r) p0[r] -= mn;
#pragma unroll
    for (int r = 0; r < 16; ++r) p1[r] -= mn;
#pragma unroll
    for (int r = 0; r < 16; ++r) p0[r] = __builtin_amdgcn_exp2f(p0[r]);
}
__device__ __forceinline__ void finishSM(f32x16& p0, f32x16& p1, float alpha, float& l_reg, bf16x8& pa0, bf16x8& pa1, bf16x8& pa2, bf16x8& pa3) {
#pragma unroll
    for (int r = 0; r < 16; ++r) p1[r] = __builtin_amdgcn_exp2f(p1[r]);
    float ps = 0;
#pragma unroll
    for (int r = 0; r < 16; ++r) ps += p0[r];
#pragma unroll
    for (int r = 0; r < 16; ++r) ps += p1[r];
    { auto rr = __builtin_amdgcn_permlane32_swap(__float_as_uint(ps), __float_as_uint(ps), false, false); ps = __uint_as_float(rr[0]) + __uint_as_float(rr[1]); }
    l_reg = l_reg * alpha + ps;
#define PK4(P, BASE, OUT) do { unsigned a0 = cvtpk(P[BASE + 0], P[BASE + 1]), a1 = cvtpk(P[BASE + 2], P[BASE + 3]);   \
    unsigned b0 = cvtpk(P[BASE + 4], P[BASE + 5]), b1 = cvtpk(P[BASE + 6], P[BASE + 7]);                              \
    auto r0 = __builtin_amdgcn_permlane32_swap(a0, b0, false, false); auto r1 = __builtin_amdgcn_permlane32_swap(a1, b1, false, false); \
    u32x4 w = {r0[0], r1[0], r0[1], r1[1]}; OUT = *reinterpret_cast<bf16x8*>(&w); } while (0)
    PK4(p0, 0, pa0); PK4(p0, 8, pa1); PK4(p1, 0, pa2); PK4(p1, 8, pa3);
#undef PK4
}
__device__ __forceinline__ void qkt(f32x16& p0, f32x16& p1, const LAS unsigned char* Ks, const bf16x8* qr, int r32, int hi) {
    p0 = f32x16{}; p1 = f32x16{};
#pragma unroll
    for (int d0 = 0; d0 < 8; ++d0) { const int cb = (d0 * 16 + hi * 8) * 2;
        const bf16x8 b0 = *reinterpret_cast<const LAS bf16x8*>(Ks + KSWZ(r32, cb));
        const bf16x8 b1 = *reinterpret_cast<const LAS bf16x8*>(Ks + KSWZ(32 + r32, cb));
        p0 = __builtin_amdgcn_mfma_f32_32x32x16_bf16(b0, qr[d0], p0, 0, 0, 0);
        p1 = __builtin_amdgcn_mfma_f32_32x32x16_bf16(b1, qr[d0], p1, 0, 0, 0); }
}
__device__ __forceinline__ int v_st(int k, int c) { const int kk = (k & ~0xC) | ((k & 4) << 1) | ((k & 8) >> 1); return ((kk >> 3) * 4 + (c >> 5)) * 512 + ((kk & 7) * 32 + (c & 31)) * 2; }
__device__ __forceinline__ int v_rd_base(int lane) { return ((lane & 3) << 3) | (((lane >> 2) & 3) << 6) | (((lane >> 4) & 1) << 5) | (((lane >> 5) & 1) << 8); }
constexpr int v_rd_off(int d0, int ks, int half) { return d0 * 512 + ks * 4096 + half * 2048; }
template <int OFF> __device__ __forceinline__ s16x4 tr_read(int vb) { s16x4 r; asm volatile("ds_read_b64_tr_b16 %0, %1 offset:%2" : "=&v"(r) : "v"(vb), "i"(OFF) : "memory"); return r; }
template <int D0> __device__ __forceinline__ void pv_one(f32x16& od, int vb, bf16x8 pa0, bf16x8 pa1, bf16x8 pa2, bf16x8 pa3) {
    const s16x4 l0 = tr_read<v_rd_off(D0, 0, 0)>(vb), h0 = tr_read<v_rd_off(D0, 0, 1)>(vb), l1 = tr_read<v_rd_off(D0, 1, 0)>(vb), h1 = tr_read<v_rd_off(D0, 1, 1)>(vb);
    const s16x4 l2 = tr_read<v_rd_off(D0, 2, 0)>(vb), h2 = tr_read<v_rd_off(D0, 2, 1)>(vb), l3 = tr_read<v_rd_off(D0, 3, 0)>(vb), h3 = tr_read<v_rd_off(D0, 3, 1)>(vb);
    asm volatile("s_waitcnt lgkmcnt(0)" ::: "memory"); SBAR();
#define PK(L, H) (bf16x8){L[0], L[1], L[2], L[3], H[0], H[1], H[2], H[3]}
    od = __builtin_amdgcn_mfma_f32_32x32x16_bf16(pa0, PK(l0, h0), od, 0, 0, 0);
    od = __builtin_amdgcn_mfma_f32_32x32x16_bf16(pa1, PK(l1, h1), od, 0, 0, 0);
    od = __builtin_amdgcn_mfma_f32_32x32x16_bf16(pa2, PK(l2, h2), od, 0, 0, 0);
    od = __builtin_amdgcn_mfma_f32_32x32x16_bf16(pa3, PK(l3, h3), od, 0, 0, 0);
#undef PK
}
__device__ __forceinline__ void pv_d0(f32x16* o, int vb, bf16x8 pa0, bf16x8 pa1, bf16x8 pa2, bf16x8 pa3) {
    pv_one<0>(o[0], vb, pa0, pa1, pa2, pa3); pv_one<1>(o[1], vb, pa0, pa1, pa2, pa3); pv_one<2>(o[2], vb, pa0, pa1, pa2, pa3); pv_one<3>(o[3], vb, pa0, pa1, pa2, pa3);
}
__device__ __forceinline__ void attn_unit(const bf16* __restrict__ QKV, int h, int jb, int q, int dsti, LAS unsigned char* lds, unsigned* __restrict__ PART, float* __restrict__ LSE, int tid) {
    const int wid = tid >> 6, lane = tid & 63, r32 = lane & 31, hi = lane >> 5;
    LAS unsigned char* V_lds = lds + OFF_V; LAS unsigned char* K_lds = lds + OFF_K;
    LAS float* ws = (LAS float*)(lds + OFF_WS) + wid * 64; LAS float* li_l = ws; LAS float* al_l = ws + 32;
    LAS int* dst_l = (LAS int*)(lds + OFF_DST) + wid * 32;
    const LAS float* bt = (const LAS float*)(lds + OFF_BT);
    const bf16* Kh = QKV + (size_t)(jb * BLK) * LDK + DM + h * HD; const bf16* Vh = Kh + DM;
    float m_reg = -1e30f, l_reg = 0; f32x16 o[4] = {}; bf16x8 qr[8];
    const bf16* Qw = QKV + (size_t)q * LDK + h * HD + hi * 8;
#pragma unroll
    for (int d0 = 0; d0 < 8; ++d0) qr[d0] = *reinterpret_cast<const bf16x8*>(Qw + d0 * 16);
    if (hi == 0) dst_l[r32] = dsti;
    const LAS float* bp0 = bt + (q - jb * BLK - 4 * hi + 256 - 59);
    const int sr = tid >> 4, sc = (tid & 15) * 8, vst0 = v_st(sr, sc), vst1 = v_st(32 + sr, sc);
    const int vb0 = (int)(uintptr_t)V_lds + v_rd_base(lane);
    struct { bf16x8 vs0, vs1, ks0, ks1; } sr_[2];
#define SLOAD(i, k0) do { sr_[i].vs0 = *reinterpret_cast<const bf16x8*>(&Vh[(size_t)((k0) + sr) * LDK + sc]); sr_[i].vs1 = *reinterpret_cast<const bf16x8*>(&Vh[(size_t)((k0) + 32 + sr) * LDK + sc]); \
    sr_[i].ks0 = *reinterpret_cast<const bf16x8*>(&Kh[(size_t)((k0) + sr) * LDK + sc]); sr_[i].ks1 = *reinterpret_cast<const bf16x8*>(&Kh[(size_t)((k0) + 32 + sr) * LDK + sc]); } while (0)
#define SWRITE(b, i) do { *(LAS bf16x8*)(V_lds + (b) * SHM_V + vst0) = sr_[i].vs0; *(LAS bf16x8*)(V_lds + (b) * SHM_V + vst1) = sr_[i].vs1; const int kc = sc * 2; \
    *(LAS bf16x8*)(K_lds + (b) * SHM_K + KSWZ(sr, kc)) = sr_[i].ks0; *(LAS bf16x8*)(K_lds + (b) * SHM_K + KSWZ(32 + sr, kc)) = sr_[i].ks1; } while (0)
#define SWAIT() asm volatile("s_waitcnt vmcnt(4)" ::: "memory")
#define RESC(a) do { if (__any((a) < 1.f)) { if (hi == 0) al_l[r32] = (a); asm volatile("s_waitcnt lgkmcnt(0)" ::: "memory"); \
    _Pragma("unroll") for (int d = 0; d < 4; ++d) _Pragma("unroll") for (int r = 0; r < 16; ++r) o[d][r] *= al_l[crow(r, hi)]; } } while (0)
    f32x16 pA0, pA1, pB0, pB1; float alA, alB; bf16x8 pa0, pa1, pa2, pa3;
    SLOAD(0, 0); asm volatile("s_waitcnt vmcnt(0)" ::: "memory"); SWRITE(0, 0); __syncthreads();
    qkt(pA0, pA1, K_lds, qr, r32, hi); partialSM(pA0, pA1, bp0, m_reg, alA);
    SLOAD(1, KVBLK); SLOAD(0, 2 * KVBLK);
    SWAIT(); SWRITE(1, 1); __syncthreads();
    SBAR(); qkt(pB0, pB1, K_lds + SHM_K, qr, r32, hi);
    finishSM(pA0, pA1, alA, l_reg, pa0, pa1, pa2, pa3); SBAR();
    SLOAD(1, 3 * KVBLK); SBAR();
    pv_d0(o, vb0, pa0, pa1, pa2, pa3); partialSM(pB0, pB1, bp0 - 64, m_reg, alB);
    __syncthreads(); SWAIT(); SWRITE(0, 0);
    RESC(alB); __syncthreads();
    SBAR(); qkt(pA0, pA1, K_lds, qr, r32, hi);
    finishSM(pB0, pB1, alB, l_reg, pa0, pa1, pa2, pa3); SBAR();
    pv_d0(o, vb0 + SHM_V, pa0, pa1, pa2, pa3); partialSM(pA0, pA1, bp0 - 128, m_reg, alA);
    __syncthreads(); asm volatile("s_waitcnt vmcnt(0)" ::: "memory"); SWRITE(1, 1);
    RESC(alA); __syncthreads();
    SBAR(); qkt(pB0, pB1, K_lds + SHM_K, qr, r32, hi);
    finishSM(pA0, pA1, alA, l_reg, pa0, pa1, pa2, pa3); SBAR();
    pv_d0(o, vb0, pa0, pa1, pa2, pa3); partialSM(pB0, pB1, bp0 - 192, m_reg, alB);
    RESC(alB);
    finishSM(pB0, pB1, alB, l_reg, pa0, pa1, pa2, pa3); SBAR();
    pv_d0(o, vb0 + SHM_V, pa0, pa1, pa2, pa3);
    if (hi == 0) { li_l[r32] = l_reg; if (dsti >= 0) LSE[dsti] = m_reg + __builtin_amdgcn_logf(l_reg); }
    asm volatile("s_waitcnt lgkmcnt(0)" ::: "memory");
#pragma unroll
    for (int r = 0; r < 16; ++r) { const int row = crow(r, hi); const float rl = __builtin_amdgcn_rcpf(li_l[row]); const int ds = dst_l[row];
        if (ds >= 0) { unsigned* pp = PART + (size_t)ds * 64 + r32; pp[0] = cvtpk(o[0][r] * rl, o[1][r] * rl); pp[32] = cvtpk(o[2][r] * rl, o[3][r] * rl); } }
    __syncthreads();
#undef SLOAD
#undef SWRITE
#undef SWAIT
#undef RESC
}
}
__device__ __forceinline__ void phase_attn_mfma(const Args& A, Frame& F, int ja) {
    int tid = F.wave * 64 + lane_id_v(); asm volatile("" : "+v"(tid));
    const unsigned* cnt = (const unsigned*)(F.ctl + CW_CNT + ja * 512); const unsigned* list = (const unsigned*)(F.ws + WS_LIST);
    LAS unsigned char* lds = F.lds + RING_OFF;
    LAS unsigned* pre = (LAS unsigned*)(lds + at::OFF_PRE);
    LAS unsigned* cl = (LAS unsigned*)(lds + at::OFF_CL);
    for (int i = tid; i < 512; i += NWAVES * 64) cl[i] = __hip_atomic_load(cnt + i, RLX_AGENT);
    __syncthreads();
    {
        const int g0 = 2 * tid, h0 = g0 >> 6, x0 = g0 & 63;
        const unsigned n0 = x0 < 32 ? (cl[h0 * 32 + x0] + 255u) >> 8 : 1u, n1 = (x0 + 1) < 32 ? (cl[h0 * 32 + x0 + 1] + 255u) >> 8 : 1u;
        unsigned v = n0 + n1; const int ln = tid & 63;
#pragma unroll
        for (int o = 1; o < 64; o <<= 1) { const unsigned t = __shfl_up(v, o); if (ln >= o) v += t; }
        LAS unsigned* wt = (LAS unsigned*)(lds + at::OFF_WT);
        if (ln == 63) wt[tid >> 6] = v;
        __syncthreads();
        unsigned base = 0;
        for (int w = 0; w < (tid >> 6); ++w) base += wt[w];
        const unsigned excl = base + v - (n0 + n1);
        pre[g0] = excl; pre[g0 + 1] = excl + n0;
        if (tid == NWAVES * 64 - 1) pre[1024] = base + v;
    }
    __syncthreads();
    const unsigned U = pre[1024];
    const unsigned u0 = (unsigned)(((unsigned long long)F.bid * U) / (unsigned)F.G), u1 = (unsigned)(((unsigned long long)(F.bid + 1) * U) / (unsigned)F.G);
    int cur_h = -1;
    const int wave = tid >> 6, r32 = tid & 31;
    for (unsigned u = u0; u < u1; ++u) {
        int lo = 0, hi_ = 1024;
        while (hi_ - lo > 1) { const int mid = (lo + hi_) >> 1; if (pre[mid] <= u) lo = mid; else hi_ = mid; }
        const int g = lo, h = g >> 6, x = g & 63, tile = (int)(u - pre[g]);
        if (h != cur_h) { __syncthreads(); const float* bsrc = (const float*)(F.ws + WS_BIAS) + h * BIAS_LD; LAS float* btl = (LAS float*)(lds + at::OFF_BT);
            {
                const int wv_ = __builtin_amdgcn_readfirstlane(tid >> 6), ln_ = tid & 63;
#pragma unroll
                for (int j = 0; j < 4; ++j) __builtin_amdgcn_global_load_lds((const unsigned*)(bsrc + (j * 8 + wv_) * 256 + ln_ * 4), (LAS unsigned*)((LAS unsigned char*)btl + (j * 8 + wv_) * 1024), 16, 0, 0);
                if (wv_ == 0) __builtin_amdgcn_global_load_lds((const unsigned*)(bsrc + 32 * 256 + ln_ * 4), (LAS unsigned*)((LAS unsigned char*)btl + 32 * 1024), 16, 0, 0); }
            cur_h = h; }
        int q, dsti, jb;
        if (x < 32) { jb = x; const int n = (int)cl[h * 32 + x]; const int e = tile * 256 + wave * 32 + r32; const unsigned ent = list[(size_t)(h * 32 + x) * 8192 + (e < n ? e : n - 1)];
            q = (int)(ent >> 2); dsti = e < n ? (q * NH + h) * 4 + (int)(ent & 3u) : -1; }
        else { jb = x - 32; q = jb * BLK + wave * 32 + r32; dsti = (q * NH + h) * 4 + 3; }
        at::attn_unit((const bf16*)(F.ws + WS_QKV), h, jb, q, dsti, lds, (unsigned*)(F.ws + WS_HID), (float*)(F.ws + WS_LSE), tid);
    }
}
template <bool OWN>
__device__ __forceinline__ void attn_phase(const Args& A, Frame& F, int ja) {
    using namespace at;
    int tid = F.wave * 64 + lane_id_v(); asm volatile("" : "+v"(tid));
    const int wid = tid >> 6, lane = tid & 63, r32 = lane & 31, hi = lane >> 5;
    const bf16* __restrict__ QKV = (const bf16*)(F.ws + WS_QKV);
    const unsigned* cnt = (const unsigned*)(F.ctl + CW_CNT + ja * 512); const unsigned* list = (const unsigned*)(F.ws + WS_LIST);
    unsigned* __restrict__ PART = (unsigned*)(F.ws + WS_HID); float* __restrict__ LSE = (float*)(F.ws + WS_LSE); bf16* __restrict__ AO = (bf16*)(F.ws + WS_AO);
    LAS unsigned char* lds = F.lds + RING_OFF;
    LAS unsigned char* V_lds = lds + OFF_V; LAS unsigned char* K_lds = lds + OFF_K;
    LAS float* ws = (LAS float*)(lds + OFF_WS) + wid * 64; LAS float* li_l = ws; LAS float* al_l = ws + 32;
    LAS int* dst_l = (LAS int*)(lds + OFF_DST) + wid * 32;
    LAS float* btl = (LAS float*)(lds + OFF_BT);
    LAS unsigned* pre = (LAS unsigned*)(lds + OFF_PRE);
    LAS unsigned* cl = (LAS unsigned*)(lds + OFF_CL);
    unsigned u0, u1;
    if (!OWN) {
        const unsigned n0 = (__hip_atomic_load(cnt + tid, RLX_AGENT));
        cl[tid] = n0;
        unsigned v = (n0 + 255u) >> 8; const unsigned mine = v;
#pragma unroll
        for (int o = 1; o < 64; o <<= 1) { const unsigned t = __shfl_up(v, o); if (lane >= o) v += t; }
        LAS unsigned* wt = (LAS unsigned*)(lds + OFF_WT);
        if (lane == 63) wt[wid] = v;
        __syncthreads();
        unsigned base = 0;
        for (int w = 0; w < wid; ++w) base += wt[w];
        pre[tid] = base + v - mine;
        if (tid == NWAVES * 64 - 1) pre[512] = base + v;
        __syncthreads();
        const unsigned U = pre[512];
        u0 = (unsigned)(((unsigned long long)F.bid * U) / (unsigned)F.G); u1 = (unsigned)(((unsigned long long)(F.bid + 1) * U) / (unsigned)F.G);
    } else { u0 = 0; u1 = (512 - F.bid + F.G - 1) / F.G; }
    const int sr = tid >> 4, sc = (tid & 15) * 8, vst0 = v_st(sr, sc), vst1 = v_st(32 + sr, sc);
    const int vb0 = (int)(uintptr_t)V_lds + v_rd_base(lane);
    struct { bf16x8 vs0, vs1, ks0, ks1; } sr_[2];
    bf16x8 qr[8];
    int h = 0, jb = 0, q = 0, dsti = -1;
#define DECODE(u_, h_, jb_, q_, d_) do { if (OWN) { const int gu = F.bid + (int)(u_) * F.G; h_ = gu >> 5; jb_ = gu & 31; q_ = jb_ * BLK + wid * 32 + r32; d_ = 0; } \
    else { int lo = 0, hi_ = 512; while (hi_ - lo > 1) { const int mid = (lo + hi_) >> 1; if (pre[mid] <= (u_)) lo = mid; else hi_ = mid; } \
        h_ = lo >> 5; jb_ = lo & 31; const int n_ = (int)cl[lo], e_ = (int)((u_) - pre[lo]) * 256 + wid * 32 + r32; \
        const unsigned ent_ = list[(size_t)lo * 8192 + (e_ < n_ ? e_ : n_ - 1)]; q_ = (int)(ent_ >> 2); d_ = e_ < n_ ? (q_ * NH + h_) * 4 + (int)(ent_ & 3u) : -1; } } while (0)
#define KVPTR(h_, jb_) (QKV + (size_t)((jb_) * BLK) * LDK + DM + (h_) * HD)
#define SLOAD(i, kp, k0) do { const bf16* kp_ = (kp); sr_[i].vs0 = *reinterpret_cast<const bf16x8*>(&kp_[DM + (size_t)((k0) + sr) * LDK + sc]); sr_[i].vs1 = *reinterpret_cast<const bf16x8*>(&kp_[DM + (size_t)((k0) + 32 + sr) * LDK + sc]); \
    sr_[i].ks0 = *reinterpret_cast<const bf16x8*>(&kp_[(size_t)((k0) + sr) * LDK + sc]); sr_[i].ks1 = *reinterpret_cast<const bf16x8*>(&kp_[(size_t)((k0) + 32 + sr) * LDK + sc]); } while (0)
#define QLOAD(h_, q_) do { const bf16* Qw_ = QKV + (size_t)(q_) * LDK + (h_) * HD + hi * 8; _Pragma("unroll") for (int d0 = 0; d0 < 8; ++d0) qr[d0] = *reinterpret_cast<const bf16x8*>(Qw_ + d0 * 16); } while (0)
#define SWRITE(b, i) do { *(LAS bf16x8*)(V_lds + (b) * SHM_V + vst0) = sr_[i].vs0; *(LAS bf16x8*)(V_lds + (b) * SHM_V + vst1) = sr_[i].vs1; const int kc = sc * 2; \
    *(LAS bf16x8*)(K_lds + (b) * SHM_K + KSWZ(sr, kc)) = sr_[i].ks0; *(LAS bf16x8*)(K_lds + (b) * SHM_K + KSWZ(32 + sr, kc)) = sr_[i].ks1; } while (0)
#define SWAIT() asm volatile("s_waitcnt vmcnt(4)" ::: "memory")
#define RESC(a) do { if (__any((a) < 1.f)) { if (hi == 0) al_l[r32] = (a); asm volatile("s_waitcnt lgkmcnt(0)" ::: "memory"); \
    _Pragma("unroll") for (int d = 0; d < 4; ++d) _Pragma("unroll") for (int r = 0; r < 16; ++r) o[d][r] *= al_l[crow(r, hi)]; } } while (0)
    if (u0 < u1) { DECODE(u0, h, jb, q, dsti); }
    int cur_h = -1;
    for (unsigned u = u0; u < u1; ++u) {
        if (h != cur_h) { const float* bsrc = (const float*)(F.ws + WS_BIAS) + h * BIAS_LD;
            {
                const int wv_ = __builtin_amdgcn_readfirstlane(tid >> 6), ln_ = tid & 63;
#pragma unroll
                for (int j = 0; j < 4; ++j) __builtin_amdgcn_global_load_lds((const unsigned*)(bsrc + (j * 8 + wv_) * 256 + ln_ * 4), (LAS unsigned*)((LAS unsigned char*)btl + (j * 8 + wv_) * 1024), 16, 0, 0);
                if (wv_ == 0) __builtin_amdgcn_global_load_lds((const unsigned*)(bsrc + 32 * 256 + ln_ * 4), (LAS unsigned*)((LAS unsigned char*)btl + 32 * 1024), 16, 0, 0); }
            cur_h = h; }
        const bf16* Kp = KVPTR(h, jb); QLOAD(h, q); SLOAD(0, Kp, 0);
        float m_reg = -1e30f, l_reg = 0; f32x16 o[4] = {};
        if (hi == 0) dst_l[r32] = dsti;
        const LAS float* bp0 = btl + (q - jb * BLK - 4 * hi + 256 - 59);
        f32x16 pA0, pA1, pB0, pB1; float alA, alB; bf16x8 pa0, pa1, pa2, pa3;
        asm volatile("s_waitcnt vmcnt(0)" ::: "memory"); SWRITE(0, 0); __syncthreads();
        qkt(pA0, pA1, K_lds, qr, r32, hi); partialSM(pA0, pA1, bp0, m_reg, alA);
        SLOAD(1, Kp, KVBLK); SLOAD(0, Kp, 2 * KVBLK);
        SWAIT(); SWRITE(1, 1); __syncthreads();
        SBAR(); qkt(pB0, pB1, K_lds + SHM_K, qr, r32, hi);
        finishSM(pA0, pA1, alA, l_reg, pa0, pa1, pa2, pa3); SBAR();
        SLOAD(1, Kp, 3 * KVBLK); SBAR();
        pv_d0(o, vb0, pa0, pa1, pa2, pa3); partialSM(pB0, pB1, bp0 - 64, m_reg, alB);
        __syncthreads(); SWAIT(); SWRITE(0, 0);
        RESC(alB); __syncthreads();
        SBAR(); qkt(pA0, pA1, K_lds, qr, r32, hi);
        finishSM(pB0, pB1, alB, l_reg, pa0, pa1, pa2, pa3); SBAR();
        pv_d0(o, vb0 + SHM_V, pa0, pa1, pa2, pa3); partialSM(pA0, pA1, bp0 - 128, m_reg, alA);
        __syncthreads(); asm volatile("s_waitcnt vmcnt(0)" ::: "memory"); SWRITE(1, 1);
        RESC(alA); __syncthreads();
        SBAR(); qkt(pB0, pB1, K_lds + SHM_K, qr, r32, hi); SBAR();
        int hn = h, jbn = jb, qn = q, dn = -1;
        if (u + 1 < u1) { DECODE(u + 1, hn, jbn, qn, dn); }
        SBAR();
        finishSM(pA0, pA1, alA, l_reg, pa0, pa1, pa2, pa3); SBAR();
        pv_d0(o, vb0, pa0, pa1, pa2, pa3); partialSM(pB0, pB1, bp0 - 192, m_reg, alB);

        RESC(alB);
        finishSM(pB0, pB1, alB, l_reg, pa0, pa1, pa2, pa3); SBAR();
        pv_d0(o, vb0 + SHM_V, pa0, pa1, pa2, pa3);
        asm volatile("s_waitcnt vmcnt(0)" ::: "memory");
        if (!OWN) {
            if (hi == 0) { li_l[r32] = l_reg; if (dsti >= 0) LSE[dsti] = m_reg + __builtin_amdgcn_logf(l_reg); }
            asm volatile("s_waitcnt lgkmcnt(0)" ::: "memory");
#pragma unroll
            for (int r = 0; r < 16; ++r) { const int row = crow(r, hi); const float rl = __builtin_amdgcn_rcpf(li_l[row]); const int ds = dst_l[row];
                if (ds >= 0) { unsigned* pp = PART + (size_t)ds * 64 + r32; pp[0] = cvtpk(o[0][r] * rl, o[1][r] * rl); pp[32] = cvtpk(o[2][r] * rl, o[3][r] * rl); } }
        } else {
            if (hi == 0) { li_l[r32] = l_reg; al_l[r32] = m_reg; }
            asm volatile("s_waitcnt lgkmcnt(0)" ::: "memory");
#pragma unroll
            for (int hf = 0; hf < 2; ++hf) {
                float wo[8], w0[8], w1[8], w2[8];
                {   f32x4 ls[8];
#pragma unroll
                    for (int rr = 0; rr < 8; ++rr) { const int row = crow(hf * 8 + rr, hi); ls[rr] = *(const f32x4*)(LSE + ((size_t)(jb * BLK + wid * 32 + row) * NH + h) * 4); }
#pragma unroll
                    for (int rr = 0; rr < 8; ++rr) { const int row = crow(hf * 8 + rr, hi); const float lrow = li_l[row], lown = al_l[row] + __builtin_amdgcn_logf(lrow);
                        const float M = fmaxf(fmaxf(lown, ls[rr][0]), fmaxf(ls[rr][1], ls[rr][2]));
                        const float eo = __builtin_amdgcn_exp2f(lown - M), e0 = __builtin_amdgcn_exp2f(ls[rr][0] - M), e1 = __builtin_amdgcn_exp2f(ls[rr][1] - M), e2 = __builtin_amdgcn_exp2f(ls[rr][2] - M);
                        const float iw = __builtin_amdgcn_rcpf((eo + e0) + (e1 + e2));
                        wo[rr] = eo * iw * __builtin_amdgcn_rcpf(lrow); w0[rr] = e0 * iw; w1[rr] = e1 * iw; w2[rr] = e2 * iw; } }
#pragma unroll
                for (int g4 = 0; g4 < 2; ++g4) {
                    unsigned pu[4][3][2];
#pragma unroll
                    for (int r4 = 0; r4 < 4; ++r4) { const int rr = g4 * 4 + r4, row = crow(hf * 8 + rr, hi); const unsigned* pp = PART + ((size_t)(jb * BLK + wid * 32 + row) * NH + h) * 256 + r32;
                        pu[r4][0][0] = w0[rr] > 0.f ? pp[0] : 0u; pu[r4][0][1] = w0[rr] > 0.f ? pp[32] : 0u;
                        pu[r4][1][0] = w1[rr] > 0.f ? pp[64] : 0u; pu[r4][1][1] = w1[rr] > 0.f ? pp[96] : 0u;
                        pu[r4][2][0] = w2[rr] > 0.f ? pp[128] : 0u; pu[r4][2][1] = w2[rr] > 0.f ? pp[160] : 0u; }
#pragma unroll
                    for (int r4 = 0; r4 < 4; ++r4) { const int rr = g4 * 4 + r4, r = hf * 8 + rr, row = crow(r, hi);
                        float a0 = o[0][r] * wo[rr], a1 = o[1][r] * wo[rr], a2 = o[2][r] * wo[rr], a3 = o[3][r] * wo[rr];
                        a0 += w0[rr] * bflo(pu[r4][0][0]) + w1[rr] * bflo(pu[r4][1][0]) + w2[rr] * bflo(pu[r4][2][0]);
                        a1 += w0[rr] * bfhi(pu[r4][0][0]) + w1[rr] * bfhi(pu[r4][1][0]) + w2[rr] * bfhi(pu[r4][2][0]);
                        a2 += w0[rr] * bflo(pu[r4][0][1]) + w1[rr] * bflo(pu[r4][1][1]) + w2[rr] * bflo(pu[r4][2][1]);
                        a3 += w0[rr] * bfhi(pu[r4][0][1]) + w1[rr] * bfhi(pu[r4][1][1]) + w2[rr] * bfhi(pu[r4][2][1]);
                        bf16* op = AO + (size_t)(jb * BLK + wid * 32 + row) * DM + h * HD + r32;
                        op[0] = (bf16)(cvtpk(a0, a0) & 0xffffu); op[32] = (bf16)(cvtpk(a1, a1) & 0xffffu); op[64] = (bf16)(cvtpk(a2, a2) & 0xffffu); op[96] = (bf16)(cvtpk(a3, a3) & 0xffffu); }
                }
            }
        }
        __syncthreads();
        h = hn; jb = jbn; q = qn; dsti = dn;
    }
#undef DECODE
#undef KVPTR
#undef SLOAD
#undef QLOAD
#undef SWRITE
#undef SWAIT
#undef RESC
}
namespace at3 {
using namespace at;
constexpr int O_K = 0, O_V = 65536, O_BT = 131072, O_WS = O_BT + BIAS_LD * 2, O_PRE = O_WS + 8 * 384, O_CL = O_PRE + 516 * 4, O_WT = O_CL + 512 * 4, O_END = O_WT + 64;
static_assert(O_END <= RING_BYTES, "attention LDS map");
__device__ __forceinline__ void sm_tile(f32x16& p0, f32x16& p1, const LAS unsigned short* bp, float& m_reg, float& l_reg, f32x16 (&o)[4], bf16x8& pa0, bf16x8& pa1, bf16x8& pa2, bf16x8& pa3, LAS float* al_l, int r32, int hi) {
    constexpr float C = 0.088388347648318440f * 1.4426950408889634f;
#pragma unroll
    for (int r = 0; r < 16; ++r) p0[r] = fmaf(p0[r], C, __builtin_bit_cast(float, (unsigned)bp[59 - ((r & 3) + 8 * (r >> 2))] << 16));
#pragma unroll
    for (int r = 0; r < 16; ++r) p1[r] = fmaf(p1[r], C, __builtin_bit_cast(float, (unsigned)bp[27 - ((r & 3) + 8 * (r >> 2))] << 16));
    float pmax = p0[0];
#pragma unroll
    for (int r = 1; r < 16; ++r) pmax = fmaxf(pmax, p0[r]);
#pragma unroll
    for (int r = 0; r < 16; ++r) pmax = fmaxf(pmax, p1[r]);
    { auto rr = __builtin_amdgcn_permlane32_swap(__float_as_uint(pmax), __float_as_uint(pmax), false, false); pmax = fmaxf(__uint_as_float(rr[0]), __uint_as_float(rr[1])); }
    float mn = m_reg, alpha = 1.f;
    if (!__all(pmax <= m_reg + 8.0f)) { const bool up = pmax > m_reg + 8.0f;
        mn = up ? pmax : m_reg; alpha = up ? __builtin_amdgcn_exp2f(m_reg - mn) : 1.f; m_reg = mn; }
#pragma unroll
    for (int r = 0; r < 16; ++r) p0[r] = __builtin_amdgcn_exp2f(p0[r] - mn);
#pragma unroll
    for (int r = 0; r < 16; ++r) p1[r] = __builtin_amdgcn_exp2f(p1[r] - mn);
    float ps = 0;
#pragma unroll
    for (int r = 0; r < 16; ++r) ps += p0[r];
#pragma unroll
    for (int r = 0; r < 16; ++r) ps += p1[r];
    { auto rr = __builtin_amdgcn_permlane32_swap(__float_as_uint(ps), __float_as_uint(ps), false, false); ps = __uint_as_float(rr[0]) + __uint_as_float(rr[1]); }
    l_reg = l_reg * alpha + ps;
#define PK4(P, BASE, OUT) do { unsigned a0 = cvtpk(P[BASE + 0], P[BASE + 1]), a1 = cvtpk(P[BASE + 2], P[BASE + 3]);   \
    unsigned b0 = cvtpk(P[BASE + 4], P[BASE + 5]), b1 = cvtpk(P[BASE + 6], P[BASE + 7]);                              \
    auto r0 = __builtin_amdgcn_permlane32_swap(a0, b0, false, false); auto r1 = __builtin_amdgcn_permlane32_swap(a1, b1, false, false); \
    u32x4 w = {r0[0], r1[0], r0[1], r1[1]}; OUT = *reinterpret_cast<bf16x8*>(&w); } while (0)
    PK4(p0, 0, pa0); PK4(p0, 8, pa1); PK4(p1, 0, pa2); PK4(p1, 8, pa3);
#undef PK4
    if (__any(alpha < 1.f)) { if (hi == 0) al_l[r32] = alpha; asm volatile("s_waitcnt lgkmcnt(0)" ::: "memory");
#pragma unroll
        for (int d = 0; d < 4; ++d)
#pragma unroll
            for (int r = 0; r < 16; ++r) o[d][r] *= al_l[crow(r, hi)]; }
}
__device__ __forceinline__ void load_kv_block(const bf16* __restrict__ QKV, int h, int jb, LAS unsigned char* lds, int tid) {
    const bf16* Kp = QKV + (size_t)(jb * BLK) * LDK + DM + h * HD;
    bf16x8 kv[8], vv[8];
#pragma unroll
    for (int i = 0; i < 8; ++i) { const int p = tid + 512 * i, row = p >> 4, c16 = p & 15; kv[i] = *reinterpret_cast<const bf16x8*>(Kp + (size_t)row * LDK + c16 * 8); vv[i] = *reinterpret_cast<const bf16x8*>(Kp + DM + (size_t)row * LDK + c16 * 8); }
#pragma unroll
    for (int i = 0; i < 8; ++i) { const int p = tid + 512 * i, row = p >> 4, c16 = p & 15, t = row >> 6, rl = row & 63;
        *(LAS bf16x8*)(lds + O_K + t * 16384 + KSWZ(rl, c16 * 16)) = kv[i]; *(LAS bf16x8*)(lds + O_V + t * 16384 + v_st(rl, c16 * 8)) = vv[i]; }
}
}
template <bool OWN>
__device__ __forceinline__ void attn_phase3(const Args& A, Frame& F, int ja) {
    using namespace at3;
    int tid = F.wave * 64 + lane_id_v(); asm volatile("" : "+v"(tid));
    const int wid = __builtin_amdgcn_readfirstlane(tid >> 6), lane = tid & 63, r32 = lane & 31, hi = lane >> 5;
    const bf16* __restrict__ QKV = (const bf16*)(F.ws + WS_QKV);
    const unsigned* cnt = (const unsigned*)(F.ctl + CW_CNT + ja * 512); const unsigned* list = (const unsigned*)(F.ws + WS_LIST);
    unsigned* __restrict__ PART = (unsigned*)(F.ws + WS_HID); float* __restrict__ LSE = (float*)(F.ws + WS_LSE); bf16* __restrict__ AO = (bf16*)(F.ws + WS_AO);
    LAS unsigned char* lds = F.lds + RING_OFF;
    LAS float* li_l = (LAS float*)(lds + O_WS + wid * 384); LAS float* al_l = li_l + 32; LAS int* dst_l = (LAS int*)(li_l + 64);
    LAS unsigned short* btl = (LAS unsigned short*)(lds + O_BT);
    LAS unsigned* pre = (LAS unsigned*)(lds + O_PRE); LAS unsigned* cl = (LAS unsigned*)(lds + O_CL);
    const int vb0 = (int)(uintptr_t)(lds + O_V) + v_rd_base(lane);
    unsigned s0 = 0, s1 = 0;
    if (!OWN) {
        const unsigned n0 = __hip_atomic_load(cnt + tid, RLX_AGENT); cl[tid] = n0;
        unsigned v = (n0 + 31u) >> 5; const unsigned mine = v;
#pragma unroll
        for (int o = 1; o < 64; o <<= 1) { const unsigned t = __shfl_up(v, o); if (lane >= o) v += t; }
        LAS unsigned* wt = (LAS unsigned*)(lds + O_WT);
        if (lane == 63) wt[wid] = v;
        __syncthreads();
        unsigned base = 0;
        for (int w = 0; w < wid; ++w) base += wt[w];
        pre[tid] = base + v - mine;
        if (tid == NWAVES * 64 - 1) pre[512] = base + v;
        __syncthreads();
        const unsigned ST = pre[512];
        s0 = (unsigned)(((unsigned long long)F.bid * ST) / (unsigned)F.G); s1 = (unsigned)(((unsigned long long)(F.bid + 1) * ST) / (unsigned)F.G);
    } else { s0 = 0; s1 = (512 - F.bid + F.G - 1) / F.G; }
    int cur_h = -1;
    while (s0 < s1) {
        int h, jb; unsigned seg_end, gbase = 0; int n_g = 0, g = 0;
        if (!OWN) { int lo = 0, hi_ = 512; while (hi_ - lo > 1) { const int mid = (lo + hi_) >> 1; if (pre[mid] <= s0) lo = mid; else hi_ = mid; }
            g = lo; h = g >> 5; jb = g & 31; gbase = pre[g]; n_g = (int)cl[g]; const unsigned ge = pre[g + 1]; seg_end = ge < s1 ? ge : s1; }
        else { const int gu = F.bid + (int)s0 * F.G; h = gu & 15; jb = gu >> 4; seg_end = s0 + 1; }
        __syncthreads();
        if (h != cur_h) { const float* bsrc = (const float*)(F.ws + WS_BIAS) + h * BIAS_LD;
            {
                const int ln_ = tid & 63;
#pragma unroll
                for (int j = 0; j < 4; ++j) __builtin_amdgcn_global_load_lds((const unsigned*)(bsrc + (j * 8 + wid) * 256 + ln_ * 4), (LAS unsigned*)(lds + O_K + (j * 8 + wid) * 1024), 16, 0, 0);
                if (wid == 0) __builtin_amdgcn_global_load_lds((const unsigned*)(bsrc + 32 * 256 + ln_ * 4), (LAS unsigned*)(lds + O_K + 32 * 1024), 16, 0, 0);
                asm volatile("s_waitcnt vmcnt(0)" ::: "memory"); __syncthreads();
                for (int i = tid; i < BIAS_LD; i += NWAVES * 64) btl[i] = (unsigned short)f2bf(((const LAS float*)(lds + O_K))[i]);
                __syncthreads(); }
            cur_h = h; }
        load_kv_block(QKV, h, jb, lds, tid);
        __syncthreads();
        const unsigned st_first = OWN ? 0u : s0 + (unsigned)wid, st_step = 8u;
        for (unsigned st = st_first; OWN ? st < 1u : st < seg_end; st += st_step) {
            int q, dsti, nt;
            if (!OWN) { const int e = (int)(st - gbase) * 32 + r32; const unsigned ent = list[(size_t)g * 8192 + (e < n_g ? e : n_g - 1)];
                q = (int)(ent >> 2); dsti = e < n_g ? (q * NH + h) * 4 + (int)(ent & 3u) : -1; nt = 4; }
            else { const int sub = wid < 4 ? 7 - wid : wid - 4; q = jb * BLK + sub * 32 + r32; dsti = 0; nt = (sub >> 1) + 1; }
            bf16x8 qr[8];
            { const bf16* Qw = QKV + (size_t)q * LDK + h * HD + hi * 8;
#pragma unroll
              for (int d0 = 0; d0 < 8; ++d0) qr[d0] = *reinterpret_cast<const bf16x8*>(Qw + d0 * 16); }
            if (!OWN) { if (hi == 0) dst_l[r32] = dsti; }
            const LAS unsigned short* bp0 = btl + (q - jb * BLK - 4 * hi + 256 - 59);
            float m_reg = -1e30f, l_reg = 0; f32x16 o[4] = {};
#pragma unroll 1
            for (int t = 0; t < nt; ++t) {
                f32x16 p0, p1; bf16x8 pa0, pa1, pa2, pa3;
                qkt(p0, p1, lds + O_K + t * 16384, qr, r32, hi);
                sm_tile(p0, p1, bp0 - 64 * t, m_reg, l_reg, o, pa0, pa1, pa2, pa3, al_l, r32, hi);
                pv_d0(o, vb0 + t * 16384, pa0, pa1, pa2, pa3);
            }
            if (!OWN) {
                if (hi == 0) { li_l[r32] = l_reg; if (dsti >= 0) LSE[dsti] = m_reg + __builtin_amdgcn_logf(l_reg); }
                asm volatile("s_waitcnt lgkmcnt(0)" ::: "memory");
#pragma unroll
                for (int r = 0; r < 16; ++r) { const int row = crow(r, hi); const float rl = __builtin_amdgcn_rcpf(li_l[row]); const int ds = dst_l[row];
                    if (ds >= 0) { unsigned* pp = PART + (size_t)ds * 64 + r32; pp[0] = cvtpk(o[0][r] * rl, o[1][r] * rl); pp[32] = cvtpk(o[2][r] * rl, o[3][r] * rl); } }
            } else {
                const int sub = wid < 4 ? 7 - wid : wid - 4, rowb = jb * BLK + sub * 32;
                if (hi == 0) { li_l[r32] = l_reg; al_l[r32] = m_reg; }
                asm volatile("s_waitcnt lgkmcnt(0)" ::: "memory");
#pragma unroll
                for (int hf = 0; hf < 2; ++hf) {
                    f32x4 ls[8]; unsigned pu[8][6];
#pragma unroll
                    for (int rr = 0; rr < 8; ++rr) { const int row = crow(hf * 8 + rr, hi); const size_t e = (size_t)(rowb + row) * NH + h;
                        ls[rr] = *(const f32x4*)(LSE + e * 4); const unsigned* pp = PART + e * 256 + r32;
                        pu[rr][0] = pp[0]; pu[rr][1] = pp[32]; pu[rr][2] = pp[64]; pu[rr][3] = pp[96]; pu[rr][4] = pp[128]; pu[rr][5] = pp[160]; }
#pragma unroll
                    for (int rr = 0; rr < 8; ++rr) { const int r = hf * 8 + rr, row = crow(r, hi); const float lrow = li_l[row], lown = al_l[row] + __builtin_amdgcn_logf(lrow);
                        const float M = fmaxf(fmaxf(lown, ls[rr][0]), fmaxf(ls[rr][1], ls[rr][2]));
                        const float eo = __builtin_amdgcn_exp2f(lown - M), e0 = __builtin_amdgcn_exp2f(ls[rr][0] - M), e1 = __builtin_amdgcn_exp2f(ls[rr][1] - M), e2 = __builtin_amdgcn_exp2f(ls[rr][2] - M);
                        const float iw = __builtin_amdgcn_rcpf((eo + e0) + (e1 + e2));
                        const float wo = eo * iw * __builtin_amdgcn_rcpf(lrow), w0 = e0 * iw, w1 = e1 * iw, w2 = e2 * iw;
                        const unsigned q00 = w0 > 0.f ? pu[rr][0] : 0u, q01 = w0 > 0.f ? pu[rr][1] : 0u, q10 = w1 > 0.f ? pu[rr][2] : 0u, q11 = w1 > 0.f ? pu[rr][3] : 0u, q20 = w2 > 0.f ? pu[rr][4] : 0u, q21 = w2 > 0.f ? pu[rr][5] : 0u;
                        const float a0 = o[0][r] * wo + (w0 * bflo(q00) + w1 * bflo(q10) + w2 * bflo(q20));
                        const float a1 = o[1][r] * wo + (w0 * bfhi(q00) + w1 * bfhi(q10) + w2 * bfhi(q20));
                        const float a2 = o[2][r] * wo + (w0 * bflo(q01) + w1 * bflo(q11) + w2 * bflo(q21));
                        const float a3 = o[3][r] * wo + (w0 * bfhi(q01) + w1 * bfhi(q11) + w2 * bfhi(q21));
                        bf16* op = AO + (size_t)(rowb + row) * DM + h * HD + r32;
                        op[0] = (bf16)(cvtpk(a0, a0) & 0xffffu); op[32] = (bf16)(cvtpk(a1, a1) & 0xffffu); op[64] = (bf16)(cvtpk(a2, a2) & 0xffffu); op[96] = (bf16)(cvtpk(a3, a3) & 0xffffu); }
                }
            }
        }
        s0 = seg_end;
    }
}
#define TOP3_INS2(x_, j_) do { const float x__ = (x_); const int j__ = (j_); \
    const bool b0 = x__ > v0 || (x__ == v0 && (unsigned)j__ < (unsigned)i0), b1 = x__ > v1 || (x__ == v1 && (unsigned)j__ < (unsigned)i1), b2 = x__ > v2 || (x__ == v2 && (unsigned)j__ < (unsigned)i2); \
    v2 = b1 ? v1 : (b2 ? x__ : v2); i2 = b1 ? i1 : (b2 ? j__ : i2); v1 = b0 ? v0 : (b1 ? x__ : v1); i1 = b0 ? i0 : (b1 ? j__ : i1); v0 = b0 ? x__ : v0; i0 = b0 ? j__ : i0; } while (0)
__device__ __forceinline__ void phase_gate2(const Args& A, Frame& F, int ja) {
    using namespace at;
    int tid = F.wave * 64 + lane_id_v(); asm volatile("" : "+v"(tid));
    const int lane = tid & 63, wave = tid >> 6, r32 = lane & 31, hi = lane >> 5;
    const bf16* QKV = (const bf16*)(F.ws + WS_QKV); const float* KMP = (const float*)(F.ws + WS_KMP);
    unsigned* cnt = (unsigned*)(F.ctl + CW_CNT + ja * 512); unsigned* list = (unsigned*)(F.ws + WS_LIST); float* LSE = (float*)(F.ws + WS_LSE);
    LAS unsigned* lc = (LAS unsigned*)(F.lds + RING_OFF);
    for (int u = F.bid; u < 512; u += F.G) {
        const int h = u & 15, c = u >> 4;
        __syncthreads();
        if (tid < 64) lc[tid] = 0u;
        __syncthreads();
        const int q = c * 256 + wave * 32 + r32;
        int i0 = -1, i1 = -1, i2 = -1;
        if (c > 0) {
            bf16x8 kh[8], kl[8], qr[8];
            const bf16* Qw = QKV + (size_t)q * NQKV + h * HD + hi * 8;
#pragma unroll
            for (int d0 = 0; d0 < 8; ++d0) qr[d0] = *reinterpret_cast<const bf16x8*>(Qw + d0 * 16);
#pragma unroll
            for (int d0 = 0; d0 < 8; ++d0) { const float* p0 = KMP + (size_t)r32 * 2048 + h * HD + d0 * 16 + hi * 8; const float* p1 = p0 + (size_t)32 * 2048;
                const f32x4 a0 = *(const f32x4*)p0 + *(const f32x4*)p1, a1 = *(const f32x4*)(p0 + 4) + *(const f32x4*)(p1 + 4);
                float v[8] = {a0[0], a0[1], a0[2], a0[3], a1[0], a1[1], a1[2], a1[3]}; unsigned hh[4], ll[4];
#pragma unroll
                for (int e = 0; e < 4; ++e) { const float x0 = v[2 * e] * (1.0f / 256.0f), x1 = v[2 * e + 1] * (1.0f / 256.0f); const unsigned ph = cvtpk(x0, x1); hh[e] = ph;
                    ll[e] = cvtpk(x0 - bflo(ph), x1 - bfhi(ph)); }
                u32x4 wh = {hh[0], hh[1], hh[2], hh[3]}, wl_ = {ll[0], ll[1], ll[2], ll[3]};
                kh[d0] = *reinterpret_cast<bf16x8*>(&wh); kl[d0] = *reinterpret_cast<bf16x8*>(&wl_); }
            f32x16 Gt = {};
#pragma unroll
            for (int d0 = 0; d0 < 8; ++d0) { Gt = __builtin_amdgcn_mfma_f32_32x32x16_bf16(kh[d0], qr[d0], Gt, 0, 0, 0); Gt = __builtin_amdgcn_mfma_f32_32x32x16_bf16(kl[d0], qr[d0], Gt, 0, 0, 0); }
            float v0 = -INFINITY, v1 = -INFINITY, v2 = -INFINITY;
#pragma unroll
            for (int r = 0; r < 16; ++r) { const int jb = crow(r, hi); if (jb < c) TOP3_INS2(Gt[r], jb); }
            const float pv0 = __shfl_xor(v0, 32), pv1 = __shfl_xor(v1, 32), pv2 = __shfl_xor(v2, 32);
            const int pi0 = __shfl_xor(i0, 32), pi1 = __shfl_xor(i1, 32), pi2 = __shfl_xor(i2, 32);
            if (pi0 >= 0) TOP3_INS2(pv0, pi0);
            if (pi1 >= 0) TOP3_INS2(pv1, pi1);
            if (pi2 >= 0) TOP3_INS2(pv2, pi2);
        }
        unsigned lp0 = 0, lp1 = 0, lp2 = 0;
        if (hi == 0) { if (i0 >= 0) lp0 = atomicAdd((unsigned*)(lc + i0), 1u); if (i1 >= 0) lp1 = atomicAdd((unsigned*)(lc + i1), 1u); if (i2 >= 0) lp2 = atomicAdd((unsigned*)(lc + i2), 1u); }
        __syncthreads();
        if (tid < 32) { const unsigned n = lc[tid]; lc[32 + tid] = n ? atomicAdd(&cnt[h * 32 + tid], n) : 0u; }
        __syncthreads();
        if (hi == 0) {
#define EMIT_PICK(k_, sj_, lp_) do { if ((sj_) >= 0) list[(size_t)(h * 32 + (sj_)) * 8192 + lc[32 + (sj_)] + (lp_)] = ((unsigned)q << 2) | (unsigned)(k_); \
                else LSE[((size_t)q * NH + h) * 4 + (k_)] = -INFINITY; } while (0)
            EMIT_PICK(0, i0, lp0); EMIT_PICK(1, i1, lp1); EMIT_PICK(2, i2, lp2);
#undef EMIT_PICK
        }
    }
}
__device__ __forceinline__ void phase_combine(const Args& A, Frame& F) {
    int tid = F.wave * 64 + lane_id_v(); asm volatile("" : "+v"(tid)); const int lane = tid & 63, wave = __builtin_amdgcn_readfirstlane(tid >> 6); (void)lane; (void)wave;
    const unsigned* PART = (const unsigned*)(F.ws + WS_HID); const float* LSE = (const float*)(F.ws + WS_LSE); bf16* AO = (bf16*)(F.ws + WS_AO);
    const int gw = F.bid * NWAVES + wave, NGW = F.G * NWAVES, l = lane;
    for (int e = gw; e < S * NH; e += NGW) {
        const f32x4 ls = *(const f32x4*)(LSE + (size_t)e * 4);
        const float M = fmaxf(fmaxf(ls[0], ls[1]), fmaxf(ls[2], ls[3]));
        float o0 = 0.f, o1 = 0.f, W = 0.f;
#pragma unroll
        for (int k = 0; k < 4; ++k) { const float w = __builtin_amdgcn_exp2f(ls[k] - M);
            if (w > 0.f) { const unsigned u = PART[((size_t)e * 4 + k) * 64 + l]; o0 += w * bflo(u); o1 += w * bfhi(u); W += w; } }
        const float inv = 1.0f / W; const int q = e >> 4, h = e & 15, c0 = 64 * (l >> 5) + (l & 31);
        bf16* op = AO + (size_t)q * DM + h * HD;
        op[c0] = (bf16)f2bf(o0 * inv); op[c0 + 32] = (bf16)f2bf(o1 * inv);
    }
}
__device__ __forceinline__ float sigmoidf_(float x) { return 1.0f / (1.0f + __expf(-x)); }
__device__ __forceinline__ void phase_rec_ab(const Args& A, Frame& F, int jr) {
    int tid = F.wave * 64 + lane_id_v(); asm volatile("" : "+v"(tid)); const int lane = tid & 63, wave = __builtin_amdgcn_readfirstlane(tid >> 6); (void)lane; (void)wave;
    const bf16* XR = (const bf16*)(F.ws + WS_QKV);
    const float* cw = A.in[8] + (size_t)jr * 4 * DM; const float* cb = A.in[9] + (size_t)jr * DM;
    const float* wrg = A.in[10] + (size_t)jr * 16 * 128 * 128; const float* brg = A.in[11] + (size_t)jr * DM;
    const float* wig = A.in[12] + (size_t)jr * 16 * 128 * 128; const float* big = A.in[13] + (size_t)jr * DM; const float* lam = A.in[14] + (size_t)jr * DM;
    float* SA = (float*)(F.ws + WS_HID); float* SB = SA + (size_t)S * DM;
    LAS float* xc = (LAS float*)(F.lds + RING_OFF);
    for (int item = F.bid; item < 256 * 16; item += F.G) {
        const int tt = item >> 4, n = item & 15;
        for (int i = tid; i < 4096; i += NWAVES * 64) { const int r = i >> 7, cc = i & 127, t = tt * 32 + r, c = n * 128 + cc;
            float a = cb[c];
#pragma unroll
            for (int jj = 0; jj < 4; ++jj) { const int ts = t - 3 + jj; if (ts >= 0) a += bf2f(XR[(size_t)ts * DM + c]) * cw[jj * DM + c]; }
            xc[i] = a; }
        __syncthreads();
        const int cc = tid & 127, rg = tid >> 7, c = n * 128 + cc;
        float ar[8], ai[8];
#pragma unroll
        for (int i = 0; i < 8; ++i) { ar[i] = 0.f; ai[i] = 0.f; }
        const float* wr_ = wrg + (size_t)n * 128 * 128 + cc; const float* wi_ = wig + (size_t)n * 128 * 128 + cc;
        for (int k = 0; k < 128; ++k) { const float a = wr_[k * 128], b = wi_[k * 128];
#pragma unroll
            for (int i = 0; i < 8; ++i) { const float x = xc[(rg + 4 * i) * 128 + k]; ar[i] += x * a; ai[i] += x * b; } }
        const float lm = lam[c]; const float lsg = (fminf(lm, 0.f) - log1pf(__expf(-fabsf(lm)))) * 8.0f;
        const float b_r = brg[c], b_i = big[c];
#pragma unroll
        for (int i = 0; i < 8; ++i) { const int r = rg + 4 * i; const size_t o = (size_t)(tt * 32 + r) * DM + c;
            const float rr = sigmoidf_(ar[i] + b_r), ii = sigmoidf_(ai[i] + b_i), la = rr * lsg;
            SA[o] = __expf(la); SB[o] = sqrtf(-expm1f(2.0f * la)) * (ii * xc[r * 128 + cc]); }
        __syncthreads();
    }
}
__device__ __forceinline__ void phase_rec_ab2(const Args& A, Frame& F, int jr) {
    using namespace at;
    int tid = F.wave * 64 + lane_id_v(); asm volatile("" : "+v"(tid));
    const int lane = tid & 63, wave = tid >> 6, r32 = lane & 31, hi = lane >> 5;
    const bf16* XR = (const bf16*)(F.ws + WS_QKV);
    const float* cw = A.in[8] + (size_t)jr * 4 * DM; const float* cb = A.in[9] + (size_t)jr * DM;
    const float* brg = A.in[11] + (size_t)jr * DM; const float* big = A.in[13] + (size_t)jr * DM; const float* lam = A.in[14] + (size_t)jr * DM;
    const bf16* WG = (const bf16*)(F.ws + WS_WG) + (size_t)jr * 2 * 16 * 128 * 128;
    unsigned* SAB = (unsigned*)(F.ws + WS_HID);
    LAS unsigned char* xcl = F.lds + RING_OFF;
    LAS unsigned char* wl = F.lds + RING_OFF + 65536;
    LAS f32x2* comp = (LAS f32x2*)(F.lds + RING_OFF + 131072);
    int cur_n = -1;
    for (int u = F.bid; u < 512; u += F.G) {
        const int n = u & 15, tt = u >> 4;
        __syncthreads();
        if (n != cur_n) { cur_n = n;
#pragma unroll
            for (int i = 0; i < 8; ++i) { const int p = tid + i * 512, g = p >> 11, ch = (p >> 4) & 127, kc = p & 15;
                *(LAS v4u*)(wl + g * 32768 + KSWZ(ch, kc * 16)) = *(const v4u*)(WG + ((size_t)(g * 16 + n) * 128 + ch) * 128 + kc * 8); } }
        {
            const int chg = tid & 15, c0 = n * 128 + chg * 8;
            float w[4][8], b8[8];
#pragma unroll
            for (int jj = 0; jj < 4; ++jj) { const f32x4 x0 = *(const f32x4*)(cw + jj * DM + c0), x1 = *(const f32x4*)(cw + jj * DM + c0 + 4);
                w[jj][0] = x0[0]; w[jj][1] = x0[1]; w[jj][2] = x0[2]; w[jj][3] = x0[3]; w[jj][4] = x1[0]; w[jj][5] = x1[1]; w[jj][6] = x1[2]; w[jj][7] = x1[3]; }
            { const f32x4 x0 = *(const f32x4*)(cb + c0), x1 = *(const f32x4*)(cb + c0 + 4); b8[0] = x0[0]; b8[1] = x0[1]; b8[2] = x0[2]; b8[3] = x0[3]; b8[4] = x1[0]; b8[5] = x1[1]; b8[6] = x1[2]; b8[7] = x1[3]; }
#pragma unroll 4
            for (int ps = 0; ps < 8; ++ps) { const int rl = (tid >> 4) + 32 * ps, t = tt * 256 + rl;
                float acc[8];
#pragma unroll
                for (int e = 0; e < 8; ++e) acc[e] = b8[e];
#pragma unroll
                for (int jj = 0; jj < 4; ++jj) { const int ts = t - 3 + jj;
                    if (ts >= 0) { const v4u xv = *(const v4u*)(XR + (size_t)ts * DM + c0);
                        acc[0] += bflo(xv.x) * w[jj][0]; acc[1] += bfhi(xv.x) * w[jj][1]; acc[2] += bflo(xv.y) * w[jj][2]; acc[3] += bfhi(xv.y) * w[jj][3];
                        acc[4] += bflo(xv.z) * w[jj][4]; acc[5] += bfhi(xv.z) * w[jj][5]; acc[6] += bflo(xv.w) * w[jj][6]; acc[7] += bfhi(xv.w) * w[jj][7]; } }
                v4u o; o.x = cvtpk(acc[0], acc[1]); o.y = cvtpk(acc[2], acc[3]); o.z = cvtpk(acc[4], acc[5]); o.w = cvtpk(acc[6], acc[7]);
                *(LAS v4u*)(xcl + KSWZ(rl, chg * 16)) = o; }
        }
        __syncthreads();
        bf16x8 xf[8];
#pragma unroll
        for (int d0 = 0; d0 < 8; ++d0) xf[d0] = *(const LAS bf16x8*)(xcl + KSWZ(wave * 32 + r32, (d0 * 16 + hi * 8) * 2));
#pragma unroll 1
        for (int ct = 0; ct < 4; ++ct) {
            f32x16 aR = {}, aI = {};
#pragma unroll
            for (int d0 = 0; d0 < 8; ++d0) { const int cbo = (d0 * 16 + hi * 8) * 2;
                const bf16x8 wr_ = *(const LAS bf16x8*)(wl + KSWZ(ct * 32 + r32, cbo)), wi_ = *(const LAS bf16x8*)(wl + 32768 + KSWZ(ct * 32 + r32, cbo));
                aR = __builtin_amdgcn_mfma_f32_32x32x16_bf16(xf[d0], wr_, aR, 0, 0, 0);
                aI = __builtin_amdgcn_mfma_f32_32x32x16_bf16(xf[d0], wi_, aI, 0, 0, 0); }
            const int chl = ct * 32 + r32, ch = n * 128 + chl;
            const float lm = lam[ch], b_r = brg[ch], b_i = big[ch];
            const float lsg2 = (fminf(lm, 0.f) - log1pf(__expf(-fabsf(lm)))) * (8.0f * 1.4426950408889634f);
            float sA[4], sH[4];
#pragma unroll
            for (int r = 0; r < 16; ++r) { const int tl = wave * 32 + crow(r, hi);
                const float xcv = bf2f(*(const LAS unsigned short*)(xcl + KSWZ(tl, chl * 2)));
                const float rr = __builtin_amdgcn_rcpf(1.0f + __builtin_amdgcn_exp2f(-1.4426950408889634f * (aR[r] + b_r)));
                const float ii = __builtin_amdgcn_rcpf(1.0f + __builtin_amdgcn_exp2f(-1.4426950408889634f * (aI[r] + b_i)));
                const float la2 = rr * lsg2;
                const float av = __builtin_amdgcn_exp2f(la2);
                const float x2 = la2 * (2.0f * 0.6931471805599453f);
                const float ser = -x2 * (1.0f + x2 * (0.5f + x2 * (0.16666667f + x2 * 0.041666668f)));
                const float om = x2 > -0.1f ? ser : 1.0f - av * av;
                const size_t o = (size_t)(tt * 256 + tl) * DM + ch;
                const float bv = __builtin_amdgcn_sqrtf(om) * (ii * xcv);
                SAB[o] = cvtpk(la2, bv);
                const int sg = r >> 2; if ((r & 3) == 0) { sA[sg] = av; sH[sg] = bv; } else { sH[sg] = av * sH[sg] + bv; sA[sg] *= av; } }
            float cA = 1.f, cH = 0.f;
#pragma unroll
            for (int sg = 0; sg < 4; ++sg) { const float pA = __shfl_xor(sA[sg], 32), pH = __shfl_xor(sH[sg], 32);
                const float fA = hi ? pA : sA[sg], fH = hi ? pH : sH[sg], gA = hi ? sA[sg] : pA, gH = hi ? sH[sg] : pH;
                cH = fA * cH + fH; cA *= fA; cH = gA * cH + gH; cA *= gA; }
            if (hi == 0) comp[wave * 128 + chl] = (f32x2){cA, cH};
        }
        __syncthreads();
        { const int k = tid >> 7, chl = tid & 127; const f32x2 c0 = comp[(2 * k) * 128 + chl], c1 = comp[(2 * k + 1) * 128 + chl];
          float* CA = (float*)(F.ws + WS_CARRY); float* CH = CA + 128 * DM; const size_t o = (size_t)(tt * 4 + k) * DM + n * 128 + chl;
          CA[o] = c0.x * c1.x; CH[o] = c1.x * c0.y + c1.y; }
    }
}
__device__ __forceinline__ void phase_rec_tot(const Args& A, Frame& F) {
    int tid = F.wave * 64 + lane_id_v(); asm volatile("" : "+v"(tid)); const int lane = tid & 63, wave = __builtin_amdgcn_readfirstlane(tid >> 6); (void)lane; (void)wave;
    const float* SA = (const float*)(F.ws + WS_HID); const float* SB = SA + (size_t)S * DM; float* CA = (float*)(F.ws + WS_CARRY); float* CH = CA + 128 * DM;
    for (int i = F.bid * (NWAVES * 64) + tid; i < 128 * 1024; i += F.G * NWAVES * 64) { const int ch = i >> 10, c = (i & 1023) * 2;
        f32x2 A = (f32x2){1.f, 1.f}, H = (f32x2){0.f, 0.f};
#pragma unroll 8
        for (int r = 0; r < 64; ++r) { const size_t o = (size_t)(ch * 64 + r) * DM + c; const f32x2 a = *(const f32x2*)(SA + o), b = *(const f32x2*)(SB + o); H = a * H + b; A = A * a; }
        *(f32x2*)(CA + ch * DM + c) = A; *(f32x2*)(CH + ch * DM + c) = H; }
}
__device__ __forceinline__ void phase_rec_scan(const Args& A, Frame& F) {
    int tid = F.wave * 64 + lane_id_v(); asm volatile("" : "+v"(tid));
    const unsigned* SAB = (const unsigned*)(F.ws + WS_HID); const float* CA = (const float*)(F.ws + WS_CARRY); const float* CH = CA + 128 * DM;
    const bf16* GG = (const bf16*)(F.ws + WS_QKV + 32 * MiB); bf16* AO = (bf16*)(F.ws + WS_AO);
    for (int i = F.bid * (NWAVES * 64) + tid; i < 128 * 1024; i += F.G * NWAVES * 64) { const int ch = i >> 10, c = (i & 1023) * 2;
        f32x2 H = (f32x2){0.f, 0.f};
        int k = 0;
        for (; k + 16 <= ch; k += 16) { f32x2 a[16], b[16];
#pragma unroll
            for (int j = 0; j < 16; ++j) { a[j] = *(const f32x2*)(CA + (k + j) * DM + c); b[j] = *(const f32x2*)(CH + (k + j) * DM + c); }
#pragma unroll
            for (int j = 0; j < 16; ++j) H = a[j] * H + b[j]; }
        if (k + 8 <= ch) { f32x2 a[8], b[8];
#pragma unroll
            for (int j = 0; j < 8; ++j) { a[j] = *(const f32x2*)(CA + (k + j) * DM + c); b[j] = *(const f32x2*)(CH + (k + j) * DM + c); }
#pragma unroll
            for (int j = 0; j < 8; ++j) H = a[j] * H + b[j];
            k += 8; }
        for (; k < ch; ++k) { const f32x2 a = *(const f32x2*)(CA + k * DM + c), b = *(const f32x2*)(CH + k * DM + c); H = a * H + b; }
#pragma unroll 1
        for (int r0 = 0; r0 < 64; r0 += 32) { v2u x[32]; unsigned g[32];
#pragma unroll
            for (int j = 0; j < 32; ++j) { const size_t o = (size_t)(ch * 64 + r0 + j) * DM + c; x[j] = __builtin_nontemporal_load((const v2u*)(SAB + o)); g[j] = *(const unsigned*)(GG + o); }
#pragma unroll
            for (int j = 0; j < 32; ++j) { const size_t o = (size_t)(ch * 64 + r0 + j) * DM + c;
                const f32x2 a = (f32x2){__builtin_amdgcn_exp2f(bflo(x[j].x)), __builtin_amdgcn_exp2f(bflo(x[j].y))}, b = (f32x2){bfhi(x[j].x), bfhi(x[j].y)};
                H = a * H + b; *(unsigned*)(AO + o) = pk2(H.x * bflo(g[j]), H.y * bfhi(g[j])); } }
    }
}
__device__ __forceinline__ int dq_layer(int li) {
    int l = 0, seen = -1;
#pragma unroll
    for (int b = 0; b < 4; ++b) if ((DQ_MASK >> b) & 1) { ++seen; if (seen == li) l = b; }
    return l;
}
__device__ __forceinline__ void wq_rows(const Args& A, Frame& F) {
    int tid = F.wave * 64 + lane_id_v(); asm volatile("" : "+v"(tid)); const int lane = tid & 63, wave = __builtin_amdgcn_readfirstlane(tid >> 6);
    const int gw = F.bid * NWAVES + wave, NGW = F.G * NWAVES;
    float* SWb = (float*)(F.ws + WS_SW);
    constexpr int NL = ((DQ_MASK >> 0) & 1) + ((DQ_MASK >> 1) & 1) + ((DQ_MASK >> 2) & 1) + ((DQ_MASK >> 3) & 1);
    for (int r0 = gw; r0 < NL * DM; r0 += 2 * NGW) {
        v4u x[2][16];
#pragma unroll
        for (int h = 0; h < 2; ++h) { const int rr = r0 + h * NGW < NL * DM ? r0 + h * NGW : r0; const int li = rr / DM, n = rr - li * DM, l = dq_layer(li);
            const bf16* src = (const bf16*)(F.ws + WS_W2) + (size_t)l * DM * FF + (size_t)n * FF;
#pragma unroll
            for (int j = 0; j < 16; ++j) x[h][j] = ((const GAS v4u*)src + lane)[64 * j]; }
#pragma unroll
        for (int h = 0; h < 2; ++h) { const int rr = r0 + h * NGW; if (rr >= NL * DM) break; const int li = rr / DM, n = rr - li * DM, l = dq_layer(li);
            unsigned char* dst = F.ws + WS_W1 + WS_W2Q_OFF * MiB + (size_t)l * DM * FF + (size_t)n * FF;
            float am = 0.f;
#pragma unroll
            for (int j = 0; j < 16; ++j)
#pragma unroll
                for (int e = 0; e < 4; ++e) am = fmaxf(am, fmaxf(fabsf(bflo(x[h][j][e])), fabsf(bfhi(x[h][j][e]))));
            am = wave_max(am);
            const float inv = am > 1e-30f ? 127.0f / am : 0.f; float cs = 0.f;
#pragma unroll
            for (int j = 0; j < 16; ++j) { float r[8];
#pragma unroll
                for (int e = 0; e < 4; ++e) { r[2 * e] = __builtin_rintf(bflo(x[h][j][e]) * inv); r[2 * e + 1] = __builtin_rintf(bfhi(x[h][j][e]) * inv); cs += r[2 * e] + r[2 * e + 1]; }
                v2u o; o.x = pack_i8x4(r[0], r[1], r[2], r[3]); o.y = pack_i8x4(r[4], r[5], r[6], r[7]);
                ((GAS v2u*)dst + lane)[64 * j] = o; }
            cs = wave_sum(cs);
            if (lane == 0) { SWb[SW_T2 + l * DM + n] = am * (1.0f / 127.0f); SWb[SW_CS2 + l * DM + n] = cs; } }
    }
    for (int r0 = gw; r0 < NL * FF; r0 += 4 * NGW) {
        v4u a[4], b2[4]; float stp[4];
#pragma unroll
        for (int h = 0; h < 4; ++h) { const int rr = r0 + h * NGW < NL * FF ? r0 + h * NGW : r0; const int li = rr / FF, n = rr - li * FF, l = dq_layer(li);
            const unsigned char* src = F.ws + WS_W1 + (size_t)l * FF * DM + (size_t)n * DM;
            a[h] = ((const GAS v4u*)src + lane)[0]; b2[h] = ((const GAS v4u*)src + lane)[64]; stp[h] = SWb[SW_W1 + l * FF + n]; }
#pragma unroll
        for (int h = 0; h < 4; ++h) { const int rr = r0 + h * NGW; if (rr >= NL * FF) break; const int li = rr / FF, n = rr - li * FF, l = dq_layer(li);
            int acc = 0;
#pragma unroll
            for (int e = 0; e < 4; ++e) { const int w0 = (int)a[h][e], w1 = (int)b2[h][e];
#pragma unroll
                for (int sh = 0; sh < 4; ++sh) { const int q0 = (w0 << (24 - 8 * sh)) >> 24, q1 = (w1 << (24 - 8 * sh)) >> 24; acc += q0 * q0 + q1 * q1; } }
            const float tot = wave_sum((float)acc);
            if (lane == 0) SWb[SW_SS + l * FF + n] = tot * stp[h] * stp[h]; }
    }
}
__device__ __forceinline__ void hidden_step(Frame& F, int l) {
    if (F.bid == 0) { float* SWb = (float*)(F.ws + WS_SW); int tid = F.wave * 64 + lane_id_v(); asm volatile("" : "+v"(tid)); const int lane = tid & 63;
        float v[16];
#pragma unroll
        for (int j = 0; j < 16; ++j) v[j] = SWb[SW_SS + l * FF + tid + 512 * j];
        float s = 0.f;
#pragma unroll
        for (int j = 0; j < 16; ++j) s += v[j];
        s = wave_sum(s);
        LAS float* red = (LAS float*)(F.lds + RING_OFF);
        if (lane == 0) red[F.wave] = s;
        __syncthreads();
        if (tid == 0) { float t = 0.f;
#pragma unroll
            for (int w = 0; w < 8; ++w) t += red[w];
            const float C = 21.16f * t * (1.0f / 8192.0f);
            SWb[SW_CL + 2 * l] = 254.0f / C; SWb[SW_CL + 2 * l + 1] = C * (1.0f / 254.0f); }
        __syncthreads(); }
}
__device__ __forceinline__ void phase_quant(const Args& A, Frame& F) {
    int tid = F.wave * 64 + lane_id_v(); asm volatile("" : "+v"(tid)); const int lane = tid & 63, wave = __builtin_amdgcn_readfirstlane(tid >> 6);
    const bf16* XB = (const bf16*)(F.ws + WS_XB); unsigned char* XQ = F.ws + WS_XQ; float* frow = (float*)(F.ws + WS_FROW);
    const int gw = F.bid * NWAVES + wave, NGW = F.G * NWAVES;
    for (int mb = gw; mb < S; mb += 4 * NGW) {
        v4u x[4][4];
#pragma unroll
        for (int r = 0; r < 4; ++r) { const int m = mb + r * NGW < S ? mb + r * NGW : mb;
#pragma unroll
            for (int j = 0; j < 4; ++j) x[r][j] = ((const GAS v4u*)(XB + (size_t)m * DM) + lane)[64 * j]; }
#pragma unroll
        for (int r = 0; r < 4; ++r) { const int m = mb + r * NGW; float s = 0.f, am = 0.f;
#pragma unroll
            for (int j = 0; j < 4; ++j) {
#pragma unroll
                for (int e = 0; e < 4; ++e) { const float a0 = bflo(x[r][j][e]), a1 = bfhi(x[r][j][e]); s += a0 * a0 + a1 * a1; am = fmaxf(am, fmaxf(fabsf(a0), fabsf(a1))); } }
            s = wave_sum(s); am = wave_max(am);
            const float inv = am > 1e-30f ? 127.0f / am : 0.f;
            if (m < S) {
#pragma unroll
                for (int j = 0; j < 4; ++j) { v2u o; o.x = pack_i8x4(bflo(x[r][j].x) * inv, bfhi(x[r][j].x) * inv, bflo(x[r][j].y) * inv, bfhi(x[r][j].y) * inv);
                    o.y = pack_i8x4(bflo(x[r][j].z) * inv, bfhi(x[r][j].z) * inv, bflo(x[r][j].w) * inv, bfhi(x[r][j].w) * inv);
                    ((GAS v2u*)(XQ + (size_t)m * DM) + lane)[64 * j] = o; }
                if (lane == 0) { const float rstd = __builtin_amdgcn_rsqf(s * (1.0f / 2048.0f) + 1e-6f); frow[m] = am * (1.0f / 127.0f) * rstd; ((float*)(F.ws + WS_RSTD))[m] = rstd; } } }
    }
}
__device__ __forceinline__ void phase_final(const Args& A, Frame& F) {
    int tid = F.wave * 64 + lane_id_v(); asm volatile("" : "+v"(tid)); const int lane = tid & 63, wave = __builtin_amdgcn_readfirstlane(tid >> 6);
    const bf16* XB = (const bf16*)(F.ws + WS_XB); const float* gf = A.in[4];
    const int gw = F.bid * NWAVES + wave, NGW = F.G * NWAVES;
    f32x4 g0[4], g1[4];
#pragma unroll
    for (int j = 0; j < 4; ++j) { g0[j] = *(const f32x4*)(gf + j * 512 + lane * 8); g1[j] = *(const f32x4*)(gf + j * 512 + lane * 8 + 4); }
    for (int m0 = gw; m0 < S; m0 += 2 * NGW) {
        const int m1 = m0 + NGW; const bool two = m1 < S;
        v4u xa[4], xb[4];
#pragma unroll
        for (int j = 0; j < 4; ++j) { xa[j] = ((const GAS v4u*)(XB + (size_t)m0 * DM) + lane)[64 * j]; xb[j] = two ? ((const GAS v4u*)(XB + (size_t)m1 * DM) + lane)[64 * j] : xa[j]; }
        float s0 = 0.f, s1 = 0.f;
#pragma unroll
        for (int j = 0; j < 4; ++j) {
#pragma unroll
            for (int e = 0; e < 4; ++e) { const float a0 = bflo(xa[j][e]), a1 = bfhi(xa[j][e]), b0 = bflo(xb[j][e]), b1 = bfhi(xb[j][e]); s0 += a0 * a0 + a1 * a1; s1 += b0 * b0 + b1 * b1; } }
        s0 = wave_sum(s0); s1 = wave_sum(s1);
        const float r0 = __builtin_amdgcn_rsqf(s0 * (1.0f / 2048.0f) + 1e-6f), r1 = __builtin_amdgcn_rsqf(s1 * (1.0f / 2048.0f) + 1e-6f);
        GAS f32x4* o0 = (GAS f32x4*)(A.out + (size_t)m0 * DM) + 2 * lane; GAS f32x4* o1 = (GAS f32x4*)(A.out + (size_t)m1 * DM) + 2 * lane;
#pragma unroll
        for (int j = 0; j < 4; ++j) { const f32x4 a = (f32x4){bflo(xa[j].x), bfhi(xa[j].x), bflo(xa[j].y), bfhi(xa[j].y)}, b = (f32x4){bflo(xa[j].z), bfhi(xa[j].z), bflo(xa[j].w), bfhi(xa[j].w)};
            __builtin_nontemporal_store(a * r0 * g0[j], &o0[128 * j]); __builtin_nontemporal_store(b * r0 * g1[j], &o0[128 * j + 1]); }
        if (two) {
#pragma unroll
            for (int j = 0; j < 4; ++j) { const f32x4 a = (f32x4){bflo(xb[j].x), bfhi(xb[j].x), bflo(xb[j].y), bfhi(xb[j].y)}, b = (f32x4){bflo(xb[j].z), bfhi(xb[j].z), bflo(xb[j].w), bfhi(xb[j].w)};
                __builtin_nontemporal_store(a * r1 * g0[j], &o1[128 * j]); __builtin_nontemporal_store(b * r1 * g1[j], &o1[128 * j + 1]); } }
    }
}
__global__ void __launch_bounds__(NWAVES * 64, 2) mega_fwd(Args A) {
    extern __shared__ __attribute__((aligned(16))) unsigned char lds[];
    Frame F;
    F.lds = (LAS unsigned char*)lds; F.ldsg = lds;
    F.MISC = (volatile LAS unsigned*)(F.lds + MISC_OFF);
    F.tid = threadIdx.x; F.lane = F.tid & 63; F.wave = __builtin_amdgcn_readfirstlane(F.tid >> 6);
    F.G = gridDim.x; F.bid = blockIdx.x;
    F.ws = A.ws; F.ctl = (gu32*)(A.ws + WS_CTL);
    for (int u = F.tid; u < (LDS_BYTES - LDSCTL_OFF) / 4; u += NWAVES * 64) ((LAS unsigned*)(F.lds + LDSCTL_OFF))[u] = 0u;
    __syncthreads();
    XcdBarrier bar; bar.bar = (unsigned*)(F.ctl + CW_BAR); bar.x = 0; bar.st = nullptr;
    if (!MK_PER_PHASE) bar = xcd_barrier_post((unsigned*)(F.ctl + CW_BAR), F.MISC + 8);
    const int lo = A.ph_lo, hi = A.ph_hi;
#define IN(k) (lo <= (k) && (k) < hi)
#define SEAM(k) do { if (IN(k) && IN((k) + 1)) xcd_barrier(bar); } while (0)

    if (IN(0) && DBG(0)) { for (int rp = 0; rp < NREP(0); ++rp) { p0_prologue(A, F); if (rp + 1 < NREP(0)) xcd_barrier(bar); } } SEAM(0);
    for (int ls = 0; ls < 2 * DEPTH; ++ls) {
        const int l = ls >> 1, st = ls & 1, jm = l >> 1, rec = l & 1;
        const int p1 = 1 + 7 * l + (st ? 5 : 0), p2 = p1 + (st ? 1 : 4);
        if (IN(p1) && DBG(1)) {
            if (ls > 0) { phase_quant(A, F); if (ls == 1 && DQ_MASK) wq_rows(A, F); if (st && ((DQ_MASK >> l) & 1)) hidden_step(F, l); xcd_barrier(bar); }
            if (!st && rec) {
                pg8::Gemm g{(const bf16*)(F.ws + WS_XB), (const bf16*)(F.ws + WS_WIN) + (size_t)jm * 2 * DM * DM, S, 2 * DM, DM, F.wave};
                pg8::FrowOrder So; So.init(S, 2 * DM, F.G, F.bid); So.frow = (const float*)(F.ws + WS_RSTD); So.tab = F.lds + 135168;
                pg8::EpiScaleT<false> E{(bf16*)(F.ws + WS_QKV), DM, F.lds + 135168, nullptr, (bf16*)(F.ws + WS_QKV + 32 * MiB), 1, nullptr, nullptr};
                pg8::gemm_phase<pg8::EpiScaleT<false>, pg8::FrowOrder, true, true, false>(F.lds + RING_OFF, g, So, E);
            } else {
            const unsigned char* Bq; const float* sc; int N, mode; bf16* O; int ldc;
            if (st) { Bq = F.ws + WS_W1 + (size_t)l * FF * DM; sc = (const float*)(F.ws + WS_SW) + SW_W1 + l * FF; N = FF; mode = ((DQ_MASK >> l) & 1) ? 3 : 2; O = (bf16*)(F.ws + WS_HID); ldc = FF; }
            else { Bq = F.ws + WS_WQKV + (size_t)jm * NQKV * DM; sc = (const float*)(F.ws + WS_SW) + SW_QKV + jm * NQKV; N = NQKV; mode = 0; O = (bf16*)(F.ws + WS_QKV); ldc = NQKV; }
            pg8::Gemm g{(const bf16*)(F.ws + WS_XQ), (const bf16*)Bq, S, N, DM / 2, F.wave};
            pg8::FrowOrder So; So.init(S, N, F.G, F.bid); So.frow = (const float*)(F.ws + WS_FROW); So.tab = F.lds + 135168;
            pg8::EpiScaleT<true> E{O, ldc, F.lds + 135168, (float*)(F.ws + WS_KMP), (bf16*)(F.ws + WS_QKV + 32 * MiB), mode, sc, (const float*)(F.ws + WS_SW) + SW_CL + 2 * l};
            for (int rp = 0; rp < NREP(1); ++rp) { pg8::gemm_phase<pg8::EpiScaleT<true>, pg8::FrowOrder, true, true, true>(F.lds + RING_OFF, g, So, E); if (rp + 1 < NREP(1)) xcd_barrier(bar); } } }
        SEAM(p1);
        if (!st) {
            if (!rec) {
                if (IN(p1 + 1) && DBG(2)) phase_gate2(A, F, jm);
                SEAM(p1 + 1);
                if (IN(p1 + 2) && DBG(3)) { for (int rp = 0; rp < NREP(3); ++rp) { attn_phase<false>(A, F, jm); if (rp + 1 < NREP(3)) xcd_barrier(bar); } }
                SEAM(p1 + 2);
                if (IN(p1 + 3) && DBG(4)) { for (int rp = 0; rp < NREP(4); ++rp) { attn_phase3<true>(A, F, jm); if (rp + 1 < NREP(4)) xcd_barrier(bar); } }
                SEAM(p1 + 3);
            } else {
                if (IN(p1 + 1) && DBG(6)) { for (int rp = 0; rp < NREP(6); ++rp) { phase_rec_ab2(A, F, jm); if (rp + 1 < NREP(6)) xcd_barrier(bar); } }
                SEAM(p1 + 1);
                                if (IN(p1 + 3) && DBG(8)) { for (int rp = 0; rp < NREP(8); ++rp) { phase_rec_scan(A, F); if (rp + 1 < NREP(8)) xcd_barrier(bar); } }
                SEAM(p1 + 3);
            }
        }
        if (IN(p2) && DBG(9) && st && ((DQ_MASK >> l) & 1)) {
            pg8::Gemm g{(const bf16*)(F.ws + WS_HID), (const bf16*)(F.ws + WS_W1 + WS_W2Q_OFF * MiB + (size_t)l * DM * FF), S, DM, FF / 2, F.wave}; pg8::StaticOrder So; So.init(S, DM, F.G, F.bid);
            pg8::EpiResQ8 E{(bf16*)(F.ws + WS_XB), (const float*)(F.ws + WS_SW) + SW_T2 + l * DM, (const float*)(F.ws + WS_SW) + SW_CS2 + l * DM, (const float*)(F.ws + WS_SW) + SW_CL + 2 * l};
            pg8::gemm_phase<pg8::EpiResQ8, pg8::StaticOrder, true, true, true>(F.lds + RING_OFF, g, So, E); }
        else if (IN(p2) && DBG(9)) {
            const bf16* Ap; const bf16* Bt; int K;
            if (st) { Ap = (const bf16*)(F.ws + WS_HID); Bt = (const bf16*)(F.ws + WS_W2) + (size_t)l * DM * FF; K = FF; }
            else { Ap = (const bf16*)(F.ws + WS_AO); Bt = (const bf16*)(F.ws + (rec ? WS_WOUT : WS_WO)) + (size_t)jm * DM * DM; K = DM; }
            pg8::Gemm g{Ap, Bt, S, DM, K, F.wave}; pg8::StaticOrder So; So.init(S, DM, F.G, F.bid);
            pg8::EpiRes E{(bf16*)(F.ws + WS_XB)};
            pg8::gemm_phase<pg8::EpiRes, pg8::StaticOrder, true, true>(F.lds + RING_OFF, g, So, E); }
        SEAM(p2);
    }
    if (IN(NPHASE - 1) && DBG(12)) { for (int rp = 0; rp < NREP(12); ++rp) { phase_final(A, F); if (rp + 1 < NREP(12)) xcd_barrier(bar); } }
#undef IN
#undef SEAM
}

extern "C" void kernel_launch(void* const* d_in, const int* in_sizes, int n_in, void* d_out, int out_size, void* d_ws, size_t ws_size, hipStream_t stream) {
    static int grid = 0;
    if (grid == 0) {
        if (n_in != 18 || in_sizes[0] != S * DM || out_size != S * DM || ws_size < WS_END) { fprintf(stderr, "kernel_launch: shape mismatch n_in %d in0 %d out %d ws %zu (need %zu)\n", n_in, n_in > 0 ? in_sizes[0] : -1, out_size, ws_size, (size_t)WS_END); grid = -1; return; }
        int dev = 0, cus = 0, per_cu = 0;
        if (hipGetDevice(&dev) != hipSuccess || hipDeviceGetAttribute(&cus, hipDeviceAttributeMultiprocessorCount, dev) != hipSuccess) { grid = -1; return; }
        if (hipFuncSetAttribute((const void*)mega_fwd, hipFuncAttributeMaxDynamicSharedMemorySize, LDS_BYTES) != hipSuccess) { fprintf(stderr, "kernel_launch: hipFuncSetAttribute failed\n"); grid = -1; return; }
        if (hipOccupancyMaxActiveBlocksPerMultiprocessor(&per_cu, (const void*)mega_fwd, NWAVES * 64, LDS_BYTES) != hipSuccess || per_cu < 1) fprintf(stderr, "kernel_launch: occupancy query says %d\n", per_cu);
        (void)hipGetLastError();
        grid = cus;
    }
    if (grid < 0) return;
    if (hipMemsetAsync((char*)d_ws + WS_CTL, 0, CTL_ZERO_BYTES, stream) != hipSuccess) { fprintf(stderr, "kernel_launch: memset failed\n"); return; }
    Args a{};
    for (int i = 0; i < 18; ++i) a.in[i] = (const float*)d_in[i];
    a.out = (float*)d_out; a.ws = (unsigned char*)d_ws;
#if MK_PER_PHASE
    for (int p = 0; p < NPHASE; ++p) { a.ph_lo = p; a.ph_hi = p + 1; hipLaunchKernelGGL(mega_fwd, dim3(grid), dim3(NWAVES * 64), LDS_BYTES, stream, a); }
#else
    a.ph_lo = 0; a.ph_hi = NPHASE; hipLaunchKernelGGL(mega_fwd, dim3(grid), dim3(NWAVES * 64), LDS_BYTES, stream, a);
#endif
    const hipError_t le = hipPeekAtLastError();
    if (le != hipSuccess) fprintf(stderr, "kernel_launch: launch failed: %s\n", hipGetErrorName(le));
}
```

```cpp
#include <hip/hip_runtime.h>
#include <cstdio>
#include <cstdint>
#include <cmath>
__device__ __forceinline__ int lane_id_v() { int l; asm volatile("v_mbcnt_lo_u32_b32 %0, -1, 0\n\tv_mbcnt_hi_u32_b32 %0, -1, %0" : "=v"(l)); return l; }
namespace pg8 {
#define PG8_LAS __attribute__((address_space(3)))
typedef unsigned short bf16_t;
typedef short bf16x8 __attribute__((ext_vector_type(8)));
typedef float f32x4 __attribute__((ext_vector_type(4)));
typedef unsigned u32x4 __attribute__((ext_vector_type(4)));
typedef int i32x4 __attribute__((ext_vector_type(4)));
template <bool I8> struct AccT { typedef f32x4 type; };
template <> struct AccT<true> { typedef i32x4 type; };
__device__ __forceinline__ f32x4 mma_op(bf16x8 a, bf16x8 b, f32x4 c) { return __builtin_amdgcn_mfma_f32_16x16x32_bf16(a, b, c, 0, 0, 0); }
__device__ __forceinline__ i32x4 mma_op(bf16x8 a, bf16x8 b, i32x4 c) { return __builtin_amdgcn_mfma_i32_16x16x64_i8(__builtin_bit_cast(i32x4, a), __builtin_bit_cast(i32x4, b), c, 0, 0, 0); }
constexpr int BM = 256, BK = 64, HALF = 128, HTB = HALF * BK * 2  , STAGE_BYTES = 8 * HTB, NXCD = 8, WGM = 8;

__host__ __device__ __forceinline__ int lds_byte(int r, int c) { const int st = (r >> 4) * 2 + (c >> 5), rr = r & 15, cc = c & 31, ob = rr * 64 + cc * 2; return st * 1024 + (ob ^ (((ob >> 9) & 1) << 5)); }
__host__ __device__ __forceinline__ void stage_rc(int b, int& R, int& C) { const int st = b / 1024, sb = b % 1024, swz = sb ^ (((sb >> 9) & 1) << 5); R = (st >> 1) * 16 + swz / 64; C = (st & 1) * 32 + (swz % 64) / 2; }
__host__ __device__ __forceinline__ int perm32(int rho) { const int n = rho >> 4, i = rho & 15; return 8 * (i >> 2) + 4 * n + (i & 3); }

struct Unit { int pm, pn, seq; };
struct Gemm { const bf16_t* A; const bf16_t* Bt; int M, N, K; int wave; };

struct StaticOrder {
    int nM, nN, nwg, G, c;
    __host__ __device__ void init(int M, int N, int G_, int c_) { nM = M / BM; nN = N / BM; nwg = nM * nN; G = G_; c = c_; }
    __host__ __device__ bool next(int i, Unit& u) const {
        const long L = (long)i * G + c; if (L >= nwg) return false;
        int wgid = (int)L; { const int q = nwg / NXCD, r = nwg % NXCD, xcd = wgid % NXCD, off = wgid / NXCD; wgid = (xcd < r ? xcd * (q + 1) : r * (q + 1) + (xcd - r) * q) + off; }
        const int nig = WGM * nN, gid = wgid / nig, fm = gid * WGM, gsz = (nM - fm) < WGM ? (nM - fm) : WGM;
        u.pm = fm + ((wgid % nig) % gsz); u.pn = (wgid % nig) / gsz; u.seq = i; return true;
    }
    __device__ __forceinline__ void a_ready(const Unit&) const {}
    __device__ __forceinline__ void done(const Unit&) const {}
};

__device__ __forceinline__ unsigned cvt_pk_bf16(float lo, float hi) { unsigned r; asm volatile("v_cvt_pk_bf16_f32 %0, %1, %2" : "=v"(r) : "v"(lo), "v"(hi)); return r; }
struct FrowOrder : StaticOrder {
    const float* frow; PG8_LAS unsigned char* tab;
    __device__ __forceinline__ void a_ready(const Unit& u) const {
        const int lane = lane_id_v();
        __builtin_amdgcn_global_load_lds((const unsigned*)(frow + (size_t)u.pm * BM + lane * 4), (PG8_LAS unsigned*)(tab + (u.seq & 1) * 1024), 16, 0, 0);
    }
};
constexpr float RMS_EPS = 1e-6f;
typedef float f32x2_ __attribute__((ext_vector_type(2)));
__device__ __forceinline__ float gelu_tanh(float x) {
    const float u = 0.7978845608028654f * (x + 0.044715f * x * x * x);
    const float e = __builtin_amdgcn_exp2f(-2.0f * 1.4426950408889634f * u);
    return x * __builtin_amdgcn_rcpf(1.0f + e);
}
template <bool I8>
struct EpiScaleT {
    static constexpr bool PERM = true, AFTER_DRAIN = false;
    bf16_t* O; int ldc; const PG8_LAS unsigned char* tab; float* kmp; bf16_t* O2; int mode; const float* scol; const float* hq;
    __device__ __forceinline__ void operator()(const typename AccT<I8>::type (&acc)[2][2][4][2], const Unit& u, int wr, int wc, int fr, int fq) const {
        const int row0 = u.pm * BM + wr * 64 + fr;
        f32x4 sc[2][2];
#pragma unroll
        for (int bj = 0; bj < 2; ++bj)
#pragma unroll
            for (int n = 0; n < 2; ++n) { if constexpr (I8) sc[bj][n] = *(const f32x4*)(scol + u.pn * BM + bj * HALF + wc * 32 + 8 * fq + 4 * n); else sc[bj][n] = (f32x4){1.f, 1.f, 1.f, 1.f}; }
        float rs[2][4];
#pragma unroll
        for (int ai = 0; ai < 2; ++ai)
#pragma unroll
            for (int m = 0; m < 4; ++m) rs[ai][m] = *(const PG8_LAS float*)(tab + (u.seq & 1) * 1024 + (wr * 64 + fr + ai * HALF + m * 16) * 4);
        int colt = u.pn * BM; bf16_t* base = O; int am = mode >= 2 ? 2 : 0; const float hqi = mode == 3 ? hq[0] : 0.f;
        if (mode == 1 && colt >= 2048) { colt -= 2048; base = O2; am = 1; }
        const int col0 = colt + wc * 32 + 8 * fq;
#pragma unroll
        for (int ai = 0; ai < 2; ++ai)
#pragma unroll
            for (int m = 0; m < 4; ++m) { bf16_t* rowp = base + (size_t)(row0 + ai * HALF + m * 16) * ldc + col0; const float r = rs[ai][m];
#pragma unroll
                for (int bj = 0; bj < 2; ++bj) { f32x4 v0 = __builtin_convertvector(acc[ai][bj][m][0], f32x4) * (sc[bj][0] * r), v1 = __builtin_convertvector(acc[ai][bj][m][1], f32x4) * (sc[bj][1] * r);
                    if (am == 1) {
#pragma unroll
                        for (int e = 0; e < 4; ++e) { v0[e] = gelu_tanh(v0[e]); v1[e] = gelu_tanh(v1[e]); } }
                    else if (am == 2) {
#pragma unroll
                        for (int e = 0; e < 4; ++e) { const float a0 = fmaxf(v0[e], 0.f), a1 = fmaxf(v1[e], 0.f); v0[e] = a0 * a0; v1[e] = a1 * a1; } }
                    u32x4 w; w.x = cvt_pk_bf16(v0[0], v0[1]); w.y = cvt_pk_bf16(v0[2], v0[3]); w.z = cvt_pk_bf16(v1[0], v1[1]); w.w = cvt_pk_bf16(v1[2], v1[3]);
                    if (mode == 3) {
                        int q[8];
#pragma unroll
                        for (int e = 0; e < 4; ++e) { q[e] = (int)__builtin_rintf(fminf(v0[e] * hqi, 254.0f)) - 127; q[4 + e] = (int)__builtin_rintf(fminf(v1[e] * hqi, 254.0f)) - 127; }
                        f32x2_ wq; wq.x = __builtin_bit_cast(float, ((unsigned)q[0] & 255u) | (((unsigned)q[1] & 255u) << 8) | (((unsigned)q[2] & 255u) << 16) | ((unsigned)q[3] << 24));
                        wq.y = __builtin_bit_cast(float, ((unsigned)q[4] & 255u) | (((unsigned)q[5] & 255u) << 8) | (((unsigned)q[6] & 255u) << 16) | ((unsigned)q[7] << 24));
                        *(f32x2_*)((unsigned char*)O + (size_t)(row0 + ai * HALF + m * 16) * 8192 + col0 + bj * HALF) = wq; }
                    else if (am == 2) __builtin_nontemporal_store(w, (u32x4*)(rowp + bj * HALF)); else *(u32x4*)(rowp + bj * HALF) = w; } }
        if (mode == 0 && u.pn >= 8 && u.pn < 16) {
            float* kp = kmp + ((size_t)wr * 32 + u.pm) * 2048 + (u.pn - 8) * BM + wc * 32 + 8 * fq;
#pragma unroll
            for (int bj = 0; bj < 2; ++bj)
#pragma unroll
                for (int n = 0; n < 2; ++n) { f32x4 s = (f32x4){0.f, 0.f, 0.f, 0.f};
#pragma unroll
                    for (int ai = 0; ai < 2; ++ai)
#pragma unroll
                        for (int m = 0; m < 4; ++m) s += __builtin_convertvector(acc[ai][bj][m][n], f32x4) * rs[ai][m];
                    s *= sc[bj][n];
#pragma unroll
                    for (int e = 0; e < 4; ++e) { float t = s[e]; t += __shfl_xor(t, 1); t += __shfl_xor(t, 2); t += __shfl_xor(t, 4); t += __shfl_xor(t, 8); s[e] = t; }
                    if (fr == 0) *(f32x4*)(kp + bj * HALF + 4 * n) = s; } }
    }
};
struct EpiRes {
    static constexpr bool PERM = true, AFTER_DRAIN = false;
    bf16_t* XB;
    __device__ __forceinline__ void operator()(const f32x4 (&acc)[2][2][4][2], const Unit& u, int wr, int wc, int fr, int fq) const {
        const int row0 = u.pm * BM + wr * 64 + fr, col0 = u.pn * BM + wc * 32 + 8 * fq;
        asm volatile("" ::: "memory"); __builtin_amdgcn_sched_barrier(0);
        u32x4 xin[2][4][2];
#pragma unroll
        for (int ai = 0; ai < 2; ++ai)
#pragma unroll
            for (int m = 0; m < 4; ++m)
#pragma unroll
                for (int bj = 0; bj < 2; ++bj) xin[ai][m][bj] = *(const u32x4*)(XB + (size_t)(row0 + ai * HALF + m * 16) * 2048 + col0 + bj * HALF);
        asm volatile("" ::: "memory"); __builtin_amdgcn_sched_barrier(0);
#pragma unroll
        for (int ai = 0; ai < 2; ++ai)
#pragma unroll
            for (int m = 0; m < 4; ++m) { const int r = row0 + ai * HALF + m * 16;
#pragma unroll
                for (int bj = 0; bj < 2; ++bj) { bf16_t* xp = XB + (size_t)r * 2048 + col0 + bj * HALF; const u32x4 xo = xin[ai][m][bj];
                    f32x4 x0, x1;
                    x0[0] = __builtin_bit_cast(float, xo.x << 16); x0[1] = __builtin_bit_cast(float, xo.x & 0xffff0000u); x0[2] = __builtin_bit_cast(float, xo.y << 16); x0[3] = __builtin_bit_cast(float, xo.y & 0xffff0000u);
                    x1[0] = __builtin_bit_cast(float, xo.z << 16); x1[1] = __builtin_bit_cast(float, xo.z & 0xffff0000u); x1[2] = __builtin_bit_cast(float, xo.w << 16); x1[3] = __builtin_bit_cast(float, xo.w & 0xffff0000u);
                    x0 += acc[ai][bj][m][0]; x1 += acc[ai][bj][m][1];
                    u32x4 w; w.x = cvt_pk_bf16(x0[0], x0[1]); w.y = cvt_pk_bf16(x0[2], x0[3]); w.z = cvt_pk_bf16(x1[0], x1[1]); w.w = cvt_pk_bf16(x1[2], x1[3]);
                    *(u32x4*)xp = w; } }
    }
};
struct EpiResQ8 {
    static constexpr bool PERM = true, AFTER_DRAIN = false;
    bf16_t* XB; const float* t2; const float* cs2; const float* hq;
    __device__ __forceinline__ void operator()(const i32x4 (&acc)[2][2][4][2], const Unit& u, int wr, int wc, int fr, int fq) const {
        const int row0 = u.pm * BM + wr * 64 + fr, col0 = u.pn * BM + wc * 32 + 8 * fq;
        const float step = hq[1];
        f32x4 sc[2][2], cc[2][2];
#pragma unroll
        for (int bj = 0; bj < 2; ++bj)
#pragma unroll
            for (int n = 0; n < 2; ++n) { sc[bj][n] = *(const f32x4*)(t2 + col0 + bj * HALF + 4 * n) * step; cc[bj][n] = *(const f32x4*)(cs2 + col0 + bj * HALF + 4 * n) * 127.0f; }
        asm volatile("" ::: "memory"); __builtin_amdgcn_sched_barrier(0);
#pragma unroll
        for (int ai = 0; ai < 2; ++ai) {
            u32x4 xin[4][2];
#pragma unroll
            for (int m = 0; m < 4; ++m)
#pragma unroll
                for (int bj = 0; bj < 2; ++bj) xin[m][bj] = *(const u32x4*)(XB + (size_t)(row0 + ai * HALF + m * 16) * 2048 + col0 + bj * HALF);
            asm volatile("" ::: "memory"); __builtin_amdgcn_sched_barrier(0);
#pragma unroll
            for (int m = 0; m < 4; ++m) { const int r = row0 + ai * HALF + m * 16;
#pragma unroll
                for (int bj = 0; bj < 2; ++bj) { bf16_t* xp = XB + (size_t)r * 2048 + col0 + bj * HALF; const u32x4 xo = xin[m][bj];
                    f32x4 x0, x1;
                    x0[0] = __builtin_bit_cast(float, xo.x << 16); x0[1] = __builtin_bit_cast(float, xo.x & 0xffff0000u); x0[2] = __builtin_bit_cast(float, xo.y << 16); x0[3] = __builtin_bit_cast(float, xo.y & 0xffff0000u);
                    x1[0] = __builtin_bit_cast(float, xo.z << 16); x1[1] = __builtin_bit_cast(float, xo.z & 0xffff0000u); x1[2] = __builtin_bit_cast(float, xo.w << 16); x1[3] = __builtin_bit_cast(float, xo.w & 0xffff0000u);
                    x0 += (__builtin_convertvector(acc[ai][bj][m][0], f32x4) + cc[bj][0]) * sc[bj][0]; x1 += (__builtin_convertvector(acc[ai][bj][m][1], f32x4) + cc[bj][1]) * sc[bj][1];
                    u32x4 w; w.x = cvt_pk_bf16(x0[0], x0[1]); w.y = cvt_pk_bf16(x0[2], x0[3]); w.z = cvt_pk_bf16(x1[0], x1[1]); w.w = cvt_pk_bf16(x1[2], x1[3]);
                    *(u32x4*)xp = w; } }
            asm volatile("" ::: "memory"); __builtin_amdgcn_sched_barrier(0); }
    }
};
template <class Epi, class Sched, bool ALIGN_EPI = false, bool SP2 = false, bool I8 = false>
__device__ __forceinline__ void gemm_phase(PG8_LAS unsigned char* lds, const Gemm g, const Sched& S, const Epi& E) {
    int tid_ = g.wave * 64 + lane_id_v(); asm volatile("" : "+v"(tid_));
    const int tid = tid_, wid = __builtin_amdgcn_readfirstlane(tid >> 6), lane = tid & 63, wr = wid >> 2, wc = wid & 3, fr = lane & 15, fq = lane >> 4;
    const int K = g.K, nt = K / BK;
    unsigned voffA[2], voffB[2];
#pragma unroll
    for (int i = 0; i < 2; ++i) { int R, C; stage_rc(tid * 16 + i * 8192, R, C); const int Rb = Epi::PERM ? ((R & ~31) + perm32(R & 31)) : R;
        voffA[i] = (unsigned)(R * K + C) * 2u; voffB[i] = (unsigned)(Rb * K + C) * 2u; }
    const size_t kstep = (size_t)(BK * 2);
    const size_t hstep = (size_t)HALF * K * 2;
    const size_t tstep = 2 * hstep;
    const unsigned ldsw = (unsigned)wid * 1024u;
    const int aoff = lds_byte(wr * 64 + fr, fq * 8), boff = lds_byte(wc * 32 + fr, fq * 8);
#define PG8_SA(b, h) (((b) * 2 + (h)) * HTB)
#define PG8_SB(b, h) ((4 + (b) * 2 + (h)) * HTB)
#define PG8_STAGE(bufoff, gbase, voff) do { _Pragma("unroll") for (int _i = 0; _i < 2; ++_i) \
        __builtin_amdgcn_global_load_lds((const unsigned*)((const char*)(gbase) + (voff)[_i]), (PG8_LAS unsigned*)(lds + (bufoff) + ldsw + _i * 8192), 16, 0, 0); } while (0)
#define PG8_LDA(dst, b, h) do { _Pragma("unroll") for (int m = 0; m < 4; ++m) _Pragma("unroll") for (int k = 0; k < 2; ++k) dst[m][k] = *(const PG8_LAS bf16x8*)(lds + PG8_SA(b, h) + aoff + m * 2048 + k * 1024); } while (0)
#define PG8_LDB(dst, b, h) do { _Pragma("unroll") for (int n = 0; n < 2; ++n) _Pragma("unroll") for (int k = 0; k < 2; ++k) dst[n][k] = *(const PG8_LAS bf16x8*)(lds + PG8_SB(b, h) + boff + n * 2048 + k * 1024); } while (0)
#define PG8_MMA(ai, bj, At, Bt) do { __builtin_amdgcn_s_setprio(1); _Pragma("unroll") for (int m = 0; m < 4; ++m) _Pragma("unroll") for (int n = 0; n < 2; ++n) _Pragma("unroll") for (int k = 0; k < 2; ++k) \
        acc[ai][bj][m][n] = mma_op(Bt[n][k], At[m][k], acc[ai][bj][m][n]); __builtin_amdgcn_s_setprio(0); } while (0)
#define PG8_WAIT_V(n) asm volatile("s_waitcnt vmcnt(" #n ")" ::: "memory")
#define PG8_WAIT_L(n) asm volatile("s_waitcnt lgkmcnt(" #n ")" ::: "memory")
#define PG8_BAR __builtin_amdgcn_s_barrier()
#define PG8_SCHED __builtin_amdgcn_sched_barrier(0)
    Unit cur, nxt; int ui = 0;
    if (!S.next(0, cur)) return;
    typedef typename AccT<I8>::type acc_t;
    acc_t acc[2][2][4][2];
#pragma unroll
    for (int a = 0; a < 2; ++a)
#pragma unroll
        for (int b = 0; b < 2; ++b)
#pragma unroll
            for (int m = 0; m < 4; ++m)
#pragma unroll
                for (int n = 0; n < 2; ++n) acc[a][b][m][n] = acc_t{};
    bf16x8 At[4][2], B0[2][2], B1[2][2];
    const char* cA = (const char*)g.A + (size_t)cur.pm * tstep; const char* cB = (const char*)g.Bt + (size_t)cur.pn * tstep;
    S.a_ready(cur);
    if constexpr (SP2) {
        PG8_STAGE(PG8_SB(0, 0), cB, voffB); PG8_STAGE(PG8_SB(0, 1), cB + hstep, voffB); PG8_STAGE(PG8_SA(0, 0), cA, voffA); PG8_STAGE(PG8_SA(0, 1), cA + hstep, voffA);
        if (wr == 1) PG8_BAR;
        PG8_WAIT_V(2); PG8_BAR;
        PG8_STAGE(PG8_SB(1, 0), cB + kstep, voffB); PG8_STAGE(PG8_SB(1, 1), cB + hstep + kstep, voffB);
        PG8_WAIT_V(4); PG8_BAR;
    } else {
        PG8_STAGE(PG8_SB(0, 0), cB, voffB); PG8_STAGE(PG8_SA(0, 0), cA, voffA); PG8_STAGE(PG8_SB(0, 1), cB + hstep, voffB); PG8_STAGE(PG8_SA(0, 1), cA + hstep, voffA);
        if (wr == 1) PG8_BAR;
        PG8_WAIT_V(4); PG8_BAR;
        PG8_STAGE(PG8_SB(1, 0), cB + kstep, voffB); PG8_STAGE(PG8_SA(1, 0), cA + kstep, voffA); PG8_STAGE(PG8_SB(1, 1), cB + hstep + kstep, voffB);
        PG8_WAIT_V(6); PG8_BAR;
    }
    for (;;) {
        const bool has_next = S.next(ui + 1, nxt);
        const char* nA = has_next ? (const char*)g.A + (size_t)nxt.pm * tstep : cA; const char* nB = has_next ? (const char*)g.Bt + (size_t)nxt.pn * tstep : cB;
        for (int t = 0; t < nt; t += 2) {
            const bool last = (t == nt - 2);
            const char* a1 = cA + (size_t)(t + 1) * kstep;
            const char* a2 = last ? nA : cA + (size_t)(t + 2) * kstep; const char* b2 = last ? nB : cB + (size_t)(t + 2) * kstep;
            const char* a3 = a2 + kstep; const char* b3 = b2 + kstep; (void)a3;
            if (last && has_next) S.a_ready(nxt);
            if constexpr (SP2) {
            PG8_LDB(B0, 0, 0); PG8_LDB(B1, 0, 1); PG8_SCHED; PG8_LDA(At, 0, 0); PG8_STAGE(PG8_SA(1, 0), a1, voffA); PG8_STAGE(PG8_SA(1, 1), a1 + hstep, voffA);
            PG8_WAIT_V(8); PG8_WAIT_L(0); PG8_BAR; PG8_MMA(0, 0, At, B0); PG8_MMA(0, 1, At, B1); PG8_BAR; PG8_SCHED;
            PG8_LDA(At, 0, 1); PG8_STAGE(PG8_SB(0, 0), b2, voffB); PG8_STAGE(PG8_SB(0, 1), b2 + hstep, voffB);
            PG8_WAIT_V(6); PG8_WAIT_L(0); PG8_BAR; PG8_MMA(1, 0, At, B0); PG8_MMA(1, 1, At, B1); PG8_BAR; PG8_SCHED;
            PG8_LDB(B0, 1, 0); PG8_LDB(B1, 1, 1); PG8_SCHED; PG8_LDA(At, 1, 0); PG8_STAGE(PG8_SA(0, 0), a2, voffA); PG8_STAGE(PG8_SA(0, 1), a2 + hstep, voffA);
            PG8_WAIT_V(8); PG8_WAIT_L(0); PG8_BAR; PG8_MMA(0, 0, At, B0); PG8_MMA(0, 1, At, B1); PG8_BAR; PG8_SCHED;
            PG8_LDA(At, 1, 1); PG8_STAGE(PG8_SB(1, 0), b3, voffB); PG8_STAGE(PG8_SB(1, 1), b3 + hstep, voffB);
            PG8_WAIT_V(6); PG8_WAIT_L(0); PG8_BAR; PG8_MMA(1, 0, At, B0); PG8_MMA(1, 1, At, B1); PG8_BAR; PG8_SCHED;
            } else {
            PG8_LDB(B0, 0, 0); PG8_SCHED; PG8_LDA(At, 0, 0); PG8_STAGE(PG8_SA(1, 1), a1 + hstep, voffA);
            PG8_WAIT_L(8); PG8_BAR; PG8_WAIT_L(0); PG8_MMA(0, 0, At, B0); PG8_BAR; PG8_SCHED;
            PG8_LDB(B1, 0, 1); PG8_STAGE(PG8_SB(0, 0), b2, voffB);
            PG8_BAR; PG8_WAIT_L(0); PG8_MMA(0, 1, At, B1); PG8_BAR;
            PG8_LDA(At, 0, 1); PG8_STAGE(PG8_SA(0, 0), a2, voffA);
            PG8_BAR; PG8_WAIT_L(0); PG8_MMA(1, 0, At, B0); PG8_BAR; PG8_SCHED;
            PG8_STAGE(PG8_SB(0, 1), b2 + hstep, voffB);
            PG8_WAIT_V(6); PG8_BAR; PG8_MMA(1, 1, At, B1); PG8_BAR;
            PG8_LDB(B0, 1, 0); PG8_SCHED; PG8_LDA(At, 1, 0); PG8_STAGE(PG8_SA(0, 1), a2 + hstep, voffA);
            PG8_WAIT_L(8); PG8_BAR; PG8_WAIT_L(0); PG8_MMA(0, 0, At, B0); PG8_BAR; PG8_SCHED;
            PG8_LDB(B1, 1, 1); PG8_STAGE(PG8_SB(1, 0), b3, voffB);
            PG8_BAR; PG8_WAIT_L(0); PG8_MMA(0, 1, At, B1); PG8_BAR;
            PG8_LDA(At, 1, 1); PG8_STAGE(PG8_SA(1, 0), a3, voffA);
            PG8_BAR; PG8_WAIT_L(0); PG8_MMA(1, 0, At, B0); PG8_BAR; PG8_SCHED;
            PG8_STAGE(PG8_SB(1, 1), b3 + hstep, voffB);
            PG8_WAIT_V(6); PG8_BAR; PG8_MMA(1, 1, At, B1); PG8_BAR;
            }
        }
        if constexpr (ALIGN_EPI) { if (wr == 0) PG8_BAR; }
        if constexpr (!Epi::AFTER_DRAIN) { E(acc, cur, wr, wc, fr, fq); S.done(cur); }
        if (!has_next) break;
#pragma unroll
        for (int a = 0; a < 2; ++a)
#pragma unroll
            for (int b = 0; b < 2; ++b)
#pragma unroll
                for (int m = 0; m < 4; ++m)
#pragma unroll
                    for (int n = 0; n < 2; ++n) acc[a][b][m][n] = acc_t{};
        cur = nxt; cA = nA; cB = nB; ++ui;
        if constexpr (ALIGN_EPI) { if (wr == 1) PG8_BAR; }
    }
    PG8_WAIT_V(0);
    if constexpr (!ALIGN_EPI) { if (wr == 0) PG8_BAR; }
    PG8_BAR;
    if constexpr (Epi::AFTER_DRAIN) { E.fused(acc, cur, wr, wc, fr, fq, lds, wid, lane); S.done(cur); }
#undef PG8_SA
#undef PG8_SB
#undef PG8_STAGE
#undef PG8_LDA
#undef PG8_LDB
#undef PG8_MMA
#undef PG8_WAIT_V
#undef PG8_WAIT_L
#undef PG8_BAR
#undef PG8_SCHED
}
}
constexpr int NWAVES = 8;
constexpr int S = 8192, DM = 2048, NH = 16, HD = 128, FF = 8192, NBLK = 32, BLK = 256, DEPTH = 4;
constexpr int NQKV = 3 * DM;
constexpr int BIAS_LD = 8448;
constexpr int NPHASE = 30;
#ifndef DBG_MASK
#define DBG_MASK 0xffff
#endif
#define DBG(b) ((DBG_MASK >> (b)) & 1)
#ifndef REP_MASK
#define REP_MASK 0
#endif
#define NREP(b) (((REP_MASK >> (b)) & 1) ? 2 : 1)
#ifndef MK_PER_PHASE
#define MK_PER_PHASE 0
#endif
constexpr size_t MiB = 1u << 20;
constexpr size_t WS_CTL = 0, CTL_ZERO_BYTES = 1 * MiB;
constexpr size_t WS_WQKV = 2 * MiB;
constexpr size_t WS_WO   = WS_WQKV + 48 * MiB;
constexpr size_t WS_WIN  = WS_WO + 16 * MiB;
constexpr size_t WS_WOUT = WS_WIN + 32 * MiB;
constexpr size_t WS_W1   = WS_WOUT + 16 * MiB;
constexpr size_t WS_W2   = WS_W1 + 128 * MiB;
constexpr size_t WS_X    = WS_W2 + 128 * MiB;
constexpr size_t WS_XQ   = WS_X;
constexpr size_t WS_FROW = WS_X + 16 * MiB;
constexpr size_t WS_RSTD = WS_FROW + 65536;
constexpr size_t WS_SW   = WS_X + 17 * MiB;
constexpr int SW_QKV = 0, SW_WIN = 2 * 6144, SW_W1 = SW_WIN + 2 * 4096;
constexpr int SW_T2 = 65536, SW_CS2 = SW_T2 + 4 * 2048, SW_SS = SW_CS2 + 4 * 2048, SW_CL = SW_SS + 4 * 8192;
#ifndef DQ_MASK
#define DQ_MASK 12
#endif
static_assert((DQ_MASK & 1) == 0 && DQ_MASK < 16, "layer 0's hidden step would be needed in the phase that computes the column norms");
constexpr size_t WS_W2Q_OFF = 64;
constexpr size_t WS_XB   = WS_X + 64 * MiB;
constexpr size_t WS_QKV  = WS_XB + 32 * MiB;
constexpr size_t WS_AO   = WS_QKV + 96 * MiB;
constexpr size_t WS_HID  = WS_AO + 32 * MiB;
constexpr size_t WS_SSQ  = WS_HID + 128 * MiB;
constexpr size_t WS_KMP  = WS_SSQ + 9 * MiB;
constexpr size_t WS_LSE  = WS_KMP + 1 * MiB;
constexpr size_t WS_LIST = WS_LSE + 2 * MiB;
constexpr size_t WS_BIAS = WS_LIST + 16 * MiB;
constexpr size_t WS_CARRY = WS_BIAS + 1 * MiB;
constexpr size_t WS_WG   = WS_CARRY + 2 * MiB;
constexpr size_t WS_END  = WS_WG + 2 * MiB;
constexpr int CW_TMO = 0, CW_CODE = 1;
constexpr int CW_BAR = 4096;
constexpr int CW_CNT = 16384;
constexpr int RING_OFF = 0, RING_BYTES = 155392;
constexpr int LDSCTL_OFF = RING_BYTES, MISC_OFF = LDSCTL_OFF + 320;
constexpr int LDS_BYTES = 157696;
#define GAS __attribute__((address_space(1)))
#define LAS __attribute__((address_space(3)))
typedef unsigned short bf16;
typedef unsigned v4u __attribute__((ext_vector_type(4)));
typedef float f32x4 __attribute__((ext_vector_type(4)));
typedef short bf16x8 __attribute__((ext_vector_type(8)));
typedef GAS unsigned gu32;
typedef GAS unsigned long long gu64;
#define RLX_AGENT __ATOMIC_RELAXED, __HIP_MEMORY_SCOPE_AGENT
#define LDS_WAIT() asm volatile("s_waitcnt lgkmcnt(0)" ::: "memory")
#define VM_WAIT() asm volatile("s_waitcnt vmcnt(0)" ::: "memory")
__device__ __forceinline__ unsigned long long rt() { return __builtin_amdgcn_s_memrealtime(); }
__device__ __forceinline__ unsigned f2bf(float f) { unsigned u = __builtin_bit_cast(unsigned, f); return (u + 0x7fffu + ((u >> 16) & 1u)) >> 16; }
__device__ __forceinline__ unsigned pk2(float lo, float hi) { return f2bf(lo) | (f2bf(hi) << 16); }

#define XB_TMO      128
#define XB_XCNT(j)  (256  + 64 * (j))
#define XB_XSUB(j)  (1280 + 64 * (j))
#define XB_XGEN(j)  (2304 + 64 * (j))
#define XB_TOP      3328
#define XB_TOPGEN   3392
#define XCD_BAR_WORDS 3456
#define XB_SPIN_CAP (1u << 22)

__device__ __forceinline__ unsigned xb_ld(unsigned* p)              { return __hip_atomic_load(p, __ATOMIC_RELAXED, __HIP_MEMORY_SCOPE_AGENT); }
__device__ __forceinline__ unsigned xb_add(unsigned* p, unsigned v) { return __hip_atomic_fetch_add(p, v, __ATOMIC_RELAXED, __HIP_MEMORY_SCOPE_AGENT); }
__device__ __forceinline__ unsigned xb_xcc_id() { return (unsigned)__builtin_amdgcn_s_getreg((3 << 11) | 20) & 0xFu; }
#define XB_SPIN(cond, bar) do { unsigned _sp = 0; while (cond) { __builtin_amdgcn_s_sleep(1); \
    if ((++_sp & 255u) == 0u) { if (xb_ld(&(bar)[XB_TMO])) break; if (_sp > XB_SPIN_CAP) { atomicAdd(&(bar)[XB_TMO], 1u); break; } } } } while (0)

struct XcdBarrier {
    unsigned* bar; unsigned x;
    volatile LAS unsigned* st;
};

__device__ __forceinline__ XcdBarrier xcd_barrier_post(unsigned* bar, volatile LAS unsigned* st) {
    XcdBarrier b; b.bar = bar; b.x = xb_xcc_id(); b.st = st;
    if (threadIdx.x == 0) (void)xb_add(&bar[XB_XCNT(b.x)], 1u);
    return b;
}
__device__ __forceinline__ void xcd_barrier_complete(unsigned* bar, unsigned x, unsigned& nloc, unsigned& nx) {
    const unsigned G = gridDim.x * gridDim.y * gridDim.z;
    unsigned sum, cnt, mine, sp = 0u;
    for (;;) {
        sum = 0u; cnt = 0u; mine = 0u;
#pragma unroll
        for (unsigned j = 0; j < 16; ++j) { const unsigned c = xb_ld(&bar[XB_XCNT(j)]); sum += c; cnt += (c > 0u) ? 1u : 0u; mine = (j == x) ? c : mine; }
        if (sum == G) break;
        __builtin_amdgcn_s_sleep(1);
        if ((++sp & 255u) == 0u) { if (xb_ld(&bar[XB_TMO])) break; if (sp > XB_SPIN_CAP) { atomicAdd(&bar[XB_TMO], 1u); break; } }
    }
    nloc = mine > 0u ? mine : 1u; nx = cnt > 0u ? cnt : 1u;
}

__device__ __forceinline__ void xcd_barrier(const XcdBarrier& b) {
    asm volatile("s_waitcnt vmcnt(0)" ::: "memory");
    __syncthreads();
    if (threadIdx.x == 0) {
        unsigned* bar = b.bar;
        __builtin_amdgcn_s_waitcnt(0);
        unsigned nloc = b.st[0], nx = b.st[1];
        if (nloc == 0u) { xcd_barrier_complete(bar, b.x, nloc, nx); b.st[0] = nloc; b.st[1] = nx; }
        const unsigned old = xb_add(&bar[XB_XSUB(b.x)], 1u);
        const unsigned gen = old / nloc;
        if (old + 1u == (gen + 1u) * nloc) {
            __builtin_amdgcn_fence(__ATOMIC_RELEASE, "agent");
            asm volatile("s_waitcnt vmcnt(0)" ::: "memory");
            const unsigned og = xb_add(&bar[XB_TOP], 1u);
            const unsigned tg = og / nx;
            if (og + 1u == (tg + 1u) * nx) xb_add(&bar[XB_TOPGEN], 1u);
            else XB_SPIN(xb_ld(&bar[XB_TOPGEN]) == tg, bar);
            __builtin_amdgcn_fence(__ATOMIC_ACQUIRE, "agent");
            xb_add(&bar[XB_XGEN(b.x)], 1u);
            asm volatile("s_waitcnt vmcnt(0)" ::: "memory");
        } else {
            XB_SPIN(xb_ld(&bar[XB_XGEN(b.x)]) == gen, bar);
            __builtin_amdgcn_fence(__ATOMIC_ACQUIRE, "agent");
            asm volatile("s_waitcnt vmcnt(0)" ::: "memory");
        }
    }
    __syncthreads();
}
typedef unsigned short bf16;
typedef unsigned v4u __attribute__((ext_vector_type(4)));
typedef unsigned v2u __attribute__((ext_vector_type(2)));
typedef float f32x2 __attribute__((ext_vector_type(2)));
__device__ __forceinline__ float bf2f(unsigned short b) { return __builtin_bit_cast(float, (unsigned)b << 16); }
__device__ __forceinline__ float bflo(unsigned u) { return __builtin_bit_cast(float, u << 16); }
__device__ __forceinline__ float bfhi(unsigned u) { return __builtin_bit_cast(float, u & 0xffff0000u); }
__device__ __forceinline__ float wave_sum(float v) {
#pragma unroll
    for (int o = 1; o < 64; o <<= 1) v += __shfl_xor(v, o);
    return v;
}
__device__ __forceinline__ float wave_max(float v) {
#pragma unroll
    for (int o = 1; o < 64; o <<= 1) v = fmaxf(v, __shfl_xor(v, o));
    return v;
}
struct Args { const float* in[18]; float* out; unsigned char* ws; int ph_lo, ph_hi; };
struct Frame {
    LAS unsigned char* lds; unsigned char* ldsg;
    volatile LAS unsigned* MISC;
    gu32* ctl;
    int tid, lane, wave, G, bid;
    unsigned char* ws;
};
__device__ __forceinline__ int pass_row(const Frame& F, int wave, int k) {
    return F.G == 256 ? (8 * ((F.bid % 8) / 2) + (F.bid / 8) % 8) * 256 + ((F.bid % 2) * 4 + F.bid / 64) * 32 + wave * 4 + k : (F.bid * NWAVES + wave) + k * (F.G * NWAVES); }
__device__ __forceinline__ int pass_nrows(const Frame& F, int wave) { const int gw = F.bid * NWAVES + wave, NGW = F.G * NWAVES; return F.G == 256 ? 4 : (gw < S ? (S - gw + NGW - 1) / NGW : 0); }

struct TrItem { const float* W; bf16* WT; const float* gain; int K, N, item; };
__device__ __forceinline__ void tr_load(const TrItem& t, int lane, f32x4 (&v)[16]) {
    const int nb = t.N >> 6, kb = t.item / nb, nbi = t.item - kb * nb, k0 = kb * 64, n0 = nbi * 64;
#pragma unroll
    for (int i = 0; i < 16; ++i) v[i] = __builtin_nontemporal_load((const f32x4*)(t.W + (size_t)(k0 + 4 * i + (lane >> 4)) * t.N + n0 + (lane & 15) * 4));
}
__device__ __forceinline__ void tr_store(const TrItem& t, int lane, const f32x4 (&v)[16], LAS float* scr) {
    const int nb = t.N >> 6, kb = t.item / nb, nbi = t.item - kb * nb, k0 = kb * 64, n0 = nbi * 64;
#pragma unroll
    for (int i = 0; i < 16; ++i) { LAS float* s = scr + (4 * i + (lane >> 4)) * 65 + (lane & 15) * 4; s[0] = v[i][0]; s[1] = v[i][1]; s[2] = v[i][2]; s[3] = v[i][3]; }
    LDS_WAIT(); asm volatile("" ::: "memory");
    const int c = lane & 7;
    float g[8];
#pragma unroll
    for (int i = 0; i < 8; ++i) g[i] = t.gain ? t.gain[k0 + 8 * c + i] : 1.0f;
#pragma unroll
    for (int j = 0; j < 8; ++j) { const int n = (lane >> 3) + 8 * j; const LAS float* s = scr + (8 * c) * 65 + n;
        v4u o; o.x = pk2(s[0 * 65] * g[0], s[1 * 65] * g[1]); o.y = pk2(s[2 * 65] * g[2], s[3 * 65] * g[3]); o.z = pk2(s[4 * 65] * g[4], s[5 * 65] * g[5]); o.w = pk2(s[6 * 65] * g[6], s[7 * 65] * g[7]);
        *(GAS v4u*)(t.WT + (size_t)(n0 + n) * t.K + k0 + 8 * c) = o; }
    LDS_WAIT(); asm volatile("" ::: "memory");
}
__device__ __forceinline__ int t5_bucket(int d) {
    if (d < 16) return d;
    const unsigned d2 = (unsigned)d * (unsigned)d; const int msb = 31 - __builtin_clz(d2);
    const int b = 16 + msb - 8; return b > 31 ? 31 : b;
}
__device__ __forceinline__ unsigned pack_i8x4(float a, float b, float c, float d) {
    const int ia = (int)__builtin_rintf(a), ib = (int)__builtin_rintf(b), ic = (int)__builtin_rintf(c), id = (int)__builtin_rintf(d);
    return ((unsigned)ia & 255u) | (((unsigned)ib & 255u) << 8) | (((unsigned)ic & 255u) << 16) | ((unsigned)id << 24);
}
__device__ __forceinline__ void st_ld(const float* W, int N, int k0, int n0, int lane, f32x4 (&v)[16]) {
    const float* p = W + (size_t)(k0 + (lane >> 4)) * N + n0 + (lane & 15) * 4; asm volatile("" : "+v"(p));
#pragma unroll
    for (int i = 0; i < 16; ++i) { v[i] = __builtin_nontemporal_load((const f32x4*)p); p += (size_t)4 * N; }
}
__device__ __forceinline__ void st_pk(const f32x4 (&v)[16], int k0, const LAS float* gl, int lane, unsigned (&h)[32], f32x4& cm) {
#pragma unroll
    for (int i = 0; i < 16; ++i) { const float g = gl[k0 + 4 * i + (lane >> 4)];
        const unsigned p0 = pg8::cvt_pk_bf16(v[i][0] * g, v[i][1] * g), p1 = pg8::cvt_pk_bf16(v[i][2] * g, v[i][3] * g); h[2 * i] = p0; h[2 * i + 1] = p1;
        cm[0] = fmaxf(cm[0], fabsf(bflo(p0))); cm[1] = fmaxf(cm[1], fabsf(bfhi(p0))); cm[2] = fmaxf(cm[2], fabsf(bflo(p1))); cm[3] = fmaxf(cm[3], fabsf(bfhi(p1))); }
    asm volatile("" ::: "memory"); __builtin_amdgcn_sched_barrier(0);
}
__device__ __forceinline__ void st_quant(const unsigned (&h)[32], f32x4 inv4, int k0, int n0, int lane, LAS float* scr, unsigned char* WQ) {
#pragma unroll
    for (int i = 0; i < 16; ++i) { LAS float* sp = scr + (4 * i + (lane >> 4)) * 65 + (lane & 15) * 4;
        sp[0] = bflo(h[2 * i]) * inv4[0]; sp[1] = bfhi(h[2 * i]) * inv4[1]; sp[2] = bflo(h[2 * i + 1]) * inv4[2]; sp[3] = bfhi(h[2 * i + 1]) * inv4[3]; }
    LDS_WAIT(); asm volatile("" ::: "memory");
    const int c = lane & 7;
#pragma unroll
    for (int j = 0; j < 8; ++j) { const int n = (lane >> 3) + 8 * j; const LAS float* sp = scr + (8 * c) * 65 + n;
        v2u o; o.x = pack_i8x4(sp[0 * 65], sp[1 * 65], sp[2 * 65], sp[3 * 65]); o.y = pack_i8x4(sp[4 * 65], sp[5 * 65], sp[6 * 65], sp[7 * 65]);
        *(GAS v2u*)(WQ + (size_t)(n0 + n) * DM + k0 + 8 * c) = o;
        if (j & 1) { asm volatile("" ::: "memory"); __builtin_amdgcn_sched_barrier(0); } }
    LDS_WAIT(); asm volatile("" ::: "memory");
}
__device__ __forceinline__ void p0_strips(const Args& A, Frame& F) {
    int tid = F.wave * 64 + lane_id_v(); asm volatile("" : "+v"(tid)); const int lane = tid & 63, wave = __builtin_amdgcn_readfirstlane(tid >> 6); (void)lane; (void)wave;
    LAS float* scr = (LAS float*)(F.lds + RING_OFF + wave * 16640);
    LAS float* cmx = (LAS float*)(F.lds + RING_OFF + 133120);
    LAS float* gl = (LAS float*)(F.lds + RING_OFF + 137216);
    const int gw = F.bid * NWAVES + wave, NGW = F.G * NWAVES;
    const float* mixn = A.in[2]; const float* mlpn = A.in[3];
    float* SWb = (float*)(F.ws + WS_SW);
    constexpr int NS_QKV = 2 * 96, NS_1 = 4 * 128, NSTRIP = NS_QKV + NS_1;
    struct SD { const float* W; const float* gain; unsigned char* WQ; float* SW; int N, n0; };
    auto dec = [&](int si) -> SD { SD d;
        if (si < NS_QKV) { const int j = si / 96, c = si - j * 96; d.W = A.in[5] + (size_t)j * DM * NQKV; d.gain = mixn + (2 * j) * DM; d.WQ = F.ws + WS_WQKV + (size_t)j * NQKV * DM; d.SW = SWb + SW_QKV + j * NQKV; d.N = NQKV; d.n0 = c * 64; }
        else { const int r = si - NS_QKV, l = r >> 7, c = r & 127; d.W = A.in[16] + (size_t)l * DM * FF; d.gain = mlpn + l * DM; d.WQ = F.ws + WS_W1 + (size_t)l * FF * DM; d.SW = SWb + SW_W1 + l * FF; d.N = FF; d.n0 = c * 64; }
        return d; };
    const int kb = wave * 256;
    int sp = 0;
    f32x4 v[16];
    if (F.bid < NSTRIP) { const SD d0 = dec(F.bid); st_ld(d0.W, d0.N, kb, d0.n0, lane, v); }
    for (int si = F.bid; si < NSTRIP; si += F.G, sp ^= 1) {
        const SD d = dec(si);
        __syncthreads();
#pragma unroll
        for (int i = 0; i < 4; ++i) gl[tid + 512 * i] = d.gain[tid + 512 * i];
        __syncthreads();
        unsigned hb[4][32]; f32x4 cm = (f32x4){0.f, 0.f, 0.f, 0.f};
        st_pk(v, kb, gl, lane, hb[0], cm);
#pragma unroll
        for (int t = 1; t < 4; ++t) { st_ld(d.W, d.N, kb + 64 * t, d.n0, lane, v); st_pk(v, kb + 64 * t, gl, lane, hb[t], cm); }
#pragma unroll
        for (int e = 0; e < 4; ++e) { float t = cm[e]; t = fmaxf(t, __shfl_xor(t, 16)); t = fmaxf(t, __shfl_xor(t, 32)); cm[e] = t; }
        if (lane < 16) *(LAS f32x4*)(cmx + (sp * 8 + wave) * 64 + lane * 4) = cm;
#pragma unroll
        for (int t = 0; t < 4; ++t)
#pragma unroll
            for (int k = 0; k < 32; ++k) asm volatile("" : "+v"(hb[t][k]));
        __syncthreads();
        f32x4 mx = *(const LAS f32x4*)(cmx + (sp * 8) * 64 + (lane & 15) * 4);
#pragma unroll
        for (int w = 1; w < 8; ++w) { const f32x4 t = *(const LAS f32x4*)(cmx + (sp * 8 + w) * 64 + (lane & 15) * 4);
#pragma unroll
            for (int e = 0; e < 4; ++e) mx[e] = fmaxf(mx[e], t[e]); }
        f32x4 inv4;
#pragma unroll
        for (int e = 0; e < 4; ++e) inv4[e] = mx[e] > 1e-30f ? 127.0f / mx[e] : 0.f;
        if (wave == 0 && lane < 16) *(f32x4*)(d.SW + d.n0 + lane * 4) = mx * (1.0f / 127.0f);
        st_quant(hb[0], inv4, kb, d.n0, lane, scr, d.WQ);
        if (si + F.G < NSTRIP) { const SD dn = dec(si + F.G); st_ld(dn.W, dn.N, kb, dn.n0, lane, v); }
#pragma unroll
        for (int t = 1; t < 4; ++t) st_quant(hb[t], inv4, kb + 64 * t, d.n0, lane, scr, d.WQ);
    }
}
__device__ __forceinline__ void p0_tiles(const Args& A, Frame& F) {
    int tid = F.wave * 64 + lane_id_v(); asm volatile("" : "+v"(tid)); const int lane = tid & 63, wave = __builtin_amdgcn_readfirstlane(tid >> 6); (void)lane; (void)wave;
    LAS float* scr = (LAS float*)(F.lds + RING_OFF + wave * 16640);
    const int gw = F.bid * NWAVES + wave, NGW = F.G * NWAVES; (void)gw; (void)NGW; (void)scr;
    constexpr int NSTRIP = 2 * 96 + 4 * 128;
    constexpr int T_O = 32 * 32, T_2 = 128 * 32, T_IN = 32 * 64;
    constexpr int NB = 4 * T_O + 4 * T_2 + 256 + 2 * T_IN;
    auto decode = [&](int it) -> TrItem {
        int r = it; TrItem t;
        if (r >= 4 * T_O + 4 * T_2 + 256) { r -= 4 * T_O + 4 * T_2 + 256; const int j = r / T_IN; r -= j * T_IN;
            t.W = A.in[7] + (size_t)j * DM * 2 * DM; t.WT = (bf16*)(F.ws + WS_WIN) + (size_t)j * 2 * DM * DM; t.gain = A.in[2] + (2 * j + 1) * DM; t.K = DM; t.N = 2 * DM; t.item = r; return t; }
        if (r >= 4 * T_O + 4 * T_2) { r -= 4 * T_O + 4 * T_2; const int blk = r >> 2, jg = blk >> 4, j = jg >> 1, g = jg & 1, n = blk & 15;
            t.W = A.in[g ? 12 : 10] + ((size_t)j * 16 + n) * 16384; t.WT = (bf16*)(F.ws + WS_WG) + (((size_t)j * 2 + g) * 16 + n) * 16384; t.gain = nullptr; t.K = 128; t.N = 128; t.item = r & 3; return t; }
        if (r < 4 * T_O) { const int jj = r / T_O, j = jj & 1; r -= jj * T_O;
            if (jj < 2) { t.W = A.in[6] + (size_t)j * DM * DM; t.WT = (bf16*)(F.ws + WS_WO) + (size_t)j * DM * DM; }
            else { t.W = A.in[15] + (size_t)j * DM * DM; t.WT = (bf16*)(F.ws + WS_WOUT) + (size_t)j * DM * DM; }
            t.gain = nullptr; t.K = DM; t.N = DM; t.item = r; return t; }
        r -= 4 * T_O;
        const int l = r / T_2; r -= l * T_2;
        t.W = A.in[17] + (size_t)l * FF * DM; t.WT = (bf16*)(F.ws + WS_W2) + (size_t)l * DM * FF; t.gain = nullptr; t.K = FF; t.N = DM; t.item = r; return t;
    };
    {
        constexpr int SW_ = 32;
        const int per = (NSTRIP * SW_ + NB + F.G - 1) / F.G;
        int start = 0, cnt = 0;
        for (int b2 = 0; b2 <= F.bid; ++b2) { const int ns = b2 < NSTRIP ? (NSTRIP - b2 + F.G - 1) / F.G : 0; int q = per - SW_ * ns; q = q < 0 ? 0 : q; if (b2 < F.bid) start += q; else cnt = q; }
        int tot = start;
        for (int b2 = F.bid; b2 < F.G; ++b2) { const int ns = b2 < NSTRIP ? (NSTRIP - b2 + F.G - 1) / F.G : 0; int q = per - SW_ * ns; tot += q < 0 ? 0 : q; }
        int end = start + cnt; if (end > NB) end = NB; if (start > NB) start = NB;
        f32x4 va[16], vb[16];
        for (int pass = 0; pass < 2; ++pass) {
            const int first = pass == 0 ? start + wave : (tot < NB ? tot + gw : NB), lim = pass == 0 ? end : NB, step = pass == 0 ? NWAVES : NGW;
            if (first >= lim) continue;
            TrItem cur = decode(first); tr_load(cur, lane, va);
            for (int it = first; it < lim; it += 2 * step) {
                const bool h1 = it + step < lim; TrItem n1 = cur; if (h1) { n1 = decode(it + step); tr_load(n1, lane, vb); }
                tr_store(cur, lane, va, scr);
                if (!h1) break;
                const bool h2 = it + 2 * step < lim; if (h2) { cur = decode(it + 2 * step); tr_load(cur, lane, va); }
                tr_store(n1, lane, vb, scr);
                if (!h2) break;
            }
        }
    }
}
__device__ __forceinline__ void p0_x(const Args& A, Frame& F) {
    int tid = F.wave * 64 + lane_id_v(); asm volatile("" : "+v"(tid)); const int lane = tid & 63, wave = __builtin_amdgcn_readfirstlane(tid >> 6); (void)lane; (void)wave;
    LAS float* scr = (LAS float*)(F.lds + RING_OFF + wave * 16640);
    const int gw = F.bid * NWAVES + wave, NGW = F.G * NWAVES; (void)gw; (void)NGW; (void)scr;
    { const float* x = A.in[0]; bf16* XB = (bf16*)(F.ws + WS_XB); unsigned char* XQ = F.ws + WS_XQ; float* frow = (float*)(F.ws + WS_FROW);
      for (int m = gw; m < S; m += NGW) { const GAS f32x4* xr = (const GAS f32x4*)(x + (size_t)m * DM) + lane;
          GAS v2u* xb = (GAS v2u*)(XB + (size_t)m * DM) + lane; GAS unsigned* xq = (GAS unsigned*)(XQ + (size_t)m * DM) + lane; float s = 0.f, am = 0.f;
          f32x4 v[8];
#pragma unroll
          for (int j = 0; j < 8; ++j) v[j] = xr[64 * j];
#pragma unroll
          for (int j = 0; j < 8; ++j) { s += (v[j].x * v[j].x + v[j].y * v[j].y) + (v[j].z * v[j].z + v[j].w * v[j].w); am = fmaxf(fmaxf(am, fmaxf(fabsf(v[j].x), fabsf(v[j].y))), fmaxf(fabsf(v[j].z), fabsf(v[j].w)));
              v2u o; o.x = pk2(v[j].x, v[j].y); o.y = pk2(v[j].z, v[j].w); xb[64 * j] = o; }
          s = wave_sum(s); am = wave_max(am);
          const float inv = am > 1e-30f ? 127.0f / am : 0.f;
#pragma unroll
          for (int j = 0; j < 8; ++j) xq[64 * j] = pack_i8x4(v[j].x * inv, v[j].y * inv, v[j].z * inv, v[j].w * inv);
          if (lane == 0) { const float rstd = __builtin_amdgcn_rsqf(s * (1.0f / 2048.0f) + 1e-6f); frow[m] = am * (1.0f / 127.0f) * rstd; ((float*)(F.ws + WS_RSTD))[m] = rstd; } } }
    { const float* rb = A.in[1]; float* bt = (float*)(F.ws + WS_BIAS);
      for (int i = F.bid * (NWAVES * 64) + tid; i < NH * BIAS_LD; i += F.G * NWAVES * 64) { const int h = i / BIAS_LD, d = i - h * BIAS_LD - 256;
          bt[i] = d < 0 ? -INFINITY : rb[t5_bucket(d) * NH + h] * 1.4426950408889634f; } }
}
__device__ __forceinline__ void p0_prologue(const Args& A, Frame& F) { p0_strips(A, F); p0_tiles(A, F); p0_x(A, F); }
#define TOP3_INS(x_, j_) do { const float x__ = (x_); const int j__ = (j_); const bool b0 = x__ > v0, b1 = x__ > v1, b2 = x__ > v2; \
    v2 = b1 ? v1 : (b2 ? x__ : v2); i2 = b1 ? i1 : (b2 ? j__ : i2); v1 = b0 ? v0 : (b1 ? x__ : v1); i1 = b0 ? i0 : (b1 ? j__ : i1); v0 = b0 ? x__ : v0; i0 = b0 ? j__ : i0; } while (0)
__device__ __forceinline__ void phase_gate(const Args& A, Frame& F, int ja) {
    int tid = F.wave * 64 + lane_id_v(); asm volatile("" : "+v"(tid)); const int lane = tid & 63, wave = __builtin_amdgcn_readfirstlane(tid >> 6); (void)lane; (void)wave;
    const bf16* QKV = (const bf16*)(F.ws + WS_QKV); const float* KMP = (const float*)(F.ws + WS_KMP);
    unsigned* cnt = (unsigned*)(F.ctl + CW_CNT + ja * 512); unsigned* list = (unsigned*)(F.ws + WS_LIST); float* LSE = (float*)(F.ws + WS_LSE);
    LAS float* km = (LAS float*)(F.lds + RING_OFF);
    LAS float* cv = km + 32 * 128;
    LAS int* ci = (LAS int*)(cv + 256 * 3);
    for (int item = F.bid; item < 512; item += F.G) {
        const int h = item & 15, c = item >> 4;
        for (int i = tid; i < 32 * 128; i += NWAVES * 64) { const int jb = i >> 7, d = i & 127;
            km[i] = (KMP[(size_t)jb * 2048 + h * 128 + d] + KMP[(size_t)(32 + jb) * 2048 + h * 128 + d]) * (1.0f / 256.0f); }
        __syncthreads();
        const int t = tid & 255, half = tid >> 8, q = c * 256 + t;
        float g[16];
#pragma unroll
        for (int jb = 0; jb < 16; ++jb) g[jb] = 0.f;
        const bf16* qp = QKV + (size_t)q * NQKV + h * HD;
        const LAS float* kmh = km + half * 16 * 128;
#pragma unroll 1
        for (int d0 = 0; d0 < 128; d0 += 8) {
            const v4u qv = *(const v4u*)(qp + d0);
            const float q0 = bflo(qv.x), q1 = bfhi(qv.x), q2 = bflo(qv.y), q3 = bfhi(qv.y), q4 = bflo(qv.z), q5 = bfhi(qv.z), q6 = bflo(qv.w), q7 = bfhi(qv.w);
#pragma unroll
            for (int jb = 0; jb < 16; ++jb) { const f32x4 k0 = *(const LAS f32x4*)(kmh + jb * 128 + d0), k1 = *(const LAS f32x4*)(kmh + jb * 128 + d0 + 4);
                g[jb] += (q0 * k0[0] + q1 * k0[1]) + (q2 * k0[2] + q3 * k0[3]) + (q4 * k1[0] + q5 * k1[1]) + (q6 * k1[2] + q7 * k1[3]);
                if ((jb & 3) == 3) __builtin_amdgcn_sched_barrier(0); }
        }
        float v0 = -INFINITY, v1 = -INFINITY, v2 = -INFINITY; int i0 = -1, i1 = -1, i2 = -1;
#pragma unroll
        for (int jb = 0; jb < 16; ++jb) { const int j = half * 16 + jb; if (j < c) TOP3_INS(g[jb], j); }
        if (half == 1) { cv[t * 3 + 0] = v0; cv[t * 3 + 1] = v1; cv[t * 3 + 2] = v2; ci[t * 3 + 0] = i0; ci[t * 3 + 1] = i1; ci[t * 3 + 2] = i2; }
        __syncthreads();
        if (half == 0) {
            { const int j = ci[t * 3 + 0]; if (j >= 0) TOP3_INS(cv[t * 3 + 0], j); }
            { const int j = ci[t * 3 + 1]; if (j >= 0) TOP3_INS(cv[t * 3 + 1], j); }
            { const int j = ci[t * 3 + 2]; if (j >= 0) TOP3_INS(cv[t * 3 + 2], j); }
#define EMIT_PICK(k_, sj_) do { if ((sj_) >= 0) { const unsigned pos = atomicAdd(&cnt[h * 32 + (sj_)], 1u); list[(size_t)(h * 32 + (sj_)) * 8192 + pos] = ((unsigned)q << 2) | (unsigned)(k_); } \
                else LSE[((size_t)q * NH + h) * 4 + (k_)] = -INFINITY; } while (0)
            EMIT_PICK(0, i0); EMIT_PICK(1, i1); EMIT_PICK(2, i2);
#undef EMIT_PICK
        }
        __syncthreads();
    }
}
__device__ __forceinline__ void attn_entry(const Args& A, Frame& F, int q, int h, int jb, int slot) {
    int tid = F.wave * 64 + lane_id_v(); asm volatile("" : "+v"(tid)); const int lane = tid & 63, wave = __builtin_amdgcn_readfirstlane(tid >> 6); (void)lane; (void)wave;
    const bf16* QKV = (const bf16*)(F.ws + WS_QKV); const int l = lane;
    const bf16* qp = QKV + (size_t)q * NQKV + h * HD;
    const bf16* Kb = QKV + (size_t)(jb * BLK) * NQKV + DM + h * HD; const bf16* Vb = Kb + DM;
    float s[4] = {0.f, 0.f, 0.f, 0.f};
    for (int d0 = 0; d0 < 128; d0 += 8) {
        const v4u qv = *(const v4u*)(qp + d0);
        const float q0 = bflo(qv.x), q1 = bfhi(qv.x), q2 = bflo(qv.y), q3 = bfhi(qv.y), q4 = bflo(qv.z), q5 = bfhi(qv.z), q6 = bflo(qv.w), q7 = bfhi(qv.w);
#pragma unroll
        for (int kk = 0; kk < 4; ++kk) { const v4u kv = *(const v4u*)(Kb + (size_t)(l + 64 * kk) * NQKV + d0);
            s[kk] += (q0 * bflo(kv.x) + q1 * bfhi(kv.x)) + (q2 * bflo(kv.y) + q3 * bfhi(kv.y)) + (q4 * bflo(kv.z) + q5 * bfhi(kv.z)) + (q6 * bflo(kv.w) + q7 * bfhi(kv.w)); }
    }
    const float C = 0.088388347648318440f * 1.4426950408889634f;
    const float* bt = (const float*)(F.ws + WS_BIAS) + h * BIAS_LD + 256;
    float t[4], m = -INFINITY;
#pragma unroll
    for (int kk = 0; kk < 4; ++kk) { const int d = q - (jb * BLK + l + 64 * kk); t[kk] = s[kk] * C + bt[d]; m = fmaxf(m, t[kk]); }
    m = wave_max(m);
    float p[4], ls = 0.f;
#pragma unroll
    for (int kk = 0; kk < 4; ++kk) { p[kk] = __builtin_amdgcn_exp2f(t[kk] - m); ls += p[kk]; }
    ls = wave_sum(ls);
    const int c0 = 64 * (l >> 5) + (l & 31);
    float o0 = 0.f, o1 = 0.f;
#pragma unroll
    for (int kk = 0; kk < 4; ++kk)
        for (int src = 0; src < 64; ++src) { const float pk = __shfl(p[kk], src); const bf16* vr = Vb + (size_t)(src + 64 * kk) * NQKV;
            o0 += pk * bf2f(vr[c0]); o1 += pk * bf2f(vr[c0 + 32]); }
    const float inv = 1.0f / ls;
    unsigned* PART = (unsigned*)(F.ws + WS_HID); float* LSE = (float*)(F.ws + WS_LSE);
    const size_t e = ((size_t)q * NH + h) * 4 + slot;
    PART[e * 64 + l] = pk2(o0 * inv, o1 * inv);
    if (l == 0) LSE[e] = m + __builtin_amdgcn_logf(ls);
}
__device__ __forceinline__ void phase_attn(const Args& A, Frame& F, int ja) {
    int tid = F.wave * 64 + lane_id_v(); asm volatile("" : "+v"(tid)); const int lane = tid & 63, wave = __builtin_amdgcn_readfirstlane(tid >> 6); (void)lane; (void)wave;
    const unsigned* cnt = (const unsigned*)(F.ctl + CW_CNT + ja * 512); const unsigned* list = (const unsigned*)(F.ws + WS_LIST);
    LAS unsigned* pre = (LAS unsigned*)(F.lds + RING_OFF);
    LAS unsigned* cl = pre + 520;
    for (int i = tid; i < 512; i += NWAVES * 64) cl[i] = __hip_atomic_load(cnt + i, RLX_AGENT);
    __syncthreads();
    if (tid == 0) { unsigned a = 0; for (int i = 0; i < 512; ++i) { pre[i] = a; a += (cl[i] + 7u) >> 3; } pre[512] = a; }
    __syncthreads();
    const int total = (int)pre[512];
    for (int tile = F.bid; tile < total + S * NH / 8; tile += F.G) {
        if (tile < total) {
            int lo = 0, hi = 512;
            while (hi - lo > 1) { const int mid = (lo + hi) >> 1; if ((int)pre[mid] <= tile) lo = mid; else hi = mid; }
            const int e = (tile - (int)pre[lo]) * 8 + wave;
            if (e < (int)cl[lo]) { const unsigned ent = list[(size_t)lo * 8192 + e]; attn_entry(A, F, (int)(ent >> 2), lo >> 5, lo & 31, (int)(ent & 3u)); }
        } else { const int e = (tile - total) * 8 + wave; const int q = e >> 4, h = e & 15; attn_entry(A, F, q, h, q >> 8, 3); }
    }
}
namespace at {
using bf16x8 = __attribute__((ext_vector_type(8))) short;
using s16x4  = __attribute__((ext_vector_type(4))) short;
using f32x16 = __attribute__((ext_vector_type(16))) float;
using u32x4  = __attribute__((ext_vector_type(4))) unsigned;
constexpr int KVBLK = 64, LDK = NQKV;
constexpr int SHM_V = KVBLK * 128 * 2, SHM_K = KVBLK * 128 * 2;
constexpr int OFF_V = 0, OFF_K = 2 * SHM_V, OFF_WS = OFF_K + 2 * SHM_K, OFF_DST = OFF_WS + 8 * 256, OFF_BT = OFF_DST + 8 * 128, OFF_PRE = OFF_BT + BIAS_LD * 4, OFF_CL = OFF_PRE + 1032 * 4, OFF_WT = OFF_CL + 512 * 4, OFF_END = OFF_WT + 64;
static_assert(OFF_END <= RING_BYTES, "attention LDS map");
#define KSWZ(row, colB) ((row) * 256 + ((colB) ^ (((row) & 7) << 4)))
#define SBAR() __builtin_amdgcn_sched_barrier(0)
__device__ __forceinline__ int crow(int r, int hi) { return (r & 3) + 8 * (r >> 2) + 4 * hi; }
__device__ __forceinline__ unsigned cvtpk(float lo, float hi) { unsigned r; asm volatile("v_cvt_pk_bf16_f32 %0, %1, %2" : "=v"(r) : "v"(lo), "v"(hi)); return r; }
__device__ __forceinline__ void partialSM(f32x16& p0, f32x16& p1, const LAS float* bp, float& m_reg, float& alpha) {
    constexpr float C = 0.088388347648318440f * 1.4426950408889634f;
#pragma unroll
    for (int r = 0; r < 16; ++r) p0[r] = fmaf(p0[r], C, bp[59 - ((r & 3) + 8 * (r >> 2))]);
#pragma unroll
    for (int r = 0; r < 16; ++r) p1[r] = fmaf(p1[r], C, bp[27 - ((r & 3) + 8 * (r >> 2))]);
    float pmax = p0[0];
#pragma unroll
    for (int r = 1; r < 16; ++r) pmax = fmaxf(pmax, p0[r]);
#pragma unroll
    for (int r = 0; r < 16; ++r) pmax = fmaxf(pmax, p1[r]);
    { auto rr = __builtin_amdgcn_permlane32_swap(__float_as_uint(pmax), __float_as_uint(pmax), false, false); pmax = fmaxf(__uint_as_float(rr[0]), __uint_as_float(rr[1])); }
    float mn = m_reg; alpha = 1.f;
    if (!__all(pmax <= m_reg + 8.0f)) { const bool up = pmax > m_reg + 8.0f;
        mn = up ? pmax : m_reg; alpha = up ? __builtin_amdgcn_exp2f(m_reg - mn) : 1.f; m_reg = mn; }
#pragma unroll
    for (int r = 0; r < 16; ++r) p0[r] -= mn;
#pragma unroll
    for (int r = 0; r < 16; ++r) p1[r] -= mn;
#pragma unroll
    for (int r = 0; r < 16; ++r) p0[r] = __builtin_amdgcn_exp2f(p0[r]);
}
__device__ __forceinline__ void finishSM(f32x16& p0, f32x16& p1, float alpha, float& l_reg, bf16x8& pa0, bf16x8& pa1, bf16x8& pa2, bf16x8& pa3) {
#pragma unroll
    for (int r = 0; r < 16; ++r) p1[r] = __builtin_amdgcn_exp2f(p1[r]);
    float ps = 0;
#pragma unroll
    for (int r = 0; r < 16; ++r) ps += p0[r];
#pragma unroll
    for (int r = 0; r < 16; ++r) ps += p1[r];
    { auto rr = __builtin_amdgcn_permlane32_swap(__float_as_uint(ps), __float_as_uint(ps), false, false); ps = __uint_as_float(rr[0]) + __uint_as_float(rr[1]); }
    l_reg = l_reg * alpha + ps;
#define PK4(P, BASE, OUT) do { unsigned a0 = cvtpk(P[BASE + 0], P[BASE + 1]), a1 = cvtpk(P[BASE + 2], P[BASE + 3]);   \
    unsigned b0 = cvtpk(P[BASE + 4], P[BASE + 5]), b1 = cvtpk(P[BASE + 6], P[BASE + 7]);                              \
    auto r0 = __builtin_amdgcn_permlane32_swap(a0, b0, false, false); auto r1 = __builtin_amdgcn_permlane32_swap(a1, b1, false, false); \
    u32x4 w = {r0[0], r1[0], r0[1], r1[1]}; OUT = *reinterpret_cast<bf16x8*>(&w); } while (0)
    PK4(p0, 0, pa0); PK4(p0, 8, pa1); PK4(p1, 0, pa2); PK4(p1, 8, pa3);
#undef PK4
}
__device__ __forceinline__ void qkt(f32x16& p0, f32x16& p1, const LAS unsigned char* Ks, const bf16x8* qr, int r32, int hi) {
    p0 = f32x16{}; p1 = f32x16{};
#pragma unroll
    for (int d0 = 0; d0 < 8; ++d0) { const int cb = (d0 * 16 + hi * 8) * 2;
        const bf16x8 b0 = *reinterpret_cast<const LAS bf16x8*>(Ks + KSWZ(r32, cb));
        const bf16x8 b1 = *reinterpret_cast<const LAS bf16x8*>(Ks + KSWZ(32 + r32, cb));
        p0 = __builtin_amdgcn_mfma_f32_32x32x16_bf16(b0, qr[d0], p0, 0, 0, 0);
        p1 = __builtin_amdgcn_mfma_f32_32x32x16_bf16(b1, qr[d0], p1, 0, 0, 0); }
}
__device__ __forceinline__ int v_st(int k, int c) { const int kk = (k & ~0xC) | ((k & 4) << 1) | ((k & 8) >> 1); return ((kk >> 3) * 4 + (c >> 5)) * 512 + ((kk & 7) * 32 + (c & 31)) * 2; }
__device__ __forceinline__ int v_rd_base(int lane) { return ((lane & 3) << 3) | (((lane >> 2) & 3) << 6) | (((lane >> 4) & 1) << 5) | (((lane >> 5) & 1) << 8); }
constexpr int v_rd_off(int d0, int ks, int half) { return d0 * 512 + ks * 4096 + half * 2048; }
template <int OFF> __device__ __forceinline__ s16x4 tr_read(int vb) { s16x4 r; asm volatile("ds_read_b64_tr_b16 %0, %1 offset:%2" : "=&v"(r) : "v"(vb), "i"(OFF) : "memory"); return r; }
template <int D0> __device__ __forceinline__ void pv_one(f32x16& od, int vb, bf16x8 pa0, bf16x8 pa1, bf16x8 pa2, bf16x8 pa3) {
    const s16x4 l0 = tr_read<v_rd_off(D0, 0, 0)>(vb), h0 = tr_read<v_rd_off(D0, 0, 1)>(vb), l1 = tr_read<v_rd_off(D0, 1, 0)>(vb), h1 = tr_read<v_rd_off(D0, 1, 1)>(vb);
    const s16x4 l2 = tr_read<v_rd_off(D0, 2, 0)>(vb), h2 = tr_read<v_rd_off(D0, 2, 1)>(vb), l3 = tr_read<v_rd_off(D0, 3, 0)>(vb), h3 = tr_read<v_rd_off(D0, 3, 1)>(vb);
    asm volatile("s_waitcnt lgkmcnt(0)" ::: "memory"); SBAR();
#define PK(L, H) (bf16x8){L[0], L[1], L[2], L[3], H[0], H[1], H[2], H[3]}
    od = __builtin_amdgcn_mfma_f32_32x32x16_bf16(pa0, PK(l0, h0), od, 0, 0, 0);
    od = __builtin_amdgcn_mfma_f32_32x32x16_bf16(pa1, PK(l1, h1), od, 0, 0, 0);
    od = __builtin_amdgcn_mfma_f32_32x32x16_bf16(pa2, PK(l2, h2), od, 0, 0, 0);
    od = __builtin_amdgcn_mfma_f32_32x32x16_bf16(pa3, PK(l3, h3), od, 0, 0, 0);
#undef PK
}
__device__ __forceinline__ void pv_d0(f32x16* o, int vb, bf16x8 pa0, bf16x8 pa1, bf16x8 pa2, bf16x8 pa3) {
    pv_one<0>(o[0], vb, pa0, pa1, pa2, pa3); pv_one<1>(o[1], vb, pa0, pa1, pa2, pa3); pv_one<2>(o[2], vb, pa0, pa1, pa2, pa3); pv_one<3>(o[3], vb, pa0, pa1, pa2, pa3);
}
__device__ __forceinline__ void attn_unit(const bf16* __restrict__ QKV, int h, int jb, int q, int dsti, LAS unsigned char* lds, unsigned* __restrict__ PART, float* __restrict__ LSE, int tid) {
    const int wid = tid >> 6, lane = tid & 63, r32 = lane & 31, hi = lane >> 5;
    LAS unsigned char* V_lds = lds + OFF_V; LAS unsigned char* K_lds = lds + OFF_K;
    LAS float* ws = (LAS float*)(lds + OFF_WS) + wid * 64; LAS float* li_l = ws; LAS float* al_l = ws + 32;
    LAS int* dst_l = (LAS int*)(lds + OFF_DST) + wid * 32;
    const LAS float* bt = (const LAS float*)(lds + OFF_BT);
    const bf16* Kh = QKV + (size_t)(jb * BLK) * LDK + DM + h * HD; const bf16* Vh = Kh + DM;
    float m_reg = -1e30f, l_reg = 0; f32x16 o[4] = {}; bf16x8 qr[8];
    const bf16* Qw = QKV + (size_t)q * LDK + h * HD + hi * 8;
#pragma unroll
    for (int d0 = 0; d0 < 8; ++d0) qr[d0] = *reinterpret_cast<const bf16x8*>(Qw + d0 * 16);
    if (hi == 0) dst_l[r32] = dsti;
    const LAS float* bp0 = bt + (q - jb * BLK - 4 * hi + 256 - 59);
    const int sr = tid >> 4, sc = (tid & 15) * 8, vst0 = v_st(sr, sc), vst1 = v_st(32 + sr, sc);
    const int vb0 = (int)(uintptr_t)V_lds + v_rd_base(lane);
    struct { bf16x8 vs0, vs1, ks0, ks1; } sr_[2];
#define SLOAD(i, k0) do { sr_[i].vs0 = *reinterpret_cast<const bf16x8*>(&Vh[(size_t)((k0) + sr) * LDK + sc]); sr_[i].vs1 = *reinterpret_cast<const bf16x8*>(&Vh[(size_t)((k0) + 32 + sr) * LDK + sc]); \
    sr_[i].ks0 = *reinterpret_cast<const bf16x8*>(&Kh[(size_t)((k0) + sr) * LDK + sc]); sr_[i].ks1 = *reinterpret_cast<const bf16x8*>(&Kh[(size_t)((k0) + 32 + sr) * LDK + sc]); } while (0)
#define SWRITE(b, i) do { *(LAS bf16x8*)(V_lds + (b) * SHM_V + vst0) = sr_[i].vs0; *(LAS bf16x8*)(V_lds + (b) * SHM_V + vst1) = sr_[i].vs1; const int kc = sc * 2; \
    *(LAS bf16x8*)(K_lds + (b) * SHM_K + KSWZ(sr, kc)) = sr_[i].ks0; *(LAS bf16x8*)(K_lds + (b) * SHM_K + KSWZ(32 + sr, kc)) = sr_[i].ks1; } while (0)
#define SWAIT() asm volatile("s_waitcnt vmcnt(4)" ::: "memory")
#define RESC(a) do { if (__any((a) < 1.f)) { if (hi == 0) al_l[r32] = (a); asm volatile("s_waitcnt lgkmcnt(0)" ::: "memory"); \
    _Pragma("unroll") for (int d = 0; d < 4; ++d) _Pragma("unroll") for (int r = 0; r < 16; ++r) o[d][r] *= al_l[crow(r, hi)]; } } while (0)
    f32x16 pA0, pA1, pB0, pB1; float alA, alB; bf16x8 pa0, pa1, pa2, pa3;
    SLOAD(0, 0); asm volatile("s_waitcnt vmcnt(0)" ::: "memory"); SWRITE(0, 0); __syncthreads();
    qkt(pA0, pA1, K_lds, qr, r32, hi); partialSM(pA0, pA1, bp0, m_reg, alA);
    SLOAD(1, KVBLK); SLOAD(0, 2 * KVBLK);
    SWAIT(); SWRITE(1, 1); __syncthreads();
    SBAR(); qkt(pB0, pB1, K_lds + SHM_K, qr, r32, hi);
    finishSM(pA0, pA1, alA, l_reg, pa0, pa1, pa2, pa3); SBAR();
    SLOAD(1, 3 * KVBLK); SBAR();
    pv_d0(o, vb0, pa0, pa1, pa2, pa3); partialSM(pB0, pB1, bp0 - 64, m_reg, alB);
    __syncthreads(); SWAIT(); SWRITE(0, 0);
    RESC(alB); __syncthreads();
    SBAR(); qkt(pA0, pA1, K_lds, qr, r32, hi);
    finishSM(pB0, pB1, alB, l_reg, pa0, pa1, pa2, pa3); SBAR();
    pv_d0(o, vb0 + SHM_V, pa0, pa1, pa2, pa3); partialSM(pA0, pA1, bp0 - 128, m_reg, alA);
    __syncthreads(); asm volatile("s_waitcnt vmcnt(0)" ::: "memory"); SWRITE(1, 1);
    RESC(alA); __syncthreads();
    SBAR(); qkt(pB0, pB1, K_lds + SHM_K, qr, r32, hi);
    finishSM(pA0, pA1, alA, l_reg, pa0, pa1, pa2, pa3); SBAR();
    pv_d0(o, vb0, pa0, pa1, pa2, pa3); partialSM(pB0, pB1, bp0 - 192, m_reg, alB);
    RESC(alB);
    finishSM(pB0, pB1, alB, l_reg, pa0, pa1, pa2, pa3); SBAR();
    pv_d0(o, vb0 + SHM_V, pa0, pa1, pa2, pa3);
    if (hi == 0) { li_l[r32] = l_reg; if (dsti >= 0) LSE[dsti] = m_reg + __builtin_amdgcn_logf(l_reg); }
    asm volatile("s_waitcnt lgkmcnt(0)" ::: "memory");
#pragma unroll
    for (int r = 0; r < 16; ++r) { const int row = crow(r, hi); const float rl = __builtin_amdgcn_rcpf(li_l[row]); const int ds = dst_l[row];
        if (ds >= 0) { unsigned* pp = PART + (size_t)ds * 64 + r32; pp[0] = cvtpk(o[0][r] * rl, o[1][r] * rl); pp[32] = cvtpk(o[2][r] * rl, o[3][r] * rl); } }
    __syncthreads();
#undef SLOAD
#undef SWRITE
#undef SWAIT
#undef RESC
}
}
__device__ __forceinline__ void phase_attn_mfma(const Args& A, Frame& F, int ja) {
    int tid = F.wave * 64 + lane_id_v(); asm volatile("" : "+v"(tid));
    const unsigned* cnt = (const unsigned*)(F.ctl + CW_CNT + ja * 512); const unsigned* list = (const unsigned*)(F.ws + WS_LIST);
    LAS unsigned char* lds = F.lds + RING_OFF;
    LAS unsigned* pre = (LAS unsigned*)(lds + at::OFF_PRE);
    LAS unsigned* cl = (LAS unsigned*)(lds + at::OFF_CL);
    for (int i = tid; i < 512; i += NWAVES * 64) cl[i] = __hip_atomic_load(cnt + i, RLX_AGENT);
    __syncthreads();
    {
        const int g0 = 2 * tid, h0 = g0 >> 6, x0 = g0 & 63;
        const unsigned n0 = x0 < 32 ? (cl[h0 * 32 + x0] + 255u) >> 8 : 1u, n1 = (x0 + 1) < 32 ? (cl[h0 * 32 + x0 + 1] + 255u) >> 8 : 1u;
        unsigned v = n0 + n1; const int ln = tid & 63;
#pragma unroll
        for (int o = 1; o < 64; o <<= 1) { const unsigned t = __shfl_up(v, o); if (ln >= o) v += t; }
        LAS unsigned* wt = (LAS unsigned*)(lds + at::OFF_WT);
        if (ln == 63) wt[tid >> 6] = v;
        __syncthreads();
        unsigned base = 0;
        for (int w = 0; w < (tid >> 6); ++w) base += wt[w];
        const unsigned excl = base + v - (n0 + n1);
        pre[g0] = excl; pre[g0 + 1] = excl + n0;
        if (tid == NWAVES * 64 - 1) pre[1024] = base + v;
    }
    __syncthreads();
    const unsigned U = pre[1024];
    const unsigned u0 = (unsigned)(((unsigned long long)F.bid * U) / (unsigned)F.G), u1 = (unsigned)(((unsigned long long)(F.bid + 1) * U) / (unsigned)F.G);
    int cur_h = -1;
    const int wave = tid >> 6, r32 = tid & 31;
    for (unsigned u = u0; u < u1; ++u) {
        int lo = 0, hi_ = 1024;
        while (hi_ - lo > 1) { const int mid = (lo + hi_) >> 1; if (pre[mid] <= u) lo = mid; else hi_ = mid; }
        const int g = lo, h = g >> 6, x = g & 63, tile = (int)(u - pre[g]);
        if (h != cur_h) { __syncthreads(); const float* bsrc = (const float*)(F.ws + WS_BIAS) + h * BIAS_LD; LAS float* btl = (LAS float*)(lds + at::OFF_BT);
            {
                const int wv_ = __builtin_amdgcn_readfirstlane(tid >> 6), ln_ = tid & 63;
#pragma unroll
                for (int j = 0; j < 4; ++j) __builtin_amdgcn_global_load_lds((const unsigned*)(bsrc + (j * 8 + wv_) * 256 + ln_ * 4), (LAS unsigned*)((LAS unsigned char*)btl + (j * 8 + wv_) * 1024), 16, 0, 0);
                if (wv_ == 0) __builtin_amdgcn_global_load_lds((const unsigned*)(bsrc + 32 * 256 + ln_ * 4), (LAS unsigned*)((LAS unsigned char*)btl + 32 * 1024), 16, 0, 0); }
            cur_h = h; }
        int q, dsti, jb;
        if (x < 32) { jb = x; const int n = (int)cl[h * 32 + x]; const int e = tile * 256 + wave * 32 + r32; const unsigned ent = list[(size_t)(h * 32 + x) * 8192 + (e < n ? e : n - 1)];
            q = (int)(ent >> 2); dsti = e < n ? (q * NH + h) * 4 + (int)(ent & 3u) : -1; }
        else { jb = x - 32; q = jb * BLK + wave * 32 + r32; dsti = (q * NH + h) * 4 + 3; }
        at::attn_unit((const bf16*)(F.ws + WS_QKV), h, jb, q, dsti, lds, (unsigned*)(F.ws + WS_HID), (float*)(F.ws + WS_LSE), tid);
    }
}
template <bool OWN>
__device__ __forceinline__ void attn_phase(const Args& A, Frame& F, int ja) {
    using namespace at;
    int tid = F.wave * 64 + lane_id_v(); asm volatile("" : "+v"(tid));
    const int wid = tid >> 6, lane = tid & 63, r32 = lane & 31, hi = lane >> 5;
    const bf16* __restrict__ QKV = (const bf16*)(F.ws + WS_QKV);
    const unsigned* cnt = (const unsigned*)(F.ctl + CW_CNT + ja * 512); const unsigned* list = (const unsigned*)(F.ws + WS_LIST);
    unsigned* __restrict__ PART = (unsigned*)(F.ws + WS_HID); float* __restrict__ LSE = (float*)(F.ws + WS_LSE); bf16* __restrict__ AO = (bf16*)(F.ws + WS_AO);
    LAS unsigned char* lds = F.lds + RING_OFF;
    LAS unsigned char* V_lds = lds + OFF_V; LAS unsigned char* K_lds = lds + OFF_K;
    LAS float* ws = (LAS float*)(lds + OFF_WS) + wid * 64; LAS float* li_l = ws; LAS float* al_l = ws + 32;
    LAS int* dst_l = (LAS int*)(lds + OFF_DST) + wid * 32;
    LAS float* btl = (LAS float*)(lds + OFF_BT);
    LAS unsigned* pre = (LAS unsigned*)(lds + OFF_PRE);
    LAS unsigned* cl = (LAS unsigned*)(lds + OFF_CL);
    unsigned u0, u1;
    if (!OWN) {
        const unsigned n0 = (__hip_atomic_load(cnt + tid, RLX_AGENT));
        cl[tid] = n0;
        unsigned v = (n0 + 255u) >> 8; const unsigned mine = v;
#pragma unroll
        for (int o = 1; o < 64; o <<= 1) { const unsigned t = __shfl_up(v, o); if (lane >= o) v += t; }
        LAS unsigned* wt = (LAS unsigned*)(lds + OFF_WT);
        if (lane == 63) wt[wid] = v;
        __syncthreads();
        unsigned base = 0;
        for (int w = 0; w < wid; ++w) base += wt[w];
        pre[tid] = base + v - mine;
        if (tid == NWAVES * 64 - 1) pre[512] = base + v;
        __syncthreads();
        const unsigned U = pre[512];
        u0 = (unsigned)(((unsigned long long)F.bid * U) / (unsigned)F.G); u1 = (unsigned)(((unsigned long long)(F.bid + 1) * U) / (unsigned)F.G);
    } else { u0 = 0; u1 = (512 - F.bid + F.G - 1) / F.G; }
    const int sr = tid >> 4, sc = (tid & 15) * 8, vst0 = v_st(sr, sc), vst1 = v_st(32 + sr, sc);
    const int vb0 = (int)(uintptr_t)V_lds + v_rd_base(lane);
    struct { bf16x8 vs0, vs1, ks0, ks1; } sr_[2];
    bf16x8 qr[8];
    int h = 0, jb = 0, q = 0, dsti = -1;
#define DECODE(u_, h_, jb_, q_, d_) do { if (OWN) { const int gu = F.bid + (int)(u_) * F.G; h_ = gu >> 5; jb_ = gu & 31; q_ = jb_ * BLK + wid * 32 + r32; d_ = 0; } \
    else { int lo = 0, hi_ = 512; while (hi_ - lo > 1) { const int mid = (lo + hi_) >> 1; if (pre[mid] <= (u_)) lo = mid; else hi_ = mid; } \
        h_ = lo >> 5; jb_ = lo & 31; const int n_ = (int)cl[lo], e_ = (int)((u_) - pre[lo]) * 256 + wid * 32 + r32; \
        const unsigned ent_ = list[(size_t)lo * 8192 + (e_ < n_ ? e_ : n_ - 1)]; q_ = (int)(ent_ >> 2); d_ = e_ < n_ ? (q_ * NH + h_) * 4 + (int)(ent_ & 3u) : -1; } } while (0)
#define KVPTR(h_, jb_) (QKV + (size_t)((jb_) * BLK) * LDK + DM + (h_) * HD)
#define SLOAD(i, kp, k0) do { const bf16* kp_ = (kp); sr_[i].vs0 = *reinterpret_cast<const bf16x8*>(&kp_[DM + (size_t)((k0) + sr) * LDK + sc]); sr_[i].vs1 = *reinterpret_cast<const bf16x8*>(&kp_[DM + (size_t)((k0) + 32 + sr) * LDK + sc]); \
    sr_[i].ks0 = *reinterpret_cast<const bf16x8*>(&kp_[(size_t)((k0) + sr) * LDK + sc]); sr_[i].ks1 = *reinterpret_cast<const bf16x8*>(&kp_[(size_t)((k0) + 32 + sr) * LDK + sc]); } while (0)
#define QLOAD(h_, q_) do { const bf16* Qw_ = QKV + (size_t)(q_) * LDK + (h_) * HD + hi * 8; _Pragma("unroll") for (int d0 = 0; d0 < 8; ++d0) qr[d0] = *reinterpret_cast<const bf16x8*>(Qw_ + d0 * 16); } while (0)
#define SWRITE(b, i) do { *(LAS bf16x8*)(V_lds + (b) * SHM_V + vst0) = sr_[i].vs0; *(LAS bf16x8*)(V_lds + (b) * SHM_V + vst1) = sr_[i].vs1; const int kc = sc * 2; \
    *(LAS bf16x8*)(K_lds + (b) * SHM_K + KSWZ(sr, kc)) = sr_[i].ks0; *(LAS bf16x8*)(K_lds + (b) * SHM_K + KSWZ(32 + sr, kc)) = sr_[i].ks1; } while (0)
#define SWAIT() asm volatile("s_waitcnt vmcnt(4)" ::: "memory")
#define RESC(a) do { if (__any((a) < 1.f)) { if (hi == 0) al_l[r32] = (a); asm volatile("s_waitcnt lgkmcnt(0)" ::: "memory"); \
    _Pragma("unroll") for (int d = 0; d < 4; ++d) _Pragma("unroll") for (int r = 0; r < 16; ++r) o[d][r] *= al_l[crow(r, hi)]; } } while (0)
    if (u0 < u1) { DECODE(u0, h, jb, q, dsti); }
    int cur_h = -1;
    for (unsigned u = u0; u < u1; ++u) {
        if (h != cur_h) { const float* bsrc = (const float*)(F.ws + WS_BIAS) + h * BIAS_LD;
            {
                const int wv_ = __builtin_amdgcn_readfirstlane(tid >> 6), ln_ = tid & 63;
#pragma unroll
                for (int j = 0; j < 4; ++j) __builtin_amdgcn_global_load_lds((const unsigned*)(bsrc + (j * 8 + wv_) * 256 + ln_ * 4), (LAS unsigned*)((LAS unsigned char*)btl + (j * 8 + wv_) * 1024), 16, 0, 0);
                if (wv_ == 0) __builtin_amdgcn_global_load_lds((const unsigned*)(bsrc + 32 * 256 + ln_ * 4), (LAS unsigned*)((LAS unsigned char*)btl + 32 * 1024), 16, 0, 0); }
            cur_h = h; }
        const bf16* Kp = KVPTR(h, jb); QLOAD(h, q); SLOAD(0, Kp, 0);
        float m_reg = -1e30f, l_reg = 0; f32x16 o[4] = {};
        if (hi == 0) dst_l[r32] = dsti;
        const LAS float* bp0 = btl + (q - jb * BLK - 4 * hi + 256 - 59);
        f32x16 pA0, pA1, pB0, pB1; float alA, alB; bf16x8 pa0, pa1, pa2, pa3;
        asm volatile("s_waitcnt vmcnt(0)" ::: "memory"); SWRITE(0, 0); __syncthreads();
        qkt(pA0, pA1, K_lds, qr, r32, hi); partialSM(pA0, pA1, bp0, m_reg, alA);
        SLOAD(1, Kp, KVBLK); SLOAD(0, Kp, 2 * KVBLK);
        SWAIT(); SWRITE(1, 1); __syncthreads();
        SBAR(); qkt(pB0, pB1, K_lds + SHM_K, qr, r32, hi);
        finishSM(pA0, pA1, alA, l_reg, pa0, pa1, pa2, pa3); SBAR();
        SLOAD(1, Kp, 3 * KVBLK); SBAR();
        pv_d0(o, vb0, pa0, pa1, pa2, pa3); partialSM(pB0, pB1, bp0 - 64, m_reg, alB);
        __syncthreads(); SWAIT(); SWRITE(0, 0);
        RESC(alB); __syncthreads();
        SBAR(); qkt(pA0, pA1, K_lds, qr, r32, hi);
        finishSM(pB0, pB1, alB, l_reg, pa0, pa1, pa2, pa3); SBAR();
        pv_d0(o, vb0 + SHM_V, pa0, pa1, pa2, pa3); partialSM(pA0, pA1, bp0 - 128, m_reg, alA);
        __syncthreads(); asm volatile("s_waitcnt vmcnt(0)" ::: "memory"); SWRITE(1, 1);
        RESC(alA); __syncthreads();
        SBAR(); qkt(pB0, pB1, K_lds + SHM_K, qr, r32, hi); SBAR();
        int hn = h, jbn = jb, qn = q, dn = -1;
        if (u + 1 < u1) { DECODE(u + 1, hn, jbn, qn, dn); }
        SBAR();
        finishSM(pA0, pA1, alA, l_reg, pa0, pa1, pa2, pa3); SBAR();
        pv_d0(o, vb0, pa0, pa1, pa2, pa3); partialSM(pB0, pB1, bp0 - 192, m_reg, alB);

        RESC(alB);
        finishSM(pB0, pB1, alB, l_reg, pa0, pa1, pa2, pa3); SBAR();
        pv_d0(o, vb0 + SHM_V, pa0, pa1, pa2, pa3);
        asm volatile("s_waitcnt vmcnt(0)" ::: "memory");
        if (!OWN) {
            if (hi == 0) { li_l[r32] = l_reg; if (dsti >= 0) LSE[dsti] = m_reg + __builtin_amdgcn_logf(l_reg); }
            asm volatile("s_waitcnt lgkmcnt(0)" ::: "memory");
#pragma unroll
            for (int r = 0; r < 16; ++r) { const int row = crow(r, hi); const float rl = __builtin_amdgcn_rcpf(li_l[row]); const int ds = dst_l[row];
                if (ds >= 0) { unsigned* pp = PART + (size_t)ds * 64 + r32; pp[0] = cvtpk(o[0][r] * rl, o[1][r] * rl); pp[32] = cvtpk(o[2][r] * rl, o[3][r] * rl); } }
        } else {
            if (hi == 0) { li_l[r32] = l_reg; al_l[r32] = m_reg; }
            asm volatile("s_waitcnt lgkmcnt(0)" ::: "memory");
#pragma unroll
            for (int hf = 0; hf < 2; ++hf) {
                float wo[8], w0[8], w1[8], w2[8];
                {   f32x4 ls[8];
#pragma unroll
                    for (int rr = 0; rr < 8; ++rr) { const int row = crow(hf * 8 + rr, hi); ls[rr] = *(const f32x4*)(LSE + ((size_t)(jb * BLK + wid * 32 + row) * NH + h) * 4); }
#pragma unroll
                    for (int rr = 0; rr < 8; ++rr) { const int row = crow(hf * 8 + rr, hi); const float lrow = li_l[row], lown = al_l[row] + __builtin_amdgcn_logf(lrow);
                        const float M = fmaxf(fmaxf(lown, ls[rr][0]), fmaxf(ls[rr][1], ls[rr][2]));
                        const float eo = __builtin_amdgcn_exp2f(lown - M), e0 = __builtin_amdgcn_exp2f(ls[rr][0] - M), e1 = __builtin_amdgcn_exp2f(ls[rr][1] - M), e2 = __builtin_amdgcn_exp2f(ls[rr][2] - M);
                        const float iw = __builtin_amdgcn_rcpf((eo + e0) + (e1 + e2));
                        wo[rr] = eo * iw * __builtin_amdgcn_rcpf(lrow); w0[rr] = e0 * iw; w1[rr] = e1 * iw; w2[rr] = e2 * iw; } }
#pragma unroll
                for (int g4 = 0; g4 < 2; ++g4) {
                    unsigned pu[4][3][2];
#pragma unroll
                    for (int r4 = 0; r4 < 4; ++r4) { const int rr = g4 * 4 + r4, row = crow(hf * 8 + rr, hi); const unsigned* pp = PART + ((size_t)(jb * BLK + wid * 32 + row) * NH + h) * 256 + r32;
                        pu[r4][0][0] = w0[rr] > 0.f ? pp[0] : 0u; pu[r4][0][1] = w0[rr] > 0.f ? pp[32] : 0u;
                        pu[r4][1][0] = w1[rr] > 0.f ? pp[64] : 0u; pu[r4][1][1] = w1[rr] > 0.f ? pp[96] : 0u;
                        pu[r4][2][0] = w2[rr] > 0.f ? pp[128] : 0u; pu[r4][2][1] = w2[rr] > 0.f ? pp[160] : 0u; }
#pragma unroll
                    for (int r4 = 0; r4 < 4; ++r4) { const int rr = g4 * 4 + r4, r = hf * 8 + rr, row = crow(r, hi);
                        float a0 = o[0][r] * wo[rr], a1 = o[1][r] * wo[rr], a2 = o[2][r] * wo[rr], a3 = o[3][r] * wo[rr];
                        a0 += w0[rr] * bflo(pu[r4][0][0]) + w1[rr] * bflo(pu[r4][1][0]) + w2[rr] * bflo(pu[r4][2][0]);
                        a1 += w0[rr] * bfhi(pu[r4][0][0]) + w1[rr] * bfhi(pu[r4][1][0]) + w2[rr] * bfhi(pu[r4][2][0]);
                        a2 += w0[rr] * bflo(pu[r4][0][1]) + w1[rr] * bflo(pu[r4][1][1]) + w2[rr] * bflo(pu[r4][2][1]);
                        a3 += w0[rr] * bfhi(pu[r4][0][1]) + w1[rr] * bfhi(pu[r4][1][1]) + w2[rr] * bfhi(pu[r4][2][1]);
                        bf16* op = AO + (size_t)(jb * BLK + wid * 32 + row) * DM + h * HD + r32;
                        op[0] = (bf16)(cvtpk(a0, a0) & 0xffffu); op[32] = (bf16)(cvtpk(a1, a1) & 0xffffu); op[64] = (bf16)(cvtpk(a2, a2) & 0xffffu); op[96] = (bf16)(cvtpk(a3, a3) & 0xffffu); }
                }
            }
        }
        __syncthreads();
        h = hn; jb = jbn; q = qn; dsti = dn;
    }
#undef DECODE
#undef KVPTR
#undef SLOAD
#undef QLOAD
#undef SWRITE
#undef SWAIT
#undef RESC
}
namespace at3 {
using namespace at;
constexpr int O_K = 0, O_V = 65536, O_BT = 131072, O_WS = O_BT + BIAS_LD * 2, O_PRE = O_WS + 8 * 384, O_CL = O_PRE + 516 * 4, O_WT = O_CL + 512 * 4, O_END = O_WT + 64;
static_assert(O_END <= RING_BYTES, "attention LDS map");
__device__ __forceinline__ void sm_tile(f32x16& p0, f32x16& p1, const LAS unsigned short* bp, float& m_reg, float& l_reg, f32x16 (&o)[4], bf16x8& pa0, bf16x8& pa1, bf16x8& pa2, bf16x8& pa3, LAS float* al_l, int r32, int hi) {
    constexpr float C = 0.088388347648318440f * 1.4426950408889634f;
#pragma unroll
    for (int r = 0; r < 16; ++r) p0[r] = fmaf(p0[r], C, __builtin_bit_cast(float, (unsigned)bp[59 - ((r & 3) + 8 * (r >> 2))] << 16));
#pragma unroll
    for (int r = 0; r < 16; ++r) p1[r] = fmaf(p1[r], C, __builtin_bit_cast(float, (unsigned)bp[27 - ((r & 3) + 8 * (r >> 2))] << 16));
    float pmax = p0[0];
#pragma unroll
    for (int r = 1; r < 16; ++r) pmax = fmaxf(pmax, p0[r]);
#pragma unroll
    for (int r = 0; r < 16; ++r) pmax = fmaxf(pmax, p1[r]);
    { auto rr = __builtin_amdgcn_permlane32_swap(__float_as_uint(pmax), __float_as_uint(pmax), false, false); pmax = fmaxf(__uint_as_float(rr[0]), __uint_as_float(rr[1])); }
    float mn = m_reg, alpha = 1.f;
    if (!__all(pmax <= m_reg + 8.0f)) { const bool up = pmax > m_reg + 8.0f;
        mn = up ? pmax : m_reg; alpha = up ? __builtin_amdgcn_exp2f(m_reg - mn) : 1.f; m_reg = mn; }
#pragma unroll
    for (int r = 0; r < 16; ++r) p0[r] = __builtin_amdgcn_exp2f(p0[r] - mn);
#pragma unroll
    for (int r = 0; r < 16; ++r) p1[r] = __builtin_amdgcn_exp2f(p1[r] - mn);
    float ps = 0;
#pragma unroll
    for (int r = 0; r < 16; ++r) ps += p0[r];
#pragma unroll
    for (int r = 0; r < 16; ++r) ps += p1[r];
    { auto rr = __builtin_amdgcn_permlane32_swap(__float_as_uint(ps), __float_as_uint(ps), false, false); ps = __uint_as_float(rr[0]) + __uint_as_float(rr[1]); }
    l_reg = l_reg * alpha + ps;
#define PK4(P, BASE, OUT) do { unsigned a0 = cvtpk(P[BASE + 0], P[BASE + 1]), a1 = cvtpk(P[BASE + 2], P[BASE + 3]);   \
    unsigned b0 = cvtpk(P[BASE + 4], P[BASE + 5]), b1 = cvtpk(P[BASE + 6], P[BASE + 7]);                              \
    auto r0 = __builtin_amdgcn_permlane32_swap(a0, b0, false, false); auto r1 = __builtin_amdgcn_permlane32_swap(a1, b1, false, false); \
    u32x4 w = {r0[0], r1[0], r0[1], r1[1]}; OUT = *reinterpret_cast<bf16x8*>(&w); } while (0)
    PK4(p0, 0, pa0); PK4(p0, 8, pa1); PK4(p1, 0, pa2); PK4(p1, 8, pa3);
#undef PK4
    if (__any(alpha < 1.f)) { if (hi == 0) al_l[r32] = alpha; asm volatile("s_waitcnt lgkmcnt(0)" ::: "memory");
#pragma unroll
        for (int d = 0; d < 4; ++d)
#pragma unroll
            for (int r = 0; r < 16; ++r) o[d][r] *= al_l[crow(r, hi)]; }
}
__device__ __forceinline__ void load_kv_block(const bf16* __restrict__ QKV, int h, int jb, LAS unsigned char* lds, int tid) {
    const bf16* Kp = QKV + (size_t)(jb * BLK) * LDK + DM + h * HD;
    bf16x8 kv[8], vv[8];
#pragma unroll
    for (int i = 0; i < 8; ++i) { const int p = tid + 512 * i, row = p >> 4, c16 = p & 15; kv[i] = *reinterpret_cast<const bf16x8*>(Kp + (size_t)row * LDK + c16 * 8); vv[i] = *reinterpret_cast<const bf16x8*>(Kp + DM + (size_t)row * LDK + c16 * 8); }
#pragma unroll
    for (int i = 0; i < 8; ++i) { const int p = tid + 512 * i, row = p >> 4, c16 = p & 15, t = row >> 6, rl = row & 63;
        *(LAS bf16x8*)(lds + O_K + t * 16384 + KSWZ(rl, c16 * 16)) = kv[i]; *(LAS bf16x8*)(lds + O_V + t * 16384 + v_st(rl, c16 * 8)) = vv[i]; }
}
}
template <bool OWN>
__device__ __forceinline__ void attn_phase3(const Args& A, Frame& F, int ja) {
    using namespace at3;
    int tid = F.wave * 64 + lane_id_v(); asm volatile("" : "+v"(tid));
    const int wid = __builtin_amdgcn_readfirstlane(tid >> 6), lane = tid & 63, r32 = lane & 31, hi = lane >> 5;
    const bf16* __restrict__ QKV = (const bf16*)(F.ws + WS_QKV);
    const unsigned* cnt = (const unsigned*)(F.ctl + CW_CNT + ja * 512); const unsigned* list = (const unsigned*)(F.ws + WS_LIST);
    unsigned* __restrict__ PART = (unsigned*)(F.ws + WS_HID); float* __restrict__ LSE = (float*)(F.ws + WS_LSE); bf16* __restrict__ AO = (bf16*)(F.ws + WS_AO);
    LAS unsigned char* lds = F.lds + RING_OFF;
    LAS float* li_l = (LAS float*)(lds + O_WS + wid * 384); LAS float* al_l = li_l + 32; LAS int* dst_l = (LAS int*)(li_l + 64);
    LAS unsigned short* btl = (LAS unsigned short*)(lds + O_BT);
    LAS unsigned* pre = (LAS unsigned*)(lds + O_PRE); LAS unsigned* cl = (LAS unsigned*)(lds + O_CL);
    const int vb0 = (int)(uintptr_t)(lds + O_V) + v_rd_base(lane);
    unsigned s0 = 0, s1 = 0;
    if (!OWN) {
        const unsigned n0 = __hip_atomic_load(cnt + tid, RLX_AGENT); cl[tid] = n0;
        unsigned v = (n0 + 31u) >> 5; const unsigned mine = v;
#pragma unroll
        for (int o = 1; o < 64; o <<= 1) { const unsigned t = __shfl_up(v, o); if (lane >= o) v += t; }
        LAS unsigned* wt = (LAS unsigned*)(lds + O_WT);
        if (lane == 63) wt[wid] = v;
        __syncthreads();
        unsigned base = 0;
        for (int w = 0; w < wid; ++w) base += wt[w];
        pre[tid] = base + v - mine;
        if (tid == NWAVES * 64 - 1) pre[512] = base + v;
        __syncthreads();
        const unsigned ST = pre[512];
        s0 = (unsigned)(((unsigned long long)F.bid * ST) / (unsigned)F.G); s1 = (unsigned)(((unsigned long long)(F.bid + 1) * ST) / (unsigned)F.G);
    } else { s0 = 0; s1 = (512 - F.bid + F.G - 1) / F.G; }
    int cur_h = -1;
    while (s0 < s1) {
        int h, jb; unsigned seg_end, gbase = 0; int n_g = 0, g = 0;
        if (!OWN) { int lo = 0, hi_ = 512; while (hi_ - lo > 1) { const int mid = (lo + hi_) >> 1; if (pre[mid] <= s0) lo = mid; else hi_ = mid; }
            g = lo; h = g >> 5; jb = g & 31; gbase = pre[g]; n_g = (int)cl[g]; const unsigned ge = pre[g + 1]; seg_end = ge < s1 ? ge : s1; }
        else { const int gu = F.bid + (int)s0 * F.G; h = gu & 15; jb = gu >> 4; seg_end = s0 + 1; }
        __syncthreads();
        if (h != cur_h) { const float* bsrc = (const float*)(F.ws + WS_BIAS) + h * BIAS_LD;
            {
                const int ln_ = tid & 63;
#pragma unroll
                for (int j = 0; j < 4; ++j) __builtin_amdgcn_global_load_lds((const unsigned*)(bsrc + (j * 8 + wid) * 256 + ln_ * 4), (LAS unsigned*)(lds + O_K + (j * 8 + wid) * 1024), 16, 0, 0);
                if (wid == 0) __builtin_amdgcn_global_load_lds((const unsigned*)(bsrc + 32 * 256 + ln_ * 4), (LAS unsigned*)(lds + O_K + 32 * 1024), 16, 0, 0);
                asm volatile("s_waitcnt vmcnt(0)" ::: "memory"); __syncthreads();
                for (int i = tid; i < BIAS_LD; i += NWAVES * 64) btl[i] = (unsigned short)f2bf(((const LAS float*)(lds + O_K))[i]);
                __syncthreads(); }
            cur_h = h; }
        load_kv_block(QKV, h, jb, lds, tid);
        __syncthreads();
        const unsigned st_first = OWN ? 0u : s0 + (unsigned)wid, st_step = 8u;
        for (unsigned st = st_first; OWN ? st < 1u : st < seg_end; st += st_step) {
            int q, dsti, nt;
            if (!OWN) { const int e = (int)(st - gbase) * 32 + r32; const unsigned ent = list[(size_t)g * 8192 + (e < n_g ? e : n_g - 1)];
                q = (int)(ent >> 2); dsti = e < n_g ? (q * NH + h) * 4 + (int)(ent & 3u) : -1; nt = 4; }
            else { const int sub = wid < 4 ? 7 - wid : wid - 4; q = jb * BLK + sub * 32 + r32; dsti = 0; nt = (sub >> 1) + 1; }
            bf16x8 qr[8];
            { const bf16* Qw = QKV + (size_t)q * LDK + h * HD + hi * 8;
#pragma unroll
              for (int d0 = 0; d0 < 8; ++d0) qr[d0] = *reinterpret_cast<const bf16x8*>(Qw + d0 * 16); }
            if (!OWN) { if (hi == 0) dst_l[r32] = dsti; }
            const LAS unsigned short* bp0 = btl + (q - jb * BLK - 4 * hi + 256 - 59);
            float m_reg = -1e30f, l_reg = 0; f32x16 o[4] = {};
#pragma unroll 1
            for (int t = 0; t < nt; ++t) {
                f32x16 p0, p1; bf16x8 pa0, pa1, pa2, pa3;
                qkt(p0, p1, lds + O_K + t * 16384, qr, r32, hi);
                sm_tile(p0, p1, bp0 - 64 * t, m_reg, l_reg, o, pa0, pa1, pa2, pa3, al_l, r32, hi);
                pv_d0(o, vb0 + t * 16384, pa0, pa1, pa2, pa3);
            }
            if (!OWN) {
                if (hi == 0) { li_l[r32] = l_reg; if (dsti >= 0) LSE[dsti] = m_reg + __builtin_amdgcn_logf(l_reg); }
                asm volatile("s_waitcnt lgkmcnt(0)" ::: "memory");
#pragma unroll
                for (int r = 0; r < 16; ++r) { const int row = crow(r, hi); const float rl = __builtin_amdgcn_rcpf(li_l[row]); const int ds = dst_l[row];
                    if (ds >= 0) { unsigned* pp = PART + (size_t)ds * 64 + r32; pp[0] = cvtpk(o[0][r] * rl, o[1][r] * rl); pp[32] = cvtpk(o[2][r] * rl, o[3][r] * rl); } }
            } else {
                const int sub = wid < 4 ? 7 - wid : wid - 4, rowb = jb * BLK + sub * 32;
                if (hi == 0) { li_l[r32] = l_reg; al_l[r32] = m_reg; }
                asm volatile("s_waitcnt lgkmcnt(0)" ::: "memory");
#pragma unroll
                for (int hf = 0; hf < 2; ++hf) {
                    f32x4 ls[8]; unsigned pu[8][6];
#pragma unroll
                    for (int rr = 0; rr < 8; ++rr) { const int row = crow(hf * 8 + rr, hi); const size_t e = (size_t)(rowb + row) * NH + h;
                        ls[rr] = *(const f32x4*)(LSE + e * 4); const unsigned* pp = PART + e * 256 + r32;
                        pu[rr][0] = pp[0]; pu[rr][1] = pp[32]; pu[rr][2] = pp[64]; pu[rr][3] = pp[96]; pu[rr][4] = pp[128]; pu[rr][5] = pp[160]; }
#pragma unroll
                    for (int rr = 0; rr < 8; ++rr) { const int r = hf * 8 + rr, row = crow(r, hi); const float lrow = li_l[row], lown = al_l[row] + __builtin_amdgcn_logf(lrow);
                        const float M = fmaxf(fmaxf(lown, ls[rr][0]), fmaxf(ls[rr][1], ls[rr][2]));
                        const float eo = __builtin_amdgcn_exp2f(lown - M), e0 = __builtin_amdgcn_exp2f(ls[rr][0] - M), e1 = __builtin_amdgcn_exp2f(ls[rr][1] - M), e2 = __builtin_amdgcn_exp2f(ls[rr][2] - M);
                        const float iw = __builtin_amdgcn_rcpf((eo + e0) + (e1 + e2));
                        const float wo = eo * iw * __builtin_amdgcn_rcpf(lrow), w0 = e0 * iw, w1 = e1 * iw, w2 = e2 * iw;
                        const unsigned q00 = w0 > 0.f ? pu[rr][0] : 0u, q01 = w0 > 0.f ? pu[rr][1] : 0u, q10 = w1 > 0.f ? pu[rr][2] : 0u, q11 = w1 > 0.f ? pu[rr][3] : 0u, q20 = w2 > 0.f ? pu[rr][4] : 0u, q21 = w2 > 0.f ? pu[rr][5] : 0u;
                        const float a0 = o[0][r] * wo + (w0 * bflo(q00) + w1 * bflo(q10) + w2 * bflo(q20));
                        const float a1 = o[1][r] * wo + (w0 * bfhi(q00) + w1 * bfhi(q10) + w2 * bfhi(q20));
                        const float a2 = o[2][r] * wo + (w0 * bflo(q01) + w1 * bflo(q11) + w2 * bflo(q21));
                        const float a3 = o[3][r] * wo + (w0 * bfhi(q01) + w1 * bfhi(q11) + w2 * bfhi(q21));
                        bf16* op = AO + (size_t)(rowb + row) * DM + h * HD + r32;
                        op[0] = (bf16)(cvtpk(a0, a0) & 0xffffu); op[32] = (bf16)(cvtpk(a1, a1) & 0xffffu); op[64] = (bf16)(cvtpk(a2, a2) & 0xffffu); op[96] = (bf16)(cvtpk(a3, a3) & 0xffffu); }
                }
            }
        }
        s0 = seg_end;
    }
}
#define TOP3_INS2(x_, j_) do { const float x__ = (x_); const int j__ = (j_); \
    const bool b0 = x__ > v0 || (x__ == v0 && (unsigned)j__ < (unsigned)i0), b1 = x__ > v1 || (x__ == v1 && (unsigned)j__ < (unsigned)i1), b2 = x__ > v2 || (x__ == v2 && (unsigned)j__ < (unsigned)i2); \
    v2 = b1 ? v1 : (b2 ? x__ : v2); i2 = b1 ? i1 : (b2 ? j__ : i2); v1 = b0 ? v0 : (b1 ? x__ : v1); i1 = b0 ? i0 : (b1 ? j__ : i1); v0 = b0 ? x__ : v0; i0 = b0 ? j__ : i0; } while (0)
__device__ __forceinline__ void phase_gate2(const Args& A, Frame& F, int ja) {
    using namespace at;
    int tid = F.wave * 64 + lane_id_v(); asm volatile("" : "+v"(tid));
    const int lane = tid & 63, wave = tid >> 6, r32 = lane & 31, hi = lane >> 5;
    const bf16* QKV = (const bf16*)(F.ws + WS_QKV); const float* KMP = (const float*)(F.ws + WS_KMP);
    unsigned* cnt = (unsigned*)(F.ctl + CW_CNT + ja * 512); unsigned* list = (unsigned*)(F.ws + WS_LIST); float* LSE = (float*)(F.ws + WS_LSE);
    LAS unsigned* lc = (LAS unsigned*)(F.lds + RING_OFF);
    for (int u = F.bid; u < 512; u += F.G) {
        const int h = u & 15, c = u >> 4;
        __syncthreads();
        if (tid < 64) lc[tid] = 0u;
        __syncthreads();
        const int q = c * 256 + wave * 32 + r32;
        int i0 = -1, i1 = -1, i2 = -1;
        if (c > 0) {
            bf16x8 kh[8], kl[8], qr[8];
            const bf16* Qw = QKV + (size_t)q * NQKV + h * HD + hi * 8;
#pragma unroll
            for (int d0 = 0; d0 < 8; ++d0) qr[d0] = *reinterpret_cast<const bf16x8*>(Qw + d0 * 16);
#pragma unroll
            for (int d0 = 0; d0 < 8; ++d0) { const float* p0 = KMP + (size_t)r32 * 2048 + h * HD + d0 * 16 + hi * 8; const float* p1 = p0 + (size_t)32 * 2048;
                const f32x4 a0 = *(const f32x4*)p0 + *(const f32x4*)p1, a1 = *(const f32x4*)(p0 + 4) + *(const f32x4*)(p1 + 4);
                float v[8] = {a0[0], a0[1], a0[2], a0[3], a1[0], a1[1], a1[2], a1[3]}; unsigned hh[4], ll[4];
#pragma unroll
                for (int e = 0; e < 4; ++e) { const float x0 = v[2 * e] * (1.0f / 256.0f), x1 = v[2 * e + 1] * (1.0f / 256.0f); const unsigned ph = cvtpk(x0, x1); hh[e] = ph;
                    ll[e] = cvtpk(x0 - bflo(ph), x1 - bfhi(ph)); }
                u32x4 wh = {hh[0], hh[1], hh[2], hh[3]}, wl_ = {ll[0], ll[1], ll[2], ll[3]};
                kh[d0] = *reinterpret_cast<bf16x8*>(&wh); kl[d0] = *reinterpret_cast<bf16x8*>(&wl_); }
            f32x16 Gt = {};
#pragma unroll
            for (int d0 = 0; d0 < 8; ++d0) { Gt = __builtin_amdgcn_mfma_f32_32x32x16_bf16(kh[d0], qr[d0], Gt, 0, 0, 0); Gt = __builtin_amdgcn_mfma_f32_32x32x16_bf16(kl[d0], qr[d0], Gt, 0, 0, 0); }
            float v0 = -INFINITY, v1 = -INFINITY, v2 = -INFINITY;
#pragma unroll
            for (int r = 0; r < 16; ++r) { const int jb = crow(r, hi); if (jb < c) TOP3_INS2(Gt[r], jb); }
            const float pv0 = __shfl_xor(v0, 32), pv1 = __shfl_xor(v1, 32), pv2 = __shfl_xor(v2, 32);
            const int pi0 = __shfl_xor(i0, 32), pi1 = __shfl_xor(i1, 32), pi2 = __shfl_xor(i2, 32);
            if (pi0 >= 0) TOP3_INS2(pv0, pi0);
            if (pi1 >= 0) TOP3_INS2(pv1, pi1);
            if (pi2 >= 0) TOP3_INS2(pv2, pi2);
        }
        unsigned lp0 = 0, lp1 = 0, lp2 = 0;
        if (hi == 0) { if (i0 >= 0) lp0 = atomicAdd((unsigned*)(lc + i0), 1u); if (i1 >= 0) lp1 = atomicAdd((unsigned*)(lc + i1), 1u); if (i2 >= 0) lp2 = atomicAdd((unsigned*)(lc + i2), 1u); }
        __syncthreads();
        if (tid < 32) { const unsigned n = lc[tid]; lc[32 + tid] = n ? atomicAdd(&cnt[h * 32 + tid], n) : 0u; }
        __syncthreads();
        if (hi == 0) {
#define EMIT_PICK(k_, sj_, lp_) do { if ((sj_) >= 0) list[(size_t)(h * 32 + (sj_)) * 8192 + lc[32 + (sj_)] + (lp_)] = ((unsigned)q << 2) | (unsigned)(k_); \
                else LSE[((size_t)q * NH + h) * 4 + (k_)] = -INFINITY; } while (0)
            EMIT_PICK(0, i0, lp0); EMIT_PICK(1, i1, lp1); EMIT_PICK(2, i2, lp2);
#undef EMIT_PICK
        }
    }
}
__device__ __forceinline__ void phase_combine(const Args& A, Frame& F) {
    int tid = F.wave * 64 + lane_id_v(); asm volatile("" : "+v"(tid)); const int lane = tid & 63, wave = __builtin_amdgcn_readfirstlane(tid >> 6); (void)lane; (void)wave;
    const unsigned* PART = (const unsigned*)(F.ws + WS_HID); const float* LSE = (const float*)(F.ws + WS_LSE); bf16* AO = (bf16*)(F.ws + WS_AO);
    const int gw = F.bid * NWAVES + wave, NGW = F.G * NWAVES, l = lane;
    for (int e = gw; e < S * NH; e += NGW) {
        const f32x4 ls = *(const f32x4*)(LSE + (size_t)e * 4);
        const float M = fmaxf(fmaxf(ls[0], ls[1]), fmaxf(ls[2], ls[3]));
        float o0 = 0.f, o1 = 0.f, W = 0.f;
#pragma unroll
        for (int k = 0; k < 4; ++k) { const float w = __builtin_amdgcn_exp2f(ls[k] - M);
            if (w > 0.f) { const unsigned u = PART[((size_t)e * 4 + k) * 64 + l]; o0 += w * bflo(u); o1 += w * bfhi(u); W += w; } }
        const float inv = 1.0f / W; const int q = e >> 4, h = e & 15, c0 = 64 * (l >> 5) + (l & 31);
        bf16* op = AO + (size_t)q * DM + h * HD;
        op[c0] = (bf16)f2bf(o0 * inv); op[c0 + 32] = (bf16)f2bf(o1 * inv);
    }
}
__device__ __forceinline__ float sigmoidf_(float x) { return 1.0f / (1.0f + __expf(-x)); }
__device__ __forceinline__ void phase_rec_ab(const Args& A, Frame& F, int jr) {
    int tid = F.wave * 64 + lane_id_v(); asm volatile("" : "+v"(tid)); const int lane = tid & 63, wave = __builtin_amdgcn_readfirstlane(tid >> 6); (void)lane; (void)wave;
    const bf16* XR = (const bf16*)(F.ws + WS_QKV);
    const float* cw = A.in[8] + (size_t)jr * 4 * DM; const float* cb = A.in[9] + (size_t)jr * DM;
    const float* wrg = A.in[10] + (size_t)jr * 16 * 128 * 128; const float* brg = A.in[11] + (size_t)jr * DM;
    const float* wig = A.in[12] + (size_t)jr * 16 * 128 * 128; const float* big = A.in[13] + (size_t)jr * DM; const float* lam = A.in[14] + (size_t)jr * DM;
    float* SA = (float*)(F.ws + WS_HID); float* SB = SA + (size_t)S * DM;
    LAS float* xc = (LAS float*)(F.lds + RING_OFF);
    for (int item = F.bid; item < 256 * 16; item += F.G) {
        const int tt = item >> 4, n = item & 15;
        for (int i = tid; i < 4096; i += NWAVES * 64) { const int r = i >> 7, cc = i & 127, t = tt * 32 + r, c = n * 128 + cc;
            float a = cb[c];
#pragma unroll
            for (int jj = 0; jj < 4; ++jj) { const int ts = t - 3 + jj; if (ts >= 0) a += bf2f(XR[(size_t)ts * DM + c]) * cw[jj * DM + c]; }
            xc[i] = a; }
        __syncthreads();
        const int cc = tid & 127, rg = tid >> 7, c = n * 128 + cc;
        float ar[8], ai[8];
#pragma unroll
        for (int i = 0; i < 8; ++i) { ar[i] = 0.f; ai[i] = 0.f; }
        const float* wr_ = wrg + (size_t)n * 128 * 128 + cc; const float* wi_ = wig + (size_t)n * 128 * 128 + cc;
        for (int k = 0; k < 128; ++k) { const float a = wr_[k * 128], b = wi_[k * 128];
#pragma unroll
            for (int i = 0; i < 8; ++i) { const float x = xc[(rg + 4 * i) * 128 + k]; ar[i] += x * a; ai[i] += x * b; } }
        const float lm = lam[c]; const float lsg = (fminf(lm, 0.f) - log1pf(__expf(-fabsf(lm)))) * 8.0f;
        const float b_r = brg[c], b_i = big[c];
#pragma unroll
        for (int i = 0; i < 8; ++i) { const int r = rg + 4 * i; const size_t o = (size_t)(tt * 32 + r) * DM + c;
            const float rr = sigmoidf_(ar[i] + b_r), ii = sigmoidf_(ai[i] + b_i), la = rr * lsg;
            SA[o] = __expf(la); SB[o] = sqrtf(-expm1f(2.0f * la)) * (ii * xc[r * 128 + cc]); }
        __syncthreads();
    }
}
__device__ __forceinline__ void phase_rec_ab2(const Args& A, Frame& F, int jr) {
    using namespace at;
    int tid = F.wave * 64 + lane_id_v(); asm volatile("" : "+v"(tid));
    const int lane = tid & 63, wave = tid >> 6, r32 = lane & 31, hi = lane >> 5;
    const bf16* XR = (const bf16*)(F.ws + WS_QKV);
    const float* cw = A.in[8] + (size_t)jr * 4 * DM; const float* cb = A.in[9] + (size_t)jr * DM;
    const float* brg = A.in[11] + (size_t)jr * DM; const float* big = A.in[13] + (size_t)jr * DM; const float* lam = A.in[14] + (size_t)jr * DM;
    const bf16* WG = (const bf16*)(F.ws + WS_WG) + (size_t)jr * 2 * 16 * 128 * 128;
    unsigned* SAB = (unsigned*)(F.ws + WS_HID);
    LAS unsigned char* xcl = F.lds + RING_OFF;
    LAS unsigned char* wl = F.lds + RING_OFF + 65536;
    LAS f32x2* comp = (LAS f32x2*)(F.lds + RING_OFF + 131072);
    int cur_n = -1;
    for (int u = F.bid; u < 512; u += F.G) {
        const int n = u & 15, tt = u >> 4;
        __syncthreads();
        if (n != cur_n) { cur_n = n;
#pragma unroll
            for (int i = 0; i < 8; ++i) { const int p = tid + i * 512, g = p >> 11, ch = (p >> 4) & 127, kc = p & 15;
                *(LAS v4u*)(wl + g * 32768 + KSWZ(ch, kc * 16)) = *(const v4u*)(WG + ((size_t)(g * 16 + n) * 128 + ch) * 128 + kc * 8); } }
        {
            const int chg = tid & 15, c0 = n * 128 + chg * 8;
            float w[4][8], b8[8];
#pragma unroll
            for (int jj = 0; jj < 4; ++jj) { const f32x4 x0 = *(const f32x4*)(cw + jj * DM + c0), x1 = *(const f32x4*)(cw + jj * DM + c0 + 4);
                w[jj][0] = x0[0]; w[jj][1] = x0[1]; w[jj][2] = x0[2]; w[jj][3] = x0[3]; w[jj][4] = x1[0]; w[jj][5] = x1[1]; w[jj][6] = x1[2]; w[jj][7] = x1[3]; }
            { const f32x4 x0 = *(const f32x4*)(cb + c0), x1 = *(const f32x4*)(cb + c0 + 4); b8[0] = x0[0]; b8[1] = x0[1]; b8[2] = x0[2]; b8[3] = x0[3]; b8[4] = x1[0]; b8[5] = x1[1]; b8[6] = x1[2]; b8[7] = x1[3]; }
#pragma unroll 4
            for (int ps = 0; ps < 8; ++ps) { const int rl = (tid >> 4) + 32 * ps, t = tt * 256 + rl;
                float acc[8];
#pragma unroll
                for (int e = 0; e < 8; ++e) acc[e] = b8[e];
#pragma unroll
                for (int jj = 0; jj < 4; ++jj) { const int ts = t - 3 + jj;
                    if (ts >= 0) { const v4u xv = *(const v4u*)(XR + (size_t)ts * DM + c0);
                        acc[0] += bflo(xv.x) * w[jj][0]; acc[1] += bfhi(xv.x) * w[jj][1]; acc[2] += bflo(xv.y) * w[jj][2]; acc[3] += bfhi(xv.y) * w[jj][3];
                        acc[4] += bflo(xv.z) * w[jj][4]; acc[5] += bfhi(xv.z) * w[jj][5]; acc[6] += bflo(xv.w) * w[jj][6]; acc[7] += bfhi(xv.w) * w[jj][7]; } }
                v4u o; o.x = cvtpk(acc[0], acc[1]); o.y = cvtpk(acc[2], acc[3]); o.z = cvtpk(acc[4], acc[5]); o.w = cvtpk(acc[6], acc[7]);
                *(LAS v4u*)(xcl + KSWZ(rl, chg * 16)) = o; }
        }
        __syncthreads();
        bf16x8 xf[8];
#pragma unroll
        for (int d0 = 0; d0 < 8; ++d0) xf[d0] = *(const LAS bf16x8*)(xcl + KSWZ(wave * 32 + r32, (d0 * 16 + hi * 8) * 2));
#pragma unroll 1
        for (int ct = 0; ct < 4; ++ct) {
            f32x16 aR = {}, aI = {};
#pragma unroll
            for (int d0 = 0; d0 < 8; ++d0) { const int cbo = (d0 * 16 + hi * 8) * 2;
                const bf16x8 wr_ = *(const LAS bf16x8*)(wl + KSWZ(ct * 32 + r32, cbo)), wi_ = *(const LAS bf16x8*)(wl + 32768 + KSWZ(ct * 32 + r32, cbo));
                aR = __builtin_amdgcn_mfma_f32_32x32x16_bf16(xf[d0], wr_, aR, 0, 0, 0);
                aI = __builtin_amdgcn_mfma_f32_32x32x16_bf16(xf[d0], wi_, aI, 0, 0, 0); }
            const int chl = ct * 32 + r32, ch = n * 128 + chl;
            const float lm = lam[ch], b_r = brg[ch], b_i = big[ch];
            const float lsg2 = (fminf(lm, 0.f) - log1pf(__expf(-fabsf(lm)))) * (8.0f * 1.4426950408889634f);
            float sA[4], sH[4];
#pragma unroll
            for (int r = 0; r < 16; ++r) { const int tl = wave * 32 + crow(r, hi);
                const float xcv = bf2f(*(const LAS unsigned short*)(xcl + KSWZ(tl, chl * 2)));
                const float rr = __builtin_amdgcn_rcpf(1.0f + __builtin_amdgcn_exp2f(-1.4426950408889634f * (aR[r] + b_r)));
                const float ii = __builtin_amdgcn_rcpf(1.0f + __builtin_amdgcn_exp2f(-1.4426950408889634f * (aI[r] + b_i)));
                const float la2 = rr * lsg2;
                const float av = __builtin_amdgcn_exp2f(la2);
                const float x2 = la2 * (2.0f * 0.6931471805599453f);
                const float ser = -x2 * (1.0f + x2 * (0.5f + x2 * (0.16666667f + x2 * 0.041666668f)));
                const float om = x2 > -0.1f ? ser : 1.0f - av * av;
                const size_t o = (size_t)(tt * 256 + tl) * DM + ch;
                const float bv = __builtin_amdgcn_sqrtf(om) * (ii * xcv);
                SAB[o] = cvtpk(la2, bv);
                const int sg = r >> 2; if ((r & 3) == 0) { sA[sg] = av; sH[sg] = bv; } else { sH[sg] = av * sH[sg] + bv; sA[sg] *= av; } }
            float cA = 1.f, cH = 0.f;
#pragma unroll
            for (int sg = 0; sg < 4; ++sg) { const float pA = __shfl_xor(sA[sg], 32), pH = __shfl_xor(sH[sg], 32);
                const float fA = hi ? pA : sA[sg], fH = hi ? pH : sH[sg], gA = hi ? sA[sg] : pA, gH = hi ? sH[sg] : pH;
                cH = fA * cH + fH; cA *= fA; cH = gA * cH + gH; cA *= gA; }
            if (hi == 0) comp[wave * 128 + chl] = (f32x2){cA, cH};
        }
        __syncthreads();
        { const int k = tid >> 7, chl = tid & 127; const f32x2 c0 = comp[(2 * k) * 128 + chl], c1 = comp[(2 * k + 1) * 128 + chl];
          float* CA = (float*)(F.ws + WS_CARRY); float* CH = CA + 128 * DM; const size_t o = (size_t)(tt * 4 + k) * DM + n * 128 + chl;
          CA[o] = c0.x * c1.x; CH[o] = c1.x * c0.y + c1.y; }
    }
}
__device__ __forceinline__ void phase_rec_tot(const Args& A, Frame& F) {
    int tid = F.wave * 64 + lane_id_v(); asm volatile("" : "+v"(tid)); const int lane = tid & 63, wave = __builtin_amdgcn_readfirstlane(tid >> 6); (void)lane; (void)wave;
    const float* SA = (const float*)(F.ws + WS_HID); const float* SB = SA + (size_t)S * DM; float* CA = (float*)(F.ws + WS_CARRY); float* CH = CA + 128 * DM;
    for (int i = F.bid * (NWAVES * 64) + tid; i < 128 * 1024; i += F.G * NWAVES * 64) { const int ch = i >> 10, c = (i & 1023) * 2;
        f32x2 A = (f32x2){1.f, 1.f}, H = (f32x2){0.f, 0.f};
#pragma unroll 8
        for (int r = 0; r < 64; ++r) { const size_t o = (size_t)(ch * 64 + r) * DM + c; const f32x2 a = *(const f32x2*)(SA + o), b = *(const f32x2*)(SB + o); H = a * H + b; A = A * a; }
        *(f32x2*)(CA + ch * DM + c) = A; *(f32x2*)(CH + ch * DM + c) = H; }
}
__device__ __forceinline__ void phase_rec_scan(const Args& A, Frame& F) {
    int tid = F.wave * 64 + lane_id_v(); asm volatile("" : "+v"(tid));
    const unsigned* SAB = (const unsigned*)(F.ws + WS_HID); const float* CA = (const float*)(F.ws + WS_CARRY); const float* CH = CA + 128 * DM;
    const bf16* GG = (const bf16*)(F.ws + WS_QKV + 32 * MiB); bf16* AO = (bf16*)(F.ws + WS_AO);
    for (int i = F.bid * (NWAVES * 64) + tid; i < 128 * 1024; i += F.G * NWAVES * 64) { const int ch = i >> 10, c = (i & 1023) * 2;
        f32x2 H = (f32x2){0.f, 0.f};
        int k = 0;
        for (; k + 16 <= ch; k += 16) { f32x2 a[16], b[16];
#pragma unroll
            for (int j = 0; j < 16; ++j) { a[j] = *(const f32x2*)(CA + (k + j) * DM + c); b[j] = *(const f32x2*)(CH + (k + j) * DM + c); }
#pragma unroll
            for (int j = 0; j < 16; ++j) H = a[j] * H + b[j]; }
        if (k + 8 <= ch) { f32x2 a[8], b[8];
#pragma unroll
            for (int j = 0; j < 8; ++j) { a[j] = *(const f32x2*)(CA + (k + j) * DM + c); b[j] = *(const f32x2*)(CH + (k + j) * DM + c); }
#pragma unroll
            for (int j = 0; j < 8; ++j) H = a[j] * H + b[j];
            k += 8; }
        for (; k < ch; ++k) { const f32x2 a = *(const f32x2*)(CA + k * DM + c), b = *(const f32x2*)(CH + k * DM + c); H = a * H + b; }
#pragma unroll 1
        for (int r0 = 0; r0 < 64; r0 += 32) { v2u x[32]; unsigned g[32];
#pragma unroll
            for (int j = 0; j < 32; ++j) { const size_t o = (size_t)(ch * 64 + r0 + j) * DM + c; x[j] = __builtin_nontemporal_load((const v2u*)(SAB + o)); g[j] = *(const unsigned*)(GG + o); }
#pragma unroll
            for (int j = 0; j < 32; ++j) { const size_t o = (size_t)(ch * 64 + r0 + j) * DM + c;
                const f32x2 a = (f32x2){__builtin_amdgcn_exp2f(bflo(x[j].x)), __builtin_amdgcn_exp2f(bflo(x[j].y))}, b = (f32x2){bfhi(x[j].x), bfhi(x[j].y)};
                H = a * H + b; *(unsigned*)(AO + o) = pk2(H.x * bflo(g[j]), H.y * bfhi(g[j])); } }
    }
}
__device__ __forceinline__ int dq_layer(int li) {
    int l = 0, seen = -1;
#pragma unroll
    for (int b = 0; b < 4; ++b) if ((DQ_MASK >> b) & 1) { ++seen; if (seen == li) l = b; }
    return l;
}
__device__ __forceinline__ void wq_rows(const Args& A, Frame& F) {
    int tid = F.wave * 64 + lane_id_v(); asm volatile("" : "+v"(tid)); const int lane = tid & 63, wave = __builtin_amdgcn_readfirstlane(tid >> 6);
    const int gw = F.bid * NWAVES + wave, NGW = F.G * NWAVES;
    float* SWb = (float*)(F.ws + WS_SW);
    constexpr int NL = ((DQ_MASK >> 0) & 1) + ((DQ_MASK >> 1) & 1) + ((DQ_MASK >> 2) & 1) + ((DQ_MASK >> 3) & 1);
    for (int r0 = gw; r0 < NL * DM; r0 += 2 * NGW) {
        v4u x[2][16];
#pragma unroll
        for (int h = 0; h < 2; ++h) { const int rr = r0 + h * NGW < NL * DM ? r0 + h * NGW : r0; const int li = rr / DM, n = rr - li * DM, l = dq_layer(li);
            const bf16* src = (const bf16*)(F.ws + WS_W2) + (size_t)l * DM * FF + (size_t)n * FF;
#pragma unroll
            for (int j = 0; j < 16; ++j) x[h][j] = ((const GAS v4u*)src + lane)[64 * j]; }
#pragma unroll
        for (int h = 0; h < 2; ++h) { const int rr = r0 + h * NGW; if (rr >= NL * DM) break; const int li = rr / DM, n = rr - li * DM, l = dq_layer(li);
            unsigned char* dst = F.ws + WS_W1 + WS_W2Q_OFF * MiB + (size_t)l * DM * FF + (size_t)n * FF;
            float am = 0.f;
#pragma unroll
            for (int j = 0; j < 16; ++j)
#pragma unroll
                for (int e = 0; e < 4; ++e) am = fmaxf(am, fmaxf(fabsf(bflo(x[h][j][e])), fabsf(bfhi(x[h][j][e]))));
            am = wave_max(am);
            const float inv = am > 1e-30f ? 127.0f / am : 0.f; float cs = 0.f;
#pragma unroll
            for (int j = 0; j < 16; ++j) { float r[8];
#pragma unroll
                for (int e = 0; e < 4; ++e) { r[2 * e] = __builtin_rintf(bflo(x[h][j][e]) * inv); r[2 * e + 1] = __builtin_rintf(bfhi(x[h][j][e]) * inv); cs += r[2 * e] + r[2 * e + 1]; }
                v2u o; o.x = pack_i8x4(r[0], r[1], r[2], r[3]); o.y = pack_i8x4(r[4], r[5], r[6], r[7]);
                ((GAS v2u*)dst + lane)[64 * j] = o; }
            cs = wave_sum(cs);
            if (lane == 0) { SWb[SW_T2 + l * DM + n] = am * (1.0f / 127.0f); SWb[SW_CS2 + l * DM + n] = cs; } }
    }
    for (int r0 = gw; r0 < NL * FF; r0 += 4 * NGW) {
        v4u a[4], b2[4]; float stp[4];
#pragma unroll
        for (int h = 0; h < 4; ++h) { const int rr = r0 + h * NGW < NL * FF ? r0 + h * NGW : r0; const int li = rr / FF, n = rr - li * FF, l = dq_layer(li);
            const unsigned char* src = F.ws + WS_W1 + (size_t)l * FF * DM + (size_t)n * DM;
            a[h] = ((const GAS v4u*)src + lane)[0]; b2[h] = ((const GAS v4u*)src + lane)[64]; stp[h] = SWb[SW_W1 + l * FF + n]; }
#pragma unroll
        for (int h = 0; h < 4; ++h) { const int rr = r0 + h * NGW; if (rr >= NL * FF) break; const int li = rr / FF, n = rr - li * FF, l = dq_layer(li);
            int acc = 0;
#pragma unroll
            for (int e = 0; e < 4; ++e) { const int w0 = (int)a[h][e], w1 = (int)b2[h][e];
#pragma unroll
                for (int sh = 0; sh < 4; ++sh) { const int q0 = (w0 << (24 - 8 * sh)) >> 24, q1 = (w1 << (24 - 8 * sh)) >> 24; acc += q0 * q0 + q1 * q1; } }
            const float tot = wave_sum((float)acc);
            if (lane == 0) SWb[SW_SS + l * FF + n] = tot * stp[h] * stp[h]; }
    }
}
__device__ __forceinline__ void hidden_step(Frame& F, int l) {
    if (F.bid == 0) { float* SWb = (float*)(F.ws + WS_SW); int tid = F.wave * 64 + lane_id_v(); asm volatile("" : "+v"(tid)); const int lane = tid & 63;
        float v[16];
#pragma unroll
        for (int j = 0; j < 16; ++j) v[j] = SWb[SW_SS + l * FF + tid + 512 * j];
        float s = 0.f;
#pragma unroll
        for (int j = 0; j < 16; ++j) s += v[j];
        s = wave_sum(s);
        LAS float* red = (LAS float*)(F.lds + RING_OFF);
        if (lane == 0) red[F.wave] = s;
        __syncthreads();
        if (tid == 0) { float t = 0.f;
#pragma unroll
            for (int w = 0; w < 8; ++w) t += red[w];
            const float C = 21.16f * t * (1.0f / 8192.0f);
            SWb[SW_CL + 2 * l] = 254.0f / C; SWb[SW_CL + 2 * l + 1] = C * (1.0f / 254.0f); }
        __syncthreads(); }
}
__device__ __forceinline__ void phase_quant(const Args& A, Frame& F) {
    int tid = F.wave * 64 + lane_id_v(); asm volatile("" : "+v"(tid)); const int lane = tid & 63, wave = __builtin_amdgcn_readfirstlane(tid >> 6);
    const bf16* XB = (const bf16*)(F.ws + WS_XB); unsigned char* XQ = F.ws + WS_XQ; float* frow = (float*)(F.ws + WS_FROW);
    const int nk = pass_nrows(F, wave);
    for (int k0 = 0; k0 < nk; k0 += 4) {
        v4u x[4][4];
#pragma unroll
        for (int r = 0; r < 4; ++r) { const int m = pass_row(F, wave, k0 + r < nk ? k0 + r : k0);
#pragma unroll
            for (int j = 0; j < 4; ++j) x[r][j] = ((const GAS v4u*)(XB + (size_t)m * DM) + lane)[64 * j]; }
#pragma unroll
        for (int r = 0; r < 4; ++r) { const int m = k0 + r < nk ? pass_row(F, wave, k0 + r) : S; float s = 0.f, am = 0.f;
#pragma unroll
            for (int j = 0; j < 4; ++j) {
#pragma unroll
                for (int e = 0; e < 4; ++e) { const float a0 = bflo(x[r][j][e]), a1 = bfhi(x[r][j][e]); s += a0 * a0 + a1 * a1; am = fmaxf(am, fmaxf(fabsf(a0), fabsf(a1))); } }
            s = wave_sum(s); am = wave_max(am);
            const float inv = am > 1e-30f ? 127.0f / am : 0.f;
            if (m < S) {
#pragma unroll
                for (int j = 0; j < 4; ++j) { v2u o; o.x = pack_i8x4(bflo(x[r][j].x) * inv, bfhi(x[r][j].x) * inv, bflo(x[r][j].y) * inv, bfhi(x[r][j].y) * inv);
                    o.y = pack_i8x4(bflo(x[r][j].z) * inv, bfhi(x[r][j].z) * inv, bflo(x[r][j].w) * inv, bfhi(x[r][j].w) * inv);
                    ((GAS v2u*)(XQ + (size_t)m * DM) + lane)[64 * j] = o; }
                if (lane == 0) { const float rstd = __builtin_amdgcn_rsqf(s * (1.0f / 2048.0f) + 1e-6f); frow[m] = am * (1.0f / 127.0f) * rstd; ((float*)(F.ws + WS_RSTD))[m] = rstd; } } }
    }
}
__device__ __forceinline__ void phase_final(const Args& A, Frame& F) {
    int tid = F.wave * 64 + lane_id_v(); asm volatile("" : "+v"(tid)); const int lane = tid & 63, wave = __builtin_amdgcn_readfirstlane(tid >> 6);
    const bf16* XB = (const bf16*)(F.ws + WS_XB); const float* gf = A.in[4];
    const int nk = pass_nrows(F, wave);
    f32x4 g0[4], g1[4];
#pragma unroll
    for (int j = 0; j < 4; ++j) { g0[j] = *(const f32x4*)(gf + j * 512 + lane * 8); g1[j] = *(const f32x4*)(gf + j * 512 + lane * 8 + 4); }
    for (int k0 = 0; k0 < nk; k0 += 2) {
        const bool two = k0 + 1 < nk; const int m0 = pass_row(F, wave, k0), m1 = two ? pass_row(F, wave, k0 + 1) : m0;
        v4u xa[4], xb[4];
#pragma unroll
        for (int j = 0; j < 4; ++j) { xa[j] = ((const GAS v4u*)(XB + (size_t)m0 * DM) + lane)[64 * j]; xb[j] = two ? ((const GAS v4u*)(XB + (size_t)m1 * DM) + lane)[64 * j] : xa[j]; }
        float s0 = 0.f, s1 = 0.f;
#pragma unroll
        for (int j = 0; j < 4; ++j) {
#pragma unroll
            for (int e = 0; e < 4; ++e) { const float a0 = bflo(xa[j][e]), a1 = bfhi(xa[j][e]), b0 = bflo(xb[j][e]), b1 = bfhi(xb[j][e]); s0 += a0 * a0 + a1 * a1; s1 += b0 * b0 + b1 * b1; } }
        s0 = wave_sum(s0); s1 = wave_sum(s1);
        const float r0 = __builtin_amdgcn_rsqf(s0 * (1.0f / 2048.0f) + 1e-6f), r1 = __builtin_amdgcn_rsqf(s1 * (1.0f / 2048.0f) + 1e-6f);
        GAS f32x4* o0 = (GAS f32x4*)(A.out + (size_t)m0 * DM) + 2 * lane; GAS f32x4* o1 = (GAS f32x4*)(A.out + (size_t)m1 * DM) + 2 * lane;
#pragma unroll
        for (int j = 0; j < 4; ++j) { const f32x4 a = (f32x4){bflo(xa[j].x), bfhi(xa[j].x), bflo(xa[j].y), bfhi(xa[j].y)}, b = (f32x4){bflo(xa[j].z), bfhi(xa[j].z), bflo(xa[j].w), bfhi(xa[j].w)};
            __builtin_nontemporal_store(a * r0 * g0[j], &o0[128 * j]); __builtin_nontemporal_store(b * r0 * g1[j], &o0[128 * j + 1]); }
        if (two) {
#pragma unroll
            for (int j = 0; j < 4; ++j) { const f32x4 a = (f32x4){bflo(xb[j].x), bfhi(xb[j].x), bflo(xb[j].y), bfhi(xb[j].y)}, b = (f32x4){bflo(xb[j].z), bfhi(xb[j].z), bflo(xb[j].w), bfhi(xb[j].w)};
                __builtin_nontemporal_store(a * r1 * g0[j], &o1[128 * j]); __builtin_nontemporal_store(b * r1 * g1[j], &o1[128 * j + 1]); } }
    }
}
__global__ void __launch_bounds__(NWAVES * 64, 2) mega_fwd(Args A) {
    extern __shared__ __attribute__((aligned(16))) unsigned char lds[];
    Frame F;
    F.lds = (LAS unsigned char*)lds; F.ldsg = lds;
    F.MISC = (volatile LAS unsigned*)(F.lds + MISC_OFF);
    F.tid = threadIdx.x; F.lane = F.tid & 63; F.wave = __builtin_amdgcn_readfirstlane(F.tid >> 6);
    F.G = gridDim.x; F.bid = blockIdx.x;
    F.ws = A.ws; F.ctl = (gu32*)(A.ws + WS_CTL);
    for (int u = F.tid; u < (LDS_BYTES - LDSCTL_OFF) / 4; u += NWAVES * 64) ((LAS unsigned*)(F.lds + LDSCTL_OFF))[u] = 0u;
    __syncthreads();
    XcdBarrier bar; bar.bar = (unsigned*)(F.ctl + CW_BAR); bar.x = 0; bar.st = nullptr;
    if (!MK_PER_PHASE) bar = xcd_barrier_post((unsigned*)(F.ctl + CW_BAR), F.MISC + 8);
    const int lo = A.ph_lo, hi = A.ph_hi;
#define IN(k) (lo <= (k) && (k) < hi)
#define SEAM(k) do { if (IN(k) && IN((k) + 1)) xcd_barrier(bar); } while (0)

    if (IN(0) && DBG(0)) { for (int rp = 0; rp < NREP(0); ++rp) { p0_prologue(A, F); if (rp + 1 < NREP(0)) xcd_barrier(bar); } } SEAM(0);
    for (int ls = 0; ls < 2 * DEPTH; ++ls) {
        const int l = ls >> 1, st = ls & 1, jm = l >> 1, rec = l & 1;
        const int p1 = 1 + 7 * l + (st ? 5 : 0), p2 = p1 + (st ? 1 : 4);
        if (IN(p1) && DBG(1)) {
            if (ls > 0) { phase_quant(A, F); if (ls == 1 && DQ_MASK) wq_rows(A, F); if (st && ((DQ_MASK >> l) & 1)) hidden_step(F, l); xcd_barrier(bar); }
            if (!st && rec) {
                pg8::Gemm g{(const bf16*)(F.ws + WS_XB), (const bf16*)(F.ws + WS_WIN) + (size_t)jm * 2 * DM * DM, S, 2 * DM, DM, F.wave};
                pg8::FrowOrder So; So.init(S, 2 * DM, F.G, F.bid); So.frow = (const float*)(F.ws + WS_RSTD); So.tab = F.lds + 135168;
                pg8::EpiScaleT<false> E{(bf16*)(F.ws + WS_QKV), DM, F.lds + 135168, nullptr, (bf16*)(F.ws + WS_QKV + 32 * MiB), 1, nullptr, nullptr};
                pg8::gemm_phase<pg8::EpiScaleT<false>, pg8::FrowOrder, true, true, false>(F.lds + RING_OFF, g, So, E);
            } else {
            const unsigned char* Bq; const float* sc; int N, mode; bf16* O; int ldc;
            if (st) { Bq = F.ws + WS_W1 + (size_t)l * FF * DM; sc = (const float*)(F.ws + WS_SW) + SW_W1 + l * FF; N = FF; mode = ((DQ_MASK >> l) & 1) ? 3 : 2; O = (bf16*)(F.ws + WS_HID); ldc = FF; }
            else { Bq = F.ws + WS_WQKV + (size_t)jm * NQKV * DM; sc = (const float*)(F.ws + WS_SW) + SW_QKV + jm * NQKV; N = NQKV; mode = 0; O = (bf16*)(F.ws + WS_QKV); ldc = NQKV; }
            pg8::Gemm g{(const bf16*)(F.ws + WS_XQ), (const bf16*)Bq, S, N, DM / 2, F.wave};
            pg8::FrowOrder So; So.init(S, N, F.G, F.bid); So.frow = (const float*)(F.ws + WS_FROW); So.tab = F.lds + 135168;
            pg8::EpiScaleT<true> E{O, ldc, F.lds + 135168, (float*)(F.ws + WS_KMP), (bf16*)(F.ws + WS_QKV + 32 * MiB), mode, sc, (const float*)(F.ws + WS_SW) + SW_CL + 2 * l};
            for (int rp = 0; rp < NREP(1); ++rp) { pg8::gemm_phase<pg8::EpiScaleT<true>, pg8::FrowOrder, true, true, true>(F.lds + RING_OFF, g, So, E); if (rp + 1 < NREP(1)) xcd_barrier(bar); } } }
        SEAM(p1);
        if (!st) {
            if (!rec) {
                if (IN(p1 + 1) && DBG(2)) phase_gate2(A, F, jm);
                SEAM(p1 + 1);
                if (IN(p1 + 2) && DBG(3)) { for (int rp = 0; rp < NREP(3); ++rp) { attn_phase<false>(A, F, jm); if (rp + 1 < NREP(3)) xcd_barrier(bar); } }
                SEAM(p1 + 2);
                if (IN(p1 + 3) && DBG(4)) { for (int rp = 0; rp < NREP(4); ++rp) { attn_phase3<true>(A, F, jm); if (rp + 1 < NREP(4)) xcd_barrier(bar); } }
                SEAM(p1 + 3);
            } else {
                if (IN(p1 + 1) && DBG(6)) { for (int rp = 0; rp < NREP(6); ++rp) { phase_rec_ab2(A, F, jm); if (rp + 1 < NREP(6)) xcd_barrier(bar); } }
                SEAM(p1 + 1);
                                if (IN(p1 + 3) && DBG(8)) { for (int rp = 0; rp < NREP(8); ++rp) { phase_rec_scan(A, F); if (rp + 1 < NREP(8)) xcd_barrier(bar); } }
                SEAM(p1 + 3);
            }
        }
        if (IN(p2) && DBG(9) && st && ((DQ_MASK >> l) & 1)) {
            pg8::Gemm g{(const bf16*)(F.ws + WS_HID), (const bf16*)(F.ws + WS_W1 + WS_W2Q_OFF * MiB + (size_t)l * DM * FF), S, DM, FF / 2, F.wave}; pg8::StaticOrder So; So.init(S, DM, F.G, F.bid);
            pg8::EpiResQ8 E{(bf16*)(F.ws + WS_XB), (const float*)(F.ws + WS_SW) + SW_T2 + l * DM, (const float*)(F.ws + WS_SW) + SW_CS2 + l * DM, (const float*)(F.ws + WS_SW) + SW_CL + 2 * l};
            pg8::gemm_phase<pg8::EpiResQ8, pg8::StaticOrder, true, true, true>(F.lds + RING_OFF, g, So, E); }
        else if (IN(p2) && DBG(9)) {
            const bf16* Ap; const bf16* Bt; int K;
            if (st) { Ap = (const bf16*)(F.ws + WS_HID); Bt = (const bf16*)(F.ws + WS_W2) + (size_t)l * DM * FF; K = FF; }
            else { Ap = (const bf16*)(F.ws + WS_AO); Bt = (const bf16*)(F.ws + (rec ? WS_WOUT : WS_WO)) + (size_t)jm * DM * DM; K = DM; }
            pg8::Gemm g{Ap, Bt, S, DM, K, F.wave}; pg8::StaticOrder So; So.init(S, DM, F.G, F.bid);
            pg8::EpiRes E{(bf16*)(F.ws + WS_XB)};
            pg8::gemm_phase<pg8::EpiRes, pg8::StaticOrder, true, true>(F.lds + RING_OFF, g, So, E); }
        SEAM(p2);
    }
    if (IN(NPHASE - 1) && DBG(12)) { for (int rp = 0; rp < NREP(12); ++rp) { phase_final(A, F); if (rp + 1 < NREP(12)) xcd_barrier(bar); } }
#undef IN
#undef SEAM
}

extern "C" void kernel_launch(void* const* d_in, const int* in_sizes, int n_in, void* d_out, int out_size, void* d_ws, size_t ws_size, hipStream_t stream) {
    static int grid = 0;
    if (grid == 0) {
        if (n_in != 18 || in_sizes[0] != S * DM || out_size != S * DM || ws_size < WS_END) { fprintf(stderr, "kernel_launch: shape mismatch n_in %d in0 %d out %d ws %zu (need %zu)\n", n_in, n_in > 0 ? in_sizes[0] : -1, out_size, ws_size, (size_t)WS_END); grid = -1; return; }
        int dev = 0, cus = 0, per_cu = 0;
        if (hipGetDevice(&dev) != hipSuccess || hipDeviceGetAttribute(&cus, hipDeviceAttributeMultiprocessorCount, dev) != hipSuccess) { grid = -1; return; }
        if (hipFuncSetAttribute((const void*)mega_fwd, hipFuncAttributeMaxDynamicSharedMemorySize, LDS_BYTES) != hipSuccess) { fprintf(stderr, "kernel_launch: hipFuncSetAttribute failed\n"); grid = -1; return; }
        if (hipOccupancyMaxActiveBlocksPerMultiprocessor(&per_cu, (const void*)mega_fwd, NWAVES * 64, LDS_BYTES) != hipSuccess || per_cu < 1) fprintf(stderr, "kernel_launch: occupancy query says %d\n", per_cu);
        (void)hipGetLastError();
        grid = cus;
    }
    if (grid < 0) return;
    if (hipMemsetAsync((char*)d_ws + WS_CTL, 0, CTL_ZERO_BYTES, stream) != hipSuccess) { fprintf(stderr, "kernel_launch: memset failed\n"); return; }
    Args a{};
    for (int i = 0; i < 18; ++i) a.in[i] = (const float*)d_in[i];
    a.out = (float*)d_out; a.ws = (unsigned char*)d_ws;
#if MK_PER_PHASE
    for (int p = 0; p < NPHASE; ++p) { a.ph_lo = p; a.ph_hi = p + 1; hipLaunchKernelGGL(mega_fwd, dim3(grid), dim3(NWAVES * 64), LDS_BYTES, stream, a); }
#else
    a.ph_lo = 0; a.ph_hi = NPHASE; hipLaunchKernelGGL(mega_fwd, dim3(grid), dim3(NWAVES * 64), LDS_BYTES, stream, a);
#endif
    const hipError_t le = hipPeekAtLastError();
    if (le != hipSuccess) fprintf(stderr, "kernel_launch: launch failed: %s\n", hipGetErrorName(le));
}
```

```cpp
#include <hip/hip_runtime.h>
#include <cstdio>
#include <cstdint>
#include <cmath>
__device__ __forceinline__ int lane_id_v() { int l; asm volatile("v_mbcnt_lo_u32_b32 %0, -1, 0\n\tv_mbcnt_hi_u32_b32 %0, -1, %0" : "=v"(l)); return l; }
namespace pg8 {
#define PG8_LAS __attribute__((address_space(3)))
typedef unsigned short bf16_t;
typedef short bf16x8 __attribute__((ext_vector_type(8)));
typedef float f32x4 __attribute__((ext_vector_type(4)));
typedef unsigned u32x4 __attribute__((ext_vector_type(4)));
typedef int i32x4 __attribute__((ext_vector_type(4)));
template <bool I8> struct AccT { typedef f32x4 type; };
template <> struct AccT<true> { typedef i32x4 type; };
__device__ __forceinline__ f32x4 mma_op(bf16x8 a, bf16x8 b, f32x4 c) { return __builtin_amdgcn_mfma_f32_16x16x32_bf16(a, b, c, 0, 0, 0); }
__device__ __forceinline__ i32x4 mma_op(bf16x8 a, bf16x8 b, i32x4 c) { return __builtin_amdgcn_mfma_i32_16x16x64_i8(__builtin_bit_cast(i32x4, a), __builtin_bit_cast(i32x4, b), c, 0, 0, 0); }
constexpr int BM = 256, BK = 64, HALF = 128, HTB = HALF * BK * 2  , STAGE_BYTES = 8 * HTB, NXCD = 8, WGM = 8;

__host__ __device__ __forceinline__ int lds_byte(int r, int c) { const int st = (r >> 4) * 2 + (c >> 5), rr = r & 15, cc = c & 31, ob = rr * 64 + cc * 2; return st * 1024 + (ob ^ (((ob >> 9) & 1) << 5)); }
__host__ __device__ __forceinline__ void stage_rc(int b, int& R, int& C) { const int st = b / 1024, sb = b % 1024, swz = sb ^ (((sb >> 9) & 1) << 5); R = (st >> 1) * 16 + swz / 64; C = (st & 1) * 32 + (swz % 64) / 2; }
__host__ __device__ __forceinline__ int perm32(int rho) { const int n = rho >> 4, i = rho & 15; return 8 * (i >> 2) + 4 * n + (i & 3); }

struct Unit { int pm, pn, seq; };
struct Gemm { const bf16_t* A; const bf16_t* Bt; int M, N, K; int wave; };

struct StaticOrder {
    int nM, nN, nwg, G, c;
    __host__ __device__ void init(int M, int N, int G_, int c_) { nM = M / BM; nN = N / BM; nwg = nM * nN; G = G_; c = c_; }
    __host__ __device__ bool next(int i, Unit& u) const {
        const long L = (long)i * G + c; if (L >= nwg) return false;
        int wgid = (int)L; { const int q = nwg / NXCD, r = nwg % NXCD, xcd = wgid % NXCD, off = wgid / NXCD; wgid = (xcd < r ? xcd * (q + 1) : r * (q + 1) + (xcd - r) * q) + off; }
        const int nig = WGM * nN, gid = wgid / nig, fm = gid * WGM, gsz = (nM - fm) < WGM ? (nM - fm) : WGM;
        u.pm = fm + ((wgid % nig) % gsz); u.pn = (wgid % nig) / gsz; u.seq = i; return true;
    }
    __device__ __forceinline__ void a_ready(const Unit&) const {}
    __device__ __forceinline__ void done(const Unit&) const {}
};

__device__ __forceinline__ unsigned cvt_pk_bf16(float lo, float hi) { unsigned r; asm volatile("v_cvt_pk_bf16_f32 %0, %1, %2" : "=v"(r) : "v"(lo), "v"(hi)); return r; }
struct FrowOrder : StaticOrder {
    const float* frow; PG8_LAS unsigned char* tab;
    __device__ __forceinline__ void a_ready(const Unit& u) const {
        const int lane = lane_id_v();
        __builtin_amdgcn_global_load_lds((const unsigned*)(frow + (size_t)u.pm * BM + lane * 4), (PG8_LAS unsigned*)(tab + (u.seq & 1) * 1024), 16, 0, 0);
    }
};
constexpr float RMS_EPS = 1e-6f;
typedef float f32x2_ __attribute__((ext_vector_type(2)));
__device__ __forceinline__ float gelu_tanh(float x) {
    const float u = 0.7978845608028654f * (x + 0.044715f * x * x * x);
    const float e = __builtin_amdgcn_exp2f(-2.0f * 1.4426950408889634f * u);
    return x * __builtin_amdgcn_rcpf(1.0f + e);
}
template <bool I8>
struct EpiScaleT {
    static constexpr bool PERM = true, AFTER_DRAIN = false;
    bf16_t* O; int ldc; const PG8_LAS unsigned char* tab; float* kmp; bf16_t* O2; int mode; const float* scol; const float* hq;
    __device__ __forceinline__ void operator()(const typename AccT<I8>::type (&acc)[2][2][4][2], const Unit& u, int wr, int wc, int fr, int fq) const {
        const int row0 = u.pm * BM + wr * 64 + fr;
        f32x4 sc[2][2];
#pragma unroll
        for (int bj = 0; bj < 2; ++bj)
#pragma unroll
            for (int n = 0; n < 2; ++n) { if constexpr (I8) sc[bj][n] = *(const f32x4*)(scol + u.pn * BM + bj * HALF + wc * 32 + 8 * fq + 4 * n); else sc[bj][n] = (f32x4){1.f, 1.f, 1.f, 1.f}; }
        float rs[2][4];
#pragma unroll
        for (int ai = 0; ai < 2; ++ai)
#pragma unroll
            for (int m = 0; m < 4; ++m) rs[ai][m] = *(const PG8_LAS float*)(tab + (u.seq & 1) * 1024 + (wr * 64 + fr + ai * HALF + m * 16) * 4);
        int colt = u.pn * BM; bf16_t* base = O; int am = mode >= 2 ? 2 : 0; const float hqi = mode == 3 ? hq[0] : 0.f;
        if (mode == 1 && colt >= 2048) { colt -= 2048; base = O2; am = 1; }
        const int col0 = colt + wc * 32 + 8 * fq;
#pragma unroll
        for (int ai = 0; ai < 2; ++ai)
#pragma unroll
            for (int m = 0; m < 4; ++m) { bf16_t* rowp = base + (size_t)(row0 + ai * HALF + m * 16) * ldc + col0; const float r = rs[ai][m];
#pragma unroll
                for (int bj = 0; bj < 2; ++bj) { f32x4 v0 = __builtin_convertvector(acc[ai][bj][m][0], f32x4) * (sc[bj][0] * r), v1 = __builtin_convertvector(acc[ai][bj][m][1], f32x4) * (sc[bj][1] * r);
                    if (am == 1) {
#pragma unroll
                        for (int e = 0; e < 4; ++e) { v0[e] = gelu_tanh(v0[e]); v1[e] = gelu_tanh(v1[e]); } }
                    else if (am == 2) {
#pragma unroll
                        for (int e = 0; e < 4; ++e) { const float a0 = fmaxf(v0[e], 0.f), a1 = fmaxf(v1[e], 0.f); v0[e] = a0 * a0; v1[e] = a1 * a1; } }
                    u32x4 w; w.x = cvt_pk_bf16(v0[0], v0[1]); w.y = cvt_pk_bf16(v0[2], v0[3]); w.z = cvt_pk_bf16(v1[0], v1[1]); w.w = cvt_pk_bf16(v1[2], v1[3]);
                    if (mode == 3) {
                        int q[8];
#pragma unroll
                        for (int e = 0; e < 4; ++e) { q[e] = (int)__builtin_rintf(fminf(v0[e] * hqi, 254.0f)) - 127; q[4 + e] = (int)__builtin_rintf(fminf(v1[e] * hqi, 254.0f)) - 127; }
                        f32x2_ wq; wq.x = __builtin_bit_cast(float, ((unsigned)q[0] & 255u) | (((unsigned)q[1] & 255u) << 8) | (((unsigned)q[2] & 255u) << 16) | ((unsigned)q[3] << 24));
                        wq.y = __builtin_bit_cast(float, ((unsigned)q[4] & 255u) | (((unsigned)q[5] & 255u) << 8) | (((unsigned)q[6] & 255u) << 16) | ((unsigned)q[7] << 24));
                        *(f32x2_*)((unsigned char*)O + (size_t)(row0 + ai * HALF + m * 16) * 8192 + col0 + bj * HALF) = wq; }
                    else if (am == 2) __builtin_nontemporal_store(w, (u32x4*)(rowp + bj * HALF)); else *(u32x4*)(rowp + bj * HALF) = w; } }
        if (mode == 0 && u.pn >= 8 && u.pn < 16) {
            float* kp = kmp + ((size_t)wr * 32 + u.pm) * 2048 + (u.pn - 8) * BM + wc * 32 + 8 * fq;
#pragma unroll
            for (int bj = 0; bj < 2; ++bj)
#pragma unroll
                for (int n = 0; n < 2; ++n) { f32x4 s = (f32x4){0.f, 0.f, 0.f, 0.f};
#pragma unroll
                    for (int ai = 0; ai < 2; ++ai)
#pragma unroll
                        for (int m = 0; m < 4; ++m) s += __builtin_convertvector(acc[ai][bj][m][n], f32x4) * rs[ai][m];
                    s *= sc[bj][n];
#pragma unroll
                    for (int e = 0; e < 4; ++e) { float t = s[e]; t += __shfl_xor(t, 1); t += __shfl_xor(t, 2); t += __shfl_xor(t, 4); t += __shfl_xor(t, 8); s[e] = t; }
                    if (fr == 0) *(f32x4*)(kp + bj * HALF + 4 * n) = s; } }
    }
};
struct EpiRes {
    static constexpr bool PERM = true, AFTER_DRAIN = false;
    bf16_t* XB;
    __device__ __forceinline__ void operator()(const f32x4 (&acc)[2][2][4][2], const Unit& u, int wr, int wc, int fr, int fq) const {
        const int row0 = u.pm * BM + wr * 64 + fr, col0 = u.pn * BM + wc * 32 + 8 * fq;
        asm volatile("" ::: "memory"); __builtin_amdgcn_sched_barrier(0);
        u32x4 xin[2][4][2];
#pragma unroll
        for (int ai = 0; ai < 2; ++ai)
#pragma unroll
            for (int m = 0; m < 4; ++m)
#pragma unroll
                for (int bj = 0; bj < 2; ++bj) xin[ai][m][bj] = *(const u32x4*)(XB + (size_t)(row0 + ai * HALF + m * 16) * 2048 + col0 + bj * HALF);
        asm volatile("" ::: "memory"); __builtin_amdgcn_sched_barrier(0);
#pragma unroll
        for (int ai = 0; ai < 2; ++ai)
#pragma unroll
            for (int m = 0; m < 4; ++m) { const int r = row0 + ai * HALF + m * 16;
#pragma unroll
                for (int bj = 0; bj < 2; ++bj) { bf16_t* xp = XB + (size_t)r * 2048 + col0 + bj * HALF; const u32x4 xo = xin[ai][m][bj];
                    f32x4 x0, x1;
                    x0[0] = __builtin_bit_cast(float, xo.x << 16); x0[1] = __builtin_bit_cast(float, xo.x & 0xffff0000u); x0[2] = __builtin_bit_cast(float, xo.y << 16); x0[3] = __builtin_bit_cast(float, xo.y & 0xffff0000u);
                    x1[0] = __builtin_bit_cast(float, xo.z << 16); x1[1] = __builtin_bit_cast(float, xo.z & 0xffff0000u); x1[2] = __builtin_bit_cast(float, xo.w << 16); x1[3] = __builtin_bit_cast(float, xo.w & 0xffff0000u);
                    x0 += acc[ai][bj][m][0]; x1 += acc[ai][bj][m][1];
                    u32x4 w; w.x = cvt_pk_bf16(x0[0], x0[1]); w.y = cvt_pk_bf16(x0[2], x0[3]); w.z = cvt_pk_bf16(x1[0], x1[1]); w.w = cvt_pk_bf16(x1[2], x1[3]);
                    *(u32x4*)xp = w; } }
    }
};
struct EpiResQ8 {
    static constexpr bool PERM = true, AFTER_DRAIN = false;
    bf16_t* XB; const float* t2; const float* cs2; const float* hq;
    __device__ __forceinline__ void operator()(const i32x4 (&acc)[2][2][4][2], const Unit& u, int wr, int wc, int fr, int fq) const {
        const int row0 = u.pm * BM + wr * 64 + fr, col0 = u.pn * BM + wc * 32 + 8 * fq;
        const float step = hq[1];
        f32x4 sc[2][2], cc[2][2];
#pragma unroll
        for (int bj = 0; bj < 2; ++bj)
#pragma unroll
            for (int n = 0; n < 2; ++n) { sc[bj][n] = *(const f32x4*)(t2 + col0 + bj * HALF + 4 * n) * step; cc[bj][n] = *(const f32x4*)(cs2 + col0 + bj * HALF + 4 * n) * 127.0f; }
        asm volatile("" ::: "memory"); __builtin_amdgcn_sched_barrier(0);
#pragma unroll
        for (int ai = 0; ai < 2; ++ai) {
            u32x4 xin[4][2];
#pragma unroll
            for (int m = 0; m < 4; ++m)
#pragma unroll
                for (int bj = 0; bj < 2; ++bj) xin[m][bj] = *(const u32x4*)(XB + (size_t)(row0 + ai * HALF + m * 16) * 2048 + col0 + bj * HALF);
            asm volatile("" ::: "memory"); __builtin_amdgcn_sched_barrier(0);
#pragma unroll
            for (int m = 0; m < 4; ++m) { const int r = row0 + ai * HALF + m * 16;
#pragma unroll
                for (int bj = 0; bj < 2; ++bj) { bf16_t* xp = XB + (size_t)r * 2048 + col0 + bj * HALF; const u32x4 xo = xin[m][bj];
                    f32x4 x0, x1;
                    x0[0] = __builtin_bit_cast(float, xo.x << 16); x0[1] = __builtin_bit_cast(float, xo.x & 0xffff0000u); x0[2] = __builtin_bit_cast(float, xo.y << 16); x0[3] = __builtin_bit_cast(float, xo.y & 0xffff0000u);
                    x1[0] = __builtin_bit_cast(float, xo.z << 16); x1[1] = __builtin_bit_cast(float, xo.z & 0xffff0000u); x1[2] = __builtin_bit_cast(float, xo.w << 16); x1[3] = __builtin_bit_cast(float, xo.w & 0xffff0000u);
                    x0 += (__builtin_convertvector(acc[ai][bj][m][0], f32x4) + cc[bj][0]) * sc[bj][0]; x1 += (__builtin_convertvector(acc[ai][bj][m][1], f32x4) + cc[bj][1]) * sc[bj][1];
                    u32x4 w; w.x = cvt_pk_bf16(x0[0], x0[1]); w.y = cvt_pk_bf16(x0[2], x0[3]); w.z = cvt_pk_bf16(x1[0], x1[1]); w.w = cvt_pk_bf16(x1[2], x1[3]);
                    *(u32x4*)xp = w; } }
            asm volatile("" ::: "memory"); __builtin_amdgcn_sched_barrier(0); }
    }
};
template <class Epi, class Sched, bool ALIGN_EPI = false, bool SP2 = false, bool I8 = false>
__device__ __forceinline__ void gemm_phase(PG8_LAS unsigned char* lds, const Gemm g, const Sched& S, const Epi& E) {
    int tid_ = g.wave * 64 + lane_id_v(); asm volatile("" : "+v"(tid_));
    const int tid = tid_, wid = __builtin_amdgcn_readfirstlane(tid >> 6), lane = tid & 63, wr = wid >> 2, wc = wid & 3, fr = lane & 15, fq = lane >> 4;
    const int K = g.K, nt = K / BK;
    unsigned voffA[2], voffB[2];
#pragma unroll
    for (int i = 0; i < 2; ++i) { int R, C; stage_rc(tid * 16 + i * 8192, R, C); const int Rb = Epi::PERM ? ((R & ~31) + perm32(R & 31)) : R;
        voffA[i] = (unsigned)(R * K + C) * 2u; voffB[i] = (unsigned)(Rb * K + C) * 2u; }
    const size_t kstep = (size_t)(BK * 2);
    const size_t hstep = (size_t)HALF * K * 2;
    const size_t tstep = 2 * hstep;
    const unsigned ldsw = (unsigned)wid * 1024u;
    const int aoff = lds_byte(wr * 64 + fr, fq * 8), boff = lds_byte(wc * 32 + fr, fq * 8);
#define PG8_SA(b, h) (((b) * 2 + (h)) * HTB)
#define PG8_SB(b, h) ((4 + (b) * 2 + (h)) * HTB)
#define PG8_STAGE(bufoff, gbase, voff) do { _Pragma("unroll") for (int _i = 0; _i < 2; ++_i) \
        __builtin_amdgcn_global_load_lds((const unsigned*)((const char*)(gbase) + (voff)[_i]), (PG8_LAS unsigned*)(lds + (bufoff) + ldsw + _i * 8192), 16, 0, 0); } while (0)
#define PG8_LDA(dst, b, h) do { _Pragma("unroll") for (int m = 0; m < 4; ++m) _Pragma("unroll") for (int k = 0; k < 2; ++k) dst[m][k] = *(const PG8_LAS bf16x8*)(lds + PG8_SA(b, h) + aoff + m * 2048 + k * 1024); } while (0)
#define PG8_LDB(dst, b, h) do { _Pragma("unroll") for (int n = 0; n < 2; ++n) _Pragma("unroll") for (int k = 0; k < 2; ++k) dst[n][k] = *(const PG8_LAS bf16x8*)(lds + PG8_SB(b, h) + boff + n * 2048 + k * 1024); } while (0)
#define PG8_MMA(ai, bj, At, Bt) do { __builtin_amdgcn_s_setprio(1); _Pragma("unroll") for (int m = 0; m < 4; ++m) _Pragma("unroll") for (int n = 0; n < 2; ++n) _Pragma("unroll") for (int k = 0; k < 2; ++k) \
        acc[ai][bj][m][n] = mma_op(Bt[n][k], At[m][k], acc[ai][bj][m][n]); __builtin_amdgcn_s_setprio(0); } while (0)
#define PG8_WAIT_V(n) asm volatile("s_waitcnt vmcnt(" #n ")" ::: "memory")
#define PG8_WAIT_L(n) asm volatile("s_waitcnt lgkmcnt(" #n ")" ::: "memory")
#define PG8_BAR __builtin_amdgcn_s_barrier()
#define PG8_SCHED __builtin_amdgcn_sched_barrier(0)
    Unit cur, nxt; int ui = 0;
    if (!S.next(0, cur)) return;
    typedef typename AccT<I8>::type acc_t;
    acc_t acc[2][2][4][2];
#pragma unroll
    for (int a = 0; a < 2; ++a)
#pragma unroll
        for (int b = 0; b < 2; ++b)
#pragma unroll
            for (int m = 0; m < 4; ++m)
#pragma unroll
                for (int n = 0; n < 2; ++n) acc[a][b][m][n] = acc_t{};
    bf16x8 At[4][2], B0[2][2], B1[2][2];
    const char* cA = (const char*)g.A + (size_t)cur.pm * tstep; const char* cB = (const char*)g.Bt + (size_t)cur.pn * tstep;
    S.a_ready(cur);
    if constexpr (SP2) {
        PG8_STAGE(PG8_SB(0, 0), cB, voffB); PG8_STAGE(PG8_SB(0, 1), cB + hstep, voffB); PG8_STAGE(PG8_SA(0, 0), cA, voffA); PG8_STAGE(PG8_SA(0, 1), cA + hstep, voffA);
        if (wr == 1) PG8_BAR;
        PG8_WAIT_V(2); PG8_BAR;
        PG8_STAGE(PG8_SB(1, 0), cB + kstep, voffB); PG8_STAGE(PG8_SB(1, 1), cB + hstep + kstep, voffB);
        PG8_WAIT_V(4); PG8_BAR;
    } else {
        PG8_STAGE(PG8_SB(0, 0), cB, voffB); PG8_STAGE(PG8_SA(0, 0), cA, voffA); PG8_STAGE(PG8_SB(0, 1), cB + hstep, voffB); PG8_STAGE(PG8_SA(0, 1), cA + hstep, voffA);
        if (wr == 1) PG8_BAR;
        PG8_WAIT_V(4); PG8_BAR;
        PG8_STAGE(PG8_SB(1, 0), cB + kstep, voffB); PG8_STAGE(PG8_SA(1, 0), cA + kstep, voffA); PG8_STAGE(PG8_SB(1, 1), cB + hstep + kstep, voffB);
        PG8_WAIT_V(6); PG8_BAR;
    }
    for (;;) {
        const bool has_next = S.next(ui + 1, nxt);
        const char* nA = has_next ? (const char*)g.A + (size_t)nxt.pm * tstep : cA; const char* nB = has_next ? (const char*)g.Bt + (size_t)nxt.pn * tstep : cB;
        for (int t = 0; t < nt; t += 2) {
            const bool last = (t == nt - 2);
            const char* a1 = cA + (size_t)(t + 1) * kstep;
            const char* a2 = last ? nA : cA + (size_t)(t + 2) * kstep; const char* b2 = last ? nB : cB + (size_t)(t + 2) * kstep;
            const char* a3 = a2 + kstep; const char* b3 = b2 + kstep; (void)a3;
            if (last && has_next) S.a_ready(nxt);
            if constexpr (SP2) {
            PG8_LDB(B0, 0, 0); PG8_LDB(B1, 0, 1); PG8_SCHED; PG8_LDA(At, 0, 0); PG8_STAGE(PG8_SA(1, 0), a1, voffA); PG8_STAGE(PG8_SA(1, 1), a1 + hstep, voffA);
            PG8_WAIT_V(8); PG8_WAIT_L(0); PG8_BAR; PG8_MMA(0, 0, At, B0); PG8_MMA(0, 1, At, B1); PG8_BAR; PG8_SCHED;
            PG8_LDA(At, 0, 1); PG8_STAGE(PG8_SB(0, 0), b2, voffB); PG8_STAGE(PG8_SB(0, 1), b2 + hstep, voffB);
            PG8_WAIT_V(6); PG8_WAIT_L(0); PG8_BAR; PG8_MMA(1, 0, At, B0); PG8_MMA(1, 1, At, B1); PG8_BAR; PG8_SCHED;
            PG8_LDB(B0, 1, 0); PG8_LDB(B1, 1, 1); PG8_SCHED; PG8_LDA(At, 1, 0); PG8_STAGE(PG8_SA(0, 0), a2, voffA); PG8_STAGE(PG8_SA(0, 1), a2 + hstep, voffA);
            PG8_WAIT_V(8); PG8_WAIT_L(0); PG8_BAR; PG8_MMA(0, 0, At, B0); PG8_MMA(0, 1, At, B1); PG8_BAR; PG8_SCHED;
            PG8_LDA(At, 1, 1); PG8_STAGE(PG8_SB(1, 0), b3, voffB); PG8_STAGE(PG8_SB(1, 1), b3 + hstep, voffB);
            PG8_WAIT_V(6); PG8_WAIT_L(0); PG8_BAR; PG8_MMA(1, 0, At, B0); PG8_MMA(1, 1, At, B1); PG8_BAR; PG8_SCHED;
            } else {
            PG8_LDB(B0, 0, 0); PG8_SCHED; PG8_LDA(At, 0, 0); PG8_STAGE(PG8_SA(1, 1), a1 + hstep, voffA);
            PG8_WAIT_L(8); PG8_BAR; PG8_WAIT_L(0); PG8_MMA(0, 0, At, B0); PG8_BAR; PG8_SCHED;
            PG8_LDB(B1, 0, 1); PG8_STAGE(PG8_SB(0, 0), b2, voffB);
            PG8_BAR; PG8_WAIT_L(0); PG8_MMA(0, 1, At, B1); PG8_BAR;
            PG8_LDA(At, 0, 1); PG8_STAGE(PG8_SA(0, 0), a2, voffA);
            PG8_BAR; PG8_WAIT_L(0); PG8_MMA(1, 0, At, B0); PG8_BAR; PG8_SCHED;
            PG8_STAGE(PG8_SB(0, 1), b2 + hstep, voffB);
            PG8_WAIT_V(6); PG8_BAR; PG8_MMA(1, 1, At, B1); PG8_BAR;
            PG8_LDB(B0, 1, 0); PG8_SCHED; PG8_LDA(At, 1, 0); PG8_STAGE(PG8_SA(0, 1), a2 + hstep, voffA);
            PG8_WAIT_L(8); PG8_BAR; PG8_WAIT_L(0); PG8_MMA(0, 0, At, B0); PG8_BAR; PG8_SCHED;
            PG8_LDB(B1, 1, 1); PG8_STAGE(PG8_SB(1, 0), b3, voffB);
            PG8_BAR; PG8_WAIT_L(0); PG8_MMA(0, 1, At, B1); PG8_BAR;
            PG8_LDA(At, 1, 1); PG8_STAGE(PG8_SA(1, 0), a3, voffA);
            PG8_BAR; PG8_WAIT_L(0); PG8_MMA(1, 0, At, B0); PG8_BAR; PG8_SCHED;
            PG8_STAGE(PG8_SB(1, 1), b3 + hstep, voffB);
            PG8_WAIT_V(6); PG8_BAR; PG8_MMA(1, 1, At, B1); PG8_BAR;
            }
        }
        if constexpr (ALIGN_EPI) { if (wr == 0) PG8_BAR; }
        if constexpr (!Epi::AFTER_DRAIN) { E(acc, cur, wr, wc, fr, fq); S.done(cur); }
        if (!has_next) break;
#pragma unroll
        for (int a = 0; a < 2; ++a)
#pragma unroll
            for (int b = 0; b < 2; ++b)
#pragma unroll
                for (int m = 0; m < 4; ++m)
#pragma unroll
                    for (int n = 0; n < 2; ++n) acc[a][b][m][n] = acc_t{};
        cur = nxt; cA = nA; cB = nB; ++ui;
        if constexpr (ALIGN_EPI) { if (wr == 1) PG8_BAR; }
    }
    PG8_WAIT_V(0);
    if constexpr (!ALIGN_EPI) { if (wr == 0) PG8_BAR; }
    PG8_BAR;
    if constexpr (Epi::AFTER_DRAIN) { E.fused(acc, cur, wr, wc, fr, fq, lds, wid, lane); S.done(cur); }
#undef PG8_SA
#undef PG8_SB
#undef PG8_STAGE
#undef PG8_LDA
#undef PG8_LDB
#undef PG8_MMA
#undef PG8_WAIT_V
#undef PG8_WAIT_L
#undef PG8_BAR
#undef PG8_SCHED
}
}
constexpr int NWAVES = 8;
constexpr int S = 8192, DM = 2048, NH = 16, HD = 128, FF = 8192, NBLK = 32, BLK = 256, DEPTH = 4;
constexpr int NQKV = 3 * DM;
constexpr int BIAS_LD = 8448;
constexpr int NPHASE = 30;
#ifndef DBG_MASK
#define DBG_MASK 0xffff
#endif
#define DBG(b) ((DBG_MASK >> (b)) & 1)
#ifndef REP_MASK
#define REP_MASK 0
#endif
#define NREP(b) (((REP_MASK >> (b)) & 1) ? 2 : 1)
#ifndef MK_PER_PHASE
#define MK_PER_PHASE 0
#endif
constexpr size_t MiB = 1u << 20;
constexpr size_t WS_CTL = 0, CTL_ZERO_BYTES = 1 * MiB;
constexpr size_t WS_WQKV = 2 * MiB;
constexpr size_t WS_WO   = WS_WQKV + 48 * MiB;
constexpr size_t WS_WIN  = WS_WO + 16 * MiB;
constexpr size_t WS_WOUT = WS_WIN + 32 * MiB;
constexpr size_t WS_W1   = WS_WOUT + 16 * MiB;
constexpr size_t WS_W2   = WS_W1 + 128 * MiB;
constexpr size_t WS_X    = WS_W2 + 128 * MiB;
constexpr size_t WS_XQ   = WS_X;
constexpr size_t WS_FROW = WS_X + 16 * MiB;
constexpr size_t WS_RSTD = WS_FROW + 65536;
constexpr size_t WS_SW   = WS_X + 17 * MiB;
constexpr int SW_QKV = 0, SW_WIN = 2 * 6144, SW_W1 = SW_WIN + 2 * 4096;
constexpr int SW_T2 = 65536, SW_CS2 = SW_T2 + 4 * 2048, SW_SS = SW_CS2 + 4 * 2048, SW_CL = SW_SS + 4 * 8192;
#ifndef DQ_MASK
#define DQ_MASK 12
#endif
static_assert((DQ_MASK & 1) == 0 && DQ_MASK < 16, "layer 0's hidden step would be needed in the phase that computes the column norms");
constexpr size_t WS_W2Q_OFF = 64;
constexpr size_t WS_XB   = WS_X + 64 * MiB;
constexpr size_t WS_QKV  = WS_XB + 32 * MiB;
constexpr size_t WS_AO   = WS_QKV + 96 * MiB;
constexpr size_t WS_HID  = WS_AO + 32 * MiB;
constexpr size_t WS_SSQ  = WS_HID + 128 * MiB;
constexpr size_t WS_KMP  = WS_SSQ + 9 * MiB;
constexpr size_t WS_LSE  = WS_KMP + 1 * MiB;
constexpr size_t WS_LIST = WS_LSE + 2 * MiB;
constexpr size_t WS_BIAS = WS_LIST + 16 * MiB;
constexpr size_t WS_CARRY = WS_BIAS + 1 * MiB;
constexpr size_t WS_WG   = WS_CARRY + 2 * MiB;
constexpr size_t WS_END  = WS_WG + 2 * MiB;
constexpr int CW_TMO = 0, CW_CODE = 1;
constexpr int CW_BAR = 4096;
constexpr int CW_CNT = 16384;
constexpr int RING_OFF = 0, RING_BYTES = 155392;
constexpr int LDSCTL_OFF = RING_BYTES, MISC_OFF = LDSCTL_OFF + 320;
constexpr int LDS_BYTES = 157696;
#define GAS __attribute__((address_space(1)))
#define LAS __attribute__((address_space(3)))
typedef unsigned short bf16;
typedef unsigned v4u __attribute__((ext_vector_type(4)));
typedef float f32x4 __attribute__((ext_vector_type(4)));
typedef short bf16x8 __attribute__((ext_vector_type(8)));
typedef GAS unsigned gu32;
typedef GAS unsigned long long gu64;
#define RLX_AGENT __ATOMIC_RELAXED, __HIP_MEMORY_SCOPE_AGENT
#define LDS_WAIT() asm volatile("s_waitcnt lgkmcnt(0)" ::: "memory")
#define VM_WAIT() asm volatile("s_waitcnt vmcnt(0)" ::: "memory")
__device__ __forceinline__ unsigned long long rt() { return __builtin_amdgcn_s_memrealtime(); }
__device__ __forceinline__ unsigned f2bf(float f) { unsigned u = __builtin_bit_cast(unsigned, f); return (u + 0x7fffu + ((u >> 16) & 1u)) >> 16; }
__device__ __forceinline__ unsigned pk2(float lo, float hi) { return f2bf(lo) | (f2bf(hi) << 16); }

#define XB_TMO      128
#define XB_XCNT(j)  (256  + 64 * (j))
#define XB_XSUB(j)  (1280 + 64 * (j))
#define XB_XGEN(j)  (2304 + 64 * (j))
#define XB_TOP      3328
#define XB_TOPGEN   3392
#define XCD_BAR_WORDS 3456
#define XB_SPIN_CAP (1u << 22)

__device__ __forceinline__ unsigned xb_ld(unsigned* p)              { return __hip_atomic_load(p, __ATOMIC_RELAXED, __HIP_MEMORY_SCOPE_AGENT); }
__device__ __forceinline__ unsigned xb_add(unsigned* p, unsigned v) { return __hip_atomic_fetch_add(p, v, __ATOMIC_RELAXED, __HIP_MEMORY_SCOPE_AGENT); }
__device__ __forceinline__ unsigned xb_xcc_id() { return (unsigned)__builtin_amdgcn_s_getreg((3 << 11) | 20) & 0xFu; }
#define XB_SPIN(cond, bar) do { unsigned _sp = 0; while (cond) { __builtin_amdgcn_s_sleep(1); \
    if ((++_sp & 255u) == 0u) { if (xb_ld(&(bar)[XB_TMO])) break; if (_sp > XB_SPIN_CAP) { atomicAdd(&(bar)[XB_TMO], 1u); break; } } } } while (0)

struct XcdBarrier {
    unsigned* bar; unsigned x;
    volatile LAS unsigned* st;
};

__device__ __forceinline__ XcdBarrier xcd_barrier_post(unsigned* bar, volatile LAS unsigned* st) {
    XcdBarrier b; b.bar = bar; b.x = xb_xcc_id(); b.st = st;
    if (threadIdx.x == 0) (void)xb_add(&bar[XB_XCNT(b.x)], 1u);
    return b;
}
__device__ __forceinline__ void xcd_barrier_complete(unsigned* bar, unsigned x, unsigned& nloc, unsigned& nx) {
    const unsigned G = gridDim.x * gridDim.y * gridDim.z;
    unsigned sum, cnt, mine, sp = 0u;
    for (;;) {
        sum = 0u; cnt = 0u; mine = 0u;
#pragma unroll
        for (unsigned j = 0; j < 16; ++j) { const unsigned c = xb_ld(&bar[XB_XCNT(j)]); sum += c; cnt += (c > 0u) ? 1u : 0u; mine = (j == x) ? c : mine; }
        if (sum == G) break;
        __builtin_amdgcn_s_sleep(1);
        if ((++sp & 255u) == 0u) { if (xb_ld(&bar[XB_TMO])) break; if (sp > XB_SPIN_CAP) { atomicAdd(&bar[XB_TMO], 1u); break; } }
    }
    nloc = mine > 0u ? mine : 1u; nx = cnt > 0u ? cnt : 1u;
}

__device__ __forceinline__ void xcd_barrier(const XcdBarrier& b) {
    asm volatile("s_waitcnt vmcnt(0)" ::: "memory");
    __syncthreads();
    if (threadIdx.x == 0) {
        unsigned* bar = b.bar;
        __builtin_amdgcn_s_waitcnt(0);
        unsigned nloc = b.st[0], nx = b.st[1];
        if (nloc == 0u) { xcd_barrier_complete(bar, b.x, nloc, nx); b.st[0] = nloc; b.st[1] = nx; }
        const unsigned old = xb_add(&bar[XB_XSUB(b.x)], 1u);
        const unsigned gen = old / nloc;
        if (old + 1u == (gen + 1u) * nloc) {
            __builtin_amdgcn_fence(__ATOMIC_RELEASE, "agent");
            asm volatile("s_waitcnt vmcnt(0)" ::: "memory");
            const unsigned og = xb_add(&bar[XB_TOP], 1u);
            const unsigned tg = og / nx;
            if (og + 1u == (tg + 1u) * nx) xb_add(&bar[XB_TOPGEN], 1u);
            else XB_SPIN(xb_ld(&bar[XB_TOPGEN]) == tg, bar);
            __builtin_amdgcn_fence(__ATOMIC_ACQUIRE, "agent");
            xb_add(&bar[XB_XGEN(b.x)], 1u);
            asm volatile("s_waitcnt vmcnt(0)" ::: "memory");
        } else {
            XB_SPIN(xb_ld(&bar[XB_XGEN(b.x)]) == gen, bar);
            __builtin_amdgcn_fence(__ATOMIC_ACQUIRE, "agent");
            asm volatile("s_waitcnt vmcnt(0)" ::: "memory");
        }
    }
    __syncthreads();
}
typedef unsigned short bf16;
typedef unsigned v4u __attribute__((ext_vector_type(4)));
typedef unsigned v2u __attribute__((ext_vector_type(2)));
typedef float f32x2 __attribute__((ext_vector_type(2)));
__device__ __forceinline__ float bf2f(unsigned short b) { return __builtin_bit_cast(float, (unsigned)b << 16); }
__device__ __forceinline__ float bflo(unsigned u) { return __builtin_bit_cast(float, u << 16); }
__device__ __forceinline__ float bfhi(unsigned u) { return __builtin_bit_cast(float, u & 0xffff0000u); }
__device__ __forceinline__ float wave_sum(float v) {
#pragma unroll
    for (int o = 1; o < 64; o <<= 1) v += __shfl_xor(v, o);
    return v;
}
__device__ __forceinline__ float wave_max(float v) {
#pragma unroll
    for (int o = 1; o < 64; o <<= 1) v = fmaxf(v, __shfl_xor(v, o));
    return v;
}
struct Args { const float* in[18]; float* out; unsigned char* ws; int ph_lo, ph_hi; };
struct Frame {
    LAS unsigned char* lds; unsigned char* ldsg;
    volatile LAS unsigned* MISC;
    gu32* ctl;
    int tid, lane, wave, G, bid;
    unsigned char* ws;
};
__device__ __forceinline__ int pass_row(const Frame& F, int wave, int k) {
    return F.G == 256 ? (8 * ((F.bid % 8) / 2) + (F.bid / 8) % 8) * 256 + ((F.bid % 2) * 4 + F.bid / 64) * 32 + wave * 4 + k : (F.bid * NWAVES + wave) + k * (F.G * NWAVES); }
__device__ __forceinline__ int pass_nrows(const Frame& F, int wave) { const int gw = F.bid * NWAVES + wave, NGW = F.G * NWAVES; return F.G == 256 ? 4 : (gw < S ? (S - gw + NGW - 1) / NGW : 0); }

struct TrItem { const float* W; bf16* WT; const float* gain; int K, N, item; };
__device__ __forceinline__ void tr_load(const TrItem& t, int lane, f32x4 (&v)[16]) {
    const int nb = t.N >> 6, kb = t.item / nb, nbi = t.item - kb * nb, k0 = kb * 64, n0 = nbi * 64;
#pragma unroll
    for (int i = 0; i < 16; ++i) v[i] = __builtin_nontemporal_load((const f32x4*)(t.W + (size_t)(k0 + 4 * i + (lane >> 4)) * t.N + n0 + (lane & 15) * 4));
}
__device__ __forceinline__ void tr_store(const TrItem& t, int lane, const f32x4 (&v)[16], LAS float* scr) {
    const int nb = t.N >> 6, kb = t.item / nb, nbi = t.item - kb * nb, k0 = kb * 64, n0 = nbi * 64;
#pragma unroll
    for (int i = 0; i < 16; ++i) { LAS float* s = scr + (4 * i + (lane >> 4)) * 65 + (lane & 15) * 4; s[0] = v[i][0]; s[1] = v[i][1]; s[2] = v[i][2]; s[3] = v[i][3]; }
    LDS_WAIT(); asm volatile("" ::: "memory");
    const int c = lane & 7;
    float g[8];
#pragma unroll
    for (int i = 0; i < 8; ++i) g[i] = t.gain ? t.gain[k0 + 8 * c + i] : 1.0f;
#pragma unroll
    for (int j = 0; j < 8; ++j) { const int n = (lane >> 3) + 8 * j; const LAS float* s = scr + (8 * c) * 65 + n;
        v4u o; o.x = pk2(s[0 * 65] * g[0], s[1 * 65] * g[1]); o.y = pk2(s[2 * 65] * g[2], s[3 * 65] * g[3]); o.z = pk2(s[4 * 65] * g[4], s[5 * 65] * g[5]); o.w = pk2(s[6 * 65] * g[6], s[7 * 65] * g[7]);
        *(GAS v4u*)(t.WT + (size_t)(n0 + n) * t.K + k0 + 8 * c) = o; }
    LDS_WAIT(); asm volatile("" ::: "memory");
}
__device__ __forceinline__ int t5_bucket(int d) {
    if (d < 16) return d;
    const unsigned d2 = (unsigned)d * (unsigned)d; const int msb = 31 - __builtin_clz(d2);
    const int b = 16 + msb - 8; return b > 31 ? 31 : b;
}
__device__ __forceinline__ unsigned pack_i8x4(float a, float b, float c, float d) {
    const int ia = (int)__builtin_rintf(a), ib = (int)__builtin_rintf(b), ic = (int)__builtin_rintf(c), id = (int)__builtin_rintf(d);
    return ((unsigned)ia & 255u) | (((unsigned)ib & 255u) << 8) | (((unsigned)ic & 255u) << 16) | ((unsigned)id << 24);
}
__device__ __forceinline__ void st_ld(const float* W, int N, int k0, int n0, int lane, f32x4 (&v)[16]) {
    const float* p = W + (size_t)(k0 + (lane >> 4)) * N + n0 + (lane & 15) * 4; asm volatile("" : "+v"(p));
#pragma unroll
    for (int i = 0; i < 16; ++i) { v[i] = __builtin_nontemporal_load((const f32x4*)p); p += (size_t)4 * N; }
}
__device__ __forceinline__ void st_pk(const f32x4 (&v)[16], int k0, const LAS float* gl, int lane, unsigned (&h)[32], f32x4& cm) {
#pragma unroll
    for (int i = 0; i < 16; ++i) { const float g = gl[k0 + 4 * i + (lane >> 4)];
        const unsigned p0 = pg8::cvt_pk_bf16(v[i][0] * g, v[i][1] * g), p1 = pg8::cvt_pk_bf16(v[i][2] * g, v[i][3] * g); h[2 * i] = p0; h[2 * i + 1] = p1;
        cm[0] = fmaxf(cm[0], fabsf(bflo(p0))); cm[1] = fmaxf(cm[1], fabsf(bfhi(p0))); cm[2] = fmaxf(cm[2], fabsf(bflo(p1))); cm[3] = fmaxf(cm[3], fabsf(bfhi(p1))); }
    asm volatile("" ::: "memory"); __builtin_amdgcn_sched_barrier(0);
}
__device__ __forceinline__ void st_quant(const unsigned (&h)[32], f32x4 inv4, int k0, int n0, int lane, LAS float* scr, unsigned char* WQ) {
#pragma unroll
    for (int i = 0; i < 16; ++i) { LAS float* sp = scr + (4 * i + (lane >> 4)) * 65 + (lane & 15) * 4;
        sp[0] = bflo(h[2 * i]) * inv4[0]; sp[1] = bfhi(h[2 * i]) * inv4[1]; sp[2] = bflo(h[2 * i + 1]) * inv4[2]; sp[3] = bfhi(h[2 * i + 1]) * inv4[3]; }
    LDS_WAIT(); asm volatile("" ::: "memory");
    const int c = lane & 7;
#pragma unroll
    for (int j = 0; j < 8; ++j) { const int n = (lane >> 3) + 8 * j; const LAS float* sp = scr + (8 * c) * 65 + n;
        v2u o; o.x = pack_i8x4(sp[0 * 65], sp[1 * 65], sp[2 * 65], sp[3 * 65]); o.y = pack_i8x4(sp[4 * 65], sp[5 * 65], sp[6 * 65], sp[7 * 65]);
        *(GAS v2u*)(WQ + (size_t)(n0 + n) * DM + k0 + 8 * c) = o;
        if (j & 1) { asm volatile("" ::: "memory"); __builtin_amdgcn_sched_barrier(0); } }
    LDS_WAIT(); asm volatile("" ::: "memory");
}
__device__ __forceinline__ void p0_strips(const Args& A, Frame& F) {
    int tid = F.wave * 64 + lane_id_v(); asm volatile("" : "+v"(tid)); const int lane = tid & 63, wave = __builtin_amdgcn_readfirstlane(tid >> 6); (void)lane; (void)wave;
    LAS float* scr = (LAS float*)(F.lds + RING_OFF + wave * 16640);
    LAS float* cmx = (LAS float*)(F.lds + RING_OFF + 133120);
    LAS float* gl = (LAS float*)(F.lds + RING_OFF + 137216);
    const int gw = F.bid * NWAVES + wave, NGW = F.G * NWAVES;
    const float* mixn = A.in[2]; const float* mlpn = A.in[3];
    float* SWb = (float*)(F.ws + WS_SW);
    constexpr int NS_QKV = 2 * 96, NS_1 = 4 * 128, NSTRIP = NS_QKV + NS_1;
    struct SD { const float* W; const float* gain; unsigned char* WQ; float* SW; int N, n0; };
    auto dec = [&](int si) -> SD { SD d;
        if (si < NS_QKV) { const int j = si / 96, c = si - j * 96; d.W = A.in[5] + (size_t)j * DM * NQKV; d.gain = mixn + (2 * j) * DM; d.WQ = F.ws + WS_WQKV + (size_t)j * NQKV * DM; d.SW = SWb + SW_QKV + j * NQKV; d.N = NQKV; d.n0 = c * 64; }
        else { const int r = si - NS_QKV, l = r >> 7, c = r & 127; d.W = A.in[16] + (size_t)l * DM * FF; d.gain = mlpn + l * DM; d.WQ = F.ws + WS_W1 + (size_t)l * FF * DM; d.SW = SWb + SW_W1 + l * FF; d.N = FF; d.n0 = c * 64; }
        return d; };
    const int kb = wave * 256;
    int sp = 0;
    f32x4 v[16];
    if (F.bid < NSTRIP) { const SD d0 = dec(F.bid); st_ld(d0.W, d0.N, kb, d0.n0, lane, v); }
    for (int si = F.bid; si < NSTRIP; si += F.G, sp ^= 1) {
        const SD d = dec(si);
        __syncthreads();
#pragma unroll
        for (int i = 0; i < 4; ++i) gl[tid + 512 * i] = d.gain[tid + 512 * i];
        __syncthreads();
        unsigned hb[4][32]; f32x4 cm = (f32x4){0.f, 0.f, 0.f, 0.f};
        st_pk(v, kb, gl, lane, hb[0], cm);
#pragma unroll
        for (int t = 1; t < 4; ++t) { st_ld(d.W, d.N, kb + 64 * t, d.n0, lane, v); st_pk(v, kb + 64 * t, gl, lane, hb[t], cm); }
#pragma unroll
        for (int e = 0; e < 4; ++e) { float t = cm[e]; t = fmaxf(t, __shfl_xor(t, 16)); t = fmaxf(t, __shfl_xor(t, 32)); cm[e] = t; }
        if (lane < 16) *(LAS f32x4*)(cmx + (sp * 8 + wave) * 64 + lane * 4) = cm;
#pragma unroll
        for (int t = 0; t < 4; ++t)
#pragma unroll
            for (int k = 0; k < 32; ++k) asm volatile("" : "+v"(hb[t][k]));
        __syncthreads();
        f32x4 mx = *(const LAS f32x4*)(cmx + (sp * 8) * 64 + (lane & 15) * 4);
#pragma unroll
        for (int w = 1; w < 8; ++w) { const f32x4 t = *(const LAS f32x4*)(cmx + (sp * 8 + w) * 64 + (lane & 15) * 4);
#pragma unroll
            for (int e = 0; e < 4; ++e) mx[e] = fmaxf(mx[e], t[e]); }
        f32x4 inv4;
#pragma unroll
        for (int e = 0; e < 4; ++e) inv4[e] = mx[e] > 1e-30f ? 127.0f / mx[e] : 0.f;
        if (wave == 0 && lane < 16) *(f32x4*)(d.SW + d.n0 + lane * 4) = mx * (1.0f / 127.0f);
        st_quant(hb[0], inv4, kb, d.n0, lane, scr, d.WQ);
        if (si + F.G < NSTRIP) { const SD dn = dec(si + F.G); st_ld(dn.W, dn.N, kb, dn.n0, lane, v); }
#pragma unroll
        for (int t = 1; t < 4; ++t) st_quant(hb[t], inv4, kb + 64 * t, d.n0, lane, scr, d.WQ);
    }
}
__device__ __forceinline__ void p0_tiles(const Args& A, Frame& F) {
    int tid = F.wave * 64 + lane_id_v(); asm volatile("" : "+v"(tid)); const int lane = tid & 63, wave = __builtin_amdgcn_readfirstlane(tid >> 6); (void)lane; (void)wave;
    LAS float* scr = (LAS float*)(F.lds + RING_OFF + wave * 16640);
    const int gw = F.bid * NWAVES + wave, NGW = F.G * NWAVES; (void)gw; (void)NGW; (void)scr;
    constexpr int NSTRIP = 2 * 96 + 4 * 128;
    constexpr int T_O = 32 * 32, T_2 = 128 * 32, T_IN = 32 * 64;
    constexpr int NB = 4 * T_O + 4 * T_2 + 256 + 2 * T_IN;
    auto decode = [&](int it) -> TrItem {
        int r = it; TrItem t;
        if (r >= 4 * T_O + 4 * T_2 + 256) { r -= 4 * T_O + 4 * T_2 + 256; const int j = r / T_IN; r -= j * T_IN;
            t.W = A.in[7] + (size_t)j * DM * 2 * DM; t.WT = (bf16*)(F.ws + WS_WIN) + (size_t)j * 2 * DM * DM; t.gain = A.in[2] + (2 * j + 1) * DM; t.K = DM; t.N = 2 * DM; t.item = r; return t; }
        if (r >= 4 * T_O + 4 * T_2) { r -= 4 * T_O + 4 * T_2; const int blk = r >> 2, jg = blk >> 4, j = jg >> 1, g = jg & 1, n = blk & 15;
            t.W = A.in[g ? 12 : 10] + ((size_t)j * 16 + n) * 16384; t.WT = (bf16*)(F.ws + WS_WG) + (((size_t)j * 2 + g) * 16 + n) * 16384; t.gain = nullptr; t.K = 128; t.N = 128; t.item = r & 3; return t; }
        if (r < 4 * T_O) { const int jj = r / T_O, j = jj & 1; r -= jj * T_O;
            if (jj < 2) { t.W = A.in[6] + (size_t)j * DM * DM; t.WT = (bf16*)(F.ws + WS_WO) + (size_t)j * DM * DM; }
            else { t.W = A.in[15] + (size_t)j * DM * DM; t.WT = (bf16*)(F.ws + WS_WOUT) + (size_t)j * DM * DM; }
            t.gain = nullptr; t.K = DM; t.N = DM; t.item = r; return t; }
        r -= 4 * T_O;
        const int l = r / T_2; r -= l * T_2;
        t.W = A.in[17] + (size_t)l * FF * DM; t.WT = (bf16*)(F.ws + WS_W2) + (size_t)l * DM * FF; t.gain = nullptr; t.K = FF; t.N = DM; t.item = r; return t;
    };
    {
        constexpr int SW_ = 32;
        const int per = (NSTRIP * SW_ + NB + F.G - 1) / F.G;
        int start = 0, cnt = 0;
        for (int b2 = 0; b2 <= F.bid; ++b2) { const int ns = b2 < NSTRIP ? (NSTRIP - b2 + F.G - 1) / F.G : 0; int q = per - SW_ * ns; q = q < 0 ? 0 : q; if (b2 < F.bid) start += q; else cnt = q; }
        int tot = start;
        for (int b2 = F.bid; b2 < F.G; ++b2) { const int ns = b2 < NSTRIP ? (NSTRIP - b2 + F.G - 1) / F.G : 0; int q = per - SW_ * ns; tot += q < 0 ? 0 : q; }
        int end = start + cnt; if (end > NB) end = NB; if (start > NB) start = NB;
        f32x4 va[16], vb[16];
        for (int pass = 0; pass < 2; ++pass) {
            const int first = pass == 0 ? start + wave : (tot < NB ? tot + gw : NB), lim = pass == 0 ? end : NB, step = pass == 0 ? NWAVES : NGW;
            if (first >= lim) continue;
            TrItem cur = decode(first); tr_load(cur, lane, va);
            for (int it = first; it < lim; it += 2 * step) {
                const bool h1 = it + step < lim; TrItem n1 = cur; if (h1) { n1 = decode(it + step); tr_load(n1, lane, vb); }
                tr_store(cur, lane, va, scr);
                if (!h1) break;
                const bool h2 = it + 2 * step < lim; if (h2) { cur = decode(it + 2 * step); tr_load(cur, lane, va); }
                tr_store(n1, lane, vb, scr);
                if (!h2) break;
            }
        }
    }
}
__device__ __forceinline__ void p0_x(const Args& A, Frame& F) {
    int tid = F.wave * 64 + lane_id_v(); asm volatile("" : "+v"(tid)); const int lane = tid & 63, wave = __builtin_amdgcn_readfirstlane(tid >> 6); (void)lane; (void)wave;
    LAS float* scr = (LAS float*)(F.lds + RING_OFF + wave * 16640);
    const int gw = F.bid * NWAVES + wave, NGW = F.G * NWAVES; (void)gw; (void)NGW; (void)scr;
    { const float* x = A.in[0]; bf16* XB = (bf16*)(F.ws + WS_XB); unsigned char* XQ = F.ws + WS_XQ; float* frow = (float*)(F.ws + WS_FROW);
      const int nk = pass_nrows(F, wave);
      for (int kk = 0; kk < nk; ++kk) { const int m = pass_row(F, wave, kk); const GAS f32x4* xr = (const GAS f32x4*)(x + (size_t)m * DM) + lane;
          GAS v2u* xb = (GAS v2u*)(XB + (size_t)m * DM) + lane; GAS unsigned* xq = (GAS unsigned*)(XQ + (size_t)m * DM) + lane; float s = 0.f, am = 0.f;
          f32x4 v[8];
#pragma unroll
          for (int j = 0; j < 8; ++j) v[j] = xr[64 * j];
#pragma unroll
          for (int j = 0; j < 8; ++j) { s += (v[j].x * v[j].x + v[j].y * v[j].y) + (v[j].z * v[j].z + v[j].w * v[j].w); am = fmaxf(fmaxf(am, fmaxf(fabsf(v[j].x), fabsf(v[j].y))), fmaxf(fabsf(v[j].z), fabsf(v[j].w)));
              v2u o; o.x = pk2(v[j].x, v[j].y); o.y = pk2(v[j].z, v[j].w); xb[64 * j] = o; }
          s = wave_sum(s); am = wave_max(am);
          const float inv = am > 1e-30f ? 127.0f / am : 0.f;
#pragma unroll
          for (int j = 0; j < 8; ++j) xq[64 * j] = pack_i8x4(v[j].x * inv, v[j].y * inv, v[j].z * inv, v[j].w * inv);
          if (lane == 0) { const float rstd = __builtin_amdgcn_rsqf(s * (1.0f / 2048.0f) + 1e-6f); frow[m] = am * (1.0f / 127.0f) * rstd; ((float*)(F.ws + WS_RSTD))[m] = rstd; } } }
    { const float* rb = A.in[1]; float* bt = (float*)(F.ws + WS_BIAS);
      for (int i = F.bid * (NWAVES * 64) + tid; i < NH * BIAS_LD; i += F.G * NWAVES * 64) { const int h = i / BIAS_LD, d = i - h * BIAS_LD - 256;
          bt[i] = d < 0 ? -INFINITY : rb[t5_bucket(d) * NH + h] * 1.4426950408889634f; } }
}
__device__ __forceinline__ void p0_prologue(const Args& A, Frame& F) { p0_strips(A, F); p0_tiles(A, F); p0_x(A, F); }
#define TOP3_INS(x_, j_) do { const float x__ = (x_); const int j__ = (j_); const bool b0 = x__ > v0, b1 = x__ > v1, b2 = x__ > v2; \
    v2 = b1 ? v1 : (b2 ? x__ : v2); i2 = b1 ? i1 : (b2 ? j__ : i2); v1 = b0 ? v0 : (b1 ? x__ : v1); i1 = b0 ? i0 : (b1 ? j__ : i1); v0 = b0 ? x__ : v0; i0 = b0 ? j__ : i0; } while (0)
__device__ __forceinline__ void phase_gate(const Args& A, Frame& F, int ja) {
    int tid = F.wave * 64 + lane_id_v(); asm volatile("" : "+v"(tid)); const int lane = tid & 63, wave = __builtin_amdgcn_readfirstlane(tid >> 6); (void)lane; (void)wave;
    const bf16* QKV = (const bf16*)(F.ws + WS_QKV); const float* KMP = (const float*)(F.ws + WS_KMP);
    unsigned* cnt = (unsigned*)(F.ctl + CW_CNT + ja * 512); unsigned* list = (unsigned*)(F.ws + WS_LIST); float* LSE = (float*)(F.ws + WS_LSE);
    LAS float* km = (LAS float*)(F.lds + RING_OFF);
    LAS float* cv = km + 32 * 128;
    LAS int* ci = (LAS int*)(cv + 256 * 3);
    for (int item = F.bid; item < 512; item += F.G) {
        const int h = item & 15, c = item >> 4;
        for (int i = tid; i < 32 * 128; i += NWAVES * 64) { const int jb = i >> 7, d = i & 127;
            km[i] = (KMP[(size_t)jb * 2048 + h * 128 + d] + KMP[(size_t)(32 + jb) * 2048 + h * 128 + d]) * (1.0f / 256.0f); }
        __syncthreads();
        const int t = tid & 255, half = tid >> 8, q = c * 256 + t;
        float g[16];
#pragma unroll
        for (int jb = 0; jb < 16; ++jb) g[jb] = 0.f;
        const bf16* qp = QKV + (size_t)q * NQKV + h * HD;
        const LAS float* kmh = km + half * 16 * 128;
#pragma unroll 1
        for (int d0 = 0; d0 < 128; d0 += 8) {
            const v4u qv = *(const v4u*)(qp + d0);
            const float q0 = bflo(qv.x), q1 = bfhi(qv.x), q2 = bflo(qv.y), q3 = bfhi(qv.y), q4 = bflo(qv.z), q5 = bfhi(qv.z), q6 = bflo(qv.w), q7 = bfhi(qv.w);
#pragma unroll
            for (int jb = 0; jb < 16; ++jb) { const f32x4 k0 = *(const LAS f32x4*)(kmh + jb * 128 + d0), k1 = *(const LAS f32x4*)(kmh + jb * 128 + d0 + 4);
                g[jb] += (q0 * k0[0] + q1 * k0[1]) + (q2 * k0[2] + q3 * k0[3]) + (q4 * k1[0] + q5 * k1[1]) + (q6 * k1[2] + q7 * k1[3]);
                if ((jb & 3) == 3) __builtin_amdgcn_sched_barrier(0); }
        }
        float v0 = -INFINITY, v1 = -INFINITY, v2 = -INFINITY; int i0 = -1, i1 = -1, i2 = -1;
#pragma unroll
        for (int jb = 0; jb < 16; ++jb) { const int j = half * 16 + jb; if (j < c) TOP3_INS(g[jb], j); }
        if (half == 1) { cv[t * 3 + 0] = v0; cv[t * 3 + 1] = v1; cv[t * 3 + 2] = v2; ci[t * 3 + 0] = i0; ci[t * 3 + 1] = i1; ci[t * 3 + 2] = i2; }
        __syncthreads();
        if (half == 0) {
            { const int j = ci[t * 3 + 0]; if (j >= 0) TOP3_INS(cv[t * 3 + 0], j); }
            { const int j = ci[t * 3 + 1]; if (j >= 0) TOP3_INS(cv[t * 3 + 1], j); }
            { const int j = ci[t * 3 + 2]; if (j >= 0) TOP3_INS(cv[t * 3 + 2], j); }
#define EMIT_PICK(k_, sj_) do { if ((sj_) >= 0) { const unsigned pos = atomicAdd(&cnt[h * 32 + (sj_)], 1u); list[(size_t)(h * 32 + (sj_)) * 8192 + pos] = ((unsigned)q << 2) | (unsigned)(k_); } \
                else LSE[((size_t)q * NH + h) * 4 + (k_)] = -INFINITY; } while (0)
            EMIT_PICK(0, i0); EMIT_PICK(1, i1); EMIT_PICK(2, i2);
#undef EMIT_PICK
        }
        __syncthreads();
    }
}
__device__ __forceinline__ void attn_entry(const Args& A, Frame& F, int q, int h, int jb, int slot) {
    int tid = F.wave * 64 + lane_id_v(); asm volatile("" : "+v"(tid)); const int lane = tid & 63, wave = __builtin_amdgcn_readfirstlane(tid >> 6); (void)lane; (void)wave;
    const bf16* QKV = (const bf16*)(F.ws + WS_QKV); const int l = lane;
    const bf16* qp = QKV + (size_t)q * NQKV + h * HD;
    const bf16* Kb = QKV + (size_t)(jb * BLK) * NQKV + DM + h * HD; const bf16* Vb = Kb + DM;
    float s[4] = {0.f, 0.f, 0.f, 0.f};
    for (int d0 = 0; d0 < 128; d0 += 8) {
        const v4u qv = *(const v4u*)(qp + d0);
        const float q0 = bflo(qv.x), q1 = bfhi(qv.x), q2 = bflo(qv.y), q3 = bfhi(qv.y), q4 = bflo(qv.z), q5 = bfhi(qv.z), q6 = bflo(qv.w), q7 = bfhi(qv.w);
#pragma unroll
        for (int kk = 0; kk < 4; ++kk) { const v4u kv = *(const v4u*)(Kb + (size_t)(l + 64 * kk) * NQKV + d0);
            s[kk] += (q0 * bflo(kv.x) + q1 * bfhi(kv.x)) + (q2 * bflo(kv.y) + q3 * bfhi(kv.y)) + (q4 * bflo(kv.z) + q5 * bfhi(kv.z)) + (q6 * bflo(kv.w) + q7 * bfhi(kv.w)); }
    }
    const float C = 0.088388347648318440f * 1.4426950408889634f;
    const float* bt = (const float*)(F.ws + WS_BIAS) + h * BIAS_LD + 256;
    float t[4], m = -INFINITY;
#pragma unroll
    for (int kk = 0; kk < 4; ++kk) { const int d = q - (jb * BLK + l + 64 * kk); t[kk] = s[kk] * C + bt[d]; m = fmaxf(m, t[kk]); }
    m = wave_max(m);
    float p[4], ls = 0.f;
#pragma unroll
    for (int kk = 0; kk < 4; ++kk) { p[kk] = __builtin_amdgcn_exp2f(t[kk] - m); ls += p[kk]; }
    ls = wave_sum(ls);
    const int c0 = 64 * (l >> 5) + (l & 31);
    float o0 = 0.f, o1 = 0.f;
#pragma unroll
    for (int kk = 0; kk < 4; ++kk)
        for (int src = 0; src < 64; ++src) { const float pk = __shfl(p[kk], src); const bf16* vr = Vb + (size_t)(src + 64 * kk) * NQKV;
            o0 += pk * bf2f(vr[c0]); o1 += pk * bf2f(vr[c0 + 32]); }
    const float inv = 1.0f / ls;
    unsigned* PART = (unsigned*)(F.ws + WS_HID); float* LSE = (float*)(F.ws + WS_LSE);
    const size_t e = ((size_t)q * NH + h) * 4 + slot;
    PART[e * 64 + l] = pk2(o0 * inv, o1 * inv);
    if (l == 0) LSE[e] = m + __builtin_amdgcn_logf(ls);
}
__device__ __forceinline__ void phase_attn(const Args& A, Frame& F, int ja) {
    int tid = F.wave * 64 + lane_id_v(); asm volatile("" : "+v"(tid)); const int lane = tid & 63, wave = __builtin_amdgcn_readfirstlane(tid >> 6); (void)lane; (void)wave;
    const unsigned* cnt = (const unsigned*)(F.ctl + CW_CNT + ja * 512); const unsigned* list = (const unsigned*)(F.ws + WS_LIST);
    LAS unsigned* pre = (LAS unsigned*)(F.lds + RING_OFF);
    LAS unsigned* cl = pre + 520;
    for (int i = tid; i < 512; i += NWAVES * 64) cl[i] = __hip_atomic_load(cnt + i, RLX_AGENT);
    __syncthreads();
    if (tid == 0) { unsigned a = 0; for (int i = 0; i < 512; ++i) { pre[i] = a; a += (cl[i] + 7u) >> 3; } pre[512] = a; }
    __syncthreads();
    const int total = (int)pre[512];
    for (int tile = F.bid; tile < total + S * NH / 8; tile += F.G) {
        if (tile < total) {
            int lo = 0, hi = 512;
            while (hi - lo > 1) { const int mid = (lo + hi) >> 1; if ((int)pre[mid] <= tile) lo = mid; else hi = mid; }
            const int e = (tile - (int)pre[lo]) * 8 + wave;
            if (e < (int)cl[lo]) { const unsigned ent = list[(size_t)lo * 8192 + e]; attn_entry(A, F, (int)(ent >> 2), lo >> 5, lo & 31, (int)(ent & 3u)); }
        } else { const int e = (tile - total) * 8 + wave; const int q = e >> 4, h = e & 15; attn_entry(A, F, q, h, q >> 8, 3); }
    }
}
namespace at {
using bf16x8 = __attribute__((ext_vector_type(8))) short;
using s16x4  = __attribute__((ext_vector_type(4))) short;
using f32x16 = __attribute__((ext_vector_type(16))) float;
using u32x4  = __attribute__((ext_vector_type(4))) unsigned;
constexpr int KVBLK = 64, LDK = NQKV;
constexpr int SHM_V = KVBLK * 128 * 2, SHM_K = KVBLK * 128 * 2;
constexpr int OFF_V = 0, OFF_K = 2 * SHM_V, OFF_WS = OFF_K + 2 * SHM_K, OFF_DST = OFF_WS + 8 * 256, OFF_BT = OFF_DST + 8 * 128, OFF_PRE = OFF_BT + BIAS_LD * 4, OFF_CL = OFF_PRE + 1032 * 4, OFF_WT = OFF_CL + 512 * 4, OFF_END = OFF_WT + 64;
static_assert(OFF_END <= RING_BYTES, "attention LDS map");
#define KSWZ(row, colB) ((row) * 256 + ((colB) ^ (((row) & 7) << 4)))
#define SBAR() __builtin_amdgcn_sched_barrier(0)
__device__ __forceinline__ int crow(int r, int hi) { return (r & 3) + 8 * (r >> 2) + 4 * hi; }
__device__ __forceinline__ unsigned cvtpk(float lo, float hi) { unsigned r; asm volatile("v_cvt_pk_bf16_f32 %0, %1, %2" : "=v"(r) : "v"(lo), "v"(hi)); return r; }
__device__ __forceinline__ void partialSM(f32x16& p0, f32x16& p1, const LAS float* bp, float& m_reg, float& alpha) {
    constexpr float C = 0.088388347648318440f * 1.4426950408889634f;
#pragma unroll
    for (int r = 0; r < 16; ++r) p0[r] = fmaf(p0[r], C, bp[59 - ((r & 3) + 8 * (r >> 2))]);
#pragma unroll
    for (int r = 0; r < 16; ++r) p1[r] = fmaf(p1[r], C, bp[27 - ((r & 3) + 8 * (r >> 2))]);
    float pmax = p0[0];
#pragma unroll
    for (int r = 1; r < 16; ++r) pmax = fmaxf(pmax, p0[r]);
#pragma unroll
    for (int r = 0; r < 16; ++r) pmax = fmaxf(pmax, p1[r]);
    { auto rr = __builtin_amdgcn_permlane32_swap(__float_as_uint(pmax), __float_as_uint(pmax), false, false); pmax = fmaxf(__uint_as_float(rr[0]), __uint_as_float(rr[1])); }
    float mn = m_reg; alpha = 1.f;
    if (!__all(pmax <= m_reg + 8.0f)) { const bool up = pmax > m_reg + 8.0f;
        mn = up ? pmax : m_reg; alpha = up ? __builtin_amdgcn_exp2f(m_reg - mn) : 1.f; m_reg = mn; }
#pragma unroll
    for (int r = 0; r < 16; ++r) p0[r] -= mn;
#pragma unroll
    for (int r = 0; r < 16; ++r) p1[r] -= mn;
#pragma unroll
    for (int r = 0; r < 16; ++r) p0[r] = __builtin_amdgcn_exp2f(p0[r]);
}
__device__ __forceinline__ void finishSM(f32x16& p0, f32x16& p1, float alpha, float& l_reg, bf16x8& pa0, bf16x8& pa1, bf16x8& pa2, bf16x8& pa3) {
#pragma unroll
    for (int r = 0; r < 16; ++r) p1[r] = __builtin_amdgcn_exp2f(p1[r]);
    float ps = 0;
#pragma unroll
    for (int r = 0; r < 16; ++r) ps += p0[r];
#pragma unroll
    for (int r = 0; r < 16; ++r) ps += p1[r];
    { auto rr = __builtin_amdgcn_permlane32_swap(__float_as_uint(ps), __float_as_uint(ps), false, false); ps = __uint_as_float(rr[0]) + __uint_as_float(rr[1]); }
    l_reg = l_reg * alpha + ps;
#define PK4(P, BASE, OUT) do { unsigned a0 = cvtpk(P[BASE + 0], P[BASE + 1]), a1 = cvtpk(P[BASE + 2], P[BASE + 3]);   \
    unsigned b0 = cvtpk(P[BASE + 4], P[BASE + 5]), b1 = cvtpk(P[BASE + 6], P[BASE + 7]);                              \
    auto r0 = __builtin_amdgcn_permlane32_swap(a0, b0, false, false); auto r1 = __builtin_amdgcn_permlane32_swap(a1, b1, false, false); \
    u32x4 w = {r0[0], r1[0], r0[1], r1[1]}; OUT = *reinterpret_cast<bf16x8*>(&w); } while (0)
    PK4(p0, 0, pa0); PK4(p0, 8, pa1); PK4(p1, 0, pa2); PK4(p1, 8, pa3);
#undef PK4
}
__device__ __forceinline__ void qkt(f32x16& p0, f32x16& p1, const LAS unsigned char* Ks, const bf16x8* qr, int r32, int hi) {
    p0 = f32x16{}; p1 = f32x16{};
#pragma unroll
    for (int d0 = 0; d0 < 8; ++d0) { const int cb = (d0 * 16 + hi * 8) * 2;
        const bf16x8 b0 = *reinterpret_cast<const LAS bf16x8*>(Ks + KSWZ(r32, cb));
        const bf16x8 b1 = *reinterpret_cast<const LAS bf16x8*>(Ks + KSWZ(32 + r32, cb));
        p0 = __builtin_amdgcn_mfma_f32_32x32x16_bf16(b0, qr[d0], p0, 0, 0, 0);
        p1 = __builtin_amdgcn_mfma_f32_32x32x16_bf16(b1, qr[d0], p1, 0, 0, 0); }
}
__device__ __forceinline__ int v_st(int k, int c) { const int kk = (k & ~0xC) | ((k & 4) << 1) | ((k & 8) >> 1); return ((kk >> 3) * 4 + (c >> 5)) * 512 + ((kk & 7) * 32 + (c & 31)) * 2; }
__device__ __forceinline__ int v_rd_base(int lane) { return ((lane & 3) << 3) | (((lane >> 2) & 3) << 6) | (((lane >> 4) & 1) << 5) | (((lane >> 5) & 1) << 8); }
constexpr int v_rd_off(int d0, int ks, int half) { return d0 * 512 + ks * 4096 + half * 2048; }
template <int OFF> __device__ __forceinline__ s16x4 tr_read(int vb) { s16x4 r; asm volatile("ds_read_b64_tr_b16 %0, %1 offset:%2" : "=&v"(r) : "v"(vb), "i"(OFF) : "memory"); return r; }
template <int D0> __device__ __forceinline__ void pv_one(f32x16& od, int vb, bf16x8 pa0, bf16x8 pa1, bf16x8 pa2, bf16x8 pa3) {
    const s16x4 l0 = tr_read<v_rd_off(D0, 0, 0)>(vb), h0 = tr_read<v_rd_off(D0, 0, 1)>(vb), l1 = tr_read<v_rd_off(D0, 1, 0)>(vb), h1 = tr_read<v_rd_off(D0, 1, 1)>(vb);
    const s16x4 l2 = tr_read<v_rd_off(D0, 2, 0)>(vb), h2 = tr_read<v_rd_off(D0, 2, 1)>(vb), l3 = tr_read<v_rd_off(D0, 3, 0)>(vb), h3 = tr_read<v_rd_off(D0, 3, 1)>(vb);
    asm volatile("s_waitcnt lgkmcnt(0)" ::: "memory"); SBAR();
#define PK(L, H) (bf16x8){L[0], L[1], L[2], L[3], H[0], H[1], H[2], H[3]}
    od = __builtin_amdgcn_mfma_f32_32x32x16_bf16(pa0, PK(l0, h0), od, 0, 0, 0);
    od = __builtin_amdgcn_mfma_f32_32x32x16_bf16(pa1, PK(l1, h1), od, 0, 0, 0);
    od = __builtin_amdgcn_mfma_f32_32x32x16_bf16(pa2, PK(l2, h2), od, 0, 0, 0);
    od = __builtin_amdgcn_mfma_f32_32x32x16_bf16(pa3, PK(l3, h3), od, 0, 0, 0);
#undef PK
}
__device__ __forceinline__ void pv_d0(f32x16* o, int vb, bf16x8 pa0, bf16x8 pa1, bf16x8 pa2, bf16x8 pa3) {
    pv_one<0>(o[0], vb, pa0, pa1, pa2, pa3); pv_one<1>(o[1], vb, pa0, pa1, pa2, pa3); pv_one<2>(o[2], vb, pa0, pa1, pa2, pa3); pv_one<3>(o[3], vb, pa0, pa1, pa2, pa3);
}
__device__ __forceinline__ void attn_unit(const bf16* __restrict__ QKV, int h, int jb, int q, int dsti, LAS unsigned char* lds, unsigned* __restrict__ PART, float* __restrict__ LSE, int tid) {
    const int wid = tid >> 6, lane = tid & 63, r32 = lane & 31, hi = lane >> 5;
    LAS unsigned char* V_lds = lds + OFF_V; LAS unsigned char* K_lds = lds + OFF_K;
    LAS float* ws = (LAS float*)(lds + OFF_WS) + wid * 64; LAS float* li_l = ws; LAS float* al_l = ws + 32;
    LAS int* dst_l = (LAS int*)(lds + OFF_DST) + wid * 32;
    const LAS float* bt = (const LAS float*)(lds + OFF_BT);
    const bf16* Kh = QKV + (size_t)(jb * BLK) * LDK + DM + h * HD; const bf16* Vh = Kh + DM;
    float m_reg = -1e30f, l_reg = 0; f32x16 o[4] = {}; bf16x8 qr[8];
    const bf16* Qw = QKV + (size_t)q * LDK + h * HD + hi * 8;
#pragma unroll
    for (int d0 = 0; d0 < 8; ++d0) qr[d0] = *reinterpret_cast<const bf16x8*>(Qw + d0 * 16);
    if (hi == 0) dst_l[r32] = dsti;
    const LAS float* bp0 = bt + (q - jb * BLK - 4 * hi + 256 - 59);
    const int sr = tid >> 4, sc = (tid & 15) * 8, vst0 = v_st(sr, sc), vst1 = v_st(32 + sr, sc);
    const int vb0 = (int)(uintptr_t)V_lds + v_rd_base(lane);
    struct { bf16x8 vs0, vs1, ks0, ks1; } sr_[2];
#define SLOAD(i, k0) do { sr_[i].vs0 = *reinterpret_cast<const bf16x8*>(&Vh[(size_t)((k0) + sr) * LDK + sc]); sr_[i].vs1 = *reinterpret_cast<const bf16x8*>(&Vh[(size_t)((k0) + 32 + sr) * LDK + sc]); \
    sr_[i].ks0 = *reinterpret_cast<const bf16x8*>(&Kh[(size_t)((k0) + sr) * LDK + sc]); sr_[i].ks1 = *reinterpret_cast<const bf16x8*>(&Kh[(size_t)((k0) + 32 + sr) * LDK + sc]); } while (0)
#define SWRITE(b, i) do { *(LAS bf16x8*)(V_lds + (b) * SHM_V + vst0) = sr_[i].vs0; *(LAS bf16x8*)(V_lds + (b) * SHM_V + vst1) = sr_[i].vs1; const int kc = sc * 2; \
    *(LAS bf16x8*)(K_lds + (b) * SHM_K + KSWZ(sr, kc)) = sr_[i].ks0; *(LAS bf16x8*)(K_lds + (b) * SHM_K + KSWZ(32 + sr, kc)) = sr_[i].ks1; } while (0)
#define SWAIT() asm volatile("s_waitcnt vmcnt(4)" ::: "memory")
#define RESC(a) do { if (__any((a) < 1.f)) { if (hi == 0) al_l[r32] = (a); asm volatile("s_waitcnt lgkmcnt(0)" ::: "memory"); \
    _Pragma("unroll") for (int d = 0; d < 4; ++d) _Pragma("unroll") for (int r = 0; r < 16; ++r) o[d][r] *= al_l[crow(r, hi)]; } } while (0)
    f32x16 pA0, pA1, pB0, pB1; float alA, alB; bf16x8 pa0, pa1, pa2, pa3;
    SLOAD(0, 0); asm volatile("s_waitcnt vmcnt(0)" ::: "memory"); SWRITE(0, 0); __syncthreads();
    qkt(pA0, pA1, K_lds, qr, r32, hi); partialSM(pA0, pA1, bp0, m_reg, alA);
    SLOAD(1, KVBLK); SLOAD(0, 2 * KVBLK);
    SWAIT(); SWRITE(1, 1); __syncthreads();
    SBAR(); qkt(pB0, pB1, K_lds + SHM_K, qr, r32, hi);
    finishSM(pA0, pA1, alA, l_reg, pa0, pa1, pa2, pa3); SBAR();
    SLOAD(1, 3 * KVBLK); SBAR();
    pv_d0(o, vb0, pa0, pa1, pa2, pa3); partialSM(pB0, pB1, bp0 - 64, m_reg, alB);
    __syncthreads(); SWAIT(); SWRITE(0, 0);
    RESC(alB); __syncthreads();
    SBAR(); qkt(pA0, pA1, K_lds, qr, r32, hi);
    finishSM(pB0, pB1, alB, l_reg, pa0, pa1, pa2, pa3); SBAR();
    pv_d0(o, vb0 + SHM_V, pa0, pa1, pa2, pa3); partialSM(pA0, pA1, bp0 - 128, m_reg, alA);
    __syncthreads(); asm volatile("s_waitcnt vmcnt(0)" ::: "memory"); SWRITE(1, 1);
    RESC(alA); __syncthreads();
    SBAR(); qkt(pB0, pB1, K_lds + SHM_K, qr, r32, hi);
    finishSM(pA0, pA1, alA, l_reg, pa0, pa1, pa2, pa3); SBAR();
    pv_d0(o, vb0, pa0, pa1, pa2, pa3); partialSM(pB0, pB1, bp0 - 192, m_reg, alB);
    RESC(alB);
    finishSM(pB0, pB1, alB, l_reg, pa0, pa1, pa2, pa3); SBAR();
    pv_d0(o, vb0 + SHM_V, pa0, pa1, pa2, pa3);
    if (hi == 0) { li_l[r32] = l_reg; if (dsti >= 0) LSE[dsti] = m_reg + __builtin_amdgcn_logf(l_reg); }
    asm volatile("s_waitcnt lgkmcnt(0)" ::: "memory");
#pragma unroll
    for (int r = 0; r < 16; ++r) { const int row = crow(r, hi); const float rl = __builtin_amdgcn_rcpf(li_l[row]); const int ds = dst_l[row];
        if (ds >= 0) { unsigned* pp = PART + (size_t)ds * 64 + r32; pp[0] = cvtpk(o[0][r] * rl, o[1][r] * rl); pp[32] = cvtpk(o[2][r] * rl, o[3][r] * rl); } }
    __syncthreads();
#undef SLOAD
#undef SWRITE
#undef SWAIT
#undef RESC
}
}
__device__ __forceinline__ void phase_attn_mfma(const Args& A, Frame& F, int ja) {
    int tid = F.wave * 64 + lane_id_v(); asm volatile("" : "+v"(tid));
    const unsigned* cnt = (const unsigned*)(F.ctl + CW_CNT + ja * 512); const unsigned* list = (const unsigned*)(F.ws + WS_LIST);
    LAS unsigned char* lds = F.lds + RING_OFF;
    LAS unsigned* pre = (LAS unsigned*)(lds + at::OFF_PRE);
    LAS unsigned* cl = (LAS unsigned*)(lds + at::OFF_CL);
    for (int i = tid; i < 512; i += NWAVES * 64) cl[i] = __hip_atomic_load(cnt + i, RLX_AGENT);
    __syncthreads();
    {
        const int g0 = 2 * tid, h0 = g0 >> 6, x0 = g0 & 63;
        const unsigned n0 = x0 < 32 ? (cl[h0 * 32 + x0] + 255u) >> 8 : 1u, n1 = (x0 + 1) < 32 ? (cl[h0 * 32 + x0 + 1] + 255u) >> 8 : 1u;
        unsigned v = n0 + n1; const int ln = tid & 63;
#pragma unroll
        for (int o = 1; o < 64; o <<= 1) { const unsigned t = __shfl_up(v, o); if (ln >= o) v += t; }
        LAS unsigned* wt = (LAS unsigned*)(lds + at::OFF_WT);
        if (ln == 63) wt[tid >> 6] = v;
        __syncthreads();
        unsigned base = 0;
        for (int w = 0; w < (tid >> 6); ++w) base += wt[w];
        const unsigned excl = base + v - (n0 + n1);
        pre[g0] = excl; pre[g0 + 1] = excl + n0;
        if (tid == NWAVES * 64 - 1) pre[1024] = base + v;
    }
    __syncthreads();
    const unsigned U = pre[1024];
    const unsigned u0 = (unsigned)(((unsigned long long)F.bid * U) / (unsigned)F.G), u1 = (unsigned)(((unsigned long long)(F.bid + 1) * U) / (unsigned)F.G);
    int cur_h = -1;
    const int wave = tid >> 6, r32 = tid & 31;
    for (unsigned u = u0; u < u1; ++u) {
        int lo = 0, hi_ = 1024;
        while (hi_ - lo > 1) { const int mid = (lo + hi_) >> 1; if (pre[mid] <= u) lo = mid; else hi_ = mid; }
        const int g = lo, h = g >> 6, x = g & 63, tile = (int)(u - pre[g]);
        if (h != cur_h) { __syncthreads(); const float* bsrc = (const float*)(F.ws + WS_BIAS) + h * BIAS_LD; LAS float* btl = (LAS float*)(lds + at::OFF_BT);
            {
                const int wv_ = __builtin_amdgcn_readfirstlane(tid >> 6), ln_ = tid & 63;
#pragma unroll
                for (int j = 0; j < 4; ++j) __builtin_amdgcn_global_load_lds((const unsigned*)(bsrc + (j * 8 + wv_) * 256 + ln_ * 4), (LAS unsigned*)((LAS unsigned char*)btl + (j * 8 + wv_) * 1024), 16, 0, 0);
                if (wv_ == 0) __builtin_amdgcn_global_load_lds((const unsigned*)(bsrc + 32 * 256 + ln_ * 4), (LAS unsigned*)((LAS unsigned char*)btl + 32 * 1024), 16, 0, 0); }
            cur_h = h; }
        int q, dsti, jb;
        if (x < 32) { jb = x; const int n = (int)cl[h * 32 + x]; const int e = tile * 256 + wave * 32 + r32; const unsigned ent = list[(size_t)(h * 32 + x) * 8192 + (e < n ? e : n - 1)];
            q = (int)(ent >> 2); dsti = e < n ? (q * NH + h) * 4 + (int)(ent & 3u) : -1; }
        else { jb = x - 32; q = jb * BLK + wave * 32 + r32; dsti = (q * NH + h) * 4 + 3; }
        at::attn_unit((const bf16*)(F.ws + WS_QKV), h, jb, q, dsti, lds, (unsigned*)(F.ws + WS_HID), (float*)(F.ws + WS_LSE), tid);
    }
}
template <bool OWN>
__device__ __forceinline__ void attn_phase(const Args& A, Frame& F, int ja) {
    using namespace at;
    int tid = F.wave * 64 + lane_id_v(); asm volatile("" : "+v"(tid));
    const int wid = tid >> 6, lane = tid & 63, r32 = lane & 31, hi = lane >> 5;
    const bf16* __restrict__ QKV = (const bf16*)(F.ws + WS_QKV);
    const unsigned* cnt = (const unsigned*)(F.ctl + CW_CNT + ja * 512); const unsigned* list = (const unsigned*)(F.ws + WS_LIST);
    unsigned* __restrict__ PART = (unsigned*)(F.ws + WS_HID); float* __restrict__ LSE = (float*)(F.ws + WS_LSE); bf16* __restrict__ AO = (bf16*)(F.ws + WS_AO);
    LAS unsigned char* lds = F.lds + RING_OFF;
    LAS unsigned char* V_lds = lds + OFF_V; LAS unsigned char* K_lds = lds + OFF_K;
    LAS float* ws = (LAS float*)(lds + OFF_WS) + wid * 64; LAS float* li_l = ws; LAS float* al_l = ws + 32;
    LAS int* dst_l = (LAS int*)(lds + OFF_DST) + wid * 32;
    LAS float* btl = (LAS float*)(lds + OFF_BT);
    LAS unsigned* pre = (LAS unsigned*)(lds + OFF_PRE);
    LAS unsigned* cl = (LAS unsigned*)(lds + OFF_CL);
    unsigned u0, u1;
    if (!OWN) {
        const unsigned n0 = (__hip_atomic_load(cnt + tid, RLX_AGENT));
        cl[tid] = n0;
        unsigned v = (n0 + 255u) >> 8; const unsigned mine = v;
#pragma unroll
        for (int o = 1; o < 64; o <<= 1) { const unsigned t = __shfl_up(v, o); if (lane >= o) v += t; }
        LAS unsigned* wt = (LAS unsigned*)(lds + OFF_WT);
        if (lane == 63) wt[wid] = v;
        __syncthreads();
        unsigned base = 0;
        for (int w = 0; w < wid; ++w) base += wt[w];
        pre[tid] = base + v - mine;
        if (tid == NWAVES * 64 - 1) pre[512] = base + v;
        __syncthreads();
        const unsigned U = pre[512];
        u0 = (unsigned)(((unsigned long long)F.bid * U) / (unsigned)F.G); u1 = (unsigned)(((unsigned long long)(F.bid + 1) * U) / (unsigned)F.G);
    } else { u0 = 0; u1 = (512 - F.bid + F.G - 1) / F.G; }
    const int sr = tid >> 4, sc = (tid & 15) * 8, vst0 = v_st(sr, sc), vst1 = v_st(32 + sr, sc);
    const int vb0 = (int)(uintptr_t)V_lds + v_rd_base(lane);
    struct { bf16x8 vs0, vs1, ks0, ks1; } sr_[2];
    bf16x8 qr[8];
    int h = 0, jb = 0, q = 0, dsti = -1;
#define DECODE(u_, h_, jb_, q_, d_) do { if (OWN) { const int gu = F.bid + (int)(u_) * F.G; h_ = gu >> 5; jb_ = gu & 31; q_ = jb_ * BLK + wid * 32 + r32; d_ = 0; } \
    else { int lo = 0, hi_ = 512; while (hi_ - lo > 1) { const int mid = (lo + hi_) >> 1; if (pre[mid] <= (u_)) lo = mid; else hi_ = mid; } \
        h_ = lo >> 5; jb_ = lo & 31; const int n_ = (int)cl[lo], e_ = (int)((u_) - pre[lo]) * 256 + wid * 32 + r32; \
        const unsigned ent_ = list[(size_t)lo * 8192 + (e_ < n_ ? e_ : n_ - 1)]; q_ = (int)(ent_ >> 2); d_ = e_ < n_ ? (q_ * NH + h_) * 4 + (int)(ent_ & 3u) : -1; } } while (0)
#define KVPTR(h_, jb_) (QKV + (size_t)((jb_) * BLK) * LDK + DM + (h_) * HD)
#define SLOAD(i, kp, k0) do { const bf16* kp_ = (kp); sr_[i].vs0 = *reinterpret_cast<const bf16x8*>(&kp_[DM + (size_t)((k0) + sr) * LDK + sc]); sr_[i].vs1 = *reinterpret_cast<const bf16x8*>(&kp_[DM + (size_t)((k0) + 32 + sr) * LDK + sc]); \
    sr_[i].ks0 = *reinterpret_cast<const bf16x8*>(&kp_[(size_t)((k0) + sr) * LDK + sc]); sr_[i].ks1 = *reinterpret_cast<const bf16x8*>(&kp_[(size_t)((k0) + 32 + sr) * LDK + sc]); } while (0)
#define QLOAD(h_, q_) do { const bf16* Qw_ = QKV + (size_t)(q_) * LDK + (h_) * HD + hi * 8; _Pragma("unroll") for (int d0 = 0; d0 < 8; ++d0) qr[d0] = *reinterpret_cast<const bf16x8*>(Qw_ + d0 * 16); } while (0)
#define SWRITE(b, i) do { *(LAS bf16x8*)(V_lds + (b) * SHM_V + vst0) = sr_[i].vs0; *(LAS bf16x8*)(V_lds + (b) * SHM_V + vst1) = sr_[i].vs1; const int kc = sc * 2; \
    *(LAS bf16x8*)(K_lds + (b) * SHM_K + KSWZ(sr, kc)) = sr_[i].ks0; *(LAS bf16x8*)(K_lds + (b) * SHM_K + KSWZ(32 + sr, kc)) = sr_[i].ks1; } while (0)
#define SWAIT() asm volatile("s_waitcnt vmcnt(4)" ::: "memory")
#define RESC(a) do { if (__any((a) < 1.f)) { if (hi == 0) al_l[r32] = (a); asm volatile("s_waitcnt lgkmcnt(0)" ::: "memory"); \
    _Pragma("unroll") for (int d = 0; d < 4; ++d) _Pragma("unroll") for (int r = 0; r < 16; ++r) o[d][r] *= al_l[crow(r, hi)]; } } while (0)
    if (u0 < u1) { DECODE(u0, h, jb, q, dsti); }
    int cur_h = -1;
    for (unsigned u = u0; u < u1; ++u) {
        if (h != cur_h) { const float* bsrc = (const float*)(F.ws + WS_BIAS) + h * BIAS_LD;
            {
                const int wv_ = __builtin_amdgcn_readfirstlane(tid >> 6), ln_ = tid & 63;
#pragma unroll
                for (int j = 0; j < 4; ++j) __builtin_amdgcn_global_load_lds((const unsigned*)(bsrc + (j * 8 + wv_) * 256 + ln_ * 4), (LAS unsigned*)((LAS unsigned char*)btl + (j * 8 + wv_) * 1024), 16, 0, 0);
                if (wv_ == 0) __builtin_amdgcn_global_load_lds((const unsigned*)(bsrc + 32 * 256 + ln_ * 4), (LAS unsigned*)((LAS unsigned char*)btl + 32 * 1024), 16, 0, 0); }
            cur_h = h; }
        const bf16* Kp = KVPTR(h, jb); QLOAD(h, q); SLOAD(0, Kp, 0);
        float m_reg = -1e30f, l_reg = 0; f32x16 o[4] = {};
        if (hi == 0) dst_l[r32] = dsti;
        const LAS float* bp0 = btl + (q - jb * BLK - 4 * hi + 256 - 59);
        f32x16 pA0, pA1, pB0, pB1; float alA, alB; bf16x8 pa0, pa1, pa2, pa3;
        asm volatile("s_waitcnt vmcnt(0)" ::: "memory"); SWRITE(0, 0); __syncthreads();
        qkt(pA0, pA1, K_lds, qr, r32, hi); partialSM(pA0, pA1, bp0, m_reg, alA);
        SLOAD(1, Kp, KVBLK); SLOAD(0, Kp, 2 * KVBLK);
        SWAIT(); SWRITE(1, 1); __syncthreads();
        SBAR(); qkt(pB0, pB1, K_lds + SHM_K, qr, r32, hi);
        finishSM(pA0, pA1, alA, l_reg, pa0, pa1, pa2, pa3); SBAR();
        SLOAD(1, Kp, 3 * KVBLK); SBAR();
        pv_d0(o, vb0, pa0, pa1, pa2, pa3); partialSM(pB0, pB1, bp0 - 64, m_reg, alB);
        __syncthreads(); SWAIT(); SWRITE(0, 0);
        RESC(alB); __syncthreads();
        SBAR(); qkt(pA0, pA1, K_lds, qr, r32, hi);
        finishSM(pB0, pB1, alB, l_reg, pa0, pa1, pa2, pa3); SBAR();
        pv_d0(o, vb0 + SHM_V, pa0, pa1, pa2, pa3); partialSM(pA0, pA1, bp0 - 128, m_reg, alA);
        __syncthreads(); asm volatile("s_waitcnt vmcnt(0)" ::: "memory"); SWRITE(1, 1);
        RESC(alA); __syncthreads();
        SBAR(); qkt(pB0, pB1, K_lds + SHM_K, qr, r32, hi); SBAR();
        int hn = h, jbn = jb, qn = q, dn = -1;
        if (u + 1 < u1) { DECODE(u + 1, hn, jbn, qn, dn); }
        SBAR();
        finishSM(pA0, pA1, alA, l_reg, pa0, pa1, pa2, pa3); SBAR();
        pv_d0(o, vb0, pa0, pa1, pa2, pa3); partialSM(pB0, pB1, bp0 - 192, m_reg, alB);

        RESC(alB);
        finishSM(pB0, pB1, alB, l_reg, pa0, pa1, pa2, pa3); SBAR();
        pv_d0(o, vb0 + SHM_V, pa0, pa1, pa2, pa3);
        asm volatile("s_waitcnt vmcnt(0)" ::: "memory");
        if (!OWN) {
            if (hi == 0) { li_l[r32] = l_reg; if (dsti >= 0) LSE[dsti] = m_reg + __builtin_amdgcn_logf(l_reg); }
            asm volatile("s_waitcnt lgkmcnt(0)" ::: "memory");
#pragma unroll
            for (int r = 0; r < 16; ++r) { const int row = crow(r, hi); const float rl = __builtin_amdgcn_rcpf(li_l[row]); const int ds = dst_l[row];
                if (ds >= 0) { unsigned* pp = PART + (size_t)ds * 64 + r32; pp[0] = cvtpk(o[0][r] * rl, o[1][r] * rl); pp[32] = cvtpk(o[2][r] * rl, o[3][r] * rl); } }
        } else {
            if (hi == 0) { li_l[r32] = l_reg; al_l[r32] = m_reg; }
            asm volatile("s_waitcnt lgkmcnt(0)" ::: "memory");
#pragma unroll
            for (int hf = 0; hf < 2; ++hf) {
                float wo[8], w0[8], w1[8], w2[8];
                {   f32x4 ls[8];
#pragma unroll
                    for (int rr = 0; rr < 8; ++rr) { const int row = crow(hf * 8 + rr, hi); ls[rr] = *(const f32x4*)(LSE + ((size_t)(jb * BLK + wid * 32 + row) * NH + h) * 4); }
#pragma unroll
                    for (int rr = 0; rr < 8; ++rr) { const int row = crow(hf * 8 + rr, hi); const float lrow = li_l[row], lown = al_l[row] + __builtin_amdgcn_logf(lrow);
                        const float M = fmaxf(fmaxf(lown, ls[rr][0]), fmaxf(ls[rr][1], ls[rr][2]));
                        const float eo = __builtin_amdgcn_exp2f(lown - M), e0 = __builtin_amdgcn_exp2f(ls[rr][0] - M), e1 = __builtin_amdgcn_exp2f(ls[rr][1] - M), e2 = __builtin_amdgcn_exp2f(ls[rr][2] - M);
                        const float iw = __builtin_amdgcn_rcpf((eo + e0) + (e1 + e2));
                        wo[rr] = eo * iw * __builtin_amdgcn_rcpf(lrow); w0[rr] = e0 * iw; w1[rr] = e1 * iw; w2[rr] = e2 * iw; } }
#pragma unroll
                for (int g4 = 0; g4 < 2; ++g4) {
                    unsigned pu[4][3][2];
#pragma unroll
                    for (int r4 = 0; r4 < 4; ++r4) { const int rr = g4 * 4 + r4, row = crow(hf * 8 + rr, hi); const unsigned* pp = PART + ((size_t)(jb * BLK + wid * 32 + row) * NH + h) * 256 + r32;
                        pu[r4][0][0] = w0[rr] > 0.f ? pp[0] : 0u; pu[r4][0][1] = w0[rr] > 0.f ? pp[32] : 0u;
                        pu[r4][1][0] = w1[rr] > 0.f ? pp[64] : 0u; pu[r4][1][1] = w1[rr] > 0.f ? pp[96] : 0u;
                        pu[r4][2][0] = w2[rr] > 0.f ? pp[128] : 0u; pu[r4][2][1] = w2[rr] > 0.f ? pp[160] : 0u; }
#pragma unroll
                    for (int r4 = 0; r4 < 4; ++r4) { const int rr = g4 * 4 + r4, r = hf * 8 + rr, row = crow(r, hi);
                        float a0 = o[0][r] * wo[rr], a1 = o[1][r] * wo[rr], a2 = o[2][r] * wo[rr], a3 = o[3][r] * wo[rr];
                        a0 += w0[rr] * bflo(pu[r4][0][0]) + w1[rr] * bflo(pu[r4][1][0]) + w2[rr] * bflo(pu[r4][2][0]);
                        a1 += w0[rr] * bfhi(pu[r4][0][0]) + w1[rr] * bfhi(pu[r4][1][0]) + w2[rr] * bfhi(pu[r4][2][0]);
                        a2 += w0[rr] * bflo(pu[r4][0][1]) + w1[rr] * bflo(pu[r4][1][1]) + w2[rr] * bflo(pu[r4][2][1]);
                        a3 += w0[rr] * bfhi(pu[r4][0][1]) + w1[rr] * bfhi(pu[r4][1][1]) + w2[rr] * bfhi(pu[r4][2][1]);
                        bf16* op = AO + (size_t)(jb * BLK + wid * 32 + row) * DM + h * HD + r32;
                        op[0] = (bf16)(cvtpk(a0, a0) & 0xffffu); op[32] = (bf16)(cvtpk(a1, a1) & 0xffffu); op[64] = (bf16)(cvtpk(a2, a2) & 0xffffu); op[96] = (bf16)(cvtpk(a3, a3) & 0xffffu); }
                }
            }
        }
        __syncthreads();
        h = hn; jb = jbn; q = qn; dsti = dn;
    }
#undef DECODE
#undef KVPTR
#undef SLOAD
#undef QLOAD
#undef SWRITE
#undef SWAIT
#undef RESC
}
namespace at3 {
using namespace at;
constexpr int O_K = 0, O_V = 65536, O_BT = 131072, O_WS = O_BT + BIAS_LD * 2, O_PRE = O_WS + 8 * 384, O_CL = O_PRE + 516 * 4, O_WT = O_CL + 512 * 4, O_END = O_WT + 64;
static_assert(O_END <= RING_BYTES, "attention LDS map");
__device__ __forceinline__ void sm_tile(f32x16& p0, f32x16& p1, const LAS unsigned short* bp, float& m_reg, float& l_reg, f32x16 (&o)[4], bf16x8& pa0, bf16x8& pa1, bf16x8& pa2, bf16x8& pa3, LAS float* al_l, int r32, int hi) {
    constexpr float C = 0.088388347648318440f * 1.4426950408889634f;
#pragma unroll
    for (int r = 0; r < 16; ++r) p0[r] = fmaf(p0[r], C, __builtin_bit_cast(float, (unsigned)bp[59 - ((r & 3) + 8 * (r >> 2))] << 16));
#pragma unroll
    for (int r = 0; r < 16; ++r) p1[r] = fmaf(p1[r], C, __builtin_bit_cast(float, (unsigned)bp[27 - ((r & 3) + 8 * (r >> 2))] << 16));
    float pmax = p0[0];
#pragma unroll
    for (int r = 1; r < 16; ++r) pmax = fmaxf(pmax, p0[r]);
#pragma unroll
    for (int r = 0; r < 16; ++r) pmax = fmaxf(pmax, p1[r]);
    { auto rr = __builtin_amdgcn_permlane32_swap(__float_as_uint(pmax), __float_as_uint(pmax), false, false); pmax = fmaxf(__uint_as_float(rr[0]), __uint_as_float(rr[1])); }
    float mn = m_reg, alpha = 1.f;
    if (!__all(pmax <= m_reg + 8.0f)) { const bool up = pmax > m_reg + 8.0f;
        mn = up ? pmax : m_reg; alpha = up ? __builtin_amdgcn_exp2f(m_reg - mn) : 1.f; m_reg = mn; }
#pragma unroll
    for (int r = 0; r < 16; ++r) p0[r] = __builtin_amdgcn_exp2f(p0[r] - mn);
#pragma unroll
    for (int r = 0; r < 16; ++r) p1[r] = __builtin_amdgcn_exp2f(p1[r] - mn);
    float ps = 0;
#pragma unroll
    for (int r = 0; r < 16; ++r) ps += p0[r];
#pragma unroll
    for (int r = 0; r < 16; ++r) ps += p1[r];
    { auto rr = __builtin_amdgcn_permlane32_swap(__float_as_uint(ps), __float_as_uint(ps), false, false); ps = __uint_as_float(rr[0]) + __uint_as_float(rr[1]); }
    l_reg = l_reg * alpha + ps;
#define PK4(P, BASE, OUT) do { unsigned a0 = cvtpk(P[BASE + 0], P[BASE + 1]), a1 = cvtpk(P[BASE + 2], P[BASE + 3]);   \
    unsigned b0 = cvtpk(P[BASE + 4], P[BASE + 5]), b1 = cvtpk(P[BASE + 6], P[BASE + 7]);                              \
    auto r0 = __builtin_amdgcn_permlane32_swap(a0, b0, false, false); auto r1 = __builtin_amdgcn_permlane32_swap(a1, b1, false, false); \
    u32x4 w = {r0[0], r1[0], r0[1], r1[1]}; OUT = *reinterpret_cast<bf16x8*>(&w); } while (0)
    PK4(p0, 0, pa0); PK4(p0, 8, pa1); PK4(p1, 0, pa2); PK4(p1, 8, pa3);
#undef PK4
    if (__any(alpha < 1.f)) { if (hi == 0) al_l[r32] = alpha; asm volatile("s_waitcnt lgkmcnt(0)" ::: "memory");
#pragma unroll
        for (int d = 0; d < 4; ++d)
#pragma unroll
            for (int r = 0; r < 16; ++r) o[d][r] *= al_l[crow(r, hi)]; }
}
__device__ __forceinline__ void load_kv_block(const bf16* __restrict__ QKV, int h, int jb, LAS unsigned char* lds, int tid) {
    const bf16* Kp = QKV + (size_t)(jb * BLK) * LDK + DM + h * HD;
    bf16x8 kv[8], vv[8];
#pragma unroll
    for (int i = 0; i < 8; ++i) { const int p = tid + 512 * i, row = p >> 4, c16 = p & 15; kv[i] = *reinterpret_cast<const bf16x8*>(Kp + (size_t)row * LDK + c16 * 8); vv[i] = *reinterpret_cast<const bf16x8*>(Kp + DM + (size_t)row * LDK + c16 * 8); }
#pragma unroll
    for (int i = 0; i < 8; ++i) { const int p = tid + 512 * i, row = p >> 4, c16 = p & 15, t = row >> 6, rl = row & 63;
        *(LAS bf16x8*)(lds + O_K + t * 16384 + KSWZ(rl, c16 * 16)) = kv[i]; *(LAS bf16x8*)(lds + O_V + t * 16384 + v_st(rl, c16 * 8)) = vv[i]; }
}
}
template <bool OWN>
__device__ __forceinline__ void attn_phase3(const Args& A, Frame& F, int ja) {
    using namespace at3;
    int tid = F.wave * 64 + lane_id_v(); asm volatile("" : "+v"(tid));
    const int wid = __builtin_amdgcn_readfirstlane(tid >> 6), lane = tid & 63, r32 = lane & 31, hi = lane >> 5;
    const bf16* __restrict__ QKV = (const bf16*)(F.ws + WS_QKV);
    const unsigned* cnt = (const unsigned*)(F.ctl + CW_CNT + ja * 512); const unsigned* list = (const unsigned*)(F.ws + WS_LIST);
    unsigned* __restrict__ PART = (unsigned*)(F.ws + WS_HID); float* __restrict__ LSE = (float*)(F.ws + WS_LSE); bf16* __restrict__ AO = (bf16*)(F.ws + WS_AO);
    LAS unsigned char* lds = F.lds + RING_OFF;
    LAS float* li_l = (LAS float*)(lds + O_WS + wid * 384); LAS float* al_l = li_l + 32; LAS int* dst_l = (LAS int*)(li_l + 64);
    LAS unsigned short* btl = (LAS unsigned short*)(lds + O_BT);
    LAS unsigned* pre = (LAS unsigned*)(lds + O_PRE); LAS unsigned* cl = (LAS unsigned*)(lds + O_CL);
    const int vb0 = (int)(uintptr_t)(lds + O_V) + v_rd_base(lane);
    unsigned s0 = 0, s1 = 0;
    if (!OWN) {
        const unsigned n0 = __hip_atomic_load(cnt + tid, RLX_AGENT); cl[tid] = n0;
        unsigned v = (n0 + 31u) >> 5; const unsigned mine = v;
#pragma unroll
        for (int o = 1; o < 64; o <<= 1) { const unsigned t = __shfl_up(v, o); if (lane >= o) v += t; }
        LAS unsigned* wt = (LAS unsigned*)(lds + O_WT);
        if (lane == 63) wt[wid] = v;
        __syncthreads();
        unsigned base = 0;
        for (int w = 0; w < wid; ++w) base += wt[w];
        pre[tid] = base + v - mine;
        if (tid == NWAVES * 64 - 1) pre[512] = base + v;
        __syncthreads();
        const unsigned ST = pre[512];
        s0 = (unsigned)(((unsigned long long)F.bid * ST) / (unsigned)F.G); s1 = (unsigned)(((unsigned long long)(F.bid + 1) * ST) / (unsigned)F.G);
    } else { s0 = 0; s1 = (512 - F.bid + F.G - 1) / F.G; }
    int cur_h = -1;
    while (s0 < s1) {
        int h, jb; unsigned seg_end, gbase = 0; int n_g = 0, g = 0;
        if (!OWN) { int lo = 0, hi_ = 512; while (hi_ - lo > 1) { const int mid = (lo + hi_) >> 1; if (pre[mid] <= s0) lo = mid; else hi_ = mid; }
            g = lo; h = g >> 5; jb = g & 31; gbase = pre[g]; n_g = (int)cl[g]; const unsigned ge = pre[g + 1]; seg_end = ge < s1 ? ge : s1; }
        else { const int gu = F.bid + (int)s0 * F.G; h = gu & 15; jb = gu >> 4; seg_end = s0 + 1; }
        __syncthreads();
        if (h != cur_h) { const float* bsrc = (const float*)(F.ws + WS_BIAS) + h * BIAS_LD;
            {
                const int ln_ = tid & 63;
#pragma unroll
                for (int j = 0; j < 4; ++j) __builtin_amdgcn_global_load_lds((const unsigned*)(bsrc + (j * 8 + wid) * 256 + ln_ * 4), (LAS unsigned*)(lds + O_K + (j * 8 + wid) * 1024), 16, 0, 0);
                if (wid == 0) __builtin_amdgcn_global_load_lds((const unsigned*)(bsrc + 32 * 256 + ln_ * 4), (LAS unsigned*)(lds + O_K + 32 * 1024), 16, 0, 0);
                asm volatile("s_waitcnt vmcnt(0)" ::: "memory"); __syncthreads();
                for (int i = tid; i < BIAS_LD; i += NWAVES * 64) btl[i] = (unsigned short)f2bf(((const LAS float*)(lds + O_K))[i]);
                __syncthreads(); }
            cur_h = h; }
        load_kv_block(QKV, h, jb, lds, tid);
        __syncthreads();
        const unsigned st_first = OWN ? 0u : s0 + (unsigned)wid, st_step = 8u;
        for (unsigned st = st_first; OWN ? st < 1u : st < seg_end; st += st_step) {
            int q, dsti, nt;
            if (!OWN) { const int e = (int)(st - gbase) * 32 + r32; const unsigned ent = list[(size_t)g * 8192 + (e < n_g ? e : n_g - 1)];
                q = (int)(ent >> 2); dsti = e < n_g ? (q * NH + h) * 4 + (int)(ent & 3u) : -1; nt = 4; }
            else { const int sub = wid < 4 ? 7 - wid : wid - 4; q = jb * BLK + sub * 32 + r32; dsti = 0; nt = (sub >> 1) + 1; }
            bf16x8 qr[8];
            { const bf16* Qw = QKV + (size_t)q * LDK + h * HD + hi * 8;
#pragma unroll
              for (int d0 = 0; d0 < 8; ++d0) qr[d0] = *reinterpret_cast<const bf16x8*>(Qw + d0 * 16); }
            if (!OWN) { if (hi == 0) dst_l[r32] = dsti; }
            const LAS unsigned short* bp0 = btl + (q - jb * BLK - 4 * hi + 256 - 59);
            float m_reg = -1e30f, l_reg = 0; f32x16 o[4] = {};
#pragma unroll 1
            for (int t = 0; t < nt; ++t) {
                f32x16 p0, p1; bf16x8 pa0, pa1, pa2, pa3;
                qkt(p0, p1, lds + O_K + t * 16384, qr, r32, hi);
                sm_tile(p0, p1, bp0 - 64 * t, m_reg, l_reg, o, pa0, pa1, pa2, pa3, al_l, r32, hi);
                pv_d0(o, vb0 + t * 16384, pa0, pa1, pa2, pa3);
            }
            if (!OWN) {
                if (hi == 0) { li_l[r32] = l_reg; if (dsti >= 0) LSE[dsti] = m_reg + __builtin_amdgcn_logf(l_reg); }
                asm volatile("s_waitcnt lgkmcnt(0)" ::: "memory");
#pragma unroll
                for (int r = 0; r < 16; ++r) { const int row = crow(r, hi); const float rl = __builtin_amdgcn_rcpf(li_l[row]); const int ds = dst_l[row];
                    if (ds >= 0) { unsigned* pp = PART + (size_t)ds * 64 + r32; pp[0] = cvtpk(o[0][r] * rl, o[1][r] * rl); pp[32] = cvtpk(o[2][r] * rl, o[3][r] * rl); } }
            } else {
                const int sub = wid < 4 ? 7 - wid : wid - 4, rowb = jb * BLK + sub * 32;
                if (hi == 0) { li_l[r32] = l_reg; al_l[r32] = m_reg; }
                asm volatile("s_waitcnt lgkmcnt(0)" ::: "memory");
#pragma unroll
                for (int hf = 0; hf < 2; ++hf) {
                    f32x4 ls[8]; unsigned pu[8][6];
#pragma unroll
                    for (int rr = 0; rr < 8; ++rr) { const int row = crow(hf * 8 + rr, hi); const size_t e = (size_t)(rowb + row) * NH + h;
                        ls[rr] = *(const f32x4*)(LSE + e * 4); const unsigned* pp = PART + e * 256 + r32;
                        pu[rr][0] = pp[0]; pu[rr][1] = pp[32]; pu[rr][2] = pp[64]; pu[rr][3] = pp[96]; pu[rr][4] = pp[128]; pu[rr][5] = pp[160]; }
#pragma unroll
                    for (int rr = 0; rr < 8; ++rr) { const int r = hf * 8 + rr, row = crow(r, hi); const float lrow = li_l[row], lown = al_l[row] + __builtin_amdgcn_logf(lrow);
                        const float M = fmaxf(fmaxf(lown, ls[rr][0]), fmaxf(ls[rr][1], ls[rr][2]));
                        const float eo = __builtin_amdgcn_exp2f(lown - M), e0 = __builtin_amdgcn_exp2f(ls[rr][0] - M), e1 = __builtin_amdgcn_exp2f(ls[rr][1] - M), e2 = __builtin_amdgcn_exp2f(ls[rr][2] - M);
                        const float iw = __builtin_amdgcn_rcpf((eo + e0) + (e1 + e2));
                        const float wo = eo * iw * __builtin_amdgcn_rcpf(lrow), w0 = e0 * iw, w1 = e1 * iw, w2 = e2 * iw;
                        const unsigned q00 = w0 > 0.f ? pu[rr][0] : 0u, q01 = w0 > 0.f ? pu[rr][1] : 0u, q10 = w1 > 0.f ? pu[rr][2] : 0u, q11 = w1 > 0.f ? pu[rr][3] : 0u, q20 = w2 > 0.f ? pu[rr][4] : 0u, q21 = w2 > 0.f ? pu[rr][5] : 0u;
                        const float a0 = o[0][r] * wo + (w0 * bflo(q00) + w1 * bflo(q10) + w2 * bflo(q20));
                        const float a1 = o[1][r] * wo + (w0 * bfhi(q00) + w1 * bfhi(q10) + w2 * bfhi(q20));
                        const float a2 = o[2][r] * wo + (w0 * bflo(q01) + w1 * bflo(q11) + w2 * bflo(q21));
                        const float a3 = o[3][r] * wo + (w0 * bfhi(q01) + w1 * bfhi(q11) + w2 * bfhi(q21));
                        bf16* op = AO + (size_t)(rowb + row) * DM + h * HD + r32;
                        op[0] = (bf16)(cvtpk(a0, a0) & 0xffffu); op[32] = (bf16)(cvtpk(a1, a1) & 0xffffu); op[64] = (bf16)(cvtpk(a2, a2) & 0xffffu); op[96] = (bf16)(cvtpk(a3, a3) & 0xffffu); }
                }
            }
        }
        s0 = seg_end;
    }
}
#define TOP3_INS2(x_, j_) do { const float x__ = (x_); const int j__ = (j_); \
    const bool b0 = x__ > v0 || (x__ == v0 && (unsigned)j__ < (unsigned)i0), b1 = x__ > v1 || (x__ == v1 && (unsigned)j__ < (unsigned)i1), b2 = x__ > v2 || (x__ == v2 && (unsigned)j__ < (unsigned)i2); \
    v2 = b1 ? v1 : (b2 ? x__ : v2); i2 = b1 ? i1 : (b2 ? j__ : i2); v1 = b0 ? v0 : (b1 ? x__ : v1); i1 = b0 ? i0 : (b1 ? j__ : i1); v0 = b0 ? x__ : v0; i0 = b0 ? j__ : i0; } while (0)
__device__ __forceinline__ void phase_gate2(const Args& A, Frame& F, int ja) {
    using namespace at;
    int tid = F.wave * 64 + lane_id_v(); asm volatile("" : "+v"(tid));
    const int lane = tid & 63, wave = tid >> 6, r32 = lane & 31, hi = lane >> 5;
    const bf16* QKV = (const bf16*)(F.ws + WS_QKV); const float* KMP = (const float*)(F.ws + WS_KMP);
    unsigned* cnt = (unsigned*)(F.ctl + CW_CNT + ja * 512); unsigned* list = (unsigned*)(F.ws + WS_LIST); float* LSE = (float*)(F.ws + WS_LSE);
    LAS unsigned* lc = (LAS unsigned*)(F.lds + RING_OFF);
    for (int u = F.bid; u < 512; u += F.G) {
        const int h = u & 15, c = u >> 4;
        __syncthreads();
        if (tid < 64) lc[tid] = 0u;
        __syncthreads();
        const int q = c * 256 + wave * 32 + r32;
        int i0 = -1, i1 = -1, i2 = -1;
        if (c > 0) {
            bf16x8 kh[8], kl[8], qr[8];
            const bf16* Qw = QKV + (size_t)q * NQKV + h * HD + hi * 8;
#pragma unroll
            for (int d0 = 0; d0 < 8; ++d0) qr[d0] = *reinterpret_cast<const bf16x8*>(Qw + d0 * 16);
#pragma unroll
            for (int d0 = 0; d0 < 8; ++d0) { const float* p0 = KMP + (size_t)r32 * 2048 + h * HD + d0 * 16 + hi * 8; const float* p1 = p0 + (size_t)32 * 2048;
                const f32x4 a0 = *(const f32x4*)p0 + *(const f32x4*)p1, a1 = *(const f32x4*)(p0 + 4) + *(const f32x4*)(p1 + 4);
                float v[8] = {a0[0], a0[1], a0[2], a0[3], a1[0], a1[1], a1[2], a1[3]}; unsigned hh[4], ll[4];
#pragma unroll
                for (int e = 0; e < 4; ++e) { const float x0 = v[2 * e] * (1.0f / 256.0f), x1 = v[2 * e + 1] * (1.0f / 256.0f); const unsigned ph = cvtpk(x0, x1); hh[e] = ph;
                    ll[e] = cvtpk(x0 - bflo(ph), x1 - bfhi(ph)); }
                u32x4 wh = {hh[0], hh[1], hh[2], hh[3]}, wl_ = {ll[0], ll[1], ll[2], ll[3]};
                kh[d0] = *reinterpret_cast<bf16x8*>(&wh); kl[d0] = *reinterpret_cast<bf16x8*>(&wl_); }
            f32x16 Gt = {};
#pragma unroll
            for (int d0 = 0; d0 < 8; ++d0) { Gt = __builtin_amdgcn_mfma_f32_32x32x16_bf16(kh[d0], qr[d0], Gt, 0, 0, 0); Gt = __builtin_amdgcn_mfma_f32_32x32x16_bf16(kl[d0], qr[d0], Gt, 0, 0, 0); }
            float v0 = -INFINITY, v1 = -INFINITY, v2 = -INFINITY;
#pragma unroll
            for (int r = 0; r < 16; ++r) { const int jb = crow(r, hi); if (jb < c) TOP3_INS2(Gt[r], jb); }
            const float pv0 = __shfl_xor(v0, 32), pv1 = __shfl_xor(v1, 32), pv2 = __shfl_xor(v2, 32);
            const int pi0 = __shfl_xor(i0, 32), pi1 = __shfl_xor(i1, 32), pi2 = __shfl_xor(i2, 32);
            if (pi0 >= 0) TOP3_INS2(pv0, pi0);
            if (pi1 >= 0) TOP3_INS2(pv1, pi1);
            if (pi2 >= 0) TOP3_INS2(pv2, pi2);
        }
        unsigned lp0 = 0, lp1 = 0, lp2 = 0;
        if (hi == 0) { if (i0 >= 0) lp0 = atomicAdd((unsigned*)(lc + i0), 1u); if (i1 >= 0) lp1 = atomicAdd((unsigned*)(lc + i1), 1u); if (i2 >= 0) lp2 = atomicAdd((unsigned*)(lc + i2), 1u); }
        __syncthreads();
        if (tid < 32) { const unsigned n = lc[tid]; lc[32 + tid] = n ? atomicAdd(&cnt[h * 32 + tid], n) : 0u; }
        __syncthreads();
        if (hi == 0) {
#define EMIT_PICK(k_, sj_, lp_) do { if ((sj_) >= 0) list[(size_t)(h * 32 + (sj_)) * 8192 + lc[32 + (sj_)] + (lp_)] = ((unsigned)q << 2) | (unsigned)(k_); \
                else LSE[((size_t)q * NH + h) * 4 + (k_)] = -INFINITY; } while (0)
            EMIT_PICK(0, i0, lp0); EMIT_PICK(1, i1, lp1); EMIT_PICK(2, i2, lp2);
#undef EMIT_PICK
        }
    }
}
__device__ __forceinline__ void phase_combine(const Args& A, Frame& F) {
    int tid = F.wave * 64 + lane_id_v(); asm volatile("" : "+v"(tid)); const int lane = tid & 63, wave = __builtin_amdgcn_readfirstlane(tid >> 6); (void)lane; (void)wave;
    const unsigned* PART = (const unsigned*)(F.ws + WS_HID); const float* LSE = (const float*)(F.ws + WS_LSE); bf16* AO = (bf16*)(F.ws + WS_AO);
    const int gw = F.bid * NWAVES + wave, NGW = F.G * NWAVES, l = lane;
    for (int e = gw; e < S * NH; e += NGW) {
        const f32x4 ls = *(const f32x4*)(LSE + (size_t)e * 4);
        const float M = fmaxf(fmaxf(ls[0], ls[1]), fmaxf(ls[2], ls[3]));
        float o0 = 0.f, o1 = 0.f, W = 0.f;
#pragma unroll
        for (int k = 0; k < 4; ++k) { const float w = __builtin_amdgcn_exp2f(ls[k] - M);
            if (w > 0.f) { const unsigned u = PART[((size_t)e * 4 + k) * 64 + l]; o0 += w * bflo(u); o1 += w * bfhi(u); W += w; } }
        const float inv = 1.0f / W; const int q = e >> 4, h = e & 15, c0 = 64 * (l >> 5) + (l & 31);
        bf16* op = AO + (size_t)q * DM + h * HD;
        op[c0] = (bf16)f2bf(o0 * inv); op[c0 + 32] = (bf16)f2bf(o1 * inv);
    }
}
__device__ __forceinline__ float sigmoidf_(float x) { return 1.0f / (1.0f + __expf(-x)); }
__device__ __forceinline__ void phase_rec_ab(const Args& A, Frame& F, int jr) {
    int tid = F.wave * 64 + lane_id_v(); asm volatile("" : "+v"(tid)); const int lane = tid & 63, wave = __builtin_amdgcn_readfirstlane(tid >> 6); (void)lane; (void)wave;
    const bf16* XR = (const bf16*)(F.ws + WS_QKV);
    const float* cw = A.in[8] + (size_t)jr * 4 * DM; const float* cb = A.in[9] + (size_t)jr * DM;
    const float* wrg = A.in[10] + (size_t)jr * 16 * 128 * 128; const float* brg = A.in[11] + (size_t)jr * DM;
    const float* wig = A.in[12] + (size_t)jr * 16 * 128 * 128; const float* big = A.in[13] + (size_t)jr * DM; const float* lam = A.in[14] + (size_t)jr * DM;
    float* SA = (float*)(F.ws + WS_HID); float* SB = SA + (size_t)S * DM;
    LAS float* xc = (LAS float*)(F.lds + RING_OFF);
    for (int item = F.bid; item < 256 * 16; item += F.G) {
        const int tt = item >> 4, n = item & 15;
        for (int i = tid; i < 4096; i += NWAVES * 64) { const int r = i >> 7, cc = i & 127, t = tt * 32 + r, c = n * 128 + cc;
            float a = cb[c];
#pragma unroll
            for (int jj = 0; jj < 4; ++jj) { const int ts = t - 3 + jj; if (ts >= 0) a += bf2f(XR[(size_t)ts * DM + c]) * cw[jj * DM + c]; }
            xc[i] = a; }
        __syncthreads();
        const int cc = tid & 127, rg = tid >> 7, c = n * 128 + cc;
        float ar[8], ai[8];
#pragma unroll
        for (int i = 0; i < 8; ++i) { ar[i] = 0.f; ai[i] = 0.f; }
        const float* wr_ = wrg + (size_t)n * 128 * 128 + cc; const float* wi_ = wig + (size_t)n * 128 * 128 + cc;
        for (int k = 0; k < 128; ++k) { const float a = wr_[k * 128], b = wi_[k * 128];
#pragma unroll
            for (int i = 0; i < 8; ++i) { const float x = xc[(rg + 4 * i) * 128 + k]; ar[i] += x * a; ai[i] += x * b; } }
        const float lm = lam[c]; const float lsg = (fminf(lm, 0.f) - log1pf(__expf(-fabsf(lm)))) * 8.0f;
        const float b_r = brg[c], b_i = big[c];
#pragma unroll
        for (int i = 0; i < 8; ++i) { const int r = rg + 4 * i; const size_t o = (size_t)(tt * 32 + r) * DM + c;
            const float rr = sigmoidf_(ar[i] + b_r), ii = sigmoidf_(ai[i] + b_i), la = rr * lsg;
            SA[o] = __expf(la); SB[o] = sqrtf(-expm1f(2.0f * la)) * (ii * xc[r * 128 + cc]); }
        __syncthreads();
    }
}
__device__ __forceinline__ void phase_rec_ab2(const Args& A, Frame& F, int jr) {
    using namespace at;
    int tid = F.wave * 64 + lane_id_v(); asm volatile("" : "+v"(tid));
    const int lane = tid & 63, wave = tid >> 6, r32 = lane & 31, hi = lane >> 5;
    const bf16* XR = (const bf16*)(F.ws + WS_QKV);
    const float* cw = A.in[8] + (size_t)jr * 4 * DM; const float* cb = A.in[9] + (size_t)jr * DM;
    const float* brg = A.in[11] + (size_t)jr * DM; const float* big = A.in[13] + (size_t)jr * DM; const float* lam = A.in[14] + (size_t)jr * DM;
    const bf16* WG = (const bf16*)(F.ws + WS_WG) + (size_t)jr * 2 * 16 * 128 * 128;
    unsigned* SAB = (unsigned*)(F.ws + WS_HID);
    LAS unsigned char* xcl = F.lds + RING_OFF;
    LAS unsigned char* wl = F.lds + RING_OFF + 65536;
    LAS f32x2* comp = (LAS f32x2*)(F.lds + RING_OFF + 131072);
    int cur_n = -1;
    for (int u = F.bid; u < 512; u += F.G) {
        const int n = u & 15, tt = u >> 4;
        __syncthreads();
        if (n != cur_n) { cur_n = n;
#pragma unroll
            for (int i = 0; i < 8; ++i) { const int p = tid + i * 512, g = p >> 11, ch = (p >> 4) & 127, kc = p & 15;
                *(LAS v4u*)(wl + g * 32768 + KSWZ(ch, kc * 16)) = *(const v4u*)(WG + ((size_t)(g * 16 + n) * 128 + ch) * 128 + kc * 8); } }
        {
            const int chg = tid & 15, c0 = n * 128 + chg * 8;
            float w[4][8], b8[8];
#pragma unroll
            for (int jj = 0; jj < 4; ++jj) { const f32x4 x0 = *(const f32x4*)(cw + jj * DM + c0), x1 = *(const f32x4*)(cw + jj * DM + c0 + 4);
                w[jj][0] = x0[0]; w[jj][1] = x0[1]; w[jj][2] = x0[2]; w[jj][3] = x0[3]; w[jj][4] = x1[0]; w[jj][5] = x1[1]; w[jj][6] = x1[2]; w[jj][7] = x1[3]; }
            { const f32x4 x0 = *(const f32x4*)(cb + c0), x1 = *(const f32x4*)(cb + c0 + 4); b8[0] = x0[0]; b8[1] = x0[1]; b8[2] = x0[2]; b8[3] = x0[3]; b8[4] = x1[0]; b8[5] = x1[1]; b8[6] = x1[2]; b8[7] = x1[3]; }
#pragma unroll 4
            for (int ps = 0; ps < 8; ++ps) { const int rl = (tid >> 4) + 32 * ps, t = tt * 256 + rl;
                float acc[8];
#pragma unroll
                for (int e = 0; e < 8; ++e) acc[e] = b8[e];
#pragma unroll
                for (int jj = 0; jj < 4; ++jj) { const int ts = t - 3 + jj;
                    if (ts >= 0) { const v4u xv = *(const v4u*)(XR + (size_t)ts * DM + c0);
                        acc[0] += bflo(xv.x) * w[jj][0]; acc[1] += bfhi(xv.x) * w[jj][1]; acc[2] += bflo(xv.y) * w[jj][2]; acc[3] += bfhi(xv.y) * w[jj][3];
                        acc[4] += bflo(xv.z) * w[jj][4]; acc[5] += bfhi(xv.z) * w[jj][5]; acc[6] += bflo(xv.w) * w[jj][6]; acc[7] += bfhi(xv.w) * w[jj][7]; } }
                v4u o; o.x = cvtpk(acc[0], acc[1]); o.y = cvtpk(acc[2], acc[3]); o.z = cvtpk(acc[4], acc[5]); o.w = cvtpk(acc[6], acc[7]);
                *(LAS v4u*)(xcl + KSWZ(rl, chg * 16)) = o; }
        }
        __syncthreads();
        bf16x8 xf[8];
#pragma unroll
        for (int d0 = 0; d0 < 8; ++d0) xf[d0] = *(const LAS bf16x8*)(xcl + KSWZ(wave * 32 + r32, (d0 * 16 + hi * 8) * 2));
#pragma unroll 1
        for (int ct = 0; ct < 4; ++ct) {
            f32x16 aR = {}, aI = {};
#pragma unroll
            for (int d0 = 0; d0 < 8; ++d0) { const int cbo = (d0 * 16 + hi * 8) * 2;
                const bf16x8 wr_ = *(const LAS bf16x8*)(wl + KSWZ(ct * 32 + r32, cbo)), wi_ = *(const LAS bf16x8*)(wl + 32768 + KSWZ(ct * 32 + r32, cbo));
                aR = __builtin_amdgcn_mfma_f32_32x32x16_bf16(xf[d0], wr_, aR, 0, 0, 0);
                aI = __builtin_amdgcn_mfma_f32_32x32x16_bf16(xf[d0], wi_, aI, 0, 0, 0); }
            const int chl = ct * 32 + r32, ch = n * 128 + chl;
            const float lm = lam[ch], b_r = brg[ch], b_i = big[ch];
            const float lsg2 = (fminf(lm, 0.f) - log1pf(__expf(-fabsf(lm)))) * (8.0f * 1.4426950408889634f);
            float sA[4], sH[4];
#pragma unroll
            for (int r = 0; r < 16; ++r) { const int tl = wave * 32 + crow(r, hi);
                const float xcv = bf2f(*(const LAS unsigned short*)(xcl + KSWZ(tl, chl * 2)));
                const float rr = __builtin_amdgcn_rcpf(1.0f + __builtin_amdgcn_exp2f(-1.4426950408889634f * (aR[r] + b_r)));
                const float ii = __builtin_amdgcn_rcpf(1.0f + __builtin_amdgcn_exp2f(-1.4426950408889634f * (aI[r] + b_i)));
                const float la2 = rr * lsg2;
                const float av = __builtin_amdgcn_exp2f(la2);
                const float x2 = la2 * (2.0f * 0.6931471805599453f);
                const float ser = -x2 * (1.0f + x2 * (0.5f + x2 * (0.16666667f + x2 * 0.041666668f)));
                const float om = x2 > -0.1f ? ser : 1.0f - av * av;
                const size_t o = (size_t)(tt * 256 + tl) * DM + ch;
                const float bv = __builtin_amdgcn_sqrtf(om) * (ii * xcv);
                SAB[o] = cvtpk(la2, bv);
                const int sg = r >> 2; if ((r & 3) == 0) { sA[sg] = av; sH[sg] = bv; } else { sH[sg] = av * sH[sg] + bv; sA[sg] *= av; } }
            float cA = 1.f, cH = 0.f;
#pragma unroll
            for (int sg = 0; sg < 4; ++sg) { const float pA = __shfl_xor(sA[sg], 32), pH = __shfl_xor(sH[sg], 32);
                const float fA = hi ? pA : sA[sg], fH = hi ? pH : sH[sg], gA = hi ? sA[sg] : pA, gH = hi ? sH[sg] : pH;
                cH = fA * cH + fH; cA *= fA; cH = gA * cH + gH; cA *= gA; }
            if (hi == 0) comp[wave * 128 + chl] = (f32x2){cA, cH};
        }
        __syncthreads();
        { const int k = tid >> 7, chl = tid & 127; const f32x2 c0 = comp[(2 * k) * 128 + chl], c1 = comp[(2 * k + 1) * 128 + chl];
          float* CA = (float*)(F.ws + WS_CARRY); float* CH = CA + 128 * DM; const size_t o = (size_t)(tt * 4 + k) * DM + n * 128 + chl;
          CA[o] = c0.x * c1.x; CH[o] = c1.x * c0.y + c1.y; }
    }
}
__device__ __forceinline__ void phase_rec_tot(const Args& A, Frame& F) {
    int tid = F.wave * 64 + lane_id_v(); asm volatile("" : "+v"(tid)); const int lane = tid & 63, wave = __builtin_amdgcn_readfirstlane(tid >> 6); (void)lane; (void)wave;
    const float* SA = (const float*)(F.ws + WS_HID); const float* SB = SA + (size_t)S * DM; float* CA = (float*)(F.ws + WS_CARRY); float* CH = CA + 128 * DM;
    for (int i = F.bid * (NWAVES * 64) + tid; i < 128 * 1024; i += F.G * NWAVES * 64) { const int ch = i >> 10, c = (i & 1023) * 2;
        f32x2 A = (f32x2){1.f, 1.f}, H = (f32x2){0.f, 0.f};
#pragma unroll 8
        for (int r = 0; r < 64; ++r) { const size_t o = (size_t)(ch * 64 + r) * DM + c; const f32x2 a = *(const f32x2*)(SA + o), b = *(const f32x2*)(SB + o); H = a * H + b; A = A * a; }
        *(f32x2*)(CA + ch * DM + c) = A; *(f32x2*)(CH + ch * DM + c) = H; }
}
__device__ __forceinline__ void phase_rec_scan(const Args& A, Frame& F) {
    int tid = F.wave * 64 + lane_id_v(); asm volatile("" : "+v"(tid));
    const unsigned* SAB = (const unsigned*)(F.ws + WS_HID); const float* CA = (const float*)(F.ws + WS_CARRY); const float* CH = CA + 128 * DM;
    const bf16* GG = (const bf16*)(F.ws + WS_QKV + 32 * MiB); bf16* AO = (bf16*)(F.ws + WS_AO);
    for (int i = F.bid * (NWAVES * 64) + tid; i < 128 * 1024; i += F.G * NWAVES * 64) { const int ch = i >> 10, c = (i & 1023) * 2;
        f32x2 H = (f32x2){0.f, 0.f};
        int k = 0;
        for (; k + 16 <= ch; k += 16) { f32x2 a[16], b[16];
#pragma unroll
            for (int j = 0; j < 16; ++j) { a[j] = *(const f32x2*)(CA + (k + j) * DM + c); b[j] = *(const f32x2*)(CH + (k + j) * DM + c); }
#pragma unroll
            for (int j = 0; j < 16; ++j) H = a[j] * H + b[j]; }
        if (k + 8 <= ch) { f32x2 a[8], b[8];
#pragma unroll
            for (int j = 0; j < 8; ++j) { a[j] = *(const f32x2*)(CA + (k + j) * DM + c); b[j] = *(const f32x2*)(CH + (k + j) * DM + c); }
#pragma unroll
            for (int j = 0; j < 8; ++j) H = a[j] * H + b[j];
            k += 8; }
        for (; k < ch; ++k) { const f32x2 a = *(const f32x2*)(CA + k * DM + c), b = *(const f32x2*)(CH + k * DM + c); H = a * H + b; }
#pragma unroll 1
        for (int r0 = 0; r0 < 64; r0 += 32) { v2u x[32]; unsigned g[32];
#pragma unroll
            for (int j = 0; j < 32; ++j) { const size_t o = (size_t)(ch * 64 + r0 + j) * DM + c; x[j] = __builtin_nontemporal_load((const v2u*)(SAB + o)); g[j] = *(const unsigned*)(GG + o); }
#pragma unroll
            for (int j = 0; j < 32; ++j) { const size_t o = (size_t)(ch * 64 + r0 + j) * DM + c;
                const f32x2 a = (f32x2){__builtin_amdgcn_exp2f(bflo(x[j].x)), __builtin_amdgcn_exp2f(bflo(x[j].y))}, b = (f32x2){bfhi(x[j].x), bfhi(x[j].y)};
                H = a * H + b; *(unsigned*)(AO + o) = pk2(H.x * bflo(g[j]), H.y * bfhi(g[j])); } }
    }
}
__device__ __forceinline__ int dq_layer(int li) {
    int l = 0, seen = -1;
#pragma unroll
    for (int b = 0; b < 4; ++b) if ((DQ_MASK >> b) & 1) { ++seen; if (seen == li) l = b; }
    return l;
}
__device__ __forceinline__ void wq_rows(const Args& A, Frame& F) {
    int tid = F.wave * 64 + lane_id_v(); asm volatile("" : "+v"(tid)); const int lane = tid & 63, wave = __builtin_amdgcn_readfirstlane(tid >> 6);
    const int gw = F.bid * NWAVES + wave, NGW = F.G * NWAVES;
    float* SWb = (float*)(F.ws + WS_SW);
    constexpr int NL = ((DQ_MASK >> 0) & 1) + ((DQ_MASK >> 1) & 1) + ((DQ_MASK >> 2) & 1) + ((DQ_MASK >> 3) & 1);
    for (int r0 = gw; r0 < NL * DM; r0 += 2 * NGW) {
        v4u x[2][16];
#pragma unroll
        for (int h = 0; h < 2; ++h) { const int rr = r0 + h * NGW < NL * DM ? r0 + h * NGW : r0; const int li = rr / DM, n = rr - li * DM, l = dq_layer(li);
            const bf16* src = (const bf16*)(F.ws + WS_W2) + (size_t)l * DM * FF + (size_t)n * FF;
#pragma unroll
            for (int j = 0; j < 16; ++j) x[h][j] = ((const GAS v4u*)src + lane)[64 * j]; }
#pragma unroll
        for (int h = 0; h < 2; ++h) { const int rr = r0 + h * NGW; if (rr >= NL * DM) break; const int li = rr / DM, n = rr - li * DM, l = dq_layer(li);
            unsigned char* dst = F.ws + WS_W1 + WS_W2Q_OFF * MiB + (size_t)l * DM * FF + (size_t)n * FF;
            float am = 0.f;
#pragma unroll
            for (int j = 0; j < 16; ++j)
#pragma unroll
                for (int e = 0; e < 4; ++e) am = fmaxf(am, fmaxf(fabsf(bflo(x[h][j][e])), fabsf(bfhi(x[h][j][e]))));
            am = wave_max(am);
            const float inv = am > 1e-30f ? 127.0f / am : 0.f; float cs = 0.f;
#pragma unroll
            for (int j = 0; j < 16; ++j) { float r[8];
#pragma unroll
                for (int e = 0; e < 4; ++e) { r[2 * e] = __builtin_rintf(bflo(x[h][j][e]) * inv); r[2 * e + 1] = __builtin_rintf(bfhi(x[h][j][e]) * inv); cs += r[2 * e] + r[2 * e + 1]; }
                v2u o; o.x = pack_i8x4(r[0], r[1], r[2], r[3]); o.y = pack_i8x4(r[4], r[5], r[6], r[7]);
                ((GAS v2u*)dst + lane)[64 * j] = o; }
            cs = wave_sum(cs);
            if (lane == 0) { SWb[SW_T2 + l * DM + n] = am * (1.0f / 127.0f); SWb[SW_CS2 + l * DM + n] = cs; } }
    }
    for (int r0 = gw; r0 < NL * FF; r0 += 4 * NGW) {
        v4u a[4], b2[4]; float stp[4];
#pragma unroll
        for (int h = 0; h < 4; ++h) { const int rr = r0 + h * NGW < NL * FF ? r0 + h * NGW : r0; const int li = rr / FF, n = rr - li * FF, l = dq_layer(li);
            const unsigned char* src = F.ws + WS_W1 + (size_t)l * FF * DM + (size_t)n * DM;
            a[h] = ((const GAS v4u*)src + lane)[0]; b2[h] = ((const GAS v4u*)src + lane)[64]; stp[h] = SWb[SW_W1 + l * FF + n]; }
#pragma unroll
        for (int h = 0; h < 4; ++h) { const int rr = r0 + h * NGW; if (rr >= NL * FF) break; const int li = rr / FF, n = rr - li * FF, l = dq_layer(li);
            int acc = 0;
#pragma unroll
            for (int e = 0; e < 4; ++e) { const int w0 = (int)a[h][e], w1 = (int)b2[h][e];
#pragma unroll
                for (int sh = 0; sh < 4; ++sh) { const int q0 = (w0 << (24 - 8 * sh)) >> 24, q1 = (w1 << (24 - 8 * sh)) >> 24; acc += q0 * q0 + q1 * q1; } }
            const float tot = wave_sum((float)acc);
            if (lane == 0) SWb[SW_SS + l * FF + n] = tot * stp[h] * stp[h]; }
    }
}
__device__ __forceinline__ void hidden_step(Frame& F, int l) {
    if (F.bid == 0) { float* SWb = (float*)(F.ws + WS_SW); int tid = F.wave * 64 + lane_id_v(); asm volatile("" : "+v"(tid)); const int lane = tid & 63;
        float v[16];
#pragma unroll
        for (int j = 0; j < 16; ++j) v[j] = SWb[SW_SS + l * FF + tid + 512 * j];
        float s = 0.f;
#pragma unroll
        for (int j = 0; j < 16; ++j) s += v[j];
        s = wave_sum(s);
        LAS float* red = (LAS float*)(F.lds + RING_OFF);
        if (lane == 0) red[F.wave] = s;
        __syncthreads();
        if (tid == 0) { float t = 0.f;
#pragma unroll
            for (int w = 0; w < 8; ++w) t += red[w];
            const float C = 21.16f * t * (1.0f / 8192.0f);
            SWb[SW_CL + 2 * l] = 254.0f / C; SWb[SW_CL + 2 * l + 1] = C * (1.0f / 254.0f); }
        __syncthreads(); }
}
__device__ __forceinline__ void phase_quant(const Args& A, Frame& F, int need_q) {
    int tid = F.wave * 64 + lane_id_v(); asm volatile("" : "+v"(tid)); const int lane = tid & 63, wave = __builtin_amdgcn_readfirstlane(tid >> 6);
    const bf16* XB = (const bf16*)(F.ws + WS_XB); unsigned char* XQ = F.ws + WS_XQ; float* frow = (float*)(F.ws + WS_FROW);
    const int nk = pass_nrows(F, wave);
    for (int k0 = 0; k0 < nk; k0 += 4) {
        v4u x[4][4];
#pragma unroll
        for (int r = 0; r < 4; ++r) { const int m = pass_row(F, wave, k0 + r < nk ? k0 + r : k0);
#pragma unroll
            for (int j = 0; j < 4; ++j) x[r][j] = ((const GAS v4u*)(XB + (size_t)m * DM) + lane)[64 * j]; }
#pragma unroll
        for (int r = 0; r < 4; ++r) { const int m = k0 + r < nk ? pass_row(F, wave, k0 + r) : S; float s = 0.f, am = 0.f;
#pragma unroll
            for (int j = 0; j < 4; ++j) {
#pragma unroll
                for (int e = 0; e < 4; ++e) { const float a0 = bflo(x[r][j][e]), a1 = bfhi(x[r][j][e]); s += a0 * a0 + a1 * a1; am = fmaxf(am, fmaxf(fabsf(a0), fabsf(a1))); } }
            s = wave_sum(s); am = wave_max(am);
            const float inv = am > 1e-30f ? 127.0f / am : 0.f;
            if (m < S) {
                if (need_q) {
#pragma unroll
                for (int j = 0; j < 4; ++j) { v2u o; o.x = pack_i8x4(bflo(x[r][j].x) * inv, bfhi(x[r][j].x) * inv, bflo(x[r][j].y) * inv, bfhi(x[r][j].y) * inv);
                    o.y = pack_i8x4(bflo(x[r][j].z) * inv, bfhi(x[r][j].z) * inv, bflo(x[r][j].w) * inv, bfhi(x[r][j].w) * inv);
                    ((GAS v2u*)(XQ + (size_t)m * DM) + lane)[64 * j] = o; } }
                if (lane == 0) { const float rstd = __builtin_amdgcn_rsqf(s * (1.0f / 2048.0f) + 1e-6f); frow[m] = am * (1.0f / 127.0f) * rstd; ((float*)(F.ws + WS_RSTD))[m] = rstd; } } }
    }
}
__device__ __forceinline__ void phase_final(const Args& A, Frame& F) {
    int tid = F.wave * 64 + lane_id_v(); asm volatile("" : "+v"(tid)); const int lane = tid & 63, wave = __builtin_amdgcn_readfirstlane(tid >> 6);
    const bf16* XB = (const bf16*)(F.ws + WS_XB); const float* gf = A.in[4];
    const int nk = pass_nrows(F, wave);
    f32x4 g0[4], g1[4];
#pragma unroll
    for (int j = 0; j < 4; ++j) { g0[j] = *(const f32x4*)(gf + j * 512 + lane * 8); g1[j] = *(const f32x4*)(gf + j * 512 + lane * 8 + 4); }
    for (int k0 = 0; k0 < nk; k0 += 2) {
        const bool two = k0 + 1 < nk; const int m0 = pass_row(F, wave, k0), m1 = two ? pass_row(F, wave, k0 + 1) : m0;
        v4u xa[4], xb[4];
#pragma unroll
        for (int j = 0; j < 4; ++j) { xa[j] = ((const GAS v4u*)(XB + (size_t)m0 * DM) + lane)[64 * j]; xb[j] = two ? ((const GAS v4u*)(XB + (size_t)m1 * DM) + lane)[64 * j] : xa[j]; }
        float s0 = 0.f, s1 = 0.f;
#pragma unroll
        for (int j = 0; j < 4; ++j) {
#pragma unroll
            for (int e = 0; e < 4; ++e) { const float a0 = bflo(xa[j][e]), a1 = bfhi(xa[j][e]), b0 = bflo(xb[j][e]), b1 = bfhi(xb[j][e]); s0 += a0 * a0 + a1 * a1; s1 += b0 * b0 + b1 * b1; } }
        s0 = wave_sum(s0); s1 = wave_sum(s1);
        const float r0 = __builtin_amdgcn_rsqf(s0 * (1.0f / 2048.0f) + 1e-6f), r1 = __builtin_amdgcn_rsqf(s1 * (1.0f / 2048.0f) + 1e-6f);
        GAS f32x4* o0 = (GAS f32x4*)(A.out + (size_t)m0 * DM) + 2 * lane; GAS f32x4* o1 = (GAS f32x4*)(A.out + (size_t)m1 * DM) + 2 * lane;
#pragma unroll
        for (int j = 0; j < 4; ++j) { const f32x4 a = (f32x4){bflo(xa[j].x), bfhi(xa[j].x), bflo(xa[j].y), bfhi(xa[j].y)}, b = (f32x4){bflo(xa[j].z), bfhi(xa[j].z), bflo(xa[j].w), bfhi(xa[j].w)};
            __builtin_nontemporal_store(a * r0 * g0[j], &o0[128 * j]); __builtin_nontemporal_store(b * r0 * g1[j], &o0[128 * j + 1]); }
        if (two) {
#pragma unroll
            for (int j = 0; j < 4; ++j) { const f32x4 a = (f32x4){bflo(xb[j].x), bfhi(xb[j].x), bflo(xb[j].y), bfhi(xb[j].y)}, b = (f32x4){bflo(xb[j].z), bfhi(xb[j].z), bflo(xb[j].w), bfhi(xb[j].w)};
                __builtin_nontemporal_store(a * r1 * g0[j], &o1[128 * j]); __builtin_nontemporal_store(b * r1 * g1[j], &o1[128 * j + 1]); } }
    }
}
__global__ void __launch_bounds__(NWAVES * 64, 2) mega_fwd(Args A) {
    extern __shared__ __attribute__((aligned(16))) unsigned char lds[];
    Frame F;
    F.lds = (LAS unsigned char*)lds; F.ldsg = lds;
    F.MISC = (volatile LAS unsigned*)(F.lds + MISC_OFF);
    F.tid = threadIdx.x; F.lane = F.tid & 63; F.wave = __builtin_amdgcn_readfirstlane(F.tid >> 6);
    F.G = gridDim.x; F.bid = blockIdx.x;
    F.ws = A.ws; F.ctl = (gu32*)(A.ws + WS_CTL);
    for (int u = F.tid; u < (LDS_BYTES - LDSCTL_OFF) / 4; u += NWAVES * 64) ((LAS unsigned*)(F.lds + LDSCTL_OFF))[u] = 0u;
    __syncthreads();
    XcdBarrier bar; bar.bar = (unsigned*)(F.ctl + CW_BAR); bar.x = 0; bar.st = nullptr;
    if (!MK_PER_PHASE) bar = xcd_barrier_post((unsigned*)(F.ctl + CW_BAR), F.MISC + 8);
    const int lo = A.ph_lo, hi = A.ph_hi;
#define IN(k) (lo <= (k) && (k) < hi)
#define SEAM(k) do { if (IN(k) && IN((k) + 1)) xcd_barrier(bar); } while (0)

    if (IN(0) && DBG(0)) { for (int rp = 0; rp < NREP(0); ++rp) { p0_prologue(A, F); if (rp + 1 < NREP(0)) xcd_barrier(bar); } } SEAM(0);
    for (int ls = 0; ls < 2 * DEPTH; ++ls) {
        const int l = ls >> 1, st = ls & 1, jm = l >> 1, rec = l & 1;
        const int p1 = 1 + 7 * l + (st ? 5 : 0), p2 = p1 + (st ? 1 : 4);
        if (IN(p1) && DBG(1)) {
            if (ls > 0) { phase_quant(A, F, (st || !rec) ? 1 : 0); if (ls == 1 && DQ_MASK) wq_rows(A, F); if (st && ((DQ_MASK >> l) & 1)) hidden_step(F, l); xcd_barrier(bar); }
            if (!st && rec) {
                pg8::Gemm g{(const bf16*)(F.ws + WS_XB), (const bf16*)(F.ws + WS_WIN) + (size_t)jm * 2 * DM * DM, S, 2 * DM, DM, F.wave};
                pg8::FrowOrder So; So.init(S, 2 * DM, F.G, F.bid); So.frow = (const float*)(F.ws + WS_RSTD); So.tab = F.lds + 135168;
                pg8::EpiScaleT<false> E{(bf16*)(F.ws + WS_QKV), DM, F.lds + 135168, nullptr, (bf16*)(F.ws + WS_QKV + 32 * MiB), 1, nullptr, nullptr};
                pg8::gemm_phase<pg8::EpiScaleT<false>, pg8::FrowOrder, true, true, false>(F.lds + RING_OFF, g, So, E);
            } else {
            const unsigned char* Bq; const float* sc; int N, mode; bf16* O; int ldc;
            if (st) { Bq = F.ws + WS_W1 + (size_t)l * FF * DM; sc = (const float*)(F.ws + WS_SW) + SW_W1 + l * FF; N = FF; mode = ((DQ_MASK >> l) & 1) ? 3 : 2; O = (bf16*)(F.ws + WS_HID); ldc = FF; }
            else { Bq = F.ws + WS_WQKV + (size_t)jm * NQKV * DM; sc = (const float*)(F.ws + WS_SW) + SW_QKV + jm * NQKV; N = NQKV; mode = 0; O = (bf16*)(F.ws + WS_QKV); ldc = NQKV; }
            pg8::Gemm g{(const bf16*)(F.ws + WS_XQ), (const bf16*)Bq, S, N, DM / 2, F.wave};
            pg8::FrowOrder So; So.init(S, N, F.G, F.bid); So.frow = (const float*)(F.ws + WS_FROW); So.tab = F.lds + 135168;
            pg8::EpiScaleT<true> E{O, ldc, F.lds + 135168, (float*)(F.ws + WS_KMP), (bf16*)(F.ws + WS_QKV + 32 * MiB), mode, sc, (const float*)(F.ws + WS_SW) + SW_CL + 2 * l};
            for (int rp = 0; rp < NREP(1); ++rp) { pg8::gemm_phase<pg8::EpiScaleT<true>, pg8::FrowOrder, true, true, true>(F.lds + RING_OFF, g, So, E); if (rp + 1 < NREP(1)) xcd_barrier(bar); } } }
        SEAM(p1);
        if (!st) {
            if (!rec) {
                if (IN(p1 + 1) && DBG(2)) phase_gate2(A, F, jm);
                SEAM(p1 + 1);
                if (IN(p1 + 2) && DBG(3)) { for (int rp = 0; rp < NREP(3); ++rp) { attn_phase<false>(A, F, jm); if (rp + 1 < NREP(3)) xcd_barrier(bar); } }
                SEAM(p1 + 2);
                if (IN(p1 + 3) && DBG(4)) { for (int rp = 0; rp < NREP(4); ++rp) { attn_phase3<true>(A, F, jm); if (rp + 1 < NREP(4)) xcd_barrier(bar); } }
                SEAM(p1 + 3);
            } else {
                if (IN(p1 + 1) && DBG(6)) { for (int rp = 0; rp < NREP(6); ++rp) { phase_rec_ab2(A, F, jm); if (rp + 1 < NREP(6)) xcd_barrier(bar); } }
                SEAM(p1 + 1);
                                if (IN(p1 + 3) && DBG(8)) { for (int rp = 0; rp < NREP(8); ++rp) { phase_rec_scan(A, F); if (rp + 1 < NREP(8)) xcd_barrier(bar); } }
                SEAM(p1 + 3);
            }
        }
        if (IN(p2) && DBG(9) && st && ((DQ_MASK >> l) & 1)) {
            pg8::Gemm g{(const bf16*)(F.ws + WS_HID), (const bf16*)(F.ws + WS_W1 + WS_W2Q_OFF * MiB + (size_t)l * DM * FF), S, DM, FF / 2, F.wave}; pg8::StaticOrder So; So.init(S, DM, F.G, F.bid);
            pg8::EpiResQ8 E{(bf16*)(F.ws + WS_XB), (const float*)(F.ws + WS_SW) + SW_T2 + l * DM, (const float*)(F.ws + WS_SW) + SW_CS2 + l * DM, (const float*)(F.ws + WS_SW) + SW_CL + 2 * l};
            pg8::gemm_phase<pg8::EpiResQ8, pg8::StaticOrder, true, true, true>(F.lds + RING_OFF, g, So, E); }
        else if (IN(p2) && DBG(9)) {
            const bf16* Ap; const bf16* Bt; int K;
            if (st) { Ap = (const bf16*)(F.ws + WS_HID); Bt = (const bf16*)(F.ws + WS_W2) + (size_t)l * DM * FF; K = FF; }
            else { Ap = (const bf16*)(F.ws + WS_AO); Bt = (const bf16*)(F.ws + (rec ? WS_WOUT : WS_WO)) + (size_t)jm * DM * DM; K = DM; }
            pg8::Gemm g{Ap, Bt, S, DM, K, F.wave}; pg8::StaticOrder So; So.init(S, DM, F.G, F.bid);
            pg8::EpiRes E{(bf16*)(F.ws + WS_XB)};
            pg8::gemm_phase<pg8::EpiRes, pg8::StaticOrder, true, true>(F.lds + RING_OFF, g, So, E); }
        SEAM(p2);
    }
    if (IN(NPHASE - 1) && DBG(12)) { for (int rp = 0; rp < NREP(12); ++rp) { phase_final(A, F); if (rp + 1 < NREP(12)) xcd_barrier(bar); } }
#undef IN
#undef SEAM
}

extern "C" void kernel_launch(void* const* d_in, const int* in_sizes, int n_in, void* d_out, int out_size, void* d_ws, size_t ws_size, hipStream_t stream) {
    static int grid = 0;
    if (grid == 0) {
        if (n_in != 18 || in_sizes[0] != S * DM || out_size != S * DM || ws_size < WS_END) { fprintf(stderr, "kernel_launch: shape mismatch n_in %d in0 %d out %d ws %zu (need %zu)\n", n_in, n_in > 0 ? in_sizes[0] : -1, out_size, ws_size, (size_t)WS_END); grid = -1; return; }
        int dev = 0, cus = 0, per_cu = 0;
        if (hipGetDevice(&dev) != hipSuccess || hipDeviceGetAttribute(&cus, hipDeviceAttributeMultiprocessorCount, dev) != hipSuccess) { grid = -1; return; }
        if (hipFuncSetAttribute((const void*)mega_fwd, hipFuncAttributeMaxDynamicSharedMemorySize, LDS_BYTES) != hipSuccess) { fprintf(stderr, "kernel_launch: hipFuncSetAttribute failed\n"); grid = -1; return; }
        if (hipOccupancyMaxActiveBlocksPerMultiprocessor(&per_cu, (const void*)mega_fwd, NWAVES * 64, LDS_BYTES) != hipSuccess || per_cu < 1) fprintf(stderr, "kernel_launch: occupancy query says %d\n", per_cu);
        (void)hipGetLastError();
        grid = cus;
    }
    if (grid < 0) return;
    if (hipMemsetAsync((char*)d_ws + WS_CTL, 0, CTL_ZERO_BYTES, stream) != hipSuccess) { fprintf(stderr, "kernel_launch: memset failed\n"); return; }
    Args a{};
    for (int i = 0; i < 18; ++i) a.in[i] = (const float*)d_in[i];
    a.out = (float*)d_out; a.ws = (unsigned char*)d_ws;
#if MK_PER_PHASE
    for (int p = 0; p < NPHASE; ++p) { a.ph_lo = p; a.ph_hi = p + 1; hipLaunchKernelGGL(mega_fwd, dim3(grid), dim3(NWAVES * 64), LDS_BYTES, stream, a); }
#else
    a.ph_lo = 0; a.ph_hi = NPHASE; hipLaunchKernelGGL(mega_fwd, dim3(grid), dim3(NWAVES * 64), LDS_BYTES, stream, a);
#endif
    const hipError_t le = hipPeekAtLastError();
    if (le != hipSuccess) fprintf(stderr, "kernel_launch: launch failed: %s\n", hipGetErrorName(le));
}
```

```cpp
#include <hip/hip_runtime.h>
#include <cstdio>
#include <cstdint>
#include <cmath>
__device__ __forceinline__ int lane_id_v() { int l; asm volatile("v_mbcnt_lo_u32_b32 %0, -1, 0\n\tv_mbcnt_hi_u32_b32 %0, -1, %0" : "=v"(l)); return l; }
namespace pg8 {
#define PG8_LAS __attribute__((address_space(3)))
typedef unsigned short bf16_t;
typedef short bf16x8 __attribute__((ext_vector_type(8)));
typedef float f32x4 __attribute__((ext_vector_type(4)));
typedef unsigned u32x4 __attribute__((ext_vector_type(4)));
typedef int i32x4 __attribute__((ext_vector_type(4)));
template <bool I8> struct AccT { typedef f32x4 type; };
template <> struct AccT<true> { typedef i32x4 type; };
__device__ __forceinline__ f32x4 mma_op(bf16x8 a, bf16x8 b, f32x4 c) { return __builtin_amdgcn_mfma_f32_16x16x32_bf16(a, b, c, 0, 0, 0); }
__device__ __forceinline__ i32x4 mma_op(bf16x8 a, bf16x8 b, i32x4 c) { return __builtin_amdgcn_mfma_i32_16x16x64_i8(__builtin_bit_cast(i32x4, a), __builtin_bit_cast(i32x4, b), c, 0, 0, 0); }
constexpr int BM = 256, BK = 64, HALF = 128, HTB = HALF * BK * 2  , STAGE_BYTES = 8 * HTB, NXCD = 8, WGM = 8;

__host__ __device__ __forceinline__ int lds_byte(int r, int c) { const int st = (r >> 4) * 2 + (c >> 5), rr = r & 15, cc = c & 31, ob = rr * 64 + cc * 2; return st * 1024 + (ob ^ (((ob >> 9) & 1) << 5)); }
__host__ __device__ __forceinline__ void stage_rc(int b, int& R, int& C) { const int st = b / 1024, sb = b % 1024, swz = sb ^ (((sb >> 9) & 1) << 5); R = (st >> 1) * 16 + swz / 64; C = (st & 1) * 32 + (swz % 64) / 2; }
__host__ __device__ __forceinline__ int perm32(int rho) { const int n = rho >> 4, i = rho & 15; return 8 * (i >> 2) + 4 * n + (i & 3); }

struct Unit { int pm, pn, seq; };
struct Gemm { const bf16_t* A; const bf16_t* Bt; int M, N, K; int wave; };

struct StaticOrder {
    int nM, nN, nwg, G, c;
    __host__ __device__ void init(int M, int N, int G_, int c_) { nM = M / BM; nN = N / BM; nwg = nM * nN; G = G_; c = c_; }
    __host__ __device__ bool next(int i, Unit& u) const {
        const long L = (long)i * G + c; if (L >= nwg) return false;
        int wgid = (int)L; { const int q = nwg / NXCD, r = nwg % NXCD, xcd = wgid % NXCD, off = wgid / NXCD; wgid = (xcd < r ? xcd * (q + 1) : r * (q + 1) + (xcd - r) * q) + off; }
        const int nig = WGM * nN, gid = wgid / nig, fm = gid * WGM, gsz = (nM - fm) < WGM ? (nM - fm) : WGM;
        u.pm = fm + ((wgid % nig) % gsz); u.pn = (wgid % nig) / gsz; u.seq = i; return true;
    }
    __device__ __forceinline__ void a_ready(const Unit&) const {}
    __device__ __forceinline__ void done(const Unit&) const {}
};

__device__ __forceinline__ unsigned cvt_pk_bf16(float lo, float hi) { unsigned r; asm volatile("v_cvt_pk_bf16_f32 %0, %1, %2" : "=v"(r) : "v"(lo), "v"(hi)); return r; }
struct FrowOrder : StaticOrder {
    const float* frow; PG8_LAS unsigned char* tab;
    __device__ __forceinline__ void a_ready(const Unit& u) const {
        const int lane = lane_id_v();
        __builtin_amdgcn_global_load_lds((const unsigned*)(frow + (size_t)u.pm * BM + lane * 4), (PG8_LAS unsigned*)(tab + (u.seq & 1) * 1024), 16, 0, 0);
    }
};
constexpr float RMS_EPS = 1e-6f;
typedef float f32x2_ __attribute__((ext_vector_type(2)));
__device__ __forceinline__ float gelu_tanh(float x) {
    const float u = 0.7978845608028654f * (x + 0.044715f * x * x * x);
    const float e = __builtin_amdgcn_exp2f(-2.0f * 1.4426950408889634f * u);
    return x * __builtin_amdgcn_rcpf(1.0f + e);
}
template <bool I8>
struct EpiScaleT {
    static constexpr bool PERM = true, AFTER_DRAIN = false;
    bf16_t* O; int ldc; const PG8_LAS unsigned char* tab; float* kmp; bf16_t* O2; int mode; const float* scol; const float* hq;
    __device__ __forceinline__ void operator()(const typename AccT<I8>::type (&acc)[2][2][4][2], const Unit& u, int wr, int wc, int fr, int fq) const {
        const int row0 = u.pm * BM + wr * 64 + fr;
        f32x4 sc[2][2];
#pragma unroll
        for (int bj = 0; bj < 2; ++bj)
#pragma unroll
            for (int n = 0; n < 2; ++n) { if constexpr (I8) sc[bj][n] = *(const f32x4*)(scol + u.pn * BM + bj * HALF + wc * 32 + 8 * fq + 4 * n); else sc[bj][n] = (f32x4){1.f, 1.f, 1.f, 1.f}; }
        float rs[2][4];
#pragma unroll
        for (int ai = 0; ai < 2; ++ai)
#pragma unroll
            for (int m = 0; m < 4; ++m) rs[ai][m] = *(const PG8_LAS float*)(tab + (u.seq & 1) * 1024 + (wr * 64 + fr + ai * HALF + m * 16) * 4);
        int colt = u.pn * BM; bf16_t* base = O; int am = mode >= 2 ? 2 : 0; const float hqi = mode == 3 ? hq[0] : 0.f;
        if (mode == 1 && colt >= 2048) { colt -= 2048; base = O2; am = 1; }
        const int col0 = colt + wc * 32 + 8 * fq;
#pragma unroll
        for (int ai = 0; ai < 2; ++ai)
#pragma unroll
            for (int m = 0; m < 4; ++m) { bf16_t* rowp = base + (size_t)(row0 + ai * HALF + m * 16) * ldc + col0; const float r = rs[ai][m];
#pragma unroll
                for (int bj = 0; bj < 2; ++bj) { f32x4 v0 = __builtin_convertvector(acc[ai][bj][m][0], f32x4) * (sc[bj][0] * r), v1 = __builtin_convertvector(acc[ai][bj][m][1], f32x4) * (sc[bj][1] * r);
                    if (am == 1) {
#pragma unroll
                        for (int e = 0; e < 4; ++e) { v0[e] = gelu_tanh(v0[e]); v1[e] = gelu_tanh(v1[e]); } }
                    else if (am == 2) {
#pragma unroll
                        for (int e = 0; e < 4; ++e) { const float a0 = fmaxf(v0[e], 0.f), a1 = fmaxf(v1[e], 0.f); v0[e] = a0 * a0; v1[e] = a1 * a1; } }
                    u32x4 w; w.x = cvt_pk_bf16(v0[0], v0[1]); w.y = cvt_pk_bf16(v0[2], v0[3]); w.z = cvt_pk_bf16(v1[0], v1[1]); w.w = cvt_pk_bf16(v1[2], v1[3]);
                    if (mode == 3) {
                        int q[8];
#pragma unroll
                        for (int e = 0; e < 4; ++e) { q[e] = (int)__builtin_rintf(fminf(v0[e] * hqi, 254.0f)) - 127; q[4 + e] = (int)__builtin_rintf(fminf(v1[e] * hqi, 254.0f)) - 127; }
                        f32x2_ wq; wq.x = __builtin_bit_cast(float, ((unsigned)q[0] & 255u) | (((unsigned)q[1] & 255u) << 8) | (((unsigned)q[2] & 255u) << 16) | ((unsigned)q[3] << 24));
                        wq.y = __builtin_bit_cast(float, ((unsigned)q[4] & 255u) | (((unsigned)q[5] & 255u) << 8) | (((unsigned)q[6] & 255u) << 16) | ((unsigned)q[7] << 24));
                        *(f32x2_*)((unsigned char*)O + (size_t)(row0 + ai * HALF + m * 16) * 8192 + col0 + bj * HALF) = wq; }
                    else if (am == 2) __builtin_nontemporal_store(w, (u32x4*)(rowp + bj * HALF)); else *(u32x4*)(rowp + bj * HALF) = w; } }
        if (mode == 0 && u.pn >= 8 && u.pn < 16) {
            float* kp = kmp + ((size_t)wr * 32 + u.pm) * 2048 + (u.pn - 8) * BM + wc * 32 + 8 * fq;
#pragma unroll
            for (int bj = 0; bj < 2; ++bj)
#pragma unroll
                for (int n = 0; n < 2; ++n) { f32x4 s = (f32x4){0.f, 0.f, 0.f, 0.f};
#pragma unroll
                    for (int ai = 0; ai < 2; ++ai)
#pragma unroll
                        for (int m = 0; m < 4; ++m) s += __builtin_convertvector(acc[ai][bj][m][n], f32x4) * rs[ai][m];
                    s *= sc[bj][n];
#pragma unroll
                    for (int e = 0; e < 4; ++e) { float t = s[e]; t += __shfl_xor(t, 1); t += __shfl_xor(t, 2); t += __shfl_xor(t, 4); t += __shfl_xor(t, 8); s[e] = t; }
                    if (fr == 0) *(f32x4*)(kp + bj * HALF + 4 * n) = s; } }
    }
};
struct EpiRes {
    static constexpr bool PERM = true, AFTER_DRAIN = false;
    bf16_t* XB;
    __device__ __forceinline__ void operator()(const f32x4 (&acc)[2][2][4][2], const Unit& u, int wr, int wc, int fr, int fq) const {
        const int row0 = u.pm * BM + wr * 64 + fr, col0 = u.pn * BM + wc * 32 + 8 * fq;
        asm volatile("" ::: "memory"); __builtin_amdgcn_sched_barrier(0);
        u32x4 xin[2][4][2];
#pragma unroll
        for (int ai = 0; ai < 2; ++ai)
#pragma unroll
            for (int m = 0; m < 4; ++m)
#pragma unroll
                for (int bj = 0; bj < 2; ++bj) xin[ai][m][bj] = *(const u32x4*)(XB + (size_t)(row0 + ai * HALF + m * 16) * 2048 + col0 + bj * HALF);
        asm volatile("" ::: "memory"); __builtin_amdgcn_sched_barrier(0);
#pragma unroll
        for (int ai = 0; ai < 2; ++ai)
#pragma unroll
            for (int m = 0; m < 4; ++m) { const int r = row0 + ai * HALF + m * 16;
#pragma unroll
                for (int bj = 0; bj < 2; ++bj) { bf16_t* xp = XB + (size_t)r * 2048 + col0 + bj * HALF; const u32x4 xo = xin[ai][m][bj];
                    f32x4 x0, x1;
                    x0[0] = __builtin_bit_cast(float, xo.x << 16); x0[1] = __builtin_bit_cast(float, xo.x & 0xffff0000u); x0[2] = __builtin_bit_cast(float, xo.y << 16); x0[3] = __builtin_bit_cast(float, xo.y & 0xffff0000u);
                    x1[0] = __builtin_bit_cast(float, xo.z << 16); x1[1] = __builtin_bit_cast(float, xo.z & 0xffff0000u); x1[2] = __builtin_bit_cast(float, xo.w << 16); x1[3] = __builtin_bit_cast(float, xo.w & 0xffff0000u);
                    x0 += acc[ai][bj][m][0]; x1 += acc[ai][bj][m][1];
                    u32x4 w; w.x = cvt_pk_bf16(x0[0], x0[1]); w.y = cvt_pk_bf16(x0[2], x0[3]); w.z = cvt_pk_bf16(x1[0], x1[1]); w.w = cvt_pk_bf16(x1[2], x1[3]);
                    *(u32x4*)xp = w; } }
    }
};
struct EpiResQ8 {
    static constexpr bool PERM = true, AFTER_DRAIN = false;
    bf16_t* XB; const float* t2; const float* cs2; const float* hq;
    __device__ __forceinline__ void operator()(const i32x4 (&acc)[2][2][4][2], const Unit& u, int wr, int wc, int fr, int fq) const {
        const int row0 = u.pm * BM + wr * 64 + fr, col0 = u.pn * BM + wc * 32 + 8 * fq;
        const float step = hq[1];
        f32x4 sc[2][2], cc[2][2];
#pragma unroll
        for (int bj = 0; bj < 2; ++bj)
#pragma unroll
            for (int n = 0; n < 2; ++n) { sc[bj][n] = *(const f32x4*)(t2 + col0 + bj * HALF + 4 * n) * step; cc[bj][n] = *(const f32x4*)(cs2 + col0 + bj * HALF + 4 * n) * 127.0f; }
        asm volatile("" ::: "memory"); __builtin_amdgcn_sched_barrier(0);
#pragma unroll
        for (int ai = 0; ai < 2; ++ai) {
            u32x4 xin[4][2];
#pragma unroll
            for (int m = 0; m < 4; ++m)
#pragma unroll
                for (int bj = 0; bj < 2; ++bj) xin[m][bj] = *(const u32x4*)(XB + (size_t)(row0 + ai * HALF + m * 16) * 2048 + col0 + bj * HALF);
            asm volatile("" ::: "memory"); __builtin_amdgcn_sched_barrier(0);
#pragma unroll
            for (int m = 0; m < 4; ++m) { const int r = row0 + ai * HALF + m * 16;
#pragma unroll
                for (int bj = 0; bj < 2; ++bj) { bf16_t* xp = XB + (size_t)r * 2048 + col0 + bj * HALF; const u32x4 xo = xin[m][bj];
                    f32x4 x0, x1;
                    x0[0] = __builtin_bit_cast(float, xo.x << 16); x0[1] = __builtin_bit_cast(float, xo.x & 0xffff0000u); x0[2] = __builtin_bit_cast(float, xo.y << 16); x0[3] = __builtin_bit_cast(float, xo.y & 0xffff0000u);
                    x1[0] = __builtin_bit_cast(float, xo.z << 16); x1[1] = __builtin_bit_cast(float, xo.z & 0xffff0000u); x1[2] = __builtin_bit_cast(float, xo.w << 16); x1[3] = __builtin_bit_cast(float, xo.w & 0xffff0000u);
                    x0 += (__builtin_convertvector(acc[ai][bj][m][0], f32x4) + cc[bj][0]) * sc[bj][0]; x1 += (__builtin_convertvector(acc[ai][bj][m][1], f32x4) + cc[bj][1]) * sc[bj][1];
                    u32x4 w; w.x = cvt_pk_bf16(x0[0], x0[1]); w.y = cvt_pk_bf16(x0[2], x0[3]); w.z = cvt_pk_bf16(x1[0], x1[1]); w.w = cvt_pk_bf16(x1[2], x1[3]);
                    *(u32x4*)xp = w; } }
            asm volatile("" ::: "memory"); __builtin_amdgcn_sched_barrier(0); }
    }
};
template <class Epi, class Sched, bool ALIGN_EPI = false, bool SP2 = false, bool I8 = false>
__device__ __forceinline__ void gemm_phase(PG8_LAS unsigned char* lds, const Gemm g, const Sched& S, const Epi& E) {
    int tid_ = g.wave * 64 + lane_id_v(); asm volatile("" : "+v"(tid_));
    const int tid = tid_, wid = __builtin_amdgcn_readfirstlane(tid >> 6), lane = tid & 63, wr = wid >> 2, wc = wid & 3, fr = lane & 15, fq = lane >> 4;
    const int K = g.K, nt = K / BK;
    unsigned voffA[2], voffB[2];
#pragma unroll
    for (int i = 0; i < 2; ++i) { int R, C; stage_rc(tid * 16 + i * 8192, R, C); const int Rb = Epi::PERM ? ((R & ~31) + perm32(R & 31)) : R;
        voffA[i] = (unsigned)(R * K + C) * 2u; voffB[i] = (unsigned)(Rb * K + C) * 2u; }
    const size_t kstep = (size_t)(BK * 2);
    const size_t hstep = (size_t)HALF * K * 2;
    const size_t tstep = 2 * hstep;
    const unsigned ldsw = (unsigned)wid * 1024u;
    const int aoff = lds_byte(wr * 64 + fr, fq * 8), boff = lds_byte(wc * 32 + fr, fq * 8);
#define PG8_SA(b, h) (((b) * 2 + (h)) * HTB)
#define PG8_SB(b, h) ((4 + (b) * 2 + (h)) * HTB)
#define PG8_STAGE(bufoff, gbase, voff) do { _Pragma("unroll") for (int _i = 0; _i < 2; ++_i) \
        __builtin_amdgcn_global_load_lds((const unsigned*)((const char*)(gbase) + (voff)[_i]), (PG8_LAS unsigned*)(lds + (bufoff) + ldsw + _i * 8192), 16, 0, 0); } while (0)
#define PG8_LDA(dst, b, h) do { _Pragma("unroll") for (int m = 0; m < 4; ++m) _Pragma("unroll") for (int k = 0; k < 2; ++k) dst[m][k] = *(const PG8_LAS bf16x8*)(lds + PG8_SA(b, h) + aoff + m * 2048 + k * 1024); } while (0)
#define PG8_LDB(dst, b, h) do { _Pragma("unroll") for (int n = 0; n < 2; ++n) _Pragma("unroll") for (int k = 0; k < 2; ++k) dst[n][k] = *(const PG8_LAS bf16x8*)(lds + PG8_SB(b, h) + boff + n * 2048 + k * 1024); } while (0)
#define PG8_MMA(ai, bj, At, Bt) do { __builtin_amdgcn_s_setprio(1); _Pragma("unroll") for (int m = 0; m < 4; ++m) _Pragma("unroll") for (int n = 0; n < 2; ++n) _Pragma("unroll") for (int k = 0; k < 2; ++k) \
        acc[ai][bj][m][n] = mma_op(Bt[n][k], At[m][k], acc[ai][bj][m][n]); __builtin_amdgcn_s_setprio(0); } while (0)
#define PG8_WAIT_V(n) asm volatile("s_waitcnt vmcnt(" #n ")" ::: "memory")
#define PG8_WAIT_L(n) asm volatile("s_waitcnt lgkmcnt(" #n ")" ::: "memory")
#define PG8_BAR __builtin_amdgcn_s_barrier()
#define PG8_SCHED __builtin_amdgcn_sched_barrier(0)
    Unit cur, nxt; int ui = 0;
    if (!S.next(0, cur)) return;
    typedef typename AccT<I8>::type acc_t;
    acc_t acc[2][2][4][2];
#pragma unroll
    for (int a = 0; a < 2; ++a)
#pragma unroll
        for (int b = 0; b < 2; ++b)
#pragma unroll
            for (int m = 0; m < 4; ++m)
#pragma unroll
                for (int n = 0; n < 2; ++n) acc[a][b][m][n] = acc_t{};
    bf16x8 At[4][2], B0[2][2], B1[2][2];
    const char* cA = (const char*)g.A + (size_t)cur.pm * tstep; const char* cB = (const char*)g.Bt + (size_t)cur.pn * tstep;
    S.a_ready(cur);
    if constexpr (SP2) {
        PG8_STAGE(PG8_SB(0, 0), cB, voffB); PG8_STAGE(PG8_SB(0, 1), cB + hstep, voffB); PG8_STAGE(PG8_SA(0, 0), cA, voffA); PG8_STAGE(PG8_SA(0, 1), cA + hstep, voffA);
        if (wr == 1) PG8_BAR;
        PG8_WAIT_V(2); PG8_BAR;
        PG8_STAGE(PG8_SB(1, 0), cB + kstep, voffB); PG8_STAGE(PG8_SB(1, 1), cB + hstep + kstep, voffB);
        PG8_WAIT_V(4); PG8_BAR;
    } else {
        PG8_STAGE(PG8_SB(0, 0), cB, voffB); PG8_STAGE(PG8_SA(0, 0), cA, voffA); PG8_STAGE(PG8_SB(0, 1), cB + hstep, voffB); PG8_STAGE(PG8_SA(0, 1), cA + hstep, voffA);
        if (wr == 1) PG8_BAR;
        PG8_WAIT_V(4); PG8_BAR;
        PG8_STAGE(PG8_SB(1, 0), cB + kstep, voffB); PG8_STAGE(PG8_SA(1, 0), cA + kstep, voffA); PG8_STAGE(PG8_SB(1, 1), cB + hstep + kstep, voffB);
        PG8_WAIT_V(6); PG8_BAR;
    }
    for (;;) {
        const bool has_next = S.next(ui + 1, nxt);
        const char* nA = has_next ? (const char*)g.A + (size_t)nxt.pm * tstep : cA; const char* nB = has_next ? (const char*)g.Bt + (size_t)nxt.pn * tstep : cB;
        for (int t = 0; t < nt; t += 2) {
            const bool last = (t == nt - 2);
            const char* a1 = cA + (size_t)(t + 1) * kstep;
            const char* a2 = last ? nA : cA + (size_t)(t + 2) * kstep; const char* b2 = last ? nB : cB + (size_t)(t + 2) * kstep;
            const char* a3 = a2 + kstep; const char* b3 = b2 + kstep; (void)a3;
            if (last && has_next) S.a_ready(nxt);
            if constexpr (SP2) {
            PG8_LDB(B0, 0, 0); PG8_LDB(B1, 0, 1); PG8_SCHED; PG8_LDA(At, 0, 0); PG8_STAGE(PG8_SA(1, 0), a1, voffA); PG8_STAGE(PG8_SA(1, 1), a1 + hstep, voffA);
            PG8_WAIT_V(8); PG8_WAIT_L(0); PG8_BAR; PG8_MMA(0, 0, At, B0); PG8_MMA(0, 1, At, B1); PG8_BAR; PG8_SCHED;
            PG8_LDA(At, 0, 1); PG8_STAGE(PG8_SB(0, 0), b2, voffB); PG8_STAGE(PG8_SB(0, 1), b2 + hstep, voffB);
            PG8_WAIT_V(6); PG8_WAIT_L(0); PG8_BAR; PG8_MMA(1, 0, At, B0); PG8_MMA(1, 1, At, B1); PG8_BAR; PG8_SCHED;
            PG8_LDB(B0, 1, 0); PG8_LDB(B1, 1, 1); PG8_SCHED; PG8_LDA(At, 1, 0); PG8_STAGE(PG8_SA(0, 0), a2, voffA); PG8_STAGE(PG8_SA(0, 1), a2 + hstep, voffA);
            PG8_WAIT_V(8); PG8_WAIT_L(0); PG8_BAR; PG8_MMA(0, 0, At, B0); PG8_MMA(0, 1, At, B1); PG8_BAR; PG8_SCHED;
            PG8_LDA(At, 1, 1); PG8_STAGE(PG8_SB(1, 0), b3, voffB); PG8_STAGE(PG8_SB(1, 1), b3 + hstep, voffB);
            PG8_WAIT_V(6); PG8_WAIT_L(0); PG8_BAR; PG8_MMA(1, 0, At, B0); PG8_MMA(1, 1, At, B1); PG8_BAR; PG8_SCHED;
            } else {
            PG8_LDB(B0, 0, 0); PG8_SCHED; PG8_LDA(At, 0, 0); PG8_STAGE(PG8_SA(1, 1), a1 + hstep, voffA);
            PG8_WAIT_L(8); PG8_BAR; PG8_WAIT_L(0); PG8_MMA(0, 0, At, B0); PG8_BAR; PG8_SCHED;
            PG8_LDB(B1, 0, 1); PG8_STAGE(PG8_SB(0, 0), b2, voffB);
            PG8_BAR; PG8_WAIT_L(0); PG8_MMA(0, 1, At, B1); PG8_BAR;
            PG8_LDA(At, 0, 1); PG8_STAGE(PG8_SA(0, 0), a2, voffA);
            PG8_BAR; PG8_WAIT_L(0); PG8_MMA(1, 0, At, B0); PG8_BAR; PG8_SCHED;
            PG8_STAGE(PG8_SB(0, 1), b2 + hstep, voffB);
            PG8_WAIT_V(6); PG8_BAR; PG8_MMA(1, 1, At, B1); PG8_BAR;
            PG8_LDB(B0, 1, 0); PG8_SCHED; PG8_LDA(At, 1, 0); PG8_STAGE(PG8_SA(0, 1), a2 + hstep, voffA);
            PG8_WAIT_L(8); PG8_BAR; PG8_WAIT_L(0); PG8_MMA(0, 0, At, B0); PG8_BAR; PG8_SCHED;
            PG8_LDB(B1, 1, 1); PG8_STAGE(PG8_SB(1, 0), b3, voffB);
            PG8_BAR; PG8_WAIT_L(0); PG8_MMA(0, 1, At, B1); PG8_BAR;
            PG8_LDA(At, 1, 1); PG8_STAGE(PG8_SA(1, 0), a3, voffA);
            PG8_BAR; PG8_WAIT_L(0); PG8_MMA(1, 0, At, B0); PG8_BAR; PG8_SCHED;
            PG8_STAGE(PG8_SB(1, 1), b3 + hstep, voffB);
            PG8_WAIT_V(6); PG8_BAR; PG8_MMA(1, 1, At, B1); PG8_BAR;
            }
        }
        if constexpr (ALIGN_EPI) { if (wr == 0) PG8_BAR; }
        if constexpr (!Epi::AFTER_DRAIN) { E(acc, cur, wr, wc, fr, fq); S.done(cur); }
        if (!has_next) break;
#pragma unroll
        for (int a = 0; a < 2; ++a)
#pragma unroll
            for (int b = 0; b < 2; ++b)
#pragma unroll
                for (int m = 0; m < 4; ++m)
#pragma unroll
                    for (int n = 0; n < 2; ++n) acc[a][b][m][n] = acc_t{};
        cur = nxt; cA = nA; cB = nB; ++ui;
        if constexpr (ALIGN_EPI) { if (wr == 1) PG8_BAR; }
    }
    PG8_WAIT_V(0);
    if constexpr (!ALIGN_EPI) { if (wr == 0) PG8_BAR; }
    PG8_BAR;
    if constexpr (Epi::AFTER_DRAIN) { E.fused(acc, cur, wr, wc, fr, fq, lds, wid, lane); S.done(cur); }
#undef PG8_SA
#undef PG8_SB
#undef PG8_STAGE
#undef PG8_LDA
#undef PG8_LDB
#undef PG8_MMA
#undef PG8_WAIT_V
#undef PG8_WAIT_L
#undef PG8_BAR
#undef PG8_SCHED
}
}
constexpr int NWAVES = 8;
constexpr int S = 8192, DM = 2048, NH = 16, HD = 128, FF = 8192, NBLK = 32, BLK = 256, DEPTH = 4;
constexpr int NQKV = 3 * DM;
constexpr int BIAS_LD = 8448;
constexpr int NPHASE = 30;
#ifndef DBG_MASK
#define DBG_MASK 0xffff
#endif
#define DBG(b) ((DBG_MASK >> (b)) & 1)
#ifndef REP_MASK
#define REP_MASK 0
#endif
#define NREP(b) (((REP_MASK >> (b)) & 1) ? 2 : 1)
#ifndef MK_PER_PHASE
#define MK_PER_PHASE 0
#endif
constexpr size_t MiB = 1u << 20;
constexpr size_t WS_CTL = 0, CTL_ZERO_BYTES = 1 * MiB;
constexpr size_t WS_WQKV = 2 * MiB;
constexpr size_t WS_WO   = WS_WQKV + 48 * MiB;
constexpr size_t WS_WIN  = WS_WO + 16 * MiB;
constexpr size_t WS_WOUT = WS_WIN + 32 * MiB;
constexpr size_t WS_W1   = WS_WOUT + 16 * MiB;
constexpr size_t WS_W2   = WS_W1 + 128 * MiB;
constexpr size_t WS_X    = WS_W2 + 128 * MiB;
constexpr size_t WS_XQ   = WS_X;
constexpr size_t WS_FROW = WS_X + 16 * MiB;
constexpr size_t WS_RSTD = WS_FROW + 65536;
constexpr size_t WS_SW   = WS_X + 17 * MiB;
constexpr int SW_QKV = 0, SW_WIN = 2 * 6144, SW_W1 = SW_WIN + 2 * 4096;
constexpr int SW_T2 = 65536, SW_CS2 = SW_T2 + 4 * 2048, SW_SS = SW_CS2 + 4 * 2048, SW_CL = SW_SS + 4 * 8192;
#ifndef DQ_MASK
#define DQ_MASK 12
#endif
static_assert((DQ_MASK & 1) == 0 && DQ_MASK < 16, "layer 0's hidden step would be needed in the phase that computes the column norms");
constexpr size_t WS_W2Q_OFF = 64;
constexpr size_t WS_XB   = WS_X + 64 * MiB;
constexpr size_t WS_QKV  = WS_XB + 32 * MiB;
constexpr size_t WS_AO   = WS_QKV + 96 * MiB;
constexpr size_t WS_HID  = WS_AO + 32 * MiB;
constexpr size_t WS_SSQ  = WS_HID + 128 * MiB;
constexpr size_t WS_KMP  = WS_SSQ + 9 * MiB;
constexpr size_t WS_LSE  = WS_KMP + 1 * MiB;
constexpr size_t WS_LIST = WS_LSE + 2 * MiB;
constexpr size_t WS_BIAS = WS_LIST + 16 * MiB;
constexpr size_t WS_CARRY = WS_BIAS + 1 * MiB;
constexpr size_t WS_WG   = WS_CARRY + 2 * MiB;
constexpr size_t WS_END  = WS_WG + 2 * MiB;
constexpr int CW_TMO = 0, CW_CODE = 1;
constexpr int CW_BAR = 4096;
constexpr int CW_CNT = 16384;
constexpr int RING_OFF = 0, RING_BYTES = 155392;
constexpr int LDSCTL_OFF = RING_BYTES, MISC_OFF = LDSCTL_OFF + 320;
constexpr int LDS_BYTES = 157696;
#define GAS __attribute__((address_space(1)))
#define LAS __attribute__((address_space(3)))
typedef unsigned short bf16;
typedef unsigned v4u __attribute__((ext_vector_type(4)));
typedef float f32x4 __attribute__((ext_vector_type(4)));
typedef short bf16x8 __attribute__((ext_vector_type(8)));
typedef GAS unsigned gu32;
typedef GAS unsigned long long gu64;
#define RLX_AGENT __ATOMIC_RELAXED, __HIP_MEMORY_SCOPE_AGENT
#define LDS_WAIT() asm volatile("s_waitcnt lgkmcnt(0)" ::: "memory")
#define VM_WAIT() asm volatile("s_waitcnt vmcnt(0)" ::: "memory")
__device__ __forceinline__ unsigned long long rt() { return __builtin_amdgcn_s_memrealtime(); }
__device__ __forceinline__ unsigned f2bf(float f) { unsigned u = __builtin_bit_cast(unsigned, f); return (u + 0x7fffu + ((u >> 16) & 1u)) >> 16; }
__device__ __forceinline__ unsigned pk2(float lo, float hi) { return f2bf(lo) | (f2bf(hi) << 16); }

#define XB_TMO      128
#define XB_XCNT(j)  (256  + 64 * (j))
#define XB_XSUB(j)  (1280 + 64 * (j))
#define XB_XGEN(j)  (2304 + 64 * (j))
#define XB_TOP      3328
#define XB_TOPGEN   3392
#define XCD_BAR_WORDS 3456
#define XB_SPIN_CAP (1u << 22)

__device__ __forceinline__ unsigned xb_ld(unsigned* p)              { return __hip_atomic_load(p, __ATOMIC_RELAXED, __HIP_MEMORY_SCOPE_AGENT); }
__device__ __forceinline__ unsigned xb_add(unsigned* p, unsigned v) { return __hip_atomic_fetch_add(p, v, __ATOMIC_RELAXED, __HIP_MEMORY_SCOPE_AGENT); }
__device__ __forceinline__ unsigned xb_xcc_id() { return (unsigned)__builtin_amdgcn_s_getreg((3 << 11) | 20) & 0xFu; }
#define XB_SPIN(cond, bar) do { unsigned _sp = 0; while (cond) { __builtin_amdgcn_s_sleep(1); \
    if ((++_sp & 255u) == 0u) { if (xb_ld(&(bar)[XB_TMO])) break; if (_sp > XB_SPIN_CAP) { atomicAdd(&(bar)[XB_TMO], 1u); break; } } } } while (0)

struct XcdBarrier {
    unsigned* bar; unsigned x;
    volatile LAS unsigned* st;
};

__device__ __forceinline__ XcdBarrier xcd_barrier_post(unsigned* bar, volatile LAS unsigned* st) {
    XcdBarrier b; b.bar = bar; b.x = xb_xcc_id(); b.st = st;
    if (threadIdx.x == 0) (void)xb_add(&bar[XB_XCNT(b.x)], 1u);
    return b;
}
__device__ __forceinline__ void xcd_barrier_complete(unsigned* bar, unsigned x, unsigned& nloc, unsigned& nx) {
    const unsigned G = gridDim.x * gridDim.y * gridDim.z;
    unsigned sum, cnt, mine, sp = 0u;
    for (;;) {
        sum = 0u; cnt = 0u; mine = 0u;
#pragma unroll
        for (unsigned j = 0; j < 16; ++j) { const unsigned c = xb_ld(&bar[XB_XCNT(j)]); sum += c; cnt += (c > 0u) ? 1u : 0u; mine = (j == x) ? c : mine; }
        if (sum == G) break;
        __builtin_amdgcn_s_sleep(1);
        if ((++sp & 255u) == 0u) { if (xb_ld(&bar[XB_TMO])) break; if (sp > XB_SPIN_CAP) { atomicAdd(&bar[XB_TMO], 1u); break; } }
    }
    nloc = mine > 0u ? mine : 1u; nx = cnt > 0u ? cnt : 1u;
}

__device__ __forceinline__ void xcd_barrier(const XcdBarrier& b) {
    asm volatile("s_waitcnt vmcnt(0)" ::: "memory");
    __syncthreads();
    if (threadIdx.x == 0) {
        unsigned* bar = b.bar;
        __builtin_amdgcn_s_waitcnt(0);
        unsigned nloc = b.st[0], nx = b.st[1];
        if (nloc == 0u) { xcd_barrier_complete(bar, b.x, nloc, nx); b.st[0] = nloc; b.st[1] = nx; }
        const unsigned old = xb_add(&bar[XB_XSUB(b.x)], 1u);
        const unsigned gen = old / nloc;
        if (old + 1u == (gen + 1u) * nloc) {
            __builtin_amdgcn_fence(__ATOMIC_RELEASE, "agent");
            asm volatile("s_waitcnt vmcnt(0)" ::: "memory");
            const unsigned og = xb_add(&bar[XB_TOP], 1u);
            const unsigned tg = og / nx;
            if (og + 1u == (tg + 1u) * nx) xb_add(&bar[XB_TOPGEN], 1u);
            else XB_SPIN(xb_ld(&bar[XB_TOPGEN]) == tg, bar);
            __builtin_amdgcn_fence(__ATOMIC_ACQUIRE, "agent");
            xb_add(&bar[XB_XGEN(b.x)], 1u);
            asm volatile("s_waitcnt vmcnt(0)" ::: "memory");
        } else {
            XB_SPIN(xb_ld(&bar[XB_XGEN(b.x)]) == gen, bar);
            __builtin_amdgcn_fence(__ATOMIC_ACQUIRE, "agent");
            asm volatile("s_waitcnt vmcnt(0)" ::: "memory");
        }
    }
    __syncthreads();
}
typedef unsigned short bf16;
typedef unsigned v4u __attribute__((ext_vector_type(4)));
typedef unsigned v2u __attribute__((ext_vector_type(2)));
typedef float f32x2 __attribute__((ext_vector_type(2)));
__device__ __forceinline__ float bf2f(unsigned short b) { return __builtin_bit_cast(float, (unsigned)b << 16); }
__device__ __forceinline__ float bflo(unsigned u) { return __builtin_bit_cast(float, u << 16); }
__device__ __forceinline__ float bfhi(unsigned u) { return __builtin_bit_cast(float, u & 0xffff0000u); }
__device__ __forceinline__ float wave_sum(float v) {
#pragma unroll
    for (int o = 1; o < 64; o <<= 1) v += __shfl_xor(v, o);
    return v;
}
__device__ __forceinline__ float wave_max(float v) {
#pragma unroll
    for (int o = 1; o < 64; o <<= 1) v = fmaxf(v, __shfl_xor(v, o));
    return v;
}
struct Args { const float* in[18]; float* out; unsigned char* ws; int ph_lo, ph_hi; };
struct Frame {
    LAS unsigned char* lds; unsigned char* ldsg;
    volatile LAS unsigned* MISC;
    gu32* ctl;
    int tid, lane, wave, G, bid;
    unsigned char* ws;
};
__device__ __forceinline__ int pass_row(const Frame& F, int wave, int k) {
    return F.G == 256 ? (8 * ((F.bid % 8) / 2) + (F.bid / 8) % 8) * 256 + ((F.bid % 2) * 4 + F.bid / 64) * 32 + wave * 4 + k : (F.bid * NWAVES + wave) + k * (F.G * NWAVES); }
__device__ __forceinline__ int pass_nrows(const Frame& F, int wave) { const int gw = F.bid * NWAVES + wave, NGW = F.G * NWAVES; return F.G == 256 ? 4 : (gw < S ? (S - gw + NGW - 1) / NGW : 0); }

struct TrItem { const float* W; bf16* WT; const float* gain; int K, N, item; };
__device__ __forceinline__ void tr_load(const TrItem& t, int lane, f32x4 (&v)[16]) {
    const int nb = t.N >> 6, kb = t.item / nb, nbi = t.item - kb * nb, k0 = kb * 64, n0 = nbi * 64;
#pragma unroll
    for (int i = 0; i < 16; ++i) v[i] = __builtin_nontemporal_load((const f32x4*)(t.W + (size_t)(k0 + 4 * i + (lane >> 4)) * t.N + n0 + (lane & 15) * 4));
}
__device__ __forceinline__ void tr_store(const TrItem& t, int lane, const f32x4 (&v)[16], LAS float* scr) {
    const int nb = t.N >> 6, kb = t.item / nb, nbi = t.item - kb * nb, k0 = kb * 64, n0 = nbi * 64;
#pragma unroll
    for (int i = 0; i < 16; ++i) { LAS float* s = scr + (4 * i + (lane >> 4)) * 65 + (lane & 15) * 4; s[0] = v[i][0]; s[1] = v[i][1]; s[2] = v[i][2]; s[3] = v[i][3]; }
    LDS_WAIT(); asm volatile("" ::: "memory");
    const int c = lane & 7;
    float g[8];
#pragma unroll
    for (int i = 0; i < 8; ++i) g[i] = t.gain ? t.gain[k0 + 8 * c + i] : 1.0f;
#pragma unroll
    for (int j = 0; j < 8; ++j) { const int n = (lane >> 3) + 8 * j; const LAS float* s = scr + (8 * c) * 65 + n;
        v4u o; o.x = pk2(s[0 * 65] * g[0], s[1 * 65] * g[1]); o.y = pk2(s[2 * 65] * g[2], s[3 * 65] * g[3]); o.z = pk2(s[4 * 65] * g[4], s[5 * 65] * g[5]); o.w = pk2(s[6 * 65] * g[6], s[7 * 65] * g[7]);
        *(GAS v4u*)(t.WT + (size_t)(n0 + n) * t.K + k0 + 8 * c) = o; }
    LDS_WAIT(); asm volatile("" ::: "memory");
}
__device__ __forceinline__ int t5_bucket(int d) {
    if (d < 16) return d;
    const unsigned d2 = (unsigned)d * (unsigned)d; const int msb = 31 - __builtin_clz(d2);
    const int b = 16 + msb - 8; return b > 31 ? 31 : b;
}
__device__ __forceinline__ unsigned pack_i8x4(float a, float b, float c, float d) {
    const int ia = (int)__builtin_rintf(a), ib = (int)__builtin_rintf(b), ic = (int)__builtin_rintf(c), id = (int)__builtin_rintf(d);
    return ((unsigned)ia & 255u) | (((unsigned)ib & 255u) << 8) | (((unsigned)ic & 255u) << 16) | ((unsigned)id << 24);
}
__device__ __forceinline__ void st_ld(const float* W, int N, int k0, int n0, int lane, f32x4 (&v)[16]) {
    const float* p = W + (size_t)(k0 + (lane >> 4)) * N + n0 + (lane & 15) * 4; asm volatile("" : "+v"(p));
#pragma unroll
    for (int i = 0; i < 16; ++i) { v[i] = __builtin_nontemporal_load((const f32x4*)p); p += (size_t)4 * N; }
}
__device__ __forceinline__ void st_pk(const f32x4 (&v)[16], int k0, const LAS float* gl, int lane, unsigned (&h)[32], f32x4& cm) {
#pragma unroll
    for (int i = 0; i < 16; ++i) { const float g = gl[k0 + 4 * i + (lane >> 4)];
        const unsigned p0 = pg8::cvt_pk_bf16(v[i][0] * g, v[i][1] * g), p1 = pg8::cvt_pk_bf16(v[i][2] * g, v[i][3] * g); h[2 * i] = p0; h[2 * i + 1] = p1;
        cm[0] = fmaxf(cm[0], fabsf(bflo(p0))); cm[1] = fmaxf(cm[1], fabsf(bfhi(p0))); cm[2] = fmaxf(cm[2], fabsf(bflo(p1))); cm[3] = fmaxf(cm[3], fabsf(bfhi(p1))); }
    asm volatile("" ::: "memory"); __builtin_amdgcn_sched_barrier(0);
}
__device__ __forceinline__ void st_quant(const unsigned (&h)[32], f32x4 inv4, int k0, int n0, int lane, LAS float* scr, unsigned char* WQ) {
#pragma unroll
    for (int i = 0; i < 16; ++i) { LAS float* sp = scr + (4 * i + (lane >> 4)) * 65 + (lane & 15) * 4;
        sp[0] = bflo(h[2 * i]) * inv4[0]; sp[1] = bfhi(h[2 * i]) * inv4[1]; sp[2] = bflo(h[2 * i + 1]) * inv4[2]; sp[3] = bfhi(h[2 * i + 1]) * inv4[3]; }
    LDS_WAIT(); asm volatile("" ::: "memory");
    const int c = lane & 7;
#pragma unroll
    for (int j = 0; j < 8; ++j) { const int n = (lane >> 3) + 8 * j; const LAS float* sp = scr + (8 * c) * 65 + n;
        v2u o; o.x = pack_i8x4(sp[0 * 65], sp[1 * 65], sp[2 * 65], sp[3 * 65]); o.y = pack_i8x4(sp[4 * 65], sp[5 * 65], sp[6 * 65], sp[7 * 65]);
        *(GAS v2u*)(WQ + (size_t)(n0 + n) * DM + k0 + 8 * c) = o;
        if (j & 1) { asm volatile("" ::: "memory"); __builtin_amdgcn_sched_barrier(0); } }
    LDS_WAIT(); asm volatile("" ::: "memory");
}
__device__ __forceinline__ void p0_strips(const Args& A, Frame& F) {
    int tid = F.wave * 64 + lane_id_v(); asm volatile("" : "+v"(tid)); const int lane = tid & 63, wave = __builtin_amdgcn_readfirstlane(tid >> 6); (void)lane; (void)wave;
    LAS float* scr = (LAS float*)(F.lds + RING_OFF + wave * 16640);
    LAS float* cmx = (LAS float*)(F.lds + RING_OFF + 133120);
    LAS float* gl = (LAS float*)(F.lds + RING_OFF + 137216);
    const int gw = F.bid * NWAVES + wave, NGW = F.G * NWAVES;
    const float* mixn = A.in[2]; const float* mlpn = A.in[3];
    float* SWb = (float*)(F.ws + WS_SW);
    constexpr int NS_QKV = 2 * 96, NS_1 = 4 * 128, NSTRIP = NS_QKV + NS_1;
    struct SD { const float* W; const float* gain; unsigned char* WQ; float* SW; int N, n0; };
    auto dec = [&](int si) -> SD { SD d;
        if (si < NS_QKV) { const int j = si / 96, c = si - j * 96; d.W = A.in[5] + (size_t)j * DM * NQKV; d.gain = mixn + (2 * j) * DM; d.WQ = F.ws + WS_WQKV + (size_t)j * NQKV * DM; d.SW = SWb + SW_QKV + j * NQKV; d.N = NQKV; d.n0 = c * 64; }
        else { const int r = si - NS_QKV, l = r >> 7, c = r & 127; d.W = A.in[16] + (size_t)l * DM * FF; d.gain = mlpn + l * DM; d.WQ = F.ws + WS_W1 + (size_t)l * FF * DM; d.SW = SWb + SW_W1 + l * FF; d.N = FF; d.n0 = c * 64; }
        return d; };
    const int kb = wave * 256;
    int sp = 0;
    f32x4 v[16];
    if (F.bid < NSTRIP) { const SD d0 = dec(F.bid); st_ld(d0.W, d0.N, kb, d0.n0, lane, v); }
    for (int si = F.bid; si < NSTRIP; si += F.G, sp ^= 1) {
        const SD d = dec(si);
        __syncthreads();
#pragma unroll
        for (int i = 0; i < 4; ++i) gl[tid + 512 * i] = d.gain[tid + 512 * i];
        __syncthreads();
        unsigned hb[4][32]; f32x4 cm = (f32x4){0.f, 0.f, 0.f, 0.f};
        st_pk(v, kb, gl, lane, hb[0], cm);
#pragma unroll
        for (int t = 1; t < 4; ++t) { st_ld(d.W, d.N, kb + 64 * t, d.n0, lane, v); st_pk(v, kb + 64 * t, gl, lane, hb[t], cm); }
#pragma unroll
        for (int e = 0; e < 4; ++e) { float t = cm[e]; t = fmaxf(t, __shfl_xor(t, 16)); t = fmaxf(t, __shfl_xor(t, 32)); cm[e] = t; }
        if (lane < 16) *(LAS f32x4*)(cmx + (sp * 8 + wave) * 64 + lane * 4) = cm;
#pragma unroll
        for (int t = 0; t < 4; ++t)
#pragma unroll
            for (int k = 0; k < 32; ++k) asm volatile("" : "+v"(hb[t][k]));
        __syncthreads();
        f32x4 mx = *(const LAS f32x4*)(cmx + (sp * 8) * 64 + (lane & 15) * 4);
#pragma unroll
        for (int w = 1; w < 8; ++w) { const f32x4 t = *(const LAS f32x4*)(cmx + (sp * 8 + w) * 64 + (lane & 15) * 4);
#pragma unroll
            for (int e = 0; e < 4; ++e) mx[e] = fmaxf(mx[e], t[e]); }
        f32x4 inv4;
#pragma unroll
        for (int e = 0; e < 4; ++e) inv4[e] = mx[e] > 1e-30f ? 127.0f / mx[e] : 0.f;
        if (wave == 0 && lane < 16) *(f32x4*)(d.SW + d.n0 + lane * 4) = mx * (1.0f / 127.0f);
        st_quant(hb[0], inv4, kb, d.n0, lane, scr, d.WQ);
        if (si + F.G < NSTRIP) { const SD dn = dec(si + F.G); st_ld(dn.W, dn.N, kb, dn.n0, lane, v); }
#pragma unroll
        for (int t = 1; t < 4; ++t) st_quant(hb[t], inv4, kb + 64 * t, d.n0, lane, scr, d.WQ);
    }
}
__device__ __forceinline__ void p0_tiles(const Args& A, Frame& F) {
    int tid = F.wave * 64 + lane_id_v(); asm volatile("" : "+v"(tid)); const int lane = tid & 63, wave = __builtin_amdgcn_readfirstlane(tid >> 6); (void)lane; (void)wave;
    LAS float* scr = (LAS float*)(F.lds + RING_OFF + wave * 16640);
    const int gw = F.bid * NWAVES + wave, NGW = F.G * NWAVES; (void)gw; (void)NGW; (void)scr;
    constexpr int NSTRIP = 2 * 96 + 4 * 128;
    constexpr int T_O = 32 * 32, T_2 = 128 * 32, T_IN = 32 * 64;
    constexpr int NB = 4 * T_O + 4 * T_2 + 256 + 2 * T_IN;
    auto decode = [&](int it) -> TrItem {
        int r = it; TrItem t;
        if (r >= 4 * T_O + 4 * T_2 + 256) { r -= 4 * T_O + 4 * T_2 + 256; const int j = r / T_IN; r -= j * T_IN;
            t.W = A.in[7] + (size_t)j * DM * 2 * DM; t.WT = (bf16*)(F.ws + WS_WIN) + (size_t)j * 2 * DM * DM; t.gain = A.in[2] + (2 * j + 1) * DM; t.K = DM; t.N = 2 * DM; t.item = r; return t; }
        if (r >= 4 * T_O + 4 * T_2) { r -= 4 * T_O + 4 * T_2; const int blk = r >> 2, jg = blk >> 4, j = jg >> 1, g = jg & 1, n = blk & 15;
            t.W = A.in[g ? 12 : 10] + ((size_t)j * 16 + n) * 16384; t.WT = (bf16*)(F.ws + WS_WG) + (((size_t)j * 2 + g) * 16 + n) * 16384; t.gain = nullptr; t.K = 128; t.N = 128; t.item = r & 3; return t; }
        if (r < 4 * T_O) { const int jj = r / T_O, j = jj & 1; r -= jj * T_O;
            if (jj < 2) { t.W = A.in[6] + (size_t)j * DM * DM; t.WT = (bf16*)(F.ws + WS_WO) + (size_t)j * DM * DM; }
            else { t.W = A.in[15] + (size_t)j * DM * DM; t.WT = (bf16*)(F.ws + WS_WOUT) + (size_t)j * DM * DM; }
            t.gain = nullptr; t.K = DM; t.N = DM; t.item = r; return t; }
        r -= 4 * T_O;
        const int l = r / T_2; r -= l * T_2;
        t.W = A.in[17] + (size_t)l * FF * DM; t.WT = (bf16*)(F.ws + WS_W2) + (size_t)l * DM * FF; t.gain = nullptr; t.K = FF; t.N = DM; t.item = r; return t;
    };
    {
        constexpr int SW_ = 32;
        const int per = (NSTRIP * SW_ + NB + F.G - 1) / F.G;
        int start = 0, cnt = 0;
        for (int b2 = 0; b2 <= F.bid; ++b2) { const int ns = b2 < NSTRIP ? (NSTRIP - b2 + F.G - 1) / F.G : 0; int q = per - SW_ * ns; q = q < 0 ? 0 : q; if (b2 < F.bid) start += q; else cnt = q; }
        int tot = start;
        for (int b2 = F.bid; b2 < F.G; ++b2) { const int ns = b2 < NSTRIP ? (NSTRIP - b2 + F.G - 1) / F.G : 0; int q = per - SW_ * ns; tot += q < 0 ? 0 : q; }
        int end = start + cnt; if (end > NB) end = NB; if (start > NB) start = NB;
        f32x4 va[16], vb[16];
        for (int pass = 0; pass < 2; ++pass) {
            const int first = pass == 0 ? start + wave : (tot < NB ? tot + gw : NB), lim = pass == 0 ? end : NB, step = pass == 0 ? NWAVES : NGW;
            if (first >= lim) continue;
            TrItem cur = decode(first); tr_load(cur, lane, va);
            for (int it = first; it < lim; it += 2 * step) {
                const bool h1 = it + step < lim; TrItem n1 = cur; if (h1) { n1 = decode(it + step); tr_load(n1, lane, vb); }
                tr_store(cur, lane, va, scr);
                if (!h1) break;
                const bool h2 = it + 2 * step < lim; if (h2) { cur = decode(it + 2 * step); tr_load(cur, lane, va); }
                tr_store(n1, lane, vb, scr);
                if (!h2) break;
            }
        }
    }
}
__device__ __forceinline__ void p0_x(const Args& A, Frame& F) {
    int tid = F.wave * 64 + lane_id_v(); asm volatile("" : "+v"(tid)); const int lane = tid & 63, wave = __builtin_amdgcn_readfirstlane(tid >> 6); (void)lane; (void)wave;
    LAS float* scr = (LAS float*)(F.lds + RING_OFF + wave * 16640);
    const int gw = F.bid * NWAVES + wave, NGW = F.G * NWAVES; (void)gw; (void)NGW; (void)scr;
    { const float* x = A.in[0]; bf16* XB = (bf16*)(F.ws + WS_XB); unsigned char* XQ = F.ws + WS_XQ; float* frow = (float*)(F.ws + WS_FROW);
      const int nk = pass_nrows(F, wave);
      for (int k0 = 0; k0 < nk; k0 += 4) {
          f32x4 v[4][8];
#pragma unroll
          for (int r = 0; r < 4; ++r) { const int m = pass_row(F, wave, k0 + r < nk ? k0 + r : k0); const GAS f32x4* xr = (const GAS f32x4*)(x + (size_t)m * DM) + lane;
#pragma unroll
              for (int j = 0; j < 8; ++j) v[r][j] = xr[64 * j]; }
#pragma unroll
          for (int r = 0; r < 4; ++r) { if (k0 + r >= nk) break; const int m = pass_row(F, wave, k0 + r);
              GAS v2u* xb = (GAS v2u*)(XB + (size_t)m * DM) + lane; GAS unsigned* xq = (GAS unsigned*)(XQ + (size_t)m * DM) + lane; float s = 0.f, am = 0.f;
#pragma unroll
              for (int j = 0; j < 8; ++j) { s += (v[r][j].x * v[r][j].x + v[r][j].y * v[r][j].y) + (v[r][j].z * v[r][j].z + v[r][j].w * v[r][j].w); am = fmaxf(fmaxf(am, fmaxf(fabsf(v[r][j].x), fabsf(v[r][j].y))), fmaxf(fabsf(v[r][j].z), fabsf(v[r][j].w)));
                  v2u o; o.x = pk2(v[r][j].x, v[r][j].y); o.y = pk2(v[r][j].z, v[r][j].w); xb[64 * j] = o; }
              s = wave_sum(s); am = wave_max(am);
              const float inv = am > 1e-30f ? 127.0f / am : 0.f;
#pragma unroll
              for (int j = 0; j < 8; ++j) xq[64 * j] = pack_i8x4(v[r][j].x * inv, v[r][j].y * inv, v[r][j].z * inv, v[r][j].w * inv);
              if (lane == 0) { const float rstd = __builtin_amdgcn_rsqf(s * (1.0f / 2048.0f) + 1e-6f); frow[m] = am * (1.0f / 127.0f) * rstd; ((float*)(F.ws + WS_RSTD))[m] = rstd; } } } }
    { const float* rb = A.in[1]; float* bt = (float*)(F.ws + WS_BIAS);
      for (int i = F.bid * (NWAVES * 64) + tid; i < NH * BIAS_LD; i += F.G * NWAVES * 64) { const int h = i / BIAS_LD, d = i - h * BIAS_LD - 256;
          bt[i] = d < 0 ? -INFINITY : rb[t5_bucket(d) * NH + h] * 1.4426950408889634f; } }
}
__device__ __forceinline__ void p0_prologue(const Args& A, Frame& F) { p0_strips(A, F); p0_tiles(A, F); p0_x(A, F); }
#define TOP3_INS(x_, j_) do { const float x__ = (x_); const int j__ = (j_); const bool b0 = x__ > v0, b1 = x__ > v1, b2 = x__ > v2; \
    v2 = b1 ? v1 : (b2 ? x__ : v2); i2 = b1 ? i1 : (b2 ? j__ : i2); v1 = b0 ? v0 : (b1 ? x__ : v1); i1 = b0 ? i0 : (b1 ? j__ : i1); v0 = b0 ? x__ : v0; i0 = b0 ? j__ : i0; } while (0)
__device__ __forceinline__ void phase_gate(const Args& A, Frame& F, int ja) {
    int tid = F.wave * 64 + lane_id_v(); asm volatile("" : "+v"(tid)); const int lane = tid & 63, wave = __builtin_amdgcn_readfirstlane(tid >> 6); (void)lane; (void)wave;
    const bf16* QKV = (const bf16*)(F.ws + WS_QKV); const float* KMP = (const float*)(F.ws + WS_KMP);
    unsigned* cnt = (unsigned*)(F.ctl + CW_CNT + ja * 512); unsigned* list = (unsigned*)(F.ws + WS_LIST); float* LSE = (float*)(F.ws + WS_LSE);
    LAS float* km = (LAS float*)(F.lds + RING_OFF);
    LAS float* cv = km + 32 * 128;
    LAS int* ci = (LAS int*)(cv + 256 * 3);
    for (int item = F.bid; item < 512; item += F.G) {
        const int h = item & 15, c = item >> 4;
        for (int i = tid; i < 32 * 128; i += NWAVES * 64) { const int jb = i >> 7, d = i & 127;
            km[i] = (KMP[(size_t)jb * 2048 + h * 128 + d] + KMP[(size_t)(32 + jb) * 2048 + h * 128 + d]) * (1.0f / 256.0f); }
        __syncthreads();
        const int t = tid & 255, half = tid >> 8, q = c * 256 + t;
        float g[16];
#pragma unroll
        for (int jb = 0; jb < 16; ++jb) g[jb] = 0.f;
        const bf16* qp = QKV + (size_t)q * NQKV + h * HD;
        const LAS float* kmh = km + half * 16 * 128;
#pragma unroll 1
        for (int d0 = 0; d0 < 128; d0 += 8) {
            const v4u qv = *(const v4u*)(qp + d0);
            const float q0 = bflo(qv.x), q1 = bfhi(qv.x), q2 = bflo(qv.y), q3 = bfhi(qv.y), q4 = bflo(qv.z), q5 = bfhi(qv.z), q6 = bflo(qv.w), q7 = bfhi(qv.w);
#pragma unroll
            for (int jb = 0; jb < 16; ++jb) { const f32x4 k0 = *(const LAS f32x4*)(kmh + jb * 128 + d0), k1 = *(const LAS f32x4*)(kmh + jb * 128 + d0 + 4);
                g[jb] += (q0 * k0[0] + q1 * k0[1]) + (q2 * k0[2] + q3 * k0[3]) + (q4 * k1[0] + q5 * k1[1]) + (q6 * k1[2] + q7 * k1[3]);
                if ((jb & 3) == 3) __builtin_amdgcn_sched_barrier(0); }
        }
        float v0 = -INFINITY, v1 = -INFINITY, v2 = -INFINITY; int i0 = -1, i1 = -1, i2 = -1;
#pragma unroll
        for (int jb = 0; jb < 16; ++jb) { const int j = half * 16 + jb; if (j < c) TOP3_INS(g[jb], j); }
        if (half == 1) { cv[t * 3 + 0] = v0; cv[t * 3 + 1] = v1; cv[t * 3 + 2] = v2; ci[t * 3 + 0] = i0; ci[t * 3 + 1] = i1; ci[t * 3 + 2] = i2; }
        __syncthreads();
        if (half == 0) {
            { const int j = ci[t * 3 + 0]; if (j >= 0) TOP3_INS(cv[t * 3 + 0], j); }
            { const int j = ci[t * 3 + 1]; if (j >= 0) TOP3_INS(cv[t * 3 + 1], j); }
            { const int j = ci[t * 3 + 2]; if (j >= 0) TOP3_INS(cv[t * 3 + 2], j); }
#define EMIT_PICK(k_, sj_) do { if ((sj_) >= 0) { const unsigned pos = atomicAdd(&cnt[h * 32 + (sj_)], 1u); list[(size_t)(h * 32 + (sj_)) * 8192 + pos] = ((unsigned)q << 2) | (unsigned)(k_); } \
                else LSE[((size_t)q * NH + h) * 4 + (k_)] = -INFINITY; } while (0)
            EMIT_PICK(0, i0); EMIT_PICK(1, i1); EMIT_PICK(2, i2);
#undef EMIT_PICK
        }
        __syncthreads();
    }
}
__device__ __forceinline__ void attn_entry(const Args& A, Frame& F, int q, int h, int jb, int slot) {
    int tid = F.wave * 64 + lane_id_v(); asm volatile("" : "+v"(tid)); const int lane = tid & 63, wave = __builtin_amdgcn_readfirstlane(tid >> 6); (void)lane; (void)wave;
    const bf16* QKV = (const bf16*)(F.ws + WS_QKV); const int l = lane;
    const bf16* qp = QKV + (size_t)q * NQKV + h * HD;
    const bf16* Kb = QKV + (size_t)(jb * BLK) * NQKV + DM + h * HD; const bf16* Vb = Kb + DM;
    float s[4] = {0.f, 0.f, 0.f, 0.f};
    for (int d0 = 0; d0 < 128; d0 += 8) {
        const v4u qv = *(const v4u*)(qp + d0);
        const float q0 = bflo(qv.x), q1 = bfhi(qv.x), q2 = bflo(qv.y), q3 = bfhi(qv.y), q4 = bflo(qv.z), q5 = bfhi(qv.z), q6 = bflo(qv.w), q7 = bfhi(qv.w);
#pragma unroll
        for (int kk = 0; kk < 4; ++kk) { const v4u kv = *(const v4u*)(Kb + (size_t)(l + 64 * kk) * NQKV + d0);
            s[kk] += (q0 * bflo(kv.x) + q1 * bfhi(kv.x)) + (q2 * bflo(kv.y) + q3 * bfhi(kv.y)) + (q4 * bflo(kv.z) + q5 * bfhi(kv.z)) + (q6 * bflo(kv.w) + q7 * bfhi(kv.w)); }
    }
    const float C = 0.088388347648318440f * 1.4426950408889634f;
    const float* bt = (const float*)(F.ws + WS_BIAS) + h * BIAS_LD + 256;
    float t[4], m = -INFINITY;
#pragma unroll
    for (int kk = 0; kk < 4; ++kk) { const int d = q - (jb * BLK + l + 64 * kk); t[kk] = s[kk] * C + bt[d]; m = fmaxf(m, t[kk]); }
    m = wave_max(m);
    float p[4], ls = 0.f;
#pragma unroll
    for (int kk = 0; kk < 4; ++kk) { p[kk] = __builtin_amdgcn_exp2f(t[kk] - m); ls += p[kk]; }
    ls = wave_sum(ls);
    const int c0 = 64 * (l >> 5) + (l & 31);
    float o0 = 0.f, o1 = 0.f;
#pragma unroll
    for (int kk = 0; kk < 4; ++kk)
        for (int src = 0; src < 64; ++src) { const float pk = __shfl(p[kk], src); const bf16* vr = Vb + (size_t)(src + 64 * kk) * NQKV;
            o0 += pk * bf2f(vr[c0]); o1 += pk * bf2f(vr[c0 + 32]); }
    const float inv = 1.0f / ls;
    unsigned* PART = (unsigned*)(F.ws + WS_HID); float* LSE = (float*)(F.ws + WS_LSE);
    const size_t e = ((size_t)q * NH + h) * 4 + slot;
    PART[e * 64 + l] = pk2(o0 * inv, o1 * inv);
    if (l == 0) LSE[e] = m + __builtin_amdgcn_logf(ls);
}
__device__ __forceinline__ void phase_attn(const Args& A, Frame& F, int ja) {
    int tid = F.wave * 64 + lane_id_v(); asm volatile("" : "+v"(tid)); const int lane = tid & 63, wave = __builtin_amdgcn_readfirstlane(tid >> 6); (void)lane; (void)wave;
    const unsigned* cnt = (const unsigned*)(F.ctl + CW_CNT + ja * 512); const unsigned* list = (const unsigned*)(F.ws + WS_LIST);
    LAS unsigned* pre = (LAS unsigned*)(F.lds + RING_OFF);
    LAS unsigned* cl = pre + 520;
    for (int i = tid; i < 512; i += NWAVES * 64) cl[i] = __hip_atomic_load(cnt + i, RLX_AGENT);
    __syncthreads();
    if (tid == 0) { unsigned a = 0; for (int i = 0; i < 512; ++i) { pre[i] = a; a += (cl[i] + 7u) >> 3; } pre[512] = a; }
    __syncthreads();
    const int total = (int)pre[512];
    for (int tile = F.bid; tile < total + S * NH / 8; tile += F.G) {
        if (tile < total) {
            int lo = 0, hi = 512;
            while (hi - lo > 1) { const int mid = (lo + hi) >> 1; if ((int)pre[mid] <= tile) lo = mid; else hi = mid; }
            const int e = (tile - (int)pre[lo]) * 8 + wave;
            if (e < (int)cl[lo]) { const unsigned ent = list[(size_t)lo * 8192 + e]; attn_entry(A, F, (int)(ent >> 2), lo >> 5, lo & 31, (int)(ent & 3u)); }
        } else { const int e = (tile - total) * 8 + wave; const int q = e >> 4, h = e & 15; attn_entry(A, F, q, h, q >> 8, 3); }
    }
}
namespace at {
using bf16x8 = __attribute__((ext_vector_type(8))) short;
using s16x4  = __attribute__((ext_vector_type(4))) short;
using f32x16 = __attribute__((ext_vector_type(16))) float;
using u32x4  = __attribute__((ext_vector_type(4))) unsigned;
constexpr int KVBLK = 64, LDK = NQKV;
constexpr int SHM_V = KVBLK * 128 * 2, SHM_K = KVBLK * 128 * 2;
constexpr int OFF_V = 0, OFF_K = 2 * SHM_V, OFF_WS = OFF_K + 2 * SHM_K, OFF_DST = OFF_WS + 8 * 256, OFF_BT = OFF_DST + 8 * 128, OFF_PRE = OFF_BT + BIAS_LD * 4, OFF_CL = OFF_PRE + 1032 * 4, OFF_WT = OFF_CL + 512 * 4, OFF_END = OFF_WT + 64;
static_assert(OFF_END <= RING_BYTES, "attention LDS map");
#define KSWZ(row, colB) ((row) * 256 + ((colB) ^ (((row) & 7) << 4)))
#define SBAR() __builtin_amdgcn_sched_barrier(0)
__device__ __forceinline__ int crow(int r, int hi) { return (r & 3) + 8 * (r >> 2) + 4 * hi; }
__device__ __forceinline__ unsigned cvtpk(float lo, float hi) { unsigned r; asm volatile("v_cvt_pk_bf16_f32 %0, %1, %2" : "=v"(r) : "v"(lo), "v"(hi)); return r; }
__device__ __forceinline__ void partialSM(f32x16& p0, f32x16& p1, const LAS float* bp, float& m_reg, float& alpha) {
    constexpr float C = 0.088388347648318440f * 1.4426950408889634f;
#pragma unroll
    for (int r = 0; r < 16; ++r) p0[r] = fmaf(p0[r], C, bp[59 - ((r & 3) + 8 * (r >> 2))]);
#pragma unroll
    for (int r = 0; r < 16; ++r) p1[r] = fmaf(p1[r], C, bp[27 - ((r & 3) + 8 * (r >> 2))]);
    float pmax = p0[0];
#pragma unroll
    for (int r = 1; r < 16; ++r) pmax = fmaxf(pmax, p0[r]);
#pragma unroll
    for (int r = 0; r < 16; ++r) pmax = fmaxf(pmax, p1[r]);
    { auto rr = __builtin_amdgcn_permlane32_swap(__float_as_uint(pmax), __float_as_uint(pmax), false, false); pmax = fmaxf(__uint_as_float(rr[0]), __uint_as_float(rr[1])); }
    float mn = m_reg; alpha = 1.f;
    if (!__all(pmax <= m_reg + 8.0f)) { const bool up = pmax > m_reg + 8.0f;
        mn = up ? pmax : m_reg; alpha = up ? __builtin_amdgcn_exp2f(m_reg - mn) : 1.f; m_reg = mn; }
#pragma unroll
    for (int r = 0; r < 16; ++r) p0[r] -= mn;
#pragma unroll
    for (int r = 0; r < 16; ++r) p1[r] -= mn;
#pragma unroll
    for (int r = 0; r < 16; ++r) p0[r] = __builtin_amdgcn_exp2f(p0[r]);
}
__device__ __forceinline__ void finishSM(f32x16& p0, f32x16& p1, float alpha, float& l_reg, bf16x8& pa0, bf16x8& pa1, bf16x8& pa2, bf16x8& pa3) {
#pragma unroll
    for (int r = 0; r < 16; ++r) p1[r] = __builtin_amdgcn_exp2f(p1[r]);
    float ps = 0;
#pragma unroll
    for (int r = 0; r < 16; ++r) ps += p0[r];
#pragma unroll
    for (int r = 0; r < 16; ++r) ps += p1[r];
    { auto rr = __builtin_amdgcn_permlane32_swap(__float_as_uint(ps), __float_as_uint(ps), false, false); ps = __uint_as_float(rr[0]) + __uint_as_float(rr[1]); }
    l_reg = l_reg * alpha + ps;
#define PK4(P, BASE, OUT) do { unsigned a0 = cvtpk(P[BASE + 0], P[BASE + 1]), a1 = cvtpk(P[BASE + 2], P[BASE + 3]);   \
    unsigned b0 = cvtpk(P[BASE + 4], P[BASE + 5]), b1 = cvtpk(P[BASE + 6], P[BASE + 7]);                              \
    auto r0 = __builtin_amdgcn_permlane32_swap(a0, b0, false, false); auto r1 = __builtin_amdgcn_permlane32_swap(a1, b1, false, false); \
    u32x4 w = {r0[0], r1[0], r0[1], r1[1]}; OUT = *reinterpret_cast<bf16x8*>(&w); } while (0)
    PK4(p0, 0, pa0); PK4(p0, 8, pa1); PK4(p1, 0, pa2); PK4(p1, 8, pa3);
#undef PK4
}
__device__ __forceinline__ void qkt(f32x16& p0, f32x16& p1, const LAS unsigned char* Ks, const bf16x8* qr, int r32, int hi) {
    p0 = f32x16{}; p1 = f32x16{};
#pragma unroll
    for (int d0 = 0; d0 < 8; ++d0) { const int cb = (d0 * 16 + hi * 8) * 2;
        const bf16x8 b0 = *reinterpret_cast<const LAS bf16x8*>(Ks + KSWZ(r32, cb));
        const bf16x8 b1 = *reinterpret_cast<const LAS bf16x8*>(Ks + KSWZ(32 + r32, cb));
        p0 = __builtin_amdgcn_mfma_f32_32x32x16_bf16(b0, qr[d0], p0, 0, 0, 0);
        p1 = __builtin_amdgcn_mfma_f32_32x32x16_bf16(b1, qr[d0], p1, 0, 0, 0); }
}
__device__ __forceinline__ int v_st(int k, int c) { const int kk = (k & ~0xC) | ((k & 4) << 1) | ((k & 8) >> 1); return ((kk >> 3) * 4 + (c >> 5)) * 512 + ((kk & 7) * 32 + (c & 31)) * 2; }
__device__ __forceinline__ int v_rd_base(int lane) { return ((lane & 3) << 3) | (((lane >> 2) & 3) << 6) | (((lane >> 4) & 1) << 5) | (((lane >> 5) & 1) << 8); }
constexpr int v_rd_off(int d0, int ks, int half) { return d0 * 512 + ks * 4096 + half * 2048; }
template <int OFF> __device__ __forceinline__ s16x4 tr_read(int vb) { s16x4 r; asm volatile("ds_read_b64_tr_b16 %0, %1 offset:%2" : "=&v"(r) : "v"(vb), "i"(OFF) : "memory"); return r; }
template <int D0> __device__ __forceinline__ void pv_one(f32x16& od, int vb, bf16x8 pa0, bf16x8 pa1, bf16x8 pa2, bf16x8 pa3) {
    const s16x4 l0 = tr_read<v_rd_off(D0, 0, 0)>(vb), h0 = tr_read<v_rd_off(D0, 0, 1)>(vb), l1 = tr_read<v_rd_off(D0, 1, 0)>(vb), h1 = tr_read<v_rd_off(D0, 1, 1)>(vb);
    const s16x4 l2 = tr_read<v_rd_off(D0, 2, 0)>(vb), h2 = tr_read<v_rd_off(D0, 2, 1)>(vb), l3 = tr_read<v_rd_off(D0, 3, 0)>(vb), h3 = tr_read<v_rd_off(D0, 3, 1)>(vb);
    asm volatile("s_waitcnt lgkmcnt(0)" ::: "memory"); SBAR();
#define PK(L, H) (bf16x8){L[0], L[1], L[2], L[3], H[0], H[1], H[2], H[3]}
    od = __builtin_amdgcn_mfma_f32_32x32x16_bf16(pa0, PK(l0, h0), od, 0, 0, 0);
    od = __builtin_amdgcn_mfma_f32_32x32x16_bf16(pa1, PK(l1, h1), od, 0, 0, 0);
    od = __builtin_amdgcn_mfma_f32_32x32x16_bf16(pa2, PK(l2, h2), od, 0, 0, 0);
    od = __builtin_amdgcn_mfma_f32_32x32x16_bf16(pa3, PK(l3, h3), od, 0, 0, 0);
#undef PK
}
__device__ __forceinline__ void pv_d0(f32x16* o, int vb, bf16x8 pa0, bf16x8 pa1, bf16x8 pa2, bf16x8 pa3) {
    pv_one<0>(o[0], vb, pa0, pa1, pa2, pa3); pv_one<1>(o[1], vb, pa0, pa1, pa2, pa3); pv_one<2>(o[2], vb, pa0, pa1, pa2, pa3); pv_one<3>(o[3], vb, pa0, pa1, pa2, pa3);
}
__device__ __forceinline__ void attn_unit(const bf16* __restrict__ QKV, int h, int jb, int q, int dsti, LAS unsigned char* lds, unsigned* __restrict__ PART, float* __restrict__ LSE, int tid) {
    const int wid = tid >> 6, lane = tid & 63, r32 = lane & 31, hi = lane >> 5;
    LAS unsigned char* V_lds = lds + OFF_V; LAS unsigned char* K_lds = lds + OFF_K;
    LAS float* ws = (LAS float*)(lds + OFF_WS) + wid * 64; LAS float* li_l = ws; LAS float* al_l = ws + 32;
    LAS int* dst_l = (LAS int*)(lds + OFF_DST) + wid * 32;
    const LAS float* bt = (const LAS float*)(lds + OFF_BT);
    const bf16* Kh = QKV + (size_t)(jb * BLK) * LDK + DM + h * HD; const bf16* Vh = Kh + DM;
    float m_reg = -1e30f, l_reg = 0; f32x16 o[4] = {}; bf16x8 qr[8];
    const bf16* Qw = QKV + (size_t)q * LDK + h * HD + hi * 8;
#pragma unroll
    for (int d0 = 0; d0 < 8; ++d0) qr[d0] = *reinterpret_cast<const bf16x8*>(Qw + d0 * 16);
    if (hi == 0) dst_l[r32] = dsti;
    const LAS float* bp0 = bt + (q - jb * BLK - 4 * hi + 256 - 59);
    const int sr = tid >> 4, sc = (tid & 15) * 8, vst0 = v_st(sr, sc), vst1 = v_st(32 + sr, sc);
    const int vb0 = (int)(uintptr_t)V_lds + v_rd_base(lane);
    struct { bf16x8 vs0, vs1, ks0, ks1; } sr_[2];
#define SLOAD(i, k0) do { sr_[i].vs0 = *reinterpret_cast<const bf16x8*>(&Vh[(size_t)((k0) + sr) * LDK + sc]); sr_[i].vs1 = *reinterpret_cast<const bf16x8*>(&Vh[(size_t)((k0) + 32 + sr) * LDK + sc]); \
    sr_[i].ks0 = *reinterpret_cast<const bf16x8*>(&Kh[(size_t)((k0) + sr) * LDK + sc]); sr_[i].ks1 = *reinterpret_cast<const bf16x8*>(&Kh[(size_t)((k0) + 32 + sr) * LDK + sc]); } while (0)
#define SWRITE(b, i) do { *(LAS bf16x8*)(V_lds + (b) * SHM_V + vst0) = sr_[i].vs0; *(LAS bf16x8*)(V_lds + (b) * SHM_V + vst1) = sr_[i].vs1; const int kc = sc * 2; \
    *(LAS bf16x8*)(K_lds + (b) * SHM_K + KSWZ(sr, kc)) = sr_[i].ks0; *(LAS bf16x8*)(K_lds + (b) * SHM_K + KSWZ(32 + sr, kc)) = sr_[i].ks1; } while (0)
#define SWAIT() asm volatile("s_waitcnt vmcnt(4)" ::: "memory")
#define RESC(a) do { if (__any((a) < 1.f)) { if (hi == 0) al_l[r32] = (a); asm volatile("s_waitcnt lgkmcnt(0)" ::: "memory"); \
    _Pragma("unroll") for (int d = 0; d < 4; ++d) _Pragma("unroll") for (int r = 0; r < 16; ++r) o[d][r] *= al_l[crow(r, hi)]; } } while (0)
    f32x16 pA0, pA1, pB0, pB1; float alA, alB; bf16x8 pa0, pa1, pa2, pa3;
    SLOAD(0, 0); asm volatile("s_waitcnt vmcnt(0)" ::: "memory"); SWRITE(0, 0); __syncthreads();
    qkt(pA0, pA1, K_lds, qr, r32, hi); partialSM(pA0, pA1, bp0, m_reg, alA);
    SLOAD(1, KVBLK); SLOAD(0, 2 * KVBLK);
    SWAIT(); SWRITE(1, 1); __syncthreads();
    SBAR(); qkt(pB0, pB1, K_lds + SHM_K, qr, r32, hi);
    finishSM(pA0, pA1, alA, l_reg, pa0, pa1, pa2, pa3); SBAR();
    SLOAD(1, 3 * KVBLK); SBAR();
    pv_d0(o, vb0, pa0, pa1, pa2, pa3); partialSM(pB0, pB1, bp0 - 64, m_reg, alB);
    __syncthreads(); SWAIT(); SWRITE(0, 0);
    RESC(alB); __syncthreads();
    SBAR(); qkt(pA0, pA1, K_lds, qr, r32, hi);
    finishSM(pB0, pB1, alB, l_reg, pa0, pa1, pa2, pa3); SBAR();
    pv_d0(o, vb0 + SHM_V, pa0, pa1, pa2, pa3); partialSM(pA0, pA1, bp0 - 128, m_reg, alA);
    __syncthreads(); asm volatile("s_waitcnt vmcnt(0)" ::: "memory"); SWRITE(1, 1);
    RESC(alA); __syncthreads();
    SBAR(); qkt(pB0, pB1, K_lds + SHM_K, qr, r32, hi);
    finishSM(pA0, pA1, alA, l_reg, pa0, pa1, pa2, pa3); SBAR();
    pv_d0(o, vb0, pa0, pa1, pa2, pa3); partialSM(pB0, pB1, bp0 - 192, m_reg, alB);
    RESC(alB);
    finishSM(pB0, pB1, alB, l_reg, pa0, pa1, pa2, pa3); SBAR();
    pv_d0(o, vb0 + SHM_V, pa0, pa1, pa2, pa3);
    if (hi == 0) { li_l[r32] = l_reg; if (dsti >= 0) LSE[dsti] = m_reg + __builtin_amdgcn_logf(l_reg); }
    asm volatile("s_waitcnt lgkmcnt(0)" ::: "memory");
#pragma unroll
    for (int r = 0; r < 16; ++r) { const int row = crow(r, hi); const float rl = __builtin_amdgcn_rcpf(li_l[row]); const int ds = dst_l[row];
        if (ds >= 0) { unsigned* pp = PART + (size_t)ds * 64 + r32; pp[0] = cvtpk(o[0][r] * rl, o[1][r] * rl); pp[32] = cvtpk(o[2][r] * rl, o[3][r] * rl); } }
    __syncthreads();
#undef SLOAD
#undef SWRITE
#undef SWAIT
#undef RESC
}
}
__device__ __forceinline__ void phase_attn_mfma(const Args& A, Frame& F, int ja) {
    int tid = F.wave * 64 + lane_id_v(); asm volatile("" : "+v"(tid));
    const unsigned* cnt = (const unsigned*)(F.ctl + CW_CNT + ja * 512); const unsigned* list = (const unsigned*)(F.ws + WS_LIST);
    LAS unsigned char* lds = F.lds + RING_OFF;
    LAS unsigned* pre = (LAS unsigned*)(lds + at::OFF_PRE);
    LAS unsigned* cl = (LAS unsigned*)(lds + at::OFF_CL);
    for (int i = tid; i < 512; i += NWAVES * 64) cl[i] = __hip_atomic_load(cnt + i, RLX_AGENT);
    __syncthreads();
    {
        const int g0 = 2 * tid, h0 = g0 >> 6, x0 = g0 & 63;
        const unsigned n0 = x0 < 32 ? (cl[h0 * 32 + x0] + 255u) >> 8 : 1u, n1 = (x0 + 1) < 32 ? (cl[h0 * 32 + x0 + 1] + 255u) >> 8 : 1u;
        unsigned v = n0 + n1; const int ln = tid & 63;
#pragma unroll
        for (int o = 1; o < 64; o <<= 1) { const unsigned t = __shfl_up(v, o); if (ln >= o) v += t; }
        LAS unsigned* wt = (LAS unsigned*)(lds + at::OFF_WT);
        if (ln == 63) wt[tid >> 6] = v;
        __syncthreads();
        unsigned base = 0;
        for (int w = 0; w < (tid >> 6); ++w) base += wt[w];
        const unsigned excl = base + v - (n0 + n1);
        pre[g0] = excl; pre[g0 + 1] = excl + n0;
        if (tid == NWAVES * 64 - 1) pre[1024] = base + v;
    }
    __syncthreads();
    const unsigned U = pre[1024];
    const unsigned u0 = (unsigned)(((unsigned long long)F.bid * U) / (unsigned)F.G), u1 = (unsigned)(((unsigned long long)(F.bid + 1) * U) / (unsigned)F.G);
    int cur_h = -1;
    const int wave = tid >> 6, r32 = tid & 31;
    for (unsigned u = u0; u < u1; ++u) {
        int lo = 0, hi_ = 1024;
        while (hi_ - lo > 1) { const int mid = (lo + hi_) >> 1; if (pre[mid] <= u) lo = mid; else hi_ = mid; }
        const int g = lo, h = g >> 6, x = g & 63, tile = (int)(u - pre[g]);
        if (h != cur_h) { __syncthreads(); const float* bsrc = (const float*)(F.ws + WS_BIAS) + h * BIAS_LD; LAS float* btl = (LAS float*)(lds + at::OFF_BT);
            {
                const int wv_ = __builtin_amdgcn_readfirstlane(tid >> 6), ln_ = tid & 63;
#pragma unroll
                for (int j = 0; j < 4; ++j) __builtin_amdgcn_global_load_lds((const unsigned*)(bsrc + (j * 8 + wv_) * 256 + ln_ * 4), (LAS unsigned*)((LAS unsigned char*)btl + (j * 8 + wv_) * 1024), 16, 0, 0);
                if (wv_ == 0) __builtin_amdgcn_global_load_lds((const unsigned*)(bsrc + 32 * 256 + ln_ * 4), (LAS unsigned*)((LAS unsigned char*)btl + 32 * 1024), 16, 0, 0); }
            cur_h = h; }
        int q, dsti, jb;
        if (x < 32) { jb = x; const int n = (int)cl[h * 32 + x]; const int e = tile * 256 + wave * 32 + r32; const unsigned ent = list[(size_t)(h * 32 + x) * 8192 + (e < n ? e : n - 1)];
            q = (int)(ent >> 2); dsti = e < n ? (q * NH + h) * 4 + (int)(ent & 3u) : -1; }
        else { jb = x - 32; q = jb * BLK + wave * 32 + r32; dsti = (q * NH + h) * 4 + 3; }
        at::attn_unit((const bf16*)(F.ws + WS_QKV), h, jb, q, dsti, lds, (unsigned*)(F.ws + WS_HID), (float*)(F.ws + WS_LSE), tid);
    }
}
template <bool OWN>
__device__ __forceinline__ void attn_phase(const Args& A, Frame& F, int ja) {
    using namespace at;
    int tid = F.wave * 64 + lane_id_v(); asm volatile("" : "+v"(tid));
    const int wid = tid >> 6, lane = tid & 63, r32 = lane & 31, hi = lane >> 5;
    const bf16* __restrict__ QKV = (const bf16*)(F.ws + WS_QKV);
    const unsigned* cnt = (const unsigned*)(F.ctl + CW_CNT + ja * 512); const unsigned* list = (const unsigned*)(F.ws + WS_LIST);
    unsigned* __restrict__ PART = (unsigned*)(F.ws + WS_HID); float* __restrict__ LSE = (float*)(F.ws + WS_LSE); bf16* __restrict__ AO = (bf16*)(F.ws + WS_AO);
    LAS unsigned char* lds = F.lds + RING_OFF;
    LAS unsigned char* V_lds = lds + OFF_V; LAS unsigned char* K_lds = lds + OFF_K;
    LAS float* ws = (LAS float*)(lds + OFF_WS) + wid * 64; LAS float* li_l = ws; LAS float* al_l = ws + 32;
    LAS int* dst_l = (LAS int*)(lds + OFF_DST) + wid * 32;
    LAS float* btl = (LAS float*)(lds + OFF_BT);
    LAS unsigned* pre = (LAS unsigned*)(lds + OFF_PRE);
    LAS unsigned* cl = (LAS unsigned*)(lds + OFF_CL);
    unsigned u0, u1;
    if (!OWN) {
        const unsigned n0 = (__hip_atomic_load(cnt + tid, RLX_AGENT));
        cl[tid] = n0;
        unsigned v = (n0 + 255u) >> 8; const unsigned mine = v;
#pragma unroll
        for (int o = 1; o < 64; o <<= 1) { const unsigned t = __shfl_up(v, o); if (lane >= o) v += t; }
        LAS unsigned* wt = (LAS unsigned*)(lds + OFF_WT);
        if (lane == 63) wt[wid] = v;
        __syncthreads();
        unsigned base = 0;
        for (int w = 0; w < wid; ++w) base += wt[w];
        pre[tid] = base + v - mine;
        if (tid == NWAVES * 64 - 1) pre[512] = base + v;
        __syncthreads();
        const unsigned U = pre[512];
        u0 = (unsigned)(((unsigned long long)F.bid * U) / (unsigned)F.G); u1 = (unsigned)(((unsigned long long)(F.bid + 1) * U) / (unsigned)F.G);
    } else { u0 = 0; u1 = (512 - F.bid + F.G - 1) / F.G; }
    const int sr = tid >> 4, sc = (tid & 15) * 8, vst0 = v_st(sr, sc), vst1 = v_st(32 + sr, sc);
    const int vb0 = (int)(uintptr_t)V_lds + v_rd_base(lane);
    struct { bf16x8 vs0, vs1, ks0, ks1; } sr_[2];
    bf16x8 qr[8];
    int h = 0, jb = 0, q = 0, dsti = -1;
#define DECODE(u_, h_, jb_, q_, d_) do { if (OWN) { const int gu = F.bid + (int)(u_) * F.G; h_ = gu >> 5; jb_ = gu & 31; q_ = jb_ * BLK + wid * 32 + r32; d_ = 0; } \
    else { int lo = 0, hi_ = 512; while (hi_ - lo > 1) { const int mid = (lo + hi_) >> 1; if (pre[mid] <= (u_)) lo = mid; else hi_ = mid; } \
        h_ = lo >> 5; jb_ = lo & 31; const int n_ = (int)cl[lo], e_ = (int)((u_) - pre[lo]) * 256 + wid * 32 + r32; \
        const unsigned ent_ = list[(size_t)lo * 8192 + (e_ < n_ ? e_ : n_ - 1)]; q_ = (int)(ent_ >> 2); d_ = e_ < n_ ? (q_ * NH + h_) * 4 + (int)(ent_ & 3u) : -1; } } while (0)
#define KVPTR(h_, jb_) (QKV + (size_t)((jb_) * BLK) * LDK + DM + (h_) * HD)
#define SLOAD(i, kp, k0) do { const bf16* kp_ = (kp); sr_[i].vs0 = *reinterpret_cast<const bf16x8*>(&kp_[DM + (size_t)((k0) + sr) * LDK + sc]); sr_[i].vs1 = *reinterpret_cast<const bf16x8*>(&kp_[DM + (size_t)((k0) + 32 + sr) * LDK + sc]); \
    sr_[i].ks0 = *reinterpret_cast<const bf16x8*>(&kp_[(size_t)((k0) + sr) * LDK + sc]); sr_[i].ks1 = *reinterpret_cast<const bf16x8*>(&kp_[(size_t)((k0) + 32 + sr) * LDK + sc]); } while (0)
#define QLOAD(h_, q_) do { const bf16* Qw_ = QKV + (size_t)(q_) * LDK + (h_) * HD + hi * 8; _Pragma("unroll") for (int d0 = 0; d0 < 8; ++d0) qr[d0] = *reinterpret_cast<const bf16x8*>(Qw_ + d0 * 16); } while (0)
#define SWRITE(b, i) do { *(LAS bf16x8*)(V_lds + (b) * SHM_V + vst0) = sr_[i].vs0; *(LAS bf16x8*)(V_lds + (b) * SHM_V + vst1) = sr_[i].vs1; const int kc = sc * 2; \
    *(LAS bf16x8*)(K_lds + (b) * SHM_K + KSWZ(sr, kc)) = sr_[i].ks0; *(LAS bf16x8*)(K_lds + (b) * SHM_K + KSWZ(32 + sr, kc)) = sr_[i].ks1; } while (0)
#define SWAIT() asm volatile("s_waitcnt vmcnt(4)" ::: "memory")
#define RESC(a) do { if (__any((a) < 1.f)) { if (hi == 0) al_l[r32] = (a); asm volatile("s_waitcnt lgkmcnt(0)" ::: "memory"); \
    _Pragma("unroll") for (int d = 0; d < 4; ++d) _Pragma("unroll") for (int r = 0; r < 16; ++r) o[d][r] *= al_l[crow(r, hi)]; } } while (0)
    if (u0 < u1) { DECODE(u0, h, jb, q, dsti); }
    int cur_h = -1;
    for (unsigned u = u0; u < u1; ++u) {
        if (h != cur_h) { const float* bsrc = (const float*)(F.ws + WS_BIAS) + h * BIAS_LD;
            {
                const int wv_ = __builtin_amdgcn_readfirstlane(tid >> 6), ln_ = tid & 63;
#pragma unroll
                for (int j = 0; j < 4; ++j) __builtin_amdgcn_global_load_lds((const unsigned*)(bsrc + (j * 8 + wv_) * 256 + ln_ * 4), (LAS unsigned*)((LAS unsigned char*)btl + (j * 8 + wv_) * 1024), 16, 0, 0);
                if (wv_ == 0) __builtin_amdgcn_global_load_lds((const unsigned*)(bsrc + 32 * 256 + ln_ * 4), (LAS unsigned*)((LAS unsigned char*)btl + 32 * 1024), 16, 0, 0); }
            cur_h = h; }
        const bf16* Kp = KVPTR(h, jb); QLOAD(h, q); SLOAD(0, Kp, 0);
        float m_reg = -1e30f, l_reg = 0; f32x16 o[4] = {};
        if (hi == 0) dst_l[r32] = dsti;
        const LAS float* bp0 = btl + (q - jb * BLK - 4 * hi + 256 - 59);
        f32x16 pA0, pA1, pB0, pB1; float alA, alB; bf16x8 pa0, pa1, pa2, pa3;
        asm volatile("s_waitcnt vmcnt(0)" ::: "memory"); SWRITE(0, 0); __syncthreads();
        qkt(pA0, pA1, K_lds, qr, r32, hi); partialSM(pA0, pA1, bp0, m_reg, alA);
        SLOAD(1, Kp, KVBLK); SLOAD(0, Kp, 2 * KVBLK);
        SWAIT(); SWRITE(1, 1); __syncthreads();
        SBAR(); qkt(pB0, pB1, K_lds + SHM_K, qr, r32, hi);
        finishSM(pA0, pA1, alA, l_reg, pa0, pa1, pa2, pa3); SBAR();
        SLOAD(1, Kp, 3 * KVBLK); SBAR();
        pv_d0(o, vb0, pa0, pa1, pa2, pa3); partialSM(pB0, pB1, bp0 - 64, m_reg, alB);
        __syncthreads(); SWAIT(); SWRITE(0, 0);
        RESC(alB); __syncthreads();
        SBAR(); qkt(pA0, pA1, K_lds, qr, r32, hi);
        finishSM(pB0, pB1, alB, l_reg, pa0, pa1, pa2, pa3); SBAR();
        pv_d0(o, vb0 + SHM_V, pa0, pa1, pa2, pa3); partialSM(pA0, pA1, bp0 - 128, m_reg, alA);
        __syncthreads(); asm volatile("s_waitcnt vmcnt(0)" ::: "memory"); SWRITE(1, 1);
        RESC(alA); __syncthreads();
        SBAR(); qkt(pB0, pB1, K_lds + SHM_K, qr, r32, hi); SBAR();
        int hn = h, jbn = jb, qn = q, dn = -1;
        if (u + 1 < u1) { DECODE(u + 1, hn, jbn, qn, dn); }
        SBAR();
        finishSM(pA0, pA1, alA, l_reg, pa0, pa1, pa2, pa3); SBAR();
        pv_d0(o, vb0, pa0, pa1, pa2, pa3); partialSM(pB0, pB1, bp0 - 192, m_reg, alB);

        RESC(alB);
        finishSM(pB0, pB1, alB, l_reg, pa0, pa1, pa2, pa3); SBAR();
        pv_d0(o, vb0 + SHM_V, pa0, pa1, pa2, pa3);
        asm volatile("s_waitcnt vmcnt(0)" ::: "memory");
        if (!OWN) {
            if (hi == 0) { li_l[r32] = l_reg; if (dsti >= 0) LSE[dsti] = m_reg + __builtin_amdgcn_logf(l_reg); }
            asm volatile("s_waitcnt lgkmcnt(0)" ::: "memory");
#pragma unroll
            for (int r = 0; r < 16; ++r) { const int row = crow(r, hi); const float rl = __builtin_amdgcn_rcpf(li_l[row]); const int ds = dst_l[row];
                if (ds >= 0) { unsigned* pp = PART + (size_t)ds * 64 + r32; pp[0] = cvtpk(o[0][r] * rl, o[1][r] * rl); pp[32] = cvtpk(o[2][r] * rl, o[3][r] * rl); } }
        } else {
            if (hi == 0) { li_l[r32] = l_reg; al_l[r32] = m_reg; }
            asm volatile("s_waitcnt lgkmcnt(0)" ::: "memory");
#pragma unroll
            for (int hf = 0; hf < 2; ++hf) {
                float wo[8], w0[8], w1[8], w2[8];
                {   f32x4 ls[8];
#pragma unroll
                    for (int rr = 0; rr < 8; ++rr) { const int row = crow(hf * 8 + rr, hi); ls[rr] = *(const f32x4*)(LSE + ((size_t)(jb * BLK + wid * 32 + row) * NH + h) * 4); }
#pragma unroll
                    for (int rr = 0; rr < 8; ++rr) { const int row = crow(hf * 8 + rr, hi); const float lrow = li_l[row], lown = al_l[row] + __builtin_amdgcn_logf(lrow);
                        const float M = fmaxf(fmaxf(lown, ls[rr][0]), fmaxf(ls[rr][1], ls[rr][2]));
                        const float eo = __builtin_amdgcn_exp2f(lown - M), e0 = __builtin_amdgcn_exp2f(ls[rr][0] - M), e1 = __builtin_amdgcn_exp2f(ls[rr][1] - M), e2 = __builtin_amdgcn_exp2f(ls[rr][2] - M);
                        const float iw = __builtin_amdgcn_rcpf((eo + e0) + (e1 + e2));
                        wo[rr] = eo * iw * __builtin_amdgcn_rcpf(lrow); w0[rr] = e0 * iw; w1[rr] = e1 * iw; w2[rr] = e2 * iw; } }
#pragma unroll
                for (int g4 = 0; g4 < 2; ++g4) {
                    unsigned pu[4][3][2];
#pragma unroll
                    for (int r4 = 0; r4 < 4; ++r4) { const int rr = g4 * 4 + r4, row = crow(hf * 8 + rr, hi); const unsigned* pp = PART + ((size_t)(jb * BLK + wid * 32 + row) * NH + h) * 256 + r32;
                        pu[r4][0][0] = w0[rr] > 0.f ? pp[0] : 0u; pu[r4][0][1] = w0[rr] > 0.f ? pp[32] : 0u;
                        pu[r4][1][0] = w1[rr] > 0.f ? pp[64] : 0u; pu[r4][1][1] = w1[rr] > 0.f ? pp[96] : 0u;
                        pu[r4][2][0] = w2[rr] > 0.f ? pp[128] : 0u; pu[r4][2][1] = w2[rr] > 0.f ? pp[160] : 0u; }
#pragma unroll
                    for (int r4 = 0; r4 < 4; ++r4) { const int rr = g4 * 4 + r4, r = hf * 8 + rr, row = crow(r, hi);
                        float a0 = o[0][r] * wo[rr], a1 = o[1][r] * wo[rr], a2 = o[2][r] * wo[rr], a3 = o[3][r] * wo[rr];
                        a0 += w0[rr] * bflo(pu[r4][0][0]) + w1[rr] * bflo(pu[r4][1][0]) + w2[rr] * bflo(pu[r4][2][0]);
                        a1 += w0[rr] * bfhi(pu[r4][0][0]) + w1[rr] * bfhi(pu[r4][1][0]) + w2[rr] * bfhi(pu[r4][2][0]);
                        a2 += w0[rr] * bflo(pu[r4][0][1]) + w1[rr] * bflo(pu[r4][1][1]) + w2[rr] * bflo(pu[r4][2][1]);
                        a3 += w0[rr] * bfhi(pu[r4][0][1]) + w1[rr] * bfhi(pu[r4][1][1]) + w2[rr] * bfhi(pu[r4][2][1]);
                        bf16* op = AO + (size_t)(jb * BLK + wid * 32 + row) * DM + h * HD + r32;
                        op[0] = (bf16)(cvtpk(a0, a0) & 0xffffu); op[32] = (bf16)(cvtpk(a1, a1) & 0xffffu); op[64] = (bf16)(cvtpk(a2, a2) & 0xffffu); op[96] = (bf16)(cvtpk(a3, a3) & 0xffffu); }
                }
            }
        }
        __syncthreads();
        h = hn; jb = jbn; q = qn; dsti = dn;
    }
#undef DECODE
#undef KVPTR
#undef SLOAD
#undef QLOAD
#undef SWRITE
#undef SWAIT
#undef RESC
}
namespace at3 {
using namespace at;
constexpr int O_K = 0, O_V = 65536, O_BT = 131072, O_WS = O_BT + BIAS_LD * 2, O_PRE = O_WS + 8 * 384, O_CL = O_PRE + 516 * 4, O_WT = O_CL + 512 * 4, O_END = O_WT + 64;
static_assert(O_END <= RING_BYTES, "attention LDS map");
__device__ __forceinline__ void sm_tile(f32x16& p0, f32x16& p1, const LAS unsigned short* bp, float& m_reg, float& l_reg, f32x16 (&o)[4], bf16x8& pa0, bf16x8& pa1, bf16x8& pa2, bf16x8& pa3, LAS float* al_l, int r32, int hi) {
    constexpr float C = 0.088388347648318440f * 1.4426950408889634f;
#pragma unroll
    for (int r = 0; r < 16; ++r) p0[r] = fmaf(p0[r], C, __builtin_bit_cast(float, (unsigned)bp[59 - ((r & 3) + 8 * (r >> 2))] << 16));
#pragma unroll
    for (int r = 0; r < 16; ++r) p1[r] = fmaf(p1[r], C, __builtin_bit_cast(float, (unsigned)bp[27 - ((r & 3) + 8 * (r >> 2))] << 16));
    float pmax = p0[0];
#pragma unroll
    for (int r = 1; r < 16; ++r) pmax = fmaxf(pmax, p0[r]);
#pragma unroll
    for (int r = 0; r < 16; ++r) pmax = fmaxf(pmax, p1[r]);
    { auto rr = __builtin_amdgcn_permlane32_swap(__float_as_uint(pmax), __float_as_uint(pmax), false, false); pmax = fmaxf(__uint_as_float(rr[0]), __uint_as_float(rr[1])); }
    float mn = m_reg, alpha = 1.f;
    if (!__all(pmax <= m_reg + 8.0f)) { const bool up = pmax > m_reg + 8.0f;
        mn = up ? pmax : m_reg; alpha = up ? __builtin_amdgcn_exp2f(m_reg - mn) : 1.f; m_reg = mn; }
#pragma unroll
    for (int r = 0; r < 16; ++r) p0[r] = __builtin_amdgcn_exp2f(p0[r] - mn);
#pragma unroll
    for (int r = 0; r < 16; ++r) p1[r] = __builtin_amdgcn_exp2f(p1[r] - mn);
    float ps = 0;
#pragma unroll
    for (int r = 0; r < 16; ++r) ps += p0[r];
#pragma unroll
    for (int r = 0; r < 16; ++r) ps += p1[r];
    { auto rr = __builtin_amdgcn_permlane32_swap(__float_as_uint(ps), __float_as_uint(ps), false, false); ps = __uint_as_float(rr[0]) + __uint_as_float(rr[1]); }
    l_reg = l_reg * alpha + ps;
#define PK4(P, BASE, OUT) do { unsigned a0 = cvtpk(P[BASE + 0], P[BASE + 1]), a1 = cvtpk(P[BASE + 2], P[BASE + 3]);   \
    unsigned b0 = cvtpk(P[BASE + 4], P[BASE + 5]), b1 = cvtpk(P[BASE + 6], P[BASE + 7]);                              \
    auto r0 = __builtin_amdgcn_permlane32_swap(a0, b0, false, false); auto r1 = __builtin_amdgcn_permlane32_swap(a1, b1, false, false); \
    u32x4 w = {r0[0], r1[0], r0[1], r1[1]}; OUT = *reinterpret_cast<bf16x8*>(&w); } while (0)
    PK4(p0, 0, pa0); PK4(p0, 8, pa1); PK4(p1, 0, pa2); PK4(p1, 8, pa3);
#undef PK4
    if (__any(alpha < 1.f)) { if (hi == 0) al_l[r32] = alpha; asm volatile("s_waitcnt lgkmcnt(0)" ::: "memory");
#pragma unroll
        for (int d = 0; d < 4; ++d)
#pragma unroll
            for (int r = 0; r < 16; ++r) o[d][r] *= al_l[crow(r, hi)]; }
}
__device__ __forceinline__ void load_kv_block(const bf16* __restrict__ QKV, int h, int jb, LAS unsigned char* lds, int tid) {
    const bf16* Kp = QKV + (size_t)(jb * BLK) * LDK + DM + h * HD;
    bf16x8 kv[8], vv[8];
#pragma unroll
    for (int i = 0; i < 8; ++i) { const int p = tid + 512 * i, row = p >> 4, c16 = p & 15; kv[i] = *reinterpret_cast<const bf16x8*>(Kp + (size_t)row * LDK + c16 * 8); vv[i] = *reinterpret_cast<const bf16x8*>(Kp + DM + (size_t)row * LDK + c16 * 8); }
#pragma unroll
    for (int i = 0; i < 8; ++i) { const int p = tid + 512 * i, row = p >> 4, c16 = p & 15, t = row >> 6, rl = row & 63;
        *(LAS bf16x8*)(lds + O_K + t * 16384 + KSWZ(rl, c16 * 16)) = kv[i]; *(LAS bf16x8*)(lds + O_V + t * 16384 + v_st(rl, c16 * 8)) = vv[i]; }
}
}
template <bool OWN>
__device__ __forceinline__ void attn_phase3(const Args& A, Frame& F, int ja) {
    using namespace at3;
    int tid = F.wave * 64 + lane_id_v(); asm volatile("" : "+v"(tid));
    const int wid = __builtin_amdgcn_readfirstlane(tid >> 6), lane = tid & 63, r32 = lane & 31, hi = lane >> 5;
    const bf16* __restrict__ QKV = (const bf16*)(F.ws + WS_QKV);
    const unsigned* cnt = (const unsigned*)(F.ctl + CW_CNT + ja * 512); const unsigned* list = (const unsigned*)(F.ws + WS_LIST);
    unsigned* __restrict__ PART = (unsigned*)(F.ws + WS_HID); float* __restrict__ LSE = (float*)(F.ws + WS_LSE); bf16* __restrict__ AO = (bf16*)(F.ws + WS_AO);
    LAS unsigned char* lds = F.lds + RING_OFF;
    LAS float* li_l = (LAS float*)(lds + O_WS + wid * 384); LAS float* al_l = li_l + 32; LAS int* dst_l = (LAS int*)(li_l + 64);
    LAS unsigned short* btl = (LAS unsigned short*)(lds + O_BT);
    LAS unsigned* pre = (LAS unsigned*)(lds + O_PRE); LAS unsigned* cl = (LAS unsigned*)(lds + O_CL);
    const int vb0 = (int)(uintptr_t)(lds + O_V) + v_rd_base(lane);
    unsigned s0 = 0, s1 = 0;
    if (!OWN) {
        const unsigned n0 = __hip_atomic_load(cnt + tid, RLX_AGENT); cl[tid] = n0;
        unsigned v = (n0 + 31u) >> 5; const unsigned mine = v;
#pragma unroll
        for (int o = 1; o < 64; o <<= 1) { const unsigned t = __shfl_up(v, o); if (lane >= o) v += t; }
        LAS unsigned* wt = (LAS unsigned*)(lds + O_WT);
        if (lane == 63) wt[wid] = v;
        __syncthreads();
        unsigned base = 0;
        for (int w = 0; w < wid; ++w) base += wt[w];
        pre[tid] = base + v - mine;
        if (tid == NWAVES * 64 - 1) pre[512] = base + v;
        __syncthreads();
        const unsigned ST = pre[512];
        s0 = (unsigned)(((unsigned long long)F.bid * ST) / (unsigned)F.G); s1 = (unsigned)(((unsigned long long)(F.bid + 1) * ST) / (unsigned)F.G);
    } else { s0 = 0; s1 = (512 - F.bid + F.G - 1) / F.G; }
    int cur_h = -1;
    while (s0 < s1) {
        int h, jb; unsigned seg_end, gbase = 0; int n_g = 0, g = 0;
        if (!OWN) { int lo = 0, hi_ = 512; while (hi_ - lo > 1) { const int mid = (lo + hi_) >> 1; if (pre[mid] <= s0) lo = mid; else hi_ = mid; }
            g = lo; h = g >> 5; jb = g & 31; gbase = pre[g]; n_g = (int)cl[g]; const unsigned ge = pre[g + 1]; seg_end = ge < s1 ? ge : s1; }
        else { const int gu = F.bid + (int)s0 * F.G; h = gu & 15; jb = gu >> 4; seg_end = s0 + 1; }
        __syncthreads();
        if (h != cur_h) { const float* bsrc = (const float*)(F.ws + WS_BIAS) + h * BIAS_LD;
            {
                const int ln_ = tid & 63;
#pragma unroll
                for (int j = 0; j < 4; ++j) __builtin_amdgcn_global_load_lds((const unsigned*)(bsrc + (j * 8 + wid) * 256 + ln_ * 4), (LAS unsigned*)(lds + O_K + (j * 8 + wid) * 1024), 16, 0, 0);
                if (wid == 0) __builtin_amdgcn_global_load_lds((const unsigned*)(bsrc + 32 * 256 + ln_ * 4), (LAS unsigned*)(lds + O_K + 32 * 1024), 16, 0, 0);
                asm volatile("s_waitcnt vmcnt(0)" ::: "memory"); __syncthreads();
                for (int i = tid; i < BIAS_LD; i += NWAVES * 64) btl[i] = (unsigned short)f2bf(((const LAS float*)(lds + O_K))[i]);
                __syncthreads(); }
            cur_h = h; }
        load_kv_block(QKV, h, jb, lds, tid);
        __syncthreads();
        const unsigned st_first = OWN ? 0u : s0 + (unsigned)wid, st_step = 8u;
        for (unsigned st = st_first; OWN ? st < 1u : st < seg_end; st += st_step) {
            int q, dsti, nt;
            if (!OWN) { const int e = (int)(st - gbase) * 32 + r32; const unsigned ent = list[(size_t)g * 8192 + (e < n_g ? e : n_g - 1)];
                q = (int)(ent >> 2); dsti = e < n_g ? (q * NH + h) * 4 + (int)(ent & 3u) : -1; nt = 4; }
            else { const int sub = wid < 4 ? 7 - wid : wid - 4; q = jb * BLK + sub * 32 + r32; dsti = 0; nt = (sub >> 1) + 1; }
            bf16x8 qr[8];
            { const bf16* Qw = QKV + (size_t)q * LDK + h * HD + hi * 8;
#pragma unroll
              for (int d0 = 0; d0 < 8; ++d0) qr[d0] = *reinterpret_cast<const bf16x8*>(Qw + d0 * 16); }
            if (!OWN) { if (hi == 0) dst_l[r32] = dsti; }
            const LAS unsigned short* bp0 = btl + (q - jb * BLK - 4 * hi + 256 - 59);
            float m_reg = -1e30f, l_reg = 0; f32x16 o[4] = {};
#pragma unroll 1
            for (int t = 0; t < nt; ++t) {
                f32x16 p0, p1; bf16x8 pa0, pa1, pa2, pa3;
                qkt(p0, p1, lds + O_K + t * 16384, qr, r32, hi);
                sm_tile(p0, p1, bp0 - 64 * t, m_reg, l_reg, o, pa0, pa1, pa2, pa3, al_l, r32, hi);
                pv_d0(o, vb0 + t * 16384, pa0, pa1, pa2, pa3);
            }
            if (!OWN) {
                if (hi == 0) { li_l[r32] = l_reg; if (dsti >= 0) LSE[dsti] = m_reg + __builtin_amdgcn_logf(l_reg); }
                asm volatile("s_waitcnt lgkmcnt(0)" ::: "memory");
#pragma unroll
                for (int r = 0; r < 16; ++r) { const int row = crow(r, hi); const float rl = __builtin_amdgcn_rcpf(li_l[row]); const int ds = dst_l[row];
                    if (ds >= 0) { unsigned* pp = PART + (size_t)ds * 64 + r32; pp[0] = cvtpk(o[0][r] * rl, o[1][r] * rl); pp[32] = cvtpk(o[2][r] * rl, o[3][r] * rl); } }
            } else {
                const int sub = wid < 4 ? 7 - wid : wid - 4, rowb = jb * BLK + sub * 32;
                if (hi == 0) { li_l[r32] = l_reg; al_l[r32] = m_reg; }
                asm volatile("s_waitcnt lgkmcnt(0)" ::: "memory");
#pragma unroll
                for (int hf = 0; hf < 2; ++hf) {
                    f32x4 ls[8]; unsigned pu[8][6];
#pragma unroll
                    for (int rr = 0; rr < 8; ++rr) { const int row = crow(hf * 8 + rr, hi); const size_t e = (size_t)(rowb + row) * NH + h;
                        ls[rr] = *(const f32x4*)(LSE + e * 4); const unsigned* pp = PART + e * 256 + r32;
                        pu[rr][0] = pp[0]; pu[rr][1] = pp[32]; pu[rr][2] = pp[64]; pu[rr][3] = pp[96]; pu[rr][4] = pp[128]; pu[rr][5] = pp[160]; }
#pragma unroll
                    for (int rr = 0; rr < 8; ++rr) { const int r = hf * 8 + rr, row = crow(r, hi); const float lrow = li_l[row], lown = al_l[row] + __builtin_amdgcn_logf(lrow);
                        const float M = fmaxf(fmaxf(lown, ls[rr][0]), fmaxf(ls[rr][1], ls[rr][2]));
                        const float eo = __builtin_amdgcn_exp2f(lown - M), e0 = __builtin_amdgcn_exp2f(ls[rr][0] - M), e1 = __builtin_amdgcn_exp2f(ls[rr][1] - M), e2 = __builtin_amdgcn_exp2f(ls[rr][2] - M);
                        const float iw = __builtin_amdgcn_rcpf((eo + e0) + (e1 + e2));
                        const float wo = eo * iw * __builtin_amdgcn_rcpf(lrow), w0 = e0 * iw, w1 = e1 * iw, w2 = e2 * iw;
                        const unsigned q00 = w0 > 0.f ? pu[rr][0] : 0u, q01 = w0 > 0.f ? pu[rr][1] : 0u, q10 = w1 > 0.f ? pu[rr][2] : 0u, q11 = w1 > 0.f ? pu[rr][3] : 0u, q20 = w2 > 0.f ? pu[rr][4] : 0u, q21 = w2 > 0.f ? pu[rr][5] : 0u;
                        const float a0 = o[0][r] * wo + (w0 * bflo(q00) + w1 * bflo(q10) + w2 * bflo(q20));
                        const float a1 = o[1][r] * wo + (w0 * bfhi(q00) + w1 * bfhi(q10) + w2 * bfhi(q20));
                        const float a2 = o[2][r] * wo + (w0 * bflo(q01) + w1 * bflo(q11) + w2 * bflo(q21));
                        const float a3 = o[3][r] * wo + (w0 * bfhi(q01) + w1 * bfhi(q11) + w2 * bfhi(q21));
                        bf16* op = AO + (size_t)(rowb + row) * DM + h * HD + r32;
                        op[0] = (bf16)(cvtpk(a0, a0) & 0xffffu); op[32] = (bf16)(cvtpk(a1, a1) & 0xffffu); op[64] = (bf16)(cvtpk(a2, a2) & 0xffffu); op[96] = (bf16)(cvtpk(a3, a3) & 0xffffu); }
                }
            }
        }
        s0 = seg_end;
    }
}
#define TOP3_INS2(x_, j_) do { const float x__ = (x_); const int j__ = (j_); \
    const bool b0 = x__ > v0 || (x__ == v0 && (unsigned)j__ < (unsigned)i0), b1 = x__ > v1 || (x__ == v1 && (unsigned)j__ < (unsigned)i1), b2 = x__ > v2 || (x__ == v2 && (unsigned)j__ < (unsigned)i2); \
    v2 = b1 ? v1 : (b2 ? x__ : v2); i2 = b1 ? i1 : (b2 ? j__ : i2); v1 = b0 ? v0 : (b1 ? x__ : v1); i1 = b0 ? i0 : (b1 ? j__ : i1); v0 = b0 ? x__ : v0; i0 = b0 ? j__ : i0; } while (0)
__device__ __forceinline__ void phase_gate2(const Args& A, Frame& F, int ja) {
    using namespace at;
    int tid = F.wave * 64 + lane_id_v(); asm volatile("" : "+v"(tid));
    const int lane = tid & 63, wave = tid >> 6, r32 = lane & 31, hi = lane >> 5;
    const bf16* QKV = (const bf16*)(F.ws + WS_QKV); const float* KMP = (const float*)(F.ws + WS_KMP);
    unsigned* cnt = (unsigned*)(F.ctl + CW_CNT + ja * 512); unsigned* list = (unsigned*)(F.ws + WS_LIST); float* LSE = (float*)(F.ws + WS_LSE);
    LAS unsigned* lc = (LAS unsigned*)(F.lds + RING_OFF);
    for (int u = F.bid; u < 512; u += F.G) {
        const int h = u & 15, c = u >> 4;
        __syncthreads();
        if (tid < 64) lc[tid] = 0u;
        __syncthreads();
        const int q = c * 256 + wave * 32 + r32;
        int i0 = -1, i1 = -1, i2 = -1;
        if (c > 0) {
            bf16x8 kh[8], kl[8], qr[8];
            const bf16* Qw = QKV + (size_t)q * NQKV + h * HD + hi * 8;
#pragma unroll
            for (int d0 = 0; d0 < 8; ++d0) qr[d0] = *reinterpret_cast<const bf16x8*>(Qw + d0 * 16);
#pragma unroll
            for (int d0 = 0; d0 < 8; ++d0) { const float* p0 = KMP + (size_t)r32 * 2048 + h * HD + d0 * 16 + hi * 8; const float* p1 = p0 + (size_t)32 * 2048;
                const f32x4 a0 = *(const f32x4*)p0 + *(const f32x4*)p1, a1 = *(const f32x4*)(p0 + 4) + *(const f32x4*)(p1 + 4);
                float v[8] = {a0[0], a0[1], a0[2], a0[3], a1[0], a1[1], a1[2], a1[3]}; unsigned hh[4], ll[4];
#pragma unroll
                for (int e = 0; e < 4; ++e) { const float x0 = v[2 * e] * (1.0f / 256.0f), x1 = v[2 * e + 1] * (1.0f / 256.0f); const unsigned ph = cvtpk(x0, x1); hh[e] = ph;
                    ll[e] = cvtpk(x0 - bflo(ph), x1 - bfhi(ph)); }
                u32x4 wh = {hh[0], hh[1], hh[2], hh[3]}, wl_ = {ll[0], ll[1], ll[2], ll[3]};
                kh[d0] = *reinterpret_cast<bf16x8*>(&wh); kl[d0] = *reinterpret_cast<bf16x8*>(&wl_); }
            f32x16 Gt = {};
#pragma unroll
            for (int d0 = 0; d0 < 8; ++d0) { Gt = __builtin_amdgcn_mfma_f32_32x32x16_bf16(kh[d0], qr[d0], Gt, 0, 0, 0); Gt = __builtin_amdgcn_mfma_f32_32x32x16_bf16(kl[d0], qr[d0], Gt, 0, 0, 0); }
            float v0 = -INFINITY, v1 = -INFINITY, v2 = -INFINITY;
#pragma unroll
            for (int r = 0; r < 16; ++r) { const int jb = crow(r, hi); if (jb < c) TOP3_INS2(Gt[r], jb); }
            const float pv0 = __shfl_xor(v0, 32), pv1 = __shfl_xor(v1, 32), pv2 = __shfl_xor(v2, 32);
            const int pi0 = __shfl_xor(i0, 32), pi1 = __shfl_xor(i1, 32), pi2 = __shfl_xor(i2, 32);
            if (pi0 >= 0) TOP3_INS2(pv0, pi0);
            if (pi1 >= 0) TOP3_INS2(pv1, pi1);
            if (pi2 >= 0) TOP3_INS2(pv2, pi2);
        }
        unsigned lp0 = 0, lp1 = 0, lp2 = 0;
        if (hi == 0) { if (i0 >= 0) lp0 = atomicAdd((unsigned*)(lc + i0), 1u); if (i1 >= 0) lp1 = atomicAdd((unsigned*)(lc + i1), 1u); if (i2 >= 0) lp2 = atomicAdd((unsigned*)(lc + i2), 1u); }
        __syncthreads();
        if (tid < 32) { const unsigned n = lc[tid]; lc[32 + tid] = n ? atomicAdd(&cnt[h * 32 + tid], n) : 0u; }
        __syncthreads();
        if (hi == 0) {
#define EMIT_PICK(k_, sj_, lp_) do { if ((sj_) >= 0) list[(size_t)(h * 32 + (sj_)) * 8192 + lc[32 + (sj_)] + (lp_)] = ((unsigned)q << 2) | (unsigned)(k_); \
                else LSE[((size_t)q * NH + h) * 4 + (k_)] = -INFINITY; } while (0)
            EMIT_PICK(0, i0, lp0); EMIT_PICK(1, i1, lp1); EMIT_PICK(2, i2, lp2);
#undef EMIT_PICK
        }
    }
}
__device__ __forceinline__ void phase_combine(const Args& A, Frame& F) {
    int tid = F.wave * 64 + lane_id_v(); asm volatile("" : "+v"(tid)); const int lane = tid & 63, wave = __builtin_amdgcn_readfirstlane(tid >> 6); (void)lane; (void)wave;
    const unsigned* PART = (const unsigned*)(F.ws + WS_HID); const float* LSE = (const float*)(F.ws + WS_LSE); bf16* AO = (bf16*)(F.ws + WS_AO);
    const int gw = F.bid * NWAVES + wave, NGW = F.G * NWAVES, l = lane;
    for (int e = gw; e < S * NH; e += NGW) {
        const f32x4 ls = *(const f32x4*)(LSE + (size_t)e * 4);
        const float M = fmaxf(fmaxf(ls[0], ls[1]), fmaxf(ls[2], ls[3]));
        float o0 = 0.f, o1 = 0.f, W = 0.f;
#pragma unroll
        for (int k = 0; k < 4; ++k) { const float w = __builtin_amdgcn_exp2f(ls[k] - M);
            if (w > 0.f) { const unsigned u = PART[((size_t)e * 4 + k) * 64 + l]; o0 += w * bflo(u); o1 += w * bfhi(u); W += w; } }
        const float inv = 1.0f / W; const int q = e >> 4, h = e & 15, c0 = 64 * (l >> 5) + (l & 31);
        bf16* op = AO + (size_t)q * DM + h * HD;
        op[c0] = (bf16)f2bf(o0 * inv); op[c0 + 32] = (bf16)f2bf(o1 * inv);
    }
}
__device__ __forceinline__ float sigmoidf_(float x) { return 1.0f / (1.0f + __expf(-x)); }
__device__ __forceinline__ void phase_rec_ab(const Args& A, Frame& F, int jr) {
    int tid = F.wave * 64 + lane_id_v(); asm volatile("" : "+v"(tid)); const int lane = tid & 63, wave = __builtin_amdgcn_readfirstlane(tid >> 6); (void)lane; (void)wave;
    const bf16* XR = (const bf16*)(F.ws + WS_QKV);
    const float* cw = A.in[8] + (size_t)jr * 4 * DM; const float* cb = A.in[9] + (size_t)jr * DM;
    const float* wrg = A.in[10] + (size_t)jr * 16 * 128 * 128; const float* brg = A.in[11] + (size_t)jr * DM;
    const float* wig = A.in[12] + (size_t)jr * 16 * 128 * 128; const float* big = A.in[13] + (size_t)jr * DM; const float* lam = A.in[14] + (size_t)jr * DM;
    float* SA = (float*)(F.ws + WS_HID); float* SB = SA + (size_t)S * DM;
    LAS float* xc = (LAS float*)(F.lds + RING_OFF);
    for (int item = F.bid; item < 256 * 16; item += F.G) {
        const int tt = item >> 4, n = item & 15;
        for (int i = tid; i < 4096; i += NWAVES * 64) { const int r = i >> 7, cc = i & 127, t = tt * 32 + r, c = n * 128 + cc;
            float a = cb[c];
#pragma unroll
            for (int jj = 0; jj < 4; ++jj) { const int ts = t - 3 + jj; if (ts >= 0) a += bf2f(XR[(size_t)ts * DM + c]) * cw[jj * DM + c]; }
            xc[i] = a; }
        __syncthreads();
        const int cc = tid & 127, rg = tid >> 7, c = n * 128 + cc;
        float ar[8], ai[8];
#pragma unroll
        for (int i = 0; i < 8; ++i) { ar[i] = 0.f; ai[i] = 0.f; }
        const float* wr_ = wrg + (size_t)n * 128 * 128 + cc; const float* wi_ = wig + (size_t)n * 128 * 128 + cc;
        for (int k = 0; k < 128; ++k) { const float a = wr_[k * 128], b = wi_[k * 128];
#pragma unroll
            for (int i = 0; i < 8; ++i) { const float x = xc[(rg + 4 * i) * 128 + k]; ar[i] += x * a; ai[i] += x * b; } }
        const float lm = lam[c]; const float lsg = (fminf(lm, 0.f) - log1pf(__expf(-fabsf(lm)))) * 8.0f;
        const float b_r = brg[c], b_i = big[c];
#pragma unroll
        for (int i = 0; i < 8; ++i) { const int r = rg + 4 * i; const size_t o = (size_t)(tt * 32 + r) * DM + c;
            const float rr = sigmoidf_(ar[i] + b_r), ii = sigmoidf_(ai[i] + b_i), la = rr * lsg;
            SA[o] = __expf(la); SB[o] = sqrtf(-expm1f(2.0f * la)) * (ii * xc[r * 128 + cc]); }
        __syncthreads();
    }
}
__device__ __forceinline__ void phase_rec_ab2(const Args& A, Frame& F, int jr) {
    using namespace at;
    int tid = F.wave * 64 + lane_id_v(); asm volatile("" : "+v"(tid));
    const int lane = tid & 63, wave = tid >> 6, r32 = lane & 31, hi = lane >> 5;
    const bf16* XR = (const bf16*)(F.ws + WS_QKV);
    const float* cw = A.in[8] + (size_t)jr * 4 * DM; const float* cb = A.in[9] + (size_t)jr * DM;
    const float* brg = A.in[11] + (size_t)jr * DM; const float* big = A.in[13] + (size_t)jr * DM; const float* lam = A.in[14] + (size_t)jr * DM;
    const bf16* WG = (const bf16*)(F.ws + WS_WG) + (size_t)jr * 2 * 16 * 128 * 128;
    unsigned* SAB = (unsigned*)(F.ws + WS_HID);
    LAS unsigned char* xcl = F.lds + RING_OFF;
    LAS unsigned char* wl = F.lds + RING_OFF + 65536;
    LAS f32x2* comp = (LAS f32x2*)(F.lds + RING_OFF + 131072);
    int cur_n = -1;
    for (int u = F.bid; u < 512; u += F.G) {
        const int n = u & 15, tt = u >> 4;
        __syncthreads();
        if (n != cur_n) { cur_n = n;
#pragma unroll
            for (int i = 0; i < 8; ++i) { const int p = tid + i * 512, g = p >> 11, ch = (p >> 4) & 127, kc = p & 15;
                *(LAS v4u*)(wl + g * 32768 + KSWZ(ch, kc * 16)) = *(const v4u*)(WG + ((size_t)(g * 16 + n) * 128 + ch) * 128 + kc * 8); } }
        {
            const int chg = tid & 15, c0 = n * 128 + chg * 8;
            float w[4][8], b8[8];
#pragma unroll
            for (int jj = 0; jj < 4; ++jj) { const f32x4 x0 = *(const f32x4*)(cw + jj * DM + c0), x1 = *(const f32x4*)(cw + jj * DM + c0 + 4);
                w[jj][0] = x0[0]; w[jj][1] = x0[1]; w[jj][2] = x0[2]; w[jj][3] = x0[3]; w[jj][4] = x1[0]; w[jj][5] = x1[1]; w[jj][6] = x1[2]; w[jj][7] = x1[3]; }
            { const f32x4 x0 = *(const f32x4*)(cb + c0), x1 = *(const f32x4*)(cb + c0 + 4); b8[0] = x0[0]; b8[1] = x0[1]; b8[2] = x0[2]; b8[3] = x0[3]; b8[4] = x1[0]; b8[5] = x1[1]; b8[6] = x1[2]; b8[7] = x1[3]; }
#pragma unroll 4
            for (int ps = 0; ps < 8; ++ps) { const int rl = (tid >> 4) + 32 * ps, t = tt * 256 + rl;
                float acc[8];
#pragma unroll
                for (int e = 0; e < 8; ++e) acc[e] = b8[e];
#pragma unroll
                for (int jj = 0; jj < 4; ++jj) { const int ts = t - 3 + jj;
                    if (ts >= 0) { const v4u xv = *(const v4u*)(XR + (size_t)ts * DM + c0);
                        acc[0] += bflo(xv.x) * w[jj][0]; acc[1] += bfhi(xv.x) * w[jj][1]; acc[2] += bflo(xv.y) * w[jj][2]; acc[3] += bfhi(xv.y) * w[jj][3];
                        acc[4] += bflo(xv.z) * w[jj][4]; acc[5] += bfhi(xv.z) * w[jj][5]; acc[6] += bflo(xv.w) * w[jj][6]; acc[7] += bfhi(xv.w) * w[jj][7]; } }
                v4u o; o.x = cvtpk(acc[0], acc[1]); o.y = cvtpk(acc[2], acc[3]); o.z = cvtpk(acc[4], acc[5]); o.w = cvtpk(acc[6], acc[7]);
                *(LAS v4u*)(xcl + KSWZ(rl, chg * 16)) = o; }
        }
        __syncthreads();
        bf16x8 xf[8];
#pragma unroll
        for (int d0 = 0; d0 < 8; ++d0) xf[d0] = *(const LAS bf16x8*)(xcl + KSWZ(wave * 32 + r32, (d0 * 16 + hi * 8) * 2));
#pragma unroll 1
        for (int ct = 0; ct < 4; ++ct) {
            f32x16 aR = {}, aI = {};
#pragma unroll
            for (int d0 = 0; d0 < 8; ++d0) { const int cbo = (d0 * 16 + hi * 8) * 2;
                const bf16x8 wr_ = *(const LAS bf16x8*)(wl + KSWZ(ct * 32 + r32, cbo)), wi_ = *(const LAS bf16x8*)(wl + 32768 + KSWZ(ct * 32 + r32, cbo));
                aR = __builtin_amdgcn_mfma_f32_32x32x16_bf16(xf[d0], wr_, aR, 0, 0, 0);
                aI = __builtin_amdgcn_mfma_f32_32x32x16_bf16(xf[d0], wi_, aI, 0, 0, 0); }
            const int chl = ct * 32 + r32, ch = n * 128 + chl;
            const float lm = lam[ch], b_r = brg[ch], b_i = big[ch];
            const float lsg2 = (fminf(lm, 0.f) - log1pf(__expf(-fabsf(lm)))) * (8.0f * 1.4426950408889634f);
            float sA[4], sH[4];
#pragma unroll
            for (int r = 0; r < 16; ++r) { const int tl = wave * 32 + crow(r, hi);
                const float xcv = bf2f(*(const LAS unsigned short*)(xcl + KSWZ(tl, chl * 2)));
                const float rr = __builtin_amdgcn_rcpf(1.0f + __builtin_amdgcn_exp2f(-1.4426950408889634f * (aR[r] + b_r)));
                const float ii = __builtin_amdgcn_rcpf(1.0f + __builtin_amdgcn_exp2f(-1.4426950408889634f * (aI[r] + b_i)));
                const float la2 = rr * lsg2;
                const float av = __builtin_amdgcn_exp2f(la2);
                const float x2 = la2 * (2.0f * 0.6931471805599453f);
                const float ser = -x2 * (1.0f + x2 * (0.5f + x2 * (0.16666667f + x2 * 0.041666668f)));
                const float om = x2 > -0.1f ? ser : 1.0f - av * av;
                const size_t o = (size_t)(tt * 256 + tl) * DM + ch;
                const float bv = __builtin_amdgcn_sqrtf(om) * (ii * xcv);
                SAB[o] = cvtpk(la2, bv);
                const int sg = r >> 2; if ((r & 3) == 0) { sA[sg] = av; sH[sg] = bv; } else { sH[sg] = av * sH[sg] + bv; sA[sg] *= av; } }
            float cA = 1.f, cH = 0.f;
#pragma unroll
            for (int sg = 0; sg < 4; ++sg) { const float pA = __shfl_xor(sA[sg], 32), pH = __shfl_xor(sH[sg], 32);
                const float fA = hi ? pA : sA[sg], fH = hi ? pH : sH[sg], gA = hi ? sA[sg] : pA, gH = hi ? sH[sg] : pH;
                cH = fA * cH + fH; cA *= fA; cH = gA * cH + gH; cA *= gA; }
            if (hi == 0) comp[wave * 128 + chl] = (f32x2){cA, cH};
        }
        __syncthreads();
        { const int k = tid >> 7, chl = tid & 127; const f32x2 c0 = comp[(2 * k) * 128 + chl], c1 = comp[(2 * k + 1) * 128 + chl];
          float* CA = (float*)(F.ws + WS_CARRY); float* CH = CA + 128 * DM; const size_t o = (size_t)(tt * 4 + k) * DM + n * 128 + chl;
          CA[o] = c0.x * c1.x; CH[o] = c1.x * c0.y + c1.y; }
    }
}
__device__ __forceinline__ void phase_rec_tot(const Args& A, Frame& F) {
    int tid = F.wave * 64 + lane_id_v(); asm volatile("" : "+v"(tid)); const int lane = tid & 63, wave = __builtin_amdgcn_readfirstlane(tid >> 6); (void)lane; (void)wave;
    const float* SA = (const float*)(F.ws + WS_HID); const float* SB = SA + (size_t)S * DM; float* CA = (float*)(F.ws + WS_CARRY); float* CH = CA + 128 * DM;
    for (int i = F.bid * (NWAVES * 64) + tid; i < 128 * 1024; i += F.G * NWAVES * 64) { const int ch = i >> 10, c = (i & 1023) * 2;
        f32x2 A = (f32x2){1.f, 1.f}, H = (f32x2){0.f, 0.f};
#pragma unroll 8
        for (int r = 0; r < 64; ++r) { const size_t o = (size_t)(ch * 64 + r) * DM + c; const f32x2 a = *(const f32x2*)(SA + o), b = *(const f32x2*)(SB + o); H = a * H + b; A = A * a; }
        *(f32x2*)(CA + ch * DM + c) = A; *(f32x2*)(CH + ch * DM + c) = H; }
}
__device__ __forceinline__ void phase_rec_scan(const Args& A, Frame& F) {
    int tid = F.wave * 64 + lane_id_v(); asm volatile("" : "+v"(tid));
    const unsigned* SAB = (const unsigned*)(F.ws + WS_HID); const float* CA = (const float*)(F.ws + WS_CARRY); const float* CH = CA + 128 * DM;
    const bf16* GG = (const bf16*)(F.ws + WS_QKV + 32 * MiB); bf16* AO = (bf16*)(F.ws + WS_AO);
    for (int i = F.bid * (NWAVES * 64) + tid; i < 128 * 1024; i += F.G * NWAVES * 64) { const int ch = i >> 10, c = (i & 1023) * 2;
        f32x2 H = (f32x2){0.f, 0.f};
        int k = 0;
        for (; k + 16 <= ch; k += 16) { f32x2 a[16], b[16];
#pragma unroll
            for (int j = 0; j < 16; ++j) { a[j] = *(const f32x2*)(CA + (k + j) * DM + c); b[j] = *(const f32x2*)(CH + (k + j) * DM + c); }
#pragma unroll
            for (int j = 0; j < 16; ++j) H = a[j] * H + b[j]; }
        if (k + 8 <= ch) { f32x2 a[8], b[8];
#pragma unroll
            for (int j = 0; j < 8; ++j) { a[j] = *(const f32x2*)(CA + (k + j) * DM + c); b[j] = *(const f32x2*)(CH + (k + j) * DM + c); }
#pragma unroll
            for (int j = 0; j < 8; ++j) H = a[j] * H + b[j];
            k += 8; }
        for (; k < ch; ++k) { const f32x2 a = *(const f32x2*)(CA + k * DM + c), b = *(const f32x2*)(CH + k * DM + c); H = a * H + b; }
#pragma unroll 1
        for (int r0 = 0; r0 < 64; r0 += 32) { v2u x[32]; unsigned g[32];
#pragma unroll
            for (int j = 0; j < 32; ++j) { const size_t o = (size_t)(ch * 64 + r0 + j) * DM + c; x[j] = __builtin_nontemporal_load((const v2u*)(SAB + o)); g[j] = *(const unsigned*)(GG + o); }
#pragma unroll
            for (int j = 0; j < 32; ++j) { const size_t o = (size_t)(ch * 64 + r0 + j) * DM + c;
                const f32x2 a = (f32x2){__builtin_amdgcn_exp2f(bflo(x[j].x)), __builtin_amdgcn_exp2f(bflo(x[j].y))}, b = (f32x2){bfhi(x[j].x), bfhi(x[j].y)};
                H = a * H + b; *(unsigned*)(AO + o) = pk2(H.x * bflo(g[j]), H.y * bfhi(g[j])); } }
    }
}
__device__ __forceinline__ int dq_layer(int li) {
    int l = 0, seen = -1;
#pragma unroll
    for (int b = 0; b < 4; ++b) if ((DQ_MASK >> b) & 1) { ++seen; if (seen == li) l = b; }
    return l;
}
__device__ __forceinline__ void wq_rows(const Args& A, Frame& F) {
    int tid = F.wave * 64 + lane_id_v(); asm volatile("" : "+v"(tid)); const int lane = tid & 63, wave = __builtin_amdgcn_readfirstlane(tid >> 6);
    const int gw = F.bid * NWAVES + wave, NGW = F.G * NWAVES;
    float* SWb = (float*)(F.ws + WS_SW);
    constexpr int NL = ((DQ_MASK >> 0) & 1) + ((DQ_MASK >> 1) & 1) + ((DQ_MASK >> 2) & 1) + ((DQ_MASK >> 3) & 1);
    for (int r0 = gw; r0 < NL * DM; r0 += 2 * NGW) {
        v4u x[2][16];
#pragma unroll
        for (int h = 0; h < 2; ++h) { const int rr = r0 + h * NGW < NL * DM ? r0 + h * NGW : r0; const int li = rr / DM, n = rr - li * DM, l = dq_layer(li);
            const bf16* src = (const bf16*)(F.ws + WS_W2) + (size_t)l * DM * FF + (size_t)n * FF;
#pragma unroll
            for (int j = 0; j < 16; ++j) x[h][j] = ((const GAS v4u*)src + lane)[64 * j]; }
#pragma unroll
        for (int h = 0; h < 2; ++h) { const int rr = r0 + h * NGW; if (rr >= NL * DM) break; const int li = rr / DM, n = rr - li * DM, l = dq_layer(li);
            unsigned char* dst = F.ws + WS_W1 + WS_W2Q_OFF * MiB + (size_t)l * DM * FF + (size_t)n * FF;
            float am = 0.f;
#pragma unroll
            for (int j = 0; j < 16; ++j)
#pragma unroll
                for (int e = 0; e < 4; ++e) am = fmaxf(am, fmaxf(fabsf(bflo(x[h][j][e])), fabsf(bfhi(x[h][j][e]))));
            am = wave_max(am);
            const float inv = am > 1e-30f ? 127.0f / am : 0.f; float cs = 0.f;
#pragma unroll
            for (int j = 0; j < 16; ++j) { float r[8];
#pragma unroll
                for (int e = 0; e < 4; ++e) { r[2 * e] = __builtin_rintf(bflo(x[h][j][e]) * inv); r[2 * e + 1] = __builtin_rintf(bfhi(x[h][j][e]) * inv); cs += r[2 * e] + r[2 * e + 1]; }
                v2u o; o.x = pack_i8x4(r[0], r[1], r[2], r[3]); o.y = pack_i8x4(r[4], r[5], r[6], r[7]);
                ((GAS v2u*)dst + lane)[64 * j] = o; }
            cs = wave_sum(cs);
            if (lane == 0) { SWb[SW_T2 + l * DM + n] = am * (1.0f / 127.0f); SWb[SW_CS2 + l * DM + n] = cs; } }
    }
    for (int r0 = gw; r0 < NL * FF; r0 += 4 * NGW) {
        v4u a[4], b2[4]; float stp[4];
#pragma unroll
        for (int h = 0; h < 4; ++h) { const int rr = r0 + h * NGW < NL * FF ? r0 + h * NGW : r0; const int li = rr / FF, n = rr - li * FF, l = dq_layer(li);
            const unsigned char* src = F.ws + WS_W1 + (size_t)l * FF * DM + (size_t)n * DM;
            a[h] = ((const GAS v4u*)src + lane)[0]; b2[h] = ((const GAS v4u*)src + lane)[64]; stp[h] = SWb[SW_W1 + l * FF + n]; }
#pragma unroll
        for (int h = 0; h < 4; ++h) { const int rr = r0 + h * NGW; if (rr >= NL * FF) break; const int li = rr / FF, n = rr - li * FF, l = dq_layer(li);
            int acc = 0;
#pragma unroll
            for (int e = 0; e < 4; ++e) { const int w0 = (int)a[h][e], w1 = (int)b2[h][e];
#pragma unroll
                for (int sh = 0; sh < 4; ++sh) { const int q0 = (w0 << (24 - 8 * sh)) >> 24, q1 = (w1 << (24 - 8 * sh)) >> 24; acc += q0 * q0 + q1 * q1; } }
            const float tot = wave_sum((float)acc);
            if (lane == 0) SWb[SW_SS + l * FF + n] = tot * stp[h] * stp[h]; }
    }
}
__device__ __forceinline__ void hidden_step(Frame& F, int l) {
    if (F.bid == 0) { float* SWb = (float*)(F.ws + WS_SW); int tid = F.wave * 64 + lane_id_v(); asm volatile("" : "+v"(tid)); const int lane = tid & 63;
        float v[16];
#pragma unroll
        for (int j = 0; j < 16; ++j) v[j] = SWb[SW_SS + l * FF + tid + 512 * j];
        float s = 0.f;
#pragma unroll
        for (int j = 0; j < 16; ++j) s += v[j];
        s = wave_sum(s);
        LAS float* red = (LAS float*)(F.lds + RING_OFF);
        if (lane == 0) red[F.wave] = s;
        __syncthreads();
        if (tid == 0) { float t = 0.f;
#pragma unroll
            for (int w = 0; w < 8; ++w) t += red[w];
            const float C = 21.16f * t * (1.0f / 8192.0f);
            SWb[SW_CL + 2 * l] = 254.0f / C; SWb[SW_CL + 2 * l + 1] = C * (1.0f / 254.0f); }
        __syncthreads(); }
}
__device__ __forceinline__ void phase_quant(const Args& A, Frame& F, int need_q) {
    int tid = F.wave * 64 + lane_id_v(); asm volatile("" : "+v"(tid)); const int lane = tid & 63, wave = __builtin_amdgcn_readfirstlane(tid >> 6);
    const bf16* XB = (const bf16*)(F.ws + WS_XB); unsigned char* XQ = F.ws + WS_XQ; float* frow = (float*)(F.ws + WS_FROW);
    const int nk = pass_nrows(F, wave);
    for (int k0 = 0; k0 < nk; k0 += 4) {
        v4u x[4][4];
#pragma unroll
        for (int r = 0; r < 4; ++r) { const int m = pass_row(F, wave, k0 + r < nk ? k0 + r : k0);
#pragma unroll
            for (int j = 0; j < 4; ++j) x[r][j] = ((const GAS v4u*)(XB + (size_t)m * DM) + lane)[64 * j]; }
#pragma unroll
        for (int r = 0; r < 4; ++r) { const int m = k0 + r < nk ? pass_row(F, wave, k0 + r) : S; float s = 0.f, am = 0.f;
#pragma unroll
            for (int j = 0; j < 4; ++j) {
#pragma unroll
                for (int e = 0; e < 4; ++e) { const float a0 = bflo(x[r][j][e]), a1 = bfhi(x[r][j][e]); s += a0 * a0 + a1 * a1; am = fmaxf(am, fmaxf(fabsf(a0), fabsf(a1))); } }
            s = wave_sum(s); am = wave_max(am);
            const float inv = am > 1e-30f ? 127.0f / am : 0.f;
            if (m < S) {
                if (need_q) {
#pragma unroll
                for (int j = 0; j < 4; ++j) { v2u o; o.x = pack_i8x4(bflo(x[r][j].x) * inv, bfhi(x[r][j].x) * inv, bflo(x[r][j].y) * inv, bfhi(x[r][j].y) * inv);
                    o.y = pack_i8x4(bflo(x[r][j].z) * inv, bfhi(x[r][j].z) * inv, bflo(x[r][j].w) * inv, bfhi(x[r][j].w) * inv);
                    ((GAS v2u*)(XQ + (size_t)m * DM) + lane)[64 * j] = o; } }
                if (lane == 0) { const float rstd = __builtin_amdgcn_rsqf(s * (1.0f / 2048.0f) + 1e-6f); frow[m] = am * (1.0f / 127.0f) * rstd; ((float*)(F.ws + WS_RSTD))[m] = rstd; } } }
    }
}
__device__ __forceinline__ void phase_final(const Args& A, Frame& F) {
    int tid = F.wave * 64 + lane_id_v(); asm volatile("" : "+v"(tid)); const int lane = tid & 63, wave = __builtin_amdgcn_readfirstlane(tid >> 6);
    const bf16* XB = (const bf16*)(F.ws + WS_XB); const float* gf = A.in[4];
    const int nk = pass_nrows(F, wave);
    f32x4 g0[4], g1[4];
#pragma unroll
    for (int j = 0; j < 4; ++j) { g0[j] = *(const f32x4*)(gf + j * 512 + lane * 8); g1[j] = *(const f32x4*)(gf + j * 512 + lane * 8 + 4); }
    for (int k0 = 0; k0 < nk; k0 += 2) {
        const bool two = k0 + 1 < nk; const int m0 = pass_row(F, wave, k0), m1 = two ? pass_row(F, wave, k0 + 1) : m0;
        v4u xa[4], xb[4];
#pragma unroll
        for (int j = 0; j < 4; ++j) { xa[j] = ((const GAS v4u*)(XB + (size_t)m0 * DM) + lane)[64 * j]; xb[j] = two ? ((const GAS v4u*)(XB + (size_t)m1 * DM) + lane)[64 * j] : xa[j]; }
        float s0 = 0.f, s1 = 0.f;
#pragma unroll
        for (int j = 0; j < 4; ++j) {
#pragma unroll
            for (int e = 0; e < 4; ++e) { const float a0 = bflo(xa[j][e]), a1 = bfhi(xa[j][e]), b0 = bflo(xb[j][e]), b1 = bfhi(xb[j][e]); s0 += a0 * a0 + a1 * a1; s1 += b0 * b0 + b1 * b1; } }
        s0 = wave_sum(s0); s1 = wave_sum(s1);
        const float r0 = __builtin_amdgcn_rsqf(s0 * (1.0f / 2048.0f) + 1e-6f), r1 = __builtin_amdgcn_rsqf(s1 * (1.0f / 2048.0f) + 1e-6f);
        GAS f32x4* o0 = (GAS f32x4*)(A.out + (size_t)m0 * DM) + 2 * lane; GAS f32x4* o1 = (GAS f32x4*)(A.out + (size_t)m1 * DM) + 2 * lane;
#pragma unroll
        for (int j = 0; j < 4; ++j) { const f32x4 a = (f32x4){bflo(xa[j].x), bfhi(xa[j].x), bflo(xa[j].y), bfhi(xa[j].y)}, b = (f32x4){bflo(xa[j].z), bfhi(xa[j].z), bflo(xa[j].w), bfhi(xa[j].w)};
            __builtin_nontemporal_store(a * r0 * g0[j], &o0[128 * j]); __builtin_nontemporal_store(b * r0 * g1[j], &o0[128 * j + 1]); }
        if (two) {
#pragma unroll
            for (int j = 0; j < 4; ++j) { const f32x4 a = (f32x4){bflo(xb[j].x), bfhi(xb[j].x), bflo(xb[j].y), bfhi(xb[j].y)}, b = (f32x4){bflo(xb[j].z), bfhi(xb[j].z), bflo(xb[j].w), bfhi(xb[j].w)};
                __builtin_nontemporal_store(a * r1 * g0[j], &o1[128 * j]); __builtin_nontemporal_store(b * r1 * g1[j], &o1[128 * j + 1]); } }
    }
}
__global__ void __launch_bounds__(NWAVES * 64, 2) mega_fwd(Args A) {
    extern __shared__ __attribute__((aligned(16))) unsigned char lds[];
    Frame F;
    F.lds = (LAS unsigned char*)lds; F.ldsg = lds;
    F.MISC = (volatile LAS unsigned*)(F.lds + MISC_OFF);
    F.tid = threadIdx.x; F.lane = F.tid & 63; F.wave = __builtin_amdgcn_readfirstlane(F.tid >> 6);
    F.G = gridDim.x; F.bid = blockIdx.x;
    F.ws = A.ws; F.ctl = (gu32*)(A.ws + WS_CTL);
    for (int u = F.tid; u < (LDS_BYTES - LDSCTL_OFF) / 4; u += NWAVES * 64) ((LAS unsigned*)(F.lds + LDSCTL_OFF))[u] = 0u;
    __syncthreads();
    XcdBarrier bar; bar.bar = (unsigned*)(F.ctl + CW_BAR); bar.x = 0; bar.st = nullptr;
    if (!MK_PER_PHASE) bar = xcd_barrier_post((unsigned*)(F.ctl + CW_BAR), F.MISC + 8);
    const int lo = A.ph_lo, hi = A.ph_hi;
#define IN(k) (lo <= (k) && (k) < hi)
#define SEAM(k) do { if (IN(k) && IN((k) + 1)) xcd_barrier(bar); } while (0)

    if (IN(0) && DBG(0)) { for (int rp = 0; rp < NREP(0); ++rp) { p0_prologue(A, F); if (rp + 1 < NREP(0)) xcd_barrier(bar); } } SEAM(0);
    for (int ls = 0; ls < 2 * DEPTH; ++ls) {
        const int l = ls >> 1, st = ls & 1, jm = l >> 1, rec = l & 1;
        const int p1 = 1 + 7 * l + (st ? 5 : 0), p2 = p1 + (st ? 1 : 4);
        if (IN(p1) && DBG(1)) {
            if (ls > 0) { phase_quant(A, F, (st || !rec) ? 1 : 0); if (ls == 1 && DQ_MASK) wq_rows(A, F); if (st && ((DQ_MASK >> l) & 1)) hidden_step(F, l); xcd_barrier(bar); }
            if (!st && rec) {
                pg8::Gemm g{(const bf16*)(F.ws + WS_XB), (const bf16*)(F.ws + WS_WIN) + (size_t)jm * 2 * DM * DM, S, 2 * DM, DM, F.wave};
                pg8::FrowOrder So; So.init(S, 2 * DM, F.G, F.bid); So.frow = (const float*)(F.ws + WS_RSTD); So.tab = F.lds + 135168;
                pg8::EpiScaleT<false> E{(bf16*)(F.ws + WS_QKV), DM, F.lds + 135168, nullptr, (bf16*)(F.ws + WS_QKV + 32 * MiB), 1, nullptr, nullptr};
                pg8::gemm_phase<pg8::EpiScaleT<false>, pg8::FrowOrder, true, true, false>(F.lds + RING_OFF, g, So, E);
            } else {
            const unsigned char* Bq; const float* sc; int N, mode; bf16* O; int ldc;
            if (st) { Bq = F.ws + WS_W1 + (size_t)l * FF * DM; sc = (const float*)(F.ws + WS_SW) + SW_W1 + l * FF; N = FF; mode = ((DQ_MASK >> l) & 1) ? 3 : 2; O = (bf16*)(F.ws + WS_HID); ldc = FF; }
            else { Bq = F.ws + WS_WQKV + (size_t)jm * NQKV * DM; sc = (const float*)(F.ws + WS_SW) + SW_QKV + jm * NQKV; N = NQKV; mode = 0; O = (bf16*)(F.ws + WS_QKV); ldc = NQKV; }
            pg8::Gemm g{(const bf16*)(F.ws + WS_XQ), (const bf16*)Bq, S, N, DM / 2, F.wave};
            pg8::FrowOrder So; So.init(S, N, F.G, F.bid); So.frow = (const float*)(F.ws + WS_FROW); So.tab = F.lds + 135168;
            pg8::EpiScaleT<true> E{O, ldc, F.lds + 135168, (float*)(F.ws + WS_KMP), (bf16*)(F.ws + WS_QKV + 32 * MiB), mode, sc, (const float*)(F.ws + WS_SW) + SW_CL + 2 * l};
            for (int rp = 0; rp < NREP(1); ++rp) { pg8::gemm_phase<pg8::EpiScaleT<true>, pg8::FrowOrder, true, true, true>(F.lds + RING_OFF, g, So, E); if (rp + 1 < NREP(1)) xcd_barrier(bar); } } }
        SEAM(p1);
        if (!st) {
            if (!rec) {
                if (IN(p1 + 1) && DBG(2)) phase_gate2(A, F, jm);
                SEAM(p1 + 1);
                if (IN(p1 + 2) && DBG(3)) { for (int rp = 0; rp < NREP(3); ++rp) { attn_phase<false>(A, F, jm); if (rp + 1 < NREP(3)) xcd_barrier(bar); } }
                SEAM(p1 + 2);
                if (IN(p1 + 3) && DBG(4)) { for (int rp = 0; rp < NREP(4); ++rp) { attn_phase3<true>(A, F, jm); if (rp + 1 < NREP(4)) xcd_barrier(bar); } }
                SEAM(p1 + 3);
            } else {
                if (IN(p1 + 1) && DBG(6)) { for (int rp = 0; rp < NREP(6); ++rp) { phase_rec_ab2(A, F, jm); if (rp + 1 < NREP(6)) xcd_barrier(bar); } }
                SEAM(p1 + 1);
                                if (IN(p1 + 3) && DBG(8)) { for (int rp = 0; rp < NREP(8); ++rp) { phase_rec_scan(A, F); if (rp + 1 < NREP(8)) xcd_barrier(bar); } }
                SEAM(p1 + 3);
            }
        }
        if (IN(p2) && DBG(9) && st && ((DQ_MASK >> l) & 1)) {
            pg8::Gemm g{(const bf16*)(F.ws + WS_HID), (const bf16*)(F.ws + WS_W1 + WS_W2Q_OFF * MiB + (size_t)l * DM * FF), S, DM, FF / 2, F.wave}; pg8::StaticOrder So; So.init(S, DM, F.G, F.bid);
            pg8::EpiResQ8 E{(bf16*)(F.ws + WS_XB), (const float*)(F.ws + WS_SW) + SW_T2 + l * DM, (const float*)(F.ws + WS_SW) + SW_CS2 + l * DM, (const float*)(F.ws + WS_SW) + SW_CL + 2 * l};
            pg8::gemm_phase<pg8::EpiResQ8, pg8::StaticOrder, true, true, true>(F.lds + RING_OFF, g, So, E); }
        else if (IN(p2) && DBG(9)) {
            const bf16* Ap; const bf16* Bt; int K;
            if (st) { Ap = (const bf16*)(F.ws + WS_HID); Bt = (const bf16*)(F.ws + WS_W2) + (size_t)l * DM * FF; K = FF; }
            else { Ap = (const bf16*)(F.ws + WS_AO); Bt = (const bf16*)(F.ws + (rec ? WS_WOUT : WS_WO)) + (size_t)jm * DM * DM; K = DM; }
            pg8::Gemm g{Ap, Bt, S, DM, K, F.wave}; pg8::StaticOrder So; So.init(S, DM, F.G, F.bid);
            pg8::EpiRes E{(bf16*)(F.ws + WS_XB)};
            pg8::gemm_phase<pg8::EpiRes, pg8::StaticOrder, true, true>(F.lds + RING_OFF, g, So, E); }
        SEAM(p2);
    }
    if (IN(NPHASE - 1) && DBG(12)) { for (int rp = 0; rp < NREP(12); ++rp) { phase_final(A, F); if (rp + 1 < NREP(12)) xcd_barrier(bar); } }
#undef IN
#undef SEAM
}

extern "C" void kernel_launch(void* const* d_in, const int* in_sizes, int n_in, void* d_out, int out_size, void* d_ws, size_t ws_size, hipStream_t stream) {
    static int grid = 0;
    if (grid == 0) {
        if (n_in != 18 || in_sizes[0] != S * DM || out_size != S * DM || ws_size < WS_END) { fprintf(stderr, "kernel_launch: shape mismatch n_in %d in0 %d out %d ws %zu (need %zu)\n", n_in, n_in > 0 ? in_sizes[0] : -1, out_size, ws_size, (size_t)WS_END); grid = -1; return; }
        int dev = 0, cus = 0, per_cu = 0;
        if (hipGetDevice(&dev) != hipSuccess || hipDeviceGetAttribute(&cus, hipDeviceAttributeMultiprocessorCount, dev) != hipSuccess) { grid = -1; return; }
        if (hipFuncSetAttribute((const void*)mega_fwd, hipFuncAttributeMaxDynamicSharedMemorySize, LDS_BYTES) != hipSuccess) { fprintf(stderr, "kernel_launch: hipFuncSetAttribute failed\n"); grid = -1; return; }
        if (hipOccupancyMaxActiveBlocksPerMultiprocessor(&per_cu, (const void*)mega_fwd, NWAVES * 64, LDS_BYTES) != hipSuccess || per_cu < 1) fprintf(stderr, "kernel_launch: occupancy query says %d\n", per_cu);
        (void)hipGetLastError();
        grid = cus;
    }
    if (grid < 0) return;
    if (hipMemsetAsync((char*)d_ws + WS_CTL, 0, CTL_ZERO_BYTES, stream) != hipSuccess) { fprintf(stderr, "kernel_launch: memset failed\n"); return; }
    Args a{};
    for (int i = 0; i < 18; ++i) a.in[i] = (const float*)d_in[i];
    a.out = (float*)d_out; a.ws = (unsigned char*)d_ws;
#if MK_PER_PHASE
    for (int p = 0; p < NPHASE; ++p) { a.ph_lo = p; a.ph_hi = p + 1; hipLaunchKernelGGL(mega_fwd, dim3(grid), dim3(NWAVES * 64), LDS_BYTES, stream, a); }
#else
    a.ph_lo = 0; a.ph_hi = NPHASE; hipLaunchKernelGGL(mega_fwd, dim3(grid), dim3(NWAVES * 64), LDS_BYTES, stream, a);
#endif
    const hipError_t le = hipPeekAtLastError();
    if (le != hipSuccess) fprintf(stderr, "kernel_launch: launch failed: %s\n", hipGetErrorName(le));
}
```

```cpp
#include <hip/hip_runtime.h>
#include <cstdio>
#include <cstdint>
#include <cmath>
__device__ __forceinline__ int lane_id_v() { int l; asm volatile("v_mbcnt_lo_u32_b32 %0, -1, 0\n\tv_mbcnt_hi_u32_b32 %0, -1, %0" : "=v"(l)); return l; }
namespace pg8 {
#define PG8_LAS __attribute__((address_space(3)))
typedef unsigned short bf16_t;
typedef short bf16x8 __attribute__((ext_vector_type(8)));
typedef float f32x4 __attribute__((ext_vector_type(4)));
typedef unsigned u32x4 __attribute__((ext_vector_type(4)));
typedef int i32x4 __attribute__((ext_vector_type(4)));
template <bool I8> struct AccT { typedef f32x4 type; };
template <> struct AccT<true> { typedef i32x4 type; };
__device__ __forceinline__ f32x4 mma_op(bf16x8 a, bf16x8 b, f32x4 c) { return __builtin_amdgcn_mfma_f32_16x16x32_bf16(a, b, c, 0, 0, 0); }
__device__ __forceinline__ i32x4 mma_op(bf16x8 a, bf16x8 b, i32x4 c) { return __builtin_amdgcn_mfma_i32_16x16x64_i8(__builtin_bit_cast(i32x4, a), __builtin_bit_cast(i32x4, b), c, 0, 0, 0); }
constexpr int BM = 256, BK = 64, HALF = 128, HTB = HALF * BK * 2  , STAGE_BYTES = 8 * HTB, NXCD = 8, WGM = 8;

__host__ __device__ __forceinline__ int lds_byte(int r, int c) { const int st = (r >> 4) * 2 + (c >> 5), rr = r & 15, cc = c & 31, ob = rr * 64 + cc * 2; return st * 1024 + (ob ^ (((ob >> 9) & 1) << 5)); }
__host__ __device__ __forceinline__ void stage_rc(int b, int& R, int& C) { const int st = b / 1024, sb = b % 1024, swz = sb ^ (((sb >> 9) & 1) << 5); R = (st >> 1) * 16 + swz / 64; C = (st & 1) * 32 + (swz % 64) / 2; }
__host__ __device__ __forceinline__ int perm32(int rho) { const int n = rho >> 4, i = rho & 15; return 8 * (i >> 2) + 4 * n + (i & 3); }

struct Unit { int pm, pn, seq; };
struct Gemm { const bf16_t* A; const bf16_t* Bt; int M, N, K; int wave; };

struct StaticOrder {
    int nM, nN, nwg, G, c;
    __host__ __device__ void init(int M, int N, int G_, int c_) { nM = M / BM; nN = N / BM; nwg = nM * nN; G = G_; c = c_; }
    __host__ __device__ bool next(int i, Unit& u) const {
        const long L = (long)i * G + c; if (L >= nwg) return false;
        int wgid = (int)L; { const int q = nwg / NXCD, r = nwg % NXCD, xcd = wgid % NXCD, off = wgid / NXCD; wgid = (xcd < r ? xcd * (q + 1) : r * (q + 1) + (xcd - r) * q) + off; }
        const int nig = WGM * nN, gid = wgid / nig, fm = gid * WGM, gsz = (nM - fm) < WGM ? (nM - fm) : WGM;
        u.pm = fm + ((wgid % nig) % gsz); u.pn = (wgid % nig) / gsz; u.seq = i; return true;
    }
    __device__ __forceinline__ void a_ready(const Unit&) const {}
    __device__ __forceinline__ void done(const Unit&) const {}
};

__device__ __forceinline__ unsigned cvt_pk_bf16(float lo, float hi) { unsigned r; asm volatile("v_cvt_pk_bf16_f32 %0, %1, %2" : "=v"(r) : "v"(lo), "v"(hi)); return r; }
struct FrowOrder : StaticOrder {
    const float* frow; PG8_LAS unsigned char* tab;
    __device__ __forceinline__ void a_ready(const Unit& u) const {
        const int lane = lane_id_v();
        __builtin_amdgcn_global_load_lds((const unsigned*)(frow + (size_t)u.pm * BM + lane * 4), (PG8_LAS unsigned*)(tab + (u.seq & 1) * 1024), 16, 0, 0);
    }
};
constexpr float RMS_EPS = 1e-6f;
typedef float f32x2_ __attribute__((ext_vector_type(2)));
__device__ __forceinline__ float gelu_tanh(float x) {
    const float u = 0.7978845608028654f * (x + 0.044715f * x * x * x);
    const float e = __builtin_amdgcn_exp2f(-2.0f * 1.4426950408889634f * u);
    return x * __builtin_amdgcn_rcpf(1.0f + e);
}
template <bool I8>
struct EpiScaleT {
    static constexpr bool PERM = true, AFTER_DRAIN = false;
    bf16_t* O; int ldc; const PG8_LAS unsigned char* tab; float* kmp; bf16_t* O2; int mode; const float* scol; const float* hq;
    __device__ __forceinline__ void operator()(const typename AccT<I8>::type (&acc)[2][2][4][2], const Unit& u, int wr, int wc, int fr, int fq) const {
        const int row0 = u.pm * BM + wr * 64 + fr;
        f32x4 sc[2][2];
#pragma unroll
        for (int bj = 0; bj < 2; ++bj)
#pragma unroll
            for (int n = 0; n < 2; ++n) { if constexpr (I8) sc[bj][n] = *(const f32x4*)(scol + u.pn * BM + bj * HALF + wc * 32 + 8 * fq + 4 * n); else sc[bj][n] = (f32x4){1.f, 1.f, 1.f, 1.f}; }
        float rs[2][4];
#pragma unroll
        for (int ai = 0; ai < 2; ++ai)
#pragma unroll
            for (int m = 0; m < 4; ++m) rs[ai][m] = *(const PG8_LAS float*)(tab + (u.seq & 1) * 1024 + (wr * 64 + fr + ai * HALF + m * 16) * 4);
        int colt = u.pn * BM; bf16_t* base = O; int am = mode >= 2 ? 2 : 0; const float hqi = mode == 3 ? hq[0] : 0.f;
        if (mode == 1 && colt >= 2048) { colt -= 2048; base = O2; am = 1; }
        const int col0 = colt + wc * 32 + 8 * fq;
#pragma unroll
        for (int ai = 0; ai < 2; ++ai)
#pragma unroll
            for (int m = 0; m < 4; ++m) { bf16_t* rowp = base + (size_t)(row0 + ai * HALF + m * 16) * ldc + col0; const float r = rs[ai][m];
#pragma unroll
                for (int bj = 0; bj < 2; ++bj) { f32x4 v0 = __builtin_convertvector(acc[ai][bj][m][0], f32x4) * (sc[bj][0] * r), v1 = __builtin_convertvector(acc[ai][bj][m][1], f32x4) * (sc[bj][1] * r);
                    if (am == 1) {
#pragma unroll
                        for (int e = 0; e < 4; ++e) { v0[e] = gelu_tanh(v0[e]); v1[e] = gelu_tanh(v1[e]); } }
                    else if (am == 2) {
#pragma unroll
                        for (int e = 0; e < 4; ++e) { const float a0 = fmaxf(v0[e], 0.f), a1 = fmaxf(v1[e], 0.f); v0[e] = a0 * a0; v1[e] = a1 * a1; } }
                    u32x4 w; w.x = cvt_pk_bf16(v0[0], v0[1]); w.y = cvt_pk_bf16(v0[2], v0[3]); w.z = cvt_pk_bf16(v1[0], v1[1]); w.w = cvt_pk_bf16(v1[2], v1[3]);
                    if (mode == 3) {
                        int q[8];
#pragma unroll
                        for (int e = 0; e < 4; ++e) { q[e] = (int)__builtin_rintf(fminf(v0[e] * hqi, 254.0f)) - 127; q[4 + e] = (int)__builtin_rintf(fminf(v1[e] * hqi, 254.0f)) - 127; }
                        f32x2_ wq; wq.x = __builtin_bit_cast(float, ((unsigned)q[0] & 255u) | (((unsigned)q[1] & 255u) << 8) | (((unsigned)q[2] & 255u) << 16) | ((unsigned)q[3] << 24));
                        wq.y = __builtin_bit_cast(float, ((unsigned)q[4] & 255u) | (((unsigned)q[5] & 255u) << 8) | (((unsigned)q[6] & 255u) << 16) | ((unsigned)q[7] << 24));
                        *(f32x2_*)((unsigned char*)O + (size_t)(row0 + ai * HALF + m * 16) * 8192 + col0 + bj * HALF) = wq; }
                    else if (am == 2) __builtin_nontemporal_store(w, (u32x4*)(rowp + bj * HALF)); else *(u32x4*)(rowp + bj * HALF) = w; } }
        if (mode == 0 && u.pn >= 8 && u.pn < 16) {
            float* kp = kmp + ((size_t)wr * 32 + u.pm) * 2048 + (u.pn - 8) * BM + wc * 32 + 8 * fq;
#pragma unroll
            for (int bj = 0; bj < 2; ++bj)
#pragma unroll
                for (int n = 0; n < 2; ++n) { f32x4 s = (f32x4){0.f, 0.f, 0.f, 0.f};
#pragma unroll
                    for (int ai = 0; ai < 2; ++ai)
#pragma unroll
                        for (int m = 0; m < 4; ++m) s += __builtin_convertvector(acc[ai][bj][m][n], f32x4) * rs[ai][m];
                    s *= sc[bj][n];
#pragma unroll
                    for (int e = 0; e < 4; ++e) { float t = s[e]; t += __shfl_xor(t, 1); t += __shfl_xor(t, 2); t += __shfl_xor(t, 4); t += __shfl_xor(t, 8); s[e] = t; }
                    if (fr == 0) *(f32x4*)(kp + bj * HALF + 4 * n) = s; } }
    }
};
struct EpiRes {
    static constexpr bool PERM = true, AFTER_DRAIN = false;
    bf16_t* XB;
    __device__ __forceinline__ void operator()(const f32x4 (&acc)[2][2][4][2], const Unit& u, int wr, int wc, int fr, int fq) const {
        const int row0 = u.pm * BM + wr * 64 + fr, col0 = u.pn * BM + wc * 32 + 8 * fq;
        asm volatile("" ::: "memory"); __builtin_amdgcn_sched_barrier(0);
        u32x4 xin[2][4][2];
#pragma unroll
        for (int ai = 0; ai < 2; ++ai)
#pragma unroll
            for (int m = 0; m < 4; ++m)
#pragma unroll
                for (int bj = 0; bj < 2; ++bj) xin[ai][m][bj] = *(const u32x4*)(XB + (size_t)(row0 + ai * HALF + m * 16) * 2048 + col0 + bj * HALF);
        asm volatile("" ::: "memory"); __builtin_amdgcn_sched_barrier(0);
#pragma unroll
        for (int ai = 0; ai < 2; ++ai)
#pragma unroll
            for (int m = 0; m < 4; ++m) { const int r = row0 + ai * HALF + m * 16;
#pragma unroll
                for (int bj = 0; bj < 2; ++bj) { bf16_t* xp = XB + (size_t)r * 2048 + col0 + bj * HALF; const u32x4 xo = xin[ai][m][bj];
                    f32x4 x0, x1;
                    x0[0] = __builtin_bit_cast(float, xo.x << 16); x0[1] = __builtin_bit_cast(float, xo.x & 0xffff0000u); x0[2] = __builtin_bit_cast(float, xo.y << 16); x0[3] = __builtin_bit_cast(float, xo.y & 0xffff0000u);
                    x1[0] = __builtin_bit_cast(float, xo.z << 16); x1[1] = __builtin_bit_cast(float, xo.z & 0xffff0000u); x1[2] = __builtin_bit_cast(float, xo.w << 16); x1[3] = __builtin_bit_cast(float, xo.w & 0xffff0000u);
                    x0 += acc[ai][bj][m][0]; x1 += acc[ai][bj][m][1];
                    u32x4 w; w.x = cvt_pk_bf16(x0[0], x0[1]); w.y = cvt_pk_bf16(x0[2], x0[3]); w.z = cvt_pk_bf16(x1[0], x1[1]); w.w = cvt_pk_bf16(x1[2], x1[3]);
                    *(u32x4*)xp = w; } }
    }
};
struct EpiResQ8 {
    static constexpr bool PERM = true, AFTER_DRAIN = false;
    bf16_t* XB; const float* t2; const float* cs2; const float* hq;
    __device__ __forceinline__ void operator()(const i32x4 (&acc)[2][2][4][2], const Unit& u, int wr, int wc, int fr, int fq) const {
        const int row0 = u.pm * BM + wr * 64 + fr, col0 = u.pn * BM + wc * 32 + 8 * fq;
        const float step = hq[1];
        f32x4 sc[2][2], cc[2][2];
#pragma unroll
        for (int bj = 0; bj < 2; ++bj)
#pragma unroll
            for (int n = 0; n < 2; ++n) { sc[bj][n] = *(const f32x4*)(t2 + col0 + bj * HALF + 4 * n) * step; cc[bj][n] = *(const f32x4*)(cs2 + col0 + bj * HALF + 4 * n) * 127.0f; }
        asm volatile("" ::: "memory"); __builtin_amdgcn_sched_barrier(0);
#pragma unroll
        for (int ai = 0; ai < 2; ++ai) {
            u32x4 xin[4][2];
#pragma unroll
            for (int m = 0; m < 4; ++m)
#pragma unroll
                for (int bj = 0; bj < 2; ++bj) xin[m][bj] = *(const u32x4*)(XB + (size_t)(row0 + ai * HALF + m * 16) * 2048 + col0 + bj * HALF);
            asm volatile("" ::: "memory"); __builtin_amdgcn_sched_barrier(0);
#pragma unroll
            for (int m = 0; m < 4; ++m) { const int r = row0 + ai * HALF + m * 16;
#pragma unroll
                for (int bj = 0; bj < 2; ++bj) { bf16_t* xp = XB + (size_t)r * 2048 + col0 + bj * HALF; const u32x4 xo = xin[m][bj];
                    f32x4 x0, x1;
                    x0[0] = __builtin_bit_cast(float, xo.x << 16); x0[1] = __builtin_bit_cast(float, xo.x & 0xffff0000u); x0[2] = __builtin_bit_cast(float, xo.y << 16); x0[3] = __builtin_bit_cast(float, xo.y & 0xffff0000u);
                    x1[0] = __builtin_bit_cast(float, xo.z << 16); x1[1] = __builtin_bit_cast(float, xo.z & 0xffff0000u); x1[2] = __builtin_bit_cast(float, xo.w << 16); x1[3] = __builtin_bit_cast(float, xo.w & 0xffff0000u);
                    x0 += (__builtin_convertvector(acc[ai][bj][m][0], f32x4) + cc[bj][0]) * sc[bj][0]; x1 += (__builtin_convertvector(acc[ai][bj][m][1], f32x4) + cc[bj][1]) * sc[bj][1];
                    u32x4 w; w.x = cvt_pk_bf16(x0[0], x0[1]); w.y = cvt_pk_bf16(x0[2], x0[3]); w.z = cvt_pk_bf16(x1[0], x1[1]); w.w = cvt_pk_bf16(x1[2], x1[3]);
                    *(u32x4*)xp = w; } }
            asm volatile("" ::: "memory"); __builtin_amdgcn_sched_barrier(0); }
    }
};
template <class Epi, class Sched, bool ALIGN_EPI = false, bool SP2 = false, bool I8 = false>
__device__ __forceinline__ void gemm_phase(PG8_LAS unsigned char* lds, const Gemm g, const Sched& S, const Epi& E) {
    int tid_ = g.wave * 64 + lane_id_v(); asm volatile("" : "+v"(tid_));
    const int tid = tid_, wid = __builtin_amdgcn_readfirstlane(tid >> 6), lane = tid & 63, wr = wid >> 2, wc = wid & 3, fr = lane & 15, fq = lane >> 4;
    const int K = g.K, nt = K / BK;
    unsigned voffA[2], voffB[2];
#pragma unroll
    for (int i = 0; i < 2; ++i) { int R, C; stage_rc(tid * 16 + i * 8192, R, C); const int Rb = Epi::PERM ? ((R & ~31) + perm32(R & 31)) : R;
        voffA[i] = (unsigned)(R * K + C) * 2u; voffB[i] = (unsigned)(Rb * K + C) * 2u; }
    const size_t kstep = (size_t)(BK * 2);
    const size_t hstep = (size_t)HALF * K * 2;
    const size_t tstep = 2 * hstep;
    const unsigned ldsw = (unsigned)wid * 1024u;
    const int aoff = lds_byte(wr * 64 + fr, fq * 8), boff = lds_byte(wc * 32 + fr, fq * 8);
#define PG8_SA(b, h) (((b) * 2 + (h)) * HTB)
#define PG8_SB(b, h) ((4 + (b) * 2 + (h)) * HTB)
#define PG8_STAGE(bufoff, gbase, voff) do { _Pragma("unroll") for (int _i = 0; _i < 2; ++_i) \
        __builtin_amdgcn_global_load_lds((const unsigned*)((const char*)(gbase) + (voff)[_i]), (PG8_LAS unsigned*)(lds + (bufoff) + ldsw + _i * 8192), 16, 0, 0); } while (0)
#define PG8_LDA(dst, b, h) do { _Pragma("unroll") for (int m = 0; m < 4; ++m) _Pragma("unroll") for (int k = 0; k < 2; ++k) dst[m][k] = *(const PG8_LAS bf16x8*)(lds + PG8_SA(b, h) + aoff + m * 2048 + k * 1024); } while (0)
#define PG8_LDB(dst, b, h) do { _Pragma("unroll") for (int n = 0; n < 2; ++n) _Pragma("unroll") for (int k = 0; k < 2; ++k) dst[n][k] = *(const PG8_LAS bf16x8*)(lds + PG8_SB(b, h) + boff + n * 2048 + k * 1024); } while (0)
#define PG8_MMA(ai, bj, At, Bt) do { __builtin_amdgcn_s_setprio(1); _Pragma("unroll") for (int m = 0; m < 4; ++m) _Pragma("unroll") for (int n = 0; n < 2; ++n) _Pragma("unroll") for (int k = 0; k < 2; ++k) \
        acc[ai][bj][m][n] = mma_op(Bt[n][k], At[m][k], acc[ai][bj][m][n]); __builtin_amdgcn_s_setprio(0); } while (0)
#define PG8_WAIT_V(n) asm volatile("s_waitcnt vmcnt(" #n ")" ::: "memory")
#define PG8_WAIT_L(n) asm volatile("s_waitcnt lgkmcnt(" #n ")" ::: "memory")
#define PG8_BAR __builtin_amdgcn_s_barrier()
#define PG8_SCHED __builtin_amdgcn_sched_barrier(0)
    Unit cur, nxt; int ui = 0;
    if (!S.next(0, cur)) return;
    typedef typename AccT<I8>::type acc_t;
    acc_t acc[2][2][4][2];
#pragma unroll
    for (int a = 0; a < 2; ++a)
#pragma unroll
        for (int b = 0; b < 2; ++b)
#pragma unroll
            for (int m = 0; m < 4; ++m)
#pragma unroll
                for (int n = 0; n < 2; ++n) acc[a][b][m][n] = acc_t{};
    bf16x8 At[4][2], B0[2][2], B1[2][2];
    const char* cA = (const char*)g.A + (size_t)cur.pm * tstep; const char* cB = (const char*)g.Bt + (size_t)cur.pn * tstep;
    S.a_ready(cur);
    if constexpr (SP2) {
        PG8_STAGE(PG8_SB(0, 0), cB, voffB); PG8_STAGE(PG8_SB(0, 1), cB + hstep, voffB); PG8_STAGE(PG8_SA(0, 0), cA, voffA); PG8_STAGE(PG8_SA(0, 1), cA + hstep, voffA);
        if (wr == 1) PG8_BAR;
        PG8_WAIT_V(2); PG8_BAR;
        PG8_STAGE(PG8_SB(1, 0), cB + kstep, voffB); PG8_STAGE(PG8_SB(1, 1), cB + hstep + kstep, voffB);
        PG8_WAIT_V(4); PG8_BAR;
    } else {
        PG8_STAGE(PG8_SB(0, 0), cB, voffB); PG8_STAGE(PG8_SA(0, 0), cA, voffA); PG8_STAGE(PG8_SB(0, 1), cB + hstep, voffB); PG8_STAGE(PG8_SA(0, 1), cA + hstep, voffA);
        if (wr == 1) PG8_BAR;
        PG8_WAIT_V(4); PG8_BAR;
        PG8_STAGE(PG8_SB(1, 0), cB + kstep, voffB); PG8_STAGE(PG8_SA(1, 0), cA + kstep, voffA); PG8_STAGE(PG8_SB(1, 1), cB + hstep + kstep, voffB);
        PG8_WAIT_V(6); PG8_BAR;
    }
    for (;;) {
        const bool has_next = S.next(ui + 1, nxt);
        const char* nA = has_next ? (const char*)g.A + (size_t)nxt.pm * tstep : cA; const char* nB = has_next ? (const char*)g.Bt + (size_t)nxt.pn * tstep : cB;
        for (int t = 0; t < nt; t += 2) {
            const bool last = (t == nt - 2);
            const char* a1 = cA + (size_t)(t + 1) * kstep;
            const char* a2 = last ? nA : cA + (size_t)(t + 2) * kstep; const char* b2 = last ? nB : cB + (size_t)(t + 2) * kstep;
            const char* a3 = a2 + kstep; const char* b3 = b2 + kstep; (void)a3;
            if (last && has_next) S.a_ready(nxt);
            if constexpr (SP2) {
            PG8_LDB(B0, 0, 0); PG8_LDB(B1, 0, 1); PG8_SCHED; PG8_LDA(At, 0, 0); PG8_STAGE(PG8_SA(1, 0), a1, voffA); PG8_STAGE(PG8_SA(1, 1), a1 + hstep, voffA);
            PG8_WAIT_V(8); PG8_WAIT_L(0); PG8_BAR; PG8_MMA(0, 0, At, B0); PG8_MMA(0, 1, At, B1); PG8_BAR; PG8_SCHED;
            PG8_LDA(At, 0, 1); PG8_STAGE(PG8_SB(0, 0), b2, voffB); PG8_STAGE(PG8_SB(0, 1), b2 + hstep, voffB);
            PG8_WAIT_V(6); PG8_WAIT_L(0); PG8_BAR; PG8_MMA(1, 0, At, B0); PG8_MMA(1, 1, At, B1); PG8_BAR; PG8_SCHED;
            PG8_LDB(B0, 1, 0); PG8_LDB(B1, 1, 1); PG8_SCHED; PG8_LDA(At, 1, 0); PG8_STAGE(PG8_SA(0, 0), a2, voffA); PG8_STAGE(PG8_SA(0, 1), a2 + hstep, voffA);
            PG8_WAIT_V(8); PG8_WAIT_L(0); PG8_BAR; PG8_MMA(0, 0, At, B0); PG8_MMA(0, 1, At, B1); PG8_BAR; PG8_SCHED;
            PG8_LDA(At, 1, 1); PG8_STAGE(PG8_SB(1, 0), b3, voffB); PG8_STAGE(PG8_SB(1, 1), b3 + hstep, voffB);
            PG8_WAIT_V(6); PG8_WAIT_L(0); PG8_BAR; PG8_MMA(1, 0, At, B0); PG8_MMA(1, 1, At, B1); PG8_BAR; PG8_SCHED;
            } else {
            PG8_LDB(B0, 0, 0); PG8_SCHED; PG8_LDA(At, 0, 0); PG8_STAGE(PG8_SA(1, 1), a1 + hstep, voffA);
            PG8_WAIT_L(8); PG8_BAR; PG8_WAIT_L(0); PG8_MMA(0, 0, At, B0); PG8_BAR; PG8_SCHED;
            PG8_LDB(B1, 0, 1); PG8_STAGE(PG8_SB(0, 0), b2, voffB);
            PG8_BAR; PG8_WAIT_L(0); PG8_MMA(0, 1, At, B1); PG8_BAR;
            PG8_LDA(At, 0, 1); PG8_STAGE(PG8_SA(0, 0), a2, voffA);
            PG8_BAR; PG8_WAIT_L(0); PG8_MMA(1, 0, At, B0); PG8_BAR; PG8_SCHED;
            PG8_STAGE(PG8_SB(0, 1), b2 + hstep, voffB);
            PG8_WAIT_V(6); PG8_BAR; PG8_MMA(1, 1, At, B1); PG8_BAR;
            PG8_LDB(B0, 1, 0); PG8_SCHED; PG8_LDA(At, 1, 0); PG8_STAGE(PG8_SA(0, 1), a2 + hstep, voffA);
            PG8_WAIT_L(8); PG8_BAR; PG8_WAIT_L(0); PG8_MMA(0, 0, At, B0); PG8_BAR; PG8_SCHED;
            PG8_LDB(B1, 1, 1); PG8_STAGE(PG8_SB(1, 0), b3, voffB);
            PG8_BAR; PG8_WAIT_L(0); PG8_MMA(0, 1, At, B1); PG8_BAR;
            PG8_LDA(At, 1, 1); PG8_STAGE(PG8_SA(1, 0), a3, voffA);
            PG8_BAR; PG8_WAIT_L(0); PG8_MMA(1, 0, At, B0); PG8_BAR; PG8_SCHED;
            PG8_STAGE(PG8_SB(1, 1), b3 + hstep, voffB);
            PG8_WAIT_V(6); PG8_BAR; PG8_MMA(1, 1, At, B1); PG8_BAR;
            }
        }
        if constexpr (ALIGN_EPI) { if (wr == 0) PG8_BAR; }
        if constexpr (!Epi::AFTER_DRAIN) { E(acc, cur, wr, wc, fr, fq); S.done(cur); }
        if (!has_next) break;
#pragma unroll
        for (int a = 0; a < 2; ++a)
#pragma unroll
            for (int b = 0; b < 2; ++b)
#pragma unroll
                for (int m = 0; m < 4; ++m)
#pragma unroll
                    for (int n = 0; n < 2; ++n) acc[a][b][m][n] = acc_t{};
        cur = nxt; cA = nA; cB = nB; ++ui;
        if constexpr (ALIGN_EPI) { if (wr == 1) PG8_BAR; }
    }
    PG8_WAIT_V(0);
    if constexpr (!ALIGN_EPI) { if (wr == 0) PG8_BAR; }
    PG8_BAR;
    if constexpr (Epi::AFTER_DRAIN) { E.fused(acc, cur, wr, wc, fr, fq, lds, wid, lane); S.done(cur); }
#undef PG8_SA
#undef PG8_SB
#undef PG8_STAGE
#undef PG8_LDA
#undef PG8_LDB
#undef PG8_MMA
#undef PG8_WAIT_V
#undef PG8_WAIT_L
#undef PG8_BAR
#undef PG8_SCHED
}
}
constexpr int NWAVES = 8;
constexpr int S = 8192, DM = 2048, NH = 16, HD = 128, FF = 8192, NBLK = 32, BLK = 256, DEPTH = 4;
constexpr int NQKV = 3 * DM;
constexpr int BIAS_LD = 8448;
constexpr int NPHASE = 30;
#ifndef DBG_MASK
#define DBG_MASK 0xffff
#endif
#define DBG(b) ((DBG_MASK >> (b)) & 1)
#ifndef REP_MASK
#define REP_MASK 0
#endif
#define NREP(b) (((REP_MASK >> (b)) & 1) ? 2 : 1)
#ifndef MK_PER_PHASE
#define MK_PER_PHASE 0
#endif
constexpr size_t MiB = 1u << 20;
constexpr size_t WS_CTL = 0, CTL_ZERO_BYTES = 1 * MiB;
constexpr size_t WS_WQKV = 2 * MiB;
constexpr size_t WS_WO   = WS_WQKV + 48 * MiB;
constexpr size_t WS_WIN  = WS_WO + 16 * MiB;
constexpr size_t WS_WOUT = WS_WIN + 32 * MiB;
constexpr size_t WS_W1   = WS_WOUT + 16 * MiB;
constexpr size_t WS_W2   = WS_W1 + 128 * MiB;
constexpr size_t WS_X    = WS_W2 + 128 * MiB;
constexpr size_t WS_XQ   = WS_X;
constexpr size_t WS_FROW = WS_X + 16 * MiB;
constexpr size_t WS_RSTD = WS_FROW + 65536;
constexpr size_t WS_SW   = WS_X + 17 * MiB;
constexpr int SW_QKV = 0, SW_WIN = 2 * 6144, SW_W1 = SW_WIN + 2 * 4096;
constexpr int SW_T2 = 65536, SW_CS2 = SW_T2 + 4 * 2048, SW_SS = SW_CS2 + 4 * 2048, SW_CL = SW_SS + 4 * 8192;
#ifndef DQ_MASK
#define DQ_MASK 12
#endif
static_assert((DQ_MASK & 1) == 0 && DQ_MASK < 16, "layer 0's hidden step would be needed in the phase that computes the column norms");
constexpr size_t WS_W2Q_OFF = 64;
constexpr size_t WS_XB   = WS_X + 64 * MiB;
constexpr size_t WS_QKV  = WS_XB + 32 * MiB;
constexpr size_t WS_AO   = WS_QKV + 96 * MiB;
constexpr size_t WS_HID  = WS_AO + 32 * MiB;
constexpr size_t WS_SSQ  = WS_HID + 128 * MiB;
constexpr size_t WS_KMP  = WS_SSQ + 9 * MiB;
constexpr size_t WS_LSE  = WS_KMP + 1 * MiB;
constexpr size_t WS_LIST = WS_LSE + 2 * MiB;
constexpr size_t WS_BIAS = WS_LIST + 16 * MiB;
constexpr size_t WS_CARRY = WS_BIAS + 1 * MiB;
constexpr size_t WS_WG   = WS_CARRY + 2 * MiB;
constexpr size_t WS_END  = WS_WG + 2 * MiB;
constexpr int CW_TMO = 0, CW_CODE = 1;
constexpr int CW_BAR = 4096;
constexpr int CW_CNT = 16384;
constexpr int RING_OFF = 0, RING_BYTES = 155392;
constexpr int LDSCTL_OFF = RING_BYTES, MISC_OFF = LDSCTL_OFF + 320;
constexpr int LDS_BYTES = 157696;
#define GAS __attribute__((address_space(1)))
#define LAS __attribute__((address_space(3)))
typedef unsigned short bf16;
typedef unsigned v4u __attribute__((ext_vector_type(4)));
typedef float f32x4 __attribute__((ext_vector_type(4)));
typedef short bf16x8 __attribute__((ext_vector_type(8)));
typedef GAS unsigned gu32;
typedef GAS unsigned long long gu64;
#define RLX_AGENT __ATOMIC_RELAXED, __HIP_MEMORY_SCOPE_AGENT
#define LDS_WAIT() asm volatile("s_waitcnt lgkmcnt(0)" ::: "memory")
#define VM_WAIT() asm volatile("s_waitcnt vmcnt(0)" ::: "memory")
__device__ __forceinline__ unsigned long long rt() { return __builtin_amdgcn_s_memrealtime(); }
__device__ __forceinline__ unsigned f2bf(float f) { unsigned u = __builtin_bit_cast(unsigned, f); return (u + 0x7fffu + ((u >> 16) & 1u)) >> 16; }
__device__ __forceinline__ unsigned pk2(float lo, float hi) { return f2bf(lo) | (f2bf(hi) << 16); }

#define XB_TMO      128
#define XB_XCNT(j)  (256  + 64 * (j))
#define XB_XSUB(j)  (1280 + 64 * (j))
#define XB_XGEN(j)  (2304 + 64 * (j))
#define XB_TOP      3328
#define XB_TOPGEN   3392
#define XCD_BAR_WORDS 3456
#define XB_SPIN_CAP (1u << 22)

__device__ __forceinline__ unsigned xb_ld(unsigned* p)              { return __hip_atomic_load(p, __ATOMIC_RELAXED, __HIP_MEMORY_SCOPE_AGENT); }
__device__ __forceinline__ unsigned xb_add(unsigned* p, unsigned v) { return __hip_atomic_fetch_add(p, v, __ATOMIC_RELAXED, __HIP_MEMORY_SCOPE_AGENT); }
__device__ __forceinline__ unsigned xb_xcc_id() { return (unsigned)__builtin_amdgcn_s_getreg((3 << 11) | 20) & 0xFu; }
#define XB_SPIN(cond, bar) do { unsigned _sp = 0; while (cond) { __builtin_amdgcn_s_sleep(1); \
    if ((++_sp & 255u) == 0u) { if (xb_ld(&(bar)[XB_TMO])) break; if (_sp > XB_SPIN_CAP) { atomicAdd(&(bar)[XB_TMO], 1u); break; } } } } while (0)

struct XcdBarrier {
    unsigned* bar; unsigned x;
    volatile LAS unsigned* st;
};

__device__ __forceinline__ XcdBarrier xcd_barrier_post(unsigned* bar, volatile LAS unsigned* st) {
    XcdBarrier b; b.bar = bar; b.x = xb_xcc_id(); b.st = st;
    if (threadIdx.x == 0) (void)xb_add(&bar[XB_XCNT(b.x)], 1u);
    return b;
}
__device__ __forceinline__ void xcd_barrier_complete(unsigned* bar, unsigned x, unsigned& nloc, unsigned& nx) {
    const unsigned G = gridDim.x * gridDim.y * gridDim.z;
    unsigned sum, cnt, mine, sp = 0u;
    for (;;) {
        sum = 0u; cnt = 0u; mine = 0u;
#pragma unroll
        for (unsigned j = 0; j < 16; ++j) { const unsigned c = xb_ld(&bar[XB_XCNT(j)]); sum += c; cnt += (c > 0u) ? 1u : 0u; mine = (j == x) ? c : mine; }
        if (sum == G) break;
        __builtin_amdgcn_s_sleep(1);
        if ((++sp & 255u) == 0u) { if (xb_ld(&bar[XB_TMO])) break; if (sp > XB_SPIN_CAP) { atomicAdd(&bar[XB_TMO], 1u); break; } }
    }
    nloc = mine > 0u ? mine : 1u; nx = cnt > 0u ? cnt : 1u;
}

__device__ __forceinline__ void xcd_barrier(const XcdBarrier& b) {
    asm volatile("s_waitcnt vmcnt(0)" ::: "memory");
    __syncthreads();
    if (threadIdx.x == 0) {
        unsigned* bar = b.bar;
        __builtin_amdgcn_s_waitcnt(0);
        unsigned nloc = b.st[0], nx = b.st[1];
        if (nloc == 0u) { xcd_barrier_complete(bar, b.x, nloc, nx); b.st[0] = nloc; b.st[1] = nx; }
        const unsigned old = xb_add(&bar[XB_XSUB(b.x)], 1u);
        const unsigned gen = old / nloc;
        if (old + 1u == (gen + 1u) * nloc) {
            __builtin_amdgcn_fence(__ATOMIC_RELEASE, "agent");
            asm volatile("s_waitcnt vmcnt(0)" ::: "memory");
            const unsigned og = xb_add(&bar[XB_TOP], 1u);
            const unsigned tg = og / nx;
            if (og + 1u == (tg + 1u) * nx) xb_add(&bar[XB_TOPGEN], 1u);
            else XB_SPIN(xb_ld(&bar[XB_TOPGEN]) == tg, bar);
            __builtin_amdgcn_fence(__ATOMIC_ACQUIRE, "agent");
            xb_add(&bar[XB_XGEN(b.x)], 1u);
            asm volatile("s_waitcnt vmcnt(0)" ::: "memory");
        } else {
            XB_SPIN(xb_ld(&bar[XB_XGEN(b.x)]) == gen, bar);
            __builtin_amdgcn_fence(__ATOMIC_ACQUIRE, "agent");
            asm volatile("s_waitcnt vmcnt(0)" ::: "memory");
        }
    }
    __syncthreads();
}
typedef unsigned short bf16;
typedef unsigned v4u __attribute__((ext_vector_type(4)));
typedef unsigned v2u __attribute__((ext_vector_type(2)));
typedef float f32x2 __attribute__((ext_vector_type(2)));
__device__ __forceinline__ float bf2f(unsigned short b) { return __builtin_bit_cast(float, (unsigned)b << 16); }
__device__ __forceinline__ float bflo(unsigned u) { return __builtin_bit_cast(float, u << 16); }
__device__ __forceinline__ float bfhi(unsigned u) { return __builtin_bit_cast(float, u & 0xffff0000u); }
__device__ __forceinline__ float wave_sum(float v) {
#pragma unroll
    for (int o = 1; o < 64; o <<= 1) v += __shfl_xor(v, o);
    return v;
}
__device__ __forceinline__ float wave_max(float v) {
#pragma unroll
    for (int o = 1; o < 64; o <<= 1) v = fmaxf(v, __shfl_xor(v, o));
    return v;
}
struct Args { const float* in[18]; float* out; unsigned char* ws; int ph_lo, ph_hi; };
struct Frame {
    LAS unsigned char* lds; unsigned char* ldsg;
    volatile LAS unsigned* MISC;
    gu32* ctl;
    int tid, lane, wave, G, bid;
    unsigned char* ws;
};
__device__ __forceinline__ int pass_row(const Frame& F, int wave, int k) {
    return F.G == 256 ? (8 * ((F.bid % 8) / 2) + (F.bid / 8) % 8) * 256 + ((F.bid % 2) * 4 + F.bid / 64) * 32 + wave * 4 + k : (F.bid * NWAVES + wave) + k * (F.G * NWAVES); }
__device__ __forceinline__ int pass_nrows(const Frame& F, int wave) { const int gw = F.bid * NWAVES + wave, NGW = F.G * NWAVES; return F.G == 256 ? 4 : (gw < S ? (S - gw + NGW - 1) / NGW : 0); }

struct TrItem { const float* W; bf16* WT; const float* gain; int K, N, item; };
__device__ __forceinline__ void tr_load(const TrItem& t, int lane, f32x4 (&v)[16]) {
    const int nb = t.N >> 6, kb = t.item / nb, nbi = t.item - kb * nb, k0 = kb * 64, n0 = nbi * 64;
#pragma unroll
    for (int i = 0; i < 16; ++i) v[i] = __builtin_nontemporal_load((const f32x4*)(t.W + (size_t)(k0 + 4 * i + (lane >> 4)) * t.N + n0 + (lane & 15) * 4));
}
__device__ __forceinline__ void tr_store(const TrItem& t, int lane, const f32x4 (&v)[16], LAS float* scr) {
    const int nb = t.N >> 6, kb = t.item / nb, nbi = t.item - kb * nb, k0 = kb * 64, n0 = nbi * 64;
#pragma unroll
    for (int i = 0; i < 16; ++i) { LAS float* s = scr + (4 * i + (lane >> 4)) * 65 + (lane & 15) * 4; s[0] = v[i][0]; s[1] = v[i][1]; s[2] = v[i][2]; s[3] = v[i][3]; }
    LDS_WAIT(); asm volatile("" ::: "memory");
    const int c = lane & 7;
    float g[8];
#pragma unroll
    for (int i = 0; i < 8; ++i) g[i] = t.gain ? t.gain[k0 + 8 * c + i] : 1.0f;
#pragma unroll
    for (int j = 0; j < 8; ++j) { const int n = (lane >> 3) + 8 * j; const LAS float* s = scr + (8 * c) * 65 + n;
        v4u o; o.x = pk2(s[0 * 65] * g[0], s[1 * 65] * g[1]); o.y = pk2(s[2 * 65] * g[2], s[3 * 65] * g[3]); o.z = pk2(s[4 * 65] * g[4], s[5 * 65] * g[5]); o.w = pk2(s[6 * 65] * g[6], s[7 * 65] * g[7]);
        *(GAS v4u*)(t.WT + (size_t)(n0 + n) * t.K + k0 + 8 * c) = o; }
    LDS_WAIT(); asm volatile("" ::: "memory");
}
__device__ __forceinline__ int t5_bucket(int d) {
    if (d < 16) return d;
    const unsigned d2 = (unsigned)d * (unsigned)d; const int msb = 31 - __builtin_clz(d2);
    const int b = 16 + msb - 8; return b > 31 ? 31 : b;
}
__device__ __forceinline__ unsigned pack_i8x4(float a, float b, float c, float d) {
    const int ia = (int)__builtin_rintf(a), ib = (int)__builtin_rintf(b), ic = (int)__builtin_rintf(c), id = (int)__builtin_rintf(d);
    return ((unsigned)ia & 255u) | (((unsigned)ib & 255u) << 8) | (((unsigned)ic & 255u) << 16) | ((unsigned)id << 24);
}
__device__ __forceinline__ void st_ld(const float* W, int N, int k0, int n0, int lane, f32x4 (&v)[16]) {
    const float* p = W + (size_t)(k0 + (lane >> 4)) * N + n0 + (lane & 15) * 4; asm volatile("" : "+v"(p));
#pragma unroll
    for (int i = 0; i < 16; ++i) { v[i] = __builtin_nontemporal_load((const f32x4*)p); p += (size_t)4 * N; }
}
typedef _Float16 h16x2 __attribute__((ext_vector_type(2)));
__device__ __forceinline__ unsigned hpk(float a, float b) { return __builtin_bit_cast(unsigned, __builtin_amdgcn_cvt_pkrtz(a, b)); }
__device__ __forceinline__ float hlo(unsigned u) { return (float)__builtin_bit_cast(h16x2, u)[0]; }
__device__ __forceinline__ float hhi(unsigned u) { return (float)__builtin_bit_cast(h16x2, u)[1]; }
__device__ __forceinline__ void st_pk(const f32x4 (&v)[16], int k0, const LAS float* gl, int lane, unsigned (&h)[32], f32x4& cm) {
#pragma unroll
    for (int i = 0; i < 16; ++i) { const float g = gl[k0 + 4 * i + (lane >> 4)];
        const unsigned p0 = hpk(v[i][0] * g, v[i][1] * g), p1 = hpk(v[i][2] * g, v[i][3] * g); h[2 * i] = p0; h[2 * i + 1] = p1;
        cm[0] = fmaxf(cm[0], fabsf(hlo(p0))); cm[1] = fmaxf(cm[1], fabsf(hhi(p0))); cm[2] = fmaxf(cm[2], fabsf(hlo(p1))); cm[3] = fmaxf(cm[3], fabsf(hhi(p1))); }
    asm volatile("" ::: "memory"); __builtin_amdgcn_sched_barrier(0);
}
__device__ __forceinline__ void st_quant(const unsigned (&h)[32], f32x4 inv4, int k0, int n0, int lane, LAS float* scr, unsigned char* WQ) {
#pragma unroll
    for (int i = 0; i < 16; ++i) { LAS float* sp = scr + (4 * i + (lane >> 4)) * 65 + (lane & 15) * 4;
        sp[0] = hlo(h[2 * i]) * inv4[0]; sp[1] = hhi(h[2 * i]) * inv4[1]; sp[2] = hlo(h[2 * i + 1]) * inv4[2]; sp[3] = hhi(h[2 * i + 1]) * inv4[3]; }
    LDS_WAIT(); asm volatile("" ::: "memory");
    const int c = lane & 7;
#pragma unroll
    for (int j = 0; j < 8; ++j) { const int n = (lane >> 3) + 8 * j; const LAS float* sp = scr + (8 * c) * 65 + n;
        v2u o; o.x = pack_i8x4(sp[0 * 65], sp[1 * 65], sp[2 * 65], sp[3 * 65]); o.y = pack_i8x4(sp[4 * 65], sp[5 * 65], sp[6 * 65], sp[7 * 65]);
        *(GAS v2u*)(WQ + (size_t)(n0 + n) * DM + k0 + 8 * c) = o;
        if (j & 1) { asm volatile("" ::: "memory"); __builtin_amdgcn_sched_barrier(0); } }
    LDS_WAIT(); asm volatile("" ::: "memory");
}
__device__ __forceinline__ void p0_strips(const Args& A, Frame& F) {
    int tid = F.wave * 64 + lane_id_v(); asm volatile("" : "+v"(tid)); const int lane = tid & 63, wave = __builtin_amdgcn_readfirstlane(tid >> 6); (void)lane; (void)wave;
    LAS float* scr = (LAS float*)(F.lds + RING_OFF + wave * 16640);
    LAS float* cmx = (LAS float*)(F.lds + RING_OFF + 133120);
    LAS float* gl = (LAS float*)(F.lds + RING_OFF + 137216);
    const int gw = F.bid * NWAVES + wave, NGW = F.G * NWAVES;
    const float* mixn = A.in[2]; const float* mlpn = A.in[3];
    float* SWb = (float*)(F.ws + WS_SW);
    constexpr int NS_QKV = 2 * 96, NS_1 = 4 * 128, NSTRIP = NS_QKV + NS_1;
    struct SD { const float* W; const float* gain; unsigned char* WQ; float* SW; int N, n0; };
    auto dec = [&](int si) -> SD { SD d;
        if (si < NS_QKV) { const int j = si / 96, c = si - j * 96; d.W = A.in[5] + (size_t)j * DM * NQKV; d.gain = mixn + (2 * j) * DM; d.WQ = F.ws + WS_WQKV + (size_t)j * NQKV * DM; d.SW = SWb + SW_QKV + j * NQKV; d.N = NQKV; d.n0 = c * 64; }
        else { const int r = si - NS_QKV, l = r >> 7, c = r & 127; d.W = A.in[16] + (size_t)l * DM * FF; d.gain = mlpn + l * DM; d.WQ = F.ws + WS_W1 + (size_t)l * FF * DM; d.SW = SWb + SW_W1 + l * FF; d.N = FF; d.n0 = c * 64; }
        return d; };
    const int kb = wave * 256;
    int sp = 0;
    f32x4 v[16];
    if (F.bid < NSTRIP) { const SD d0 = dec(F.bid); st_ld(d0.W, d0.N, kb, d0.n0, lane, v); }
    for (int si = F.bid; si < NSTRIP; si += F.G, sp ^= 1) {
        const SD d = dec(si);
        __syncthreads();
#pragma unroll
        for (int i = 0; i < 4; ++i) gl[tid + 512 * i] = d.gain[tid + 512 * i];
        __syncthreads();
        unsigned hb[4][32]; f32x4 cm = (f32x4){0.f, 0.f, 0.f, 0.f};
        st_pk(v, kb, gl, lane, hb[0], cm);
#pragma unroll
        for (int t = 1; t < 4; ++t) { st_ld(d.W, d.N, kb + 64 * t, d.n0, lane, v); st_pk(v, kb + 64 * t, gl, lane, hb[t], cm); }
#pragma unroll
        for (int e = 0; e < 4; ++e) { float t = cm[e]; t = fmaxf(t, __shfl_xor(t, 16)); t = fmaxf(t, __shfl_xor(t, 32)); cm[e] = t; }
        if (lane < 16) *(LAS f32x4*)(cmx + (sp * 8 + wave) * 64 + lane * 4) = cm;
#pragma unroll
        for (int t = 0; t < 4; ++t)
#pragma unroll
            for (int k = 0; k < 32; ++k) asm volatile("" : "+v"(hb[t][k]));
        __syncthreads();
        f32x4 mx = *(const LAS f32x4*)(cmx + (sp * 8) * 64 + (lane & 15) * 4);
#pragma unroll
        for (int w = 1; w < 8; ++w) { const f32x4 t = *(const LAS f32x4*)(cmx + (sp * 8 + w) * 64 + (lane & 15) * 4);
#pragma unroll
            for (int e = 0; e < 4; ++e) mx[e] = fmaxf(mx[e], t[e]); }
        f32x4 inv4;
#pragma unroll
        for (int e = 0; e < 4; ++e) inv4[e] = mx[e] > 1e-30f ? 127.0f / mx[e] : 0.f;
        if (wave == 0 && lane < 16) *(f32x4*)(d.SW + d.n0 + lane * 4) = mx * (1.0f / 127.0f);
        st_quant(hb[0], inv4, kb, d.n0, lane, scr, d.WQ);
        if (si + F.G < NSTRIP) { const SD dn = dec(si + F.G); st_ld(dn.W, dn.N, kb, dn.n0, lane, v); }
#pragma unroll
        for (int t = 1; t < 4; ++t) st_quant(hb[t], inv4, kb + 64 * t, d.n0, lane, scr, d.WQ);
    }
}
__device__ __forceinline__ void p0_tiles(const Args& A, Frame& F) {
    int tid = F.wave * 64 + lane_id_v(); asm volatile("" : "+v"(tid)); const int lane = tid & 63, wave = __builtin_amdgcn_readfirstlane(tid >> 6); (void)lane; (void)wave;
    LAS float* scr = (LAS float*)(F.lds + RING_OFF + wave * 16640);
    const int gw = F.bid * NWAVES + wave, NGW = F.G * NWAVES; (void)gw; (void)NGW; (void)scr;
    constexpr int NSTRIP = 2 * 96 + 4 * 128;
    constexpr int T_O = 32 * 32, T_2 = 128 * 32, T_IN = 32 * 64;
    constexpr int NB = 4 * T_O + 4 * T_2 + 256 + 2 * T_IN;
    auto decode = [&](int it) -> TrItem {
        int r = it; TrItem t;
        if (r >= 4 * T_O + 4 * T_2 + 256) { r -= 4 * T_O + 4 * T_2 + 256; const int j = r / T_IN; r -= j * T_IN;
            t.W = A.in[7] + (size_t)j * DM * 2 * DM; t.WT = (bf16*)(F.ws + WS_WIN) + (size_t)j * 2 * DM * DM; t.gain = A.in[2] + (2 * j + 1) * DM; t.K = DM; t.N = 2 * DM; t.item = r; return t; }
        if (r >= 4 * T_O + 4 * T_2) { r -= 4 * T_O + 4 * T_2; const int blk = r >> 2, jg = blk >> 4, j = jg >> 1, g = jg & 1, n = blk & 15;
            t.W = A.in[g ? 12 : 10] + ((size_t)j * 16 + n) * 16384; t.WT = (bf16*)(F.ws + WS_WG) + (((size_t)j * 2 + g) * 16 + n) * 16384; t.gain = nullptr; t.K = 128; t.N = 128; t.item = r & 3; return t; }
        if (r < 4 * T_O) { const int jj = r / T_O, j = jj & 1; r -= jj * T_O;
            if (jj < 2) { t.W = A.in[6] + (size_t)j * DM * DM; t.WT = (bf16*)(F.ws + WS_WO) + (size_t)j * DM * DM; }
            else { t.W = A.in[15] + (size_t)j * DM * DM; t.WT = (bf16*)(F.ws + WS_WOUT) + (size_t)j * DM * DM; }
            t.gain = nullptr; t.K = DM; t.N = DM; t.item = r; return t; }
        r -= 4 * T_O;
        const int l = r / T_2; r -= l * T_2;
        t.W = A.in[17] + (size_t)l * FF * DM; t.WT = (bf16*)(F.ws + WS_W2) + (size_t)l * DM * FF; t.gain = nullptr; t.K = FF; t.N = DM; t.item = r; return t;
    };
    {
        constexpr int SW_ = 32;
        const int per = (NSTRIP * SW_ + NB + F.G - 1) / F.G;
        int start = 0, cnt = 0;
        for (int b2 = 0; b2 <= F.bid; ++b2) { const int ns = b2 < NSTRIP ? (NSTRIP - b2 + F.G - 1) / F.G : 0; int q = per - SW_ * ns; q = q < 0 ? 0 : q; if (b2 < F.bid) start += q; else cnt = q; }
        int tot = start;
        for (int b2 = F.bid; b2 < F.G; ++b2) { const int ns = b2 < NSTRIP ? (NSTRIP - b2 + F.G - 1) / F.G : 0; int q = per - SW_ * ns; tot += q < 0 ? 0 : q; }
        int end = start + cnt; if (end > NB) end = NB; if (start > NB) start = NB;
        f32x4 va[16], vb[16];
        for (int pass = 0; pass < 2; ++pass) {
            const int first = pass == 0 ? start + wave : (tot < NB ? tot + gw : NB), lim = pass == 0 ? end : NB, step = pass == 0 ? NWAVES : NGW;
            if (first >= lim) continue;
            TrItem cur = decode(first); tr_load(cur, lane, va);
            for (int it = first; it < lim; it += 2 * step) {
                const bool h1 = it + step < lim; TrItem n1 = cur; if (h1) { n1 = decode(it + step); tr_load(n1, lane, vb); }
                tr_store(cur, lane, va, scr);
                if (!h1) break;
                const bool h2 = it + 2 * step < lim; if (h2) { cur = decode(it + 2 * step); tr_load(cur, lane, va); }
                tr_store(n1, lane, vb, scr);
                if (!h2) break;
            }
        }
    }
}
__device__ __forceinline__ void p0_x(const Args& A, Frame& F) {
    int tid = F.wave * 64 + lane_id_v(); asm volatile("" : "+v"(tid)); const int lane = tid & 63, wave = __builtin_amdgcn_readfirstlane(tid >> 6); (void)lane; (void)wave;
    LAS float* scr = (LAS float*)(F.lds + RING_OFF + wave * 16640);
    const int gw = F.bid * NWAVES + wave, NGW = F.G * NWAVES; (void)gw; (void)NGW; (void)scr;
    { const float* x = A.in[0]; bf16* XB = (bf16*)(F.ws + WS_XB); unsigned char* XQ = F.ws + WS_XQ; float* frow = (float*)(F.ws + WS_FROW);
      const int nk = pass_nrows(F, wave);
      for (int k0 = 0; k0 < nk; k0 += 4) {
          f32x4 v[4][8];
#pragma unroll
          for (int r = 0; r < 4; ++r) { const int m = pass_row(F, wave, k0 + r < nk ? k0 + r : k0); const GAS f32x4* xr = (const GAS f32x4*)(x + (size_t)m * DM) + lane;
#pragma unroll
              for (int j = 0; j < 8; ++j) v[r][j] = xr[64 * j]; }
#pragma unroll
          for (int r = 0; r < 4; ++r) { if (k0 + r >= nk) break; const int m = pass_row(F, wave, k0 + r);
              GAS v2u* xb = (GAS v2u*)(XB + (size_t)m * DM) + lane; GAS unsigned* xq = (GAS unsigned*)(XQ + (size_t)m * DM) + lane; float s = 0.f, am = 0.f;
#pragma unroll
              for (int j = 0; j < 8; ++j) { s += (v[r][j].x * v[r][j].x + v[r][j].y * v[r][j].y) + (v[r][j].z * v[r][j].z + v[r][j].w * v[r][j].w); am = fmaxf(fmaxf(am, fmaxf(fabsf(v[r][j].x), fabsf(v[r][j].y))), fmaxf(fabsf(v[r][j].z), fabsf(v[r][j].w)));
                  v2u o; o.x = pk2(v[r][j].x, v[r][j].y); o.y = pk2(v[r][j].z, v[r][j].w); xb[64 * j] = o; }
              s = wave_sum(s); am = wave_max(am);
              const float inv = am > 1e-30f ? 127.0f / am : 0.f;
#pragma unroll
              for (int j = 0; j < 8; ++j) xq[64 * j] = pack_i8x4(v[r][j].x * inv, v[r][j].y * inv, v[r][j].z * inv, v[r][j].w * inv);
              if (lane == 0) { const float rstd = __builtin_amdgcn_rsqf(s * (1.0f / 2048.0f) + 1e-6f); frow[m] = am * (1.0f / 127.0f) * rstd; ((float*)(F.ws + WS_RSTD))[m] = rstd; } } } }
    { const float* rb = A.in[1]; float* bt = (float*)(F.ws + WS_BIAS);
      for (int i = F.bid * (NWAVES * 64) + tid; i < NH * BIAS_LD; i += F.G * NWAVES * 64) { const int h = i / BIAS_LD, d = i - h * BIAS_LD - 256;
          bt[i] = d < 0 ? -INFINITY : rb[t5_bucket(d) * NH + h] * 1.4426950408889634f; } }
}
__device__ __forceinline__ void p0_prologue(const Args& A, Frame& F) { p0_strips(A, F); p0_tiles(A, F); p0_x(A, F); }
#define TOP3_INS(x_, j_) do { const float x__ = (x_); const int j__ = (j_); const bool b0 = x__ > v0, b1 = x__ > v1, b2 = x__ > v2; \
    v2 = b1 ? v1 : (b2 ? x__ : v2); i2 = b1 ? i1 : (b2 ? j__ : i2); v1 = b0 ? v0 : (b1 ? x__ : v1); i1 = b0 ? i0 : (b1 ? j__ : i1); v0 = b0 ? x__ : v0; i0 = b0 ? j__ : i0; } while (0)
__device__ __forceinline__ void phase_gate(const Args& A, Frame& F, int ja) {
    int tid = F.wave * 64 + lane_id_v(); asm volatile("" : "+v"(tid)); const int lane = tid & 63, wave = __builtin_amdgcn_readfirstlane(tid >> 6); (void)lane; (void)wave;
    const bf16* QKV = (const bf16*)(F.ws + WS_QKV); const float* KMP = (const float*)(F.ws + WS_KMP);
    unsigned* cnt = (unsigned*)(F.ctl + CW_CNT + ja * 512); unsigned* list = (unsigned*)(F.ws + WS_LIST); float* LSE = (float*)(F.ws + WS_LSE);
    LAS float* km = (LAS float*)(F.lds + RING_OFF);
    LAS float* cv = km + 32 * 128;
    LAS int* ci = (LAS int*)(cv + 256 * 3);
    for (int item = F.bid; item < 512; item += F.G) {
        const int h = item & 15, c = item >> 4;
        for (int i = tid; i < 32 * 128; i += NWAVES * 64) { const int jb = i >> 7, d = i & 127;
            km[i] = (KMP[(size_t)jb * 2048 + h * 128 + d] + KMP[(size_t)(32 + jb) * 2048 + h * 128 + d]) * (1.0f / 256.0f); }
        __syncthreads();
        const int t = tid & 255, half = tid >> 8, q = c * 256 + t;
        float g[16];
#pragma unroll
        for (int jb = 0; jb < 16; ++jb) g[jb] = 0.f;
        const bf16* qp = QKV + (size_t)q * NQKV + h * HD;
        const LAS float* kmh = km + half * 16 * 128;
#pragma unroll 1
        for (int d0 = 0; d0 < 128; d0 += 8) {
            const v4u qv = *(const v4u*)(qp + d0);
            const float q0 = bflo(qv.x), q1 = bfhi(qv.x), q2 = bflo(qv.y), q3 = bfhi(qv.y), q4 = bflo(qv.z), q5 = bfhi(qv.z), q6 = bflo(qv.w), q7 = bfhi(qv.w);
#pragma unroll
            for (int jb = 0; jb < 16; ++jb) { const f32x4 k0 = *(const LAS f32x4*)(kmh + jb * 128 + d0), k1 = *(const LAS f32x4*)(kmh + jb * 128 + d0 + 4);
                g[jb] += (q0 * k0[0] + q1 * k0[1]) + (q2 * k0[2] + q3 * k0[3]) + (q4 * k1[0] + q5 * k1[1]) + (q6 * k1[2] + q7 * k1[3]);
                if ((jb & 3) == 3) __builtin_amdgcn_sched_barrier(0); }
        }
        float v0 = -INFINITY, v1 = -INFINITY, v2 = -INFINITY; int i0 = -1, i1 = -1, i2 = -1;
#pragma unroll
        for (int jb = 0; jb < 16; ++jb) { const int j = half * 16 + jb; if (j < c) TOP3_INS(g[jb], j); }
        if (half == 1) { cv[t * 3 + 0] = v0; cv[t * 3 + 1] = v1; cv[t * 3 + 2] = v2; ci[t * 3 + 0] = i0; ci[t * 3 + 1] = i1; ci[t * 3 + 2] = i2; }
        __syncthreads();
        if (half == 0) {
            { const int j = ci[t * 3 + 0]; if (j >= 0) TOP3_INS(cv[t * 3 + 0], j); }
            { const int j = ci[t * 3 + 1]; if (j >= 0) TOP3_INS(cv[t * 3 + 1], j); }
            { const int j = ci[t * 3 + 2]; if (j >= 0) TOP3_INS(cv[t * 3 + 2], j); }
#define EMIT_PICK(k_, sj_) do { if ((sj_) >= 0) { const unsigned pos = atomicAdd(&cnt[h * 32 + (sj_)], 1u); list[(size_t)(h * 32 + (sj_)) * 8192 + pos] = ((unsigned)q << 2) | (unsigned)(k_); } \
                else LSE[((size_t)q * NH + h) * 4 + (k_)] = -INFINITY; } while (0)
            EMIT_PICK(0, i0); EMIT_PICK(1, i1); EMIT_PICK(2, i2);
#undef EMIT_PICK
        }
        __syncthreads();
    }
}
__device__ __forceinline__ void attn_entry(const Args& A, Frame& F, int q, int h, int jb, int slot) {
    int tid = F.wave * 64 + lane_id_v(); asm volatile("" : "+v"(tid)); const int lane = tid & 63, wave = __builtin_amdgcn_readfirstlane(tid >> 6); (void)lane; (void)wave;
    const bf16* QKV = (const bf16*)(F.ws + WS_QKV); const int l = lane;
    const bf16* qp = QKV + (size_t)q * NQKV + h * HD;
    const bf16* Kb = QKV + (size_t)(jb * BLK) * NQKV + DM + h * HD; const bf16* Vb = Kb + DM;
    float s[4] = {0.f, 0.f, 0.f, 0.f};
    for (int d0 = 0; d0 < 128; d0 += 8) {
        const v4u qv = *(const v4u*)(qp + d0);
        const float q0 = bflo(qv.x), q1 = bfhi(qv.x), q2 = bflo(qv.y), q3 = bfhi(qv.y), q4 = bflo(qv.z), q5 = bfhi(qv.z), q6 = bflo(qv.w), q7 = bfhi(qv.w);
#pragma unroll
        for (int kk = 0; kk < 4; ++kk) { const v4u kv = *(const v4u*)(Kb + (size_t)(l + 64 * kk) * NQKV + d0);
            s[kk] += (q0 * bflo(kv.x) + q1 * bfhi(kv.x)) + (q2 * bflo(kv.y) + q3 * bfhi(kv.y)) + (q4 * bflo(kv.z) + q5 * bfhi(kv.z)) + (q6 * bflo(kv.w) + q7 * bfhi(kv.w)); }
    }
    const float C = 0.088388347648318440f * 1.4426950408889634f;
    const float* bt = (const float*)(F.ws + WS_BIAS) + h * BIAS_LD + 256;
    float t[4], m = -INFINITY;
#pragma unroll
    for (int kk = 0; kk < 4; ++kk) { const int d = q - (jb * BLK + l + 64 * kk); t[kk] = s[kk] * C + bt[d]; m = fmaxf(m, t[kk]); }
    m = wave_max(m);
    float p[4], ls = 0.f;
#pragma unroll
    for (int kk = 0; kk < 4; ++kk) { p[kk] = __builtin_amdgcn_exp2f(t[kk] - m); ls += p[kk]; }
    ls = wave_sum(ls);
    const int c0 = 64 * (l >> 5) + (l & 31);
    float o0 = 0.f, o1 = 0.f;
#pragma unroll
    for (int kk = 0; kk < 4; ++kk)
        for (int src = 0; src < 64; ++src) { const float pk = __shfl(p[kk], src); const bf16* vr = Vb + (size_t)(src + 64 * kk) * NQKV;
            o0 += pk * bf2f(vr[c0]); o1 += pk * bf2f(vr[c0 + 32]); }
    const float inv = 1.0f / ls;
    unsigned* PART = (unsigned*)(F.ws + WS_HID); float* LSE = (float*)(F.ws + WS_LSE);
    const size_t e = ((size_t)q * NH + h) * 4 + slot;
    PART[e * 64 + l] = pk2(o0 * inv, o1 * inv);
    if (l == 0) LSE[e] = m + __builtin_amdgcn_logf(ls);
}
__device__ __forceinline__ void phase_attn(const Args& A, Frame& F, int ja) {
    int tid = F.wave * 64 + lane_id_v(); asm volatile("" : "+v"(tid)); const int lane = tid & 63, wave = __builtin_amdgcn_readfirstlane(tid >> 6); (void)lane; (void)wave;
    const unsigned* cnt = (const unsigned*)(F.ctl + CW_CNT + ja * 512); const unsigned* list = (const unsigned*)(F.ws + WS_LIST);
    LAS unsigned* pre = (LAS unsigned*)(F.lds + RING_OFF);
    LAS unsigned* cl = pre + 520;
    for (int i = tid; i < 512; i += NWAVES * 64) cl[i] = __hip_atomic_load(cnt + i, RLX_AGENT);
    __syncthreads();
    if (tid == 0) { unsigned a = 0; for (int i = 0; i < 512; ++i) { pre[i] = a; a += (cl[i] + 7u) >> 3; } pre[512] = a; }
    __syncthreads();
    const int total = (int)pre[512];
    for (int tile = F.bid; tile < total + S * NH / 8; tile += F.G) {
        if (tile < total) {
            int lo = 0, hi = 512;
            while (hi - lo > 1) { const int mid = (lo + hi) >> 1; if ((int)pre[mid] <= tile) lo = mid; else hi = mid; }
            const int e = (tile - (int)pre[lo]) * 8 + wave;
            if (e < (int)cl[lo]) { const unsigned ent = list[(size_t)lo * 8192 + e]; attn_entry(A, F, (int)(ent >> 2), lo >> 5, lo & 31, (int)(ent & 3u)); }
        } else { const int e = (tile - total) * 8 + wave; const int q = e >> 4, h = e & 15; attn_entry(A, F, q, h, q >> 8, 3); }
    }
}
namespace at {
using bf16x8 = __attribute__((ext_vector_type(8))) short;
using s16x4  = __attribute__((ext_vector_type(4))) short;
using f32x16 = __attribute__((ext_vector_type(16))) float;
using u32x4  = __attribute__((ext_vector_type(4))) unsigned;
constexpr int KVBLK = 64, LDK = NQKV;
constexpr int SHM_V = KVBLK * 128 * 2, SHM_K = KVBLK * 128 * 2;
constexpr int OFF_V = 0, OFF_K = 2 * SHM_V, OFF_WS = OFF_K + 2 * SHM_K, OFF_DST = OFF_WS + 8 * 256, OFF_BT = OFF_DST + 8 * 128, OFF_PRE = OFF_BT + BIAS_LD * 4, OFF_CL = OFF_PRE + 1032 * 4, OFF_WT = OFF_CL + 512 * 4, OFF_END = OFF_WT + 64;
static_assert(OFF_END <= RING_BYTES, "attention LDS map");
#define KSWZ(row, colB) ((row) * 256 + ((colB) ^ (((row) & 7) << 4)))
#define SBAR() __builtin_amdgcn_sched_barrier(0)
__device__ __forceinline__ int crow(int r, int hi) { return (r & 3) + 8 * (r >> 2) + 4 * hi; }
__device__ __forceinline__ unsigned cvtpk(float lo, float hi) { unsigned r; asm volatile("v_cvt_pk_bf16_f32 %0, %1, %2" : "=v"(r) : "v"(lo), "v"(hi)); return r; }
__device__ __forceinline__ void partialSM(f32x16& p0, f32x16& p1, const LAS float* bp, float& m_reg, float& alpha) {
    constexpr float C = 0.088388347648318440f * 1.4426950408889634f;
#pragma unroll
    for (int r = 0; r < 16; ++r) p0[r] = fmaf(p0[r], C, bp[59 - ((r & 3) + 8 * (r >> 2))]);
#pragma unroll
    for (int r = 0; r < 16; ++r) p1[r] = fmaf(p1[r], C, bp[27 - ((r & 3) + 8 * (r >> 2))]);
    float pmax = p0[0];
#pragma unroll
    for (int r = 1; r < 16; ++r) pmax = fmaxf(pmax, p0[r]);
#pragma unroll
    for (int r = 0; r < 16; ++r) pmax = fmaxf(pmax, p1[r]);
    { auto rr = __builtin_amdgcn_permlane32_swap(__float_as_uint(pmax), __float_as_uint(pmax), false, false); pmax = fmaxf(__uint_as_float(rr[0]), __uint_as_float(rr[1])); }
    float mn = m_reg; alpha = 1.f;
    if (!__all(pmax <= m_reg + 8.0f)) { const bool up = pmax > m_reg + 8.0f;
        mn = up ? pmax : m_reg; alpha = up ? __builtin_amdgcn_exp2f(m_reg - mn) : 1.f; m_reg = mn; }
#pragma unroll
    for (int r = 0; r < 16; ++r) p0[r] -= mn;
#pragma unroll
    for (int r = 0; r < 16; ++r) p1[r] -= mn;
#pragma unroll
    for (int r = 0; r < 16; ++r) p0[r] = __builtin_amdgcn_exp2f(p0[r]);
}
__device__ __forceinline__ void finishSM(f32x16& p0, f32x16& p1, float alpha, float& l_reg, bf16x8& pa0, bf16x8& pa1, bf16x8& pa2, bf16x8& pa3) {
#pragma unroll
    for (int r = 0; r < 16; ++r) p1[r] = __builtin_amdgcn_exp2f(p1[r]);
    float ps = 0;
#pragma unroll
    for (int r = 0; r < 16; ++r) ps += p0[r];
#pragma unroll
    for (int r = 0; r < 16; ++r) ps += p1[r];
    { auto rr = __builtin_amdgcn_permlane32_swap(__float_as_uint(ps), __float_as_uint(ps), false, false); ps = __uint_as_float(rr[0]) + __uint_as_float(rr[1]); }
    l_reg = l_reg * alpha + ps;
#define PK4(P, BASE, OUT) do { unsigned a0 = cvtpk(P[BASE + 0], P[BASE + 1]), a1 = cvtpk(P[BASE + 2], P[BASE + 3]);   \
    unsigned b0 = cvtpk(P[BASE + 4], P[BASE + 5]), b1 = cvtpk(P[BASE + 6], P[BASE + 7]);                              \
    auto r0 = __builtin_amdgcn_permlane32_swap(a0, b0, false, false); auto r1 = __builtin_amdgcn_permlane32_swap(a1, b1, false, false); \
    u32x4 w = {r0[0], r1[0], r0[1], r1[1]}; OUT = *reinterpret_cast<bf16x8*>(&w); } while (0)
    PK4(p0, 0, pa0); PK4(p0, 8, pa1); PK4(p1, 0, pa2); PK4(p1, 8, pa3);
#undef PK4
}
__device__ __forceinline__ void qkt(f32x16& p0, f32x16& p1, const LAS unsigned char* Ks, const bf16x8* qr, int r32, int hi) {
    p0 = f32x16{}; p1 = f32x16{};
#pragma unroll
    for (int d0 = 0; d0 < 8; ++d0) { const int cb = (d0 * 16 + hi * 8) * 2;
        const bf16x8 b0 = *reinterpret_cast<const LAS bf16x8*>(Ks + KSWZ(r32, cb));
        const bf16x8 b1 = *reinterpret_cast<const LAS bf16x8*>(Ks + KSWZ(32 + r32, cb));
        p0 = __builtin_amdgcn_mfma_f32_32x32x16_bf16(b0, qr[d0], p0, 0, 0, 0);
        p1 = __builtin_amdgcn_mfma_f32_32x32x16_bf16(b1, qr[d0], p1, 0, 0, 0); }
}
__device__ __forceinline__ int v_st(int k, int c) { const int kk = (k & ~0xC) | ((k & 4) << 1) | ((k & 8) >> 1); return ((kk >> 3) * 4 + (c >> 5)) * 512 + ((kk & 7) * 32 + (c & 31)) * 2; }
__device__ __forceinline__ int v_rd_base(int lane) { return ((lane & 3) << 3) | (((lane >> 2) & 3) << 6) | (((lane >> 4) & 1) << 5) | (((lane >> 5) & 1) << 8); }
constexpr int v_rd_off(int d0, int ks, int half) { return d0 * 512 + ks * 4096 + half * 2048; }
template <int OFF> __device__ __forceinline__ s16x4 tr_read(int vb) { s16x4 r; asm volatile("ds_read_b64_tr_b16 %0, %1 offset:%2" : "=&v"(r) : "v"(vb), "i"(OFF) : "memory"); return r; }
template <int D0> __device__ __forceinline__ void pv_one(f32x16& od, int vb, bf16x8 pa0, bf16x8 pa1, bf16x8 pa2, bf16x8 pa3) {
    const s16x4 l0 = tr_read<v_rd_off(D0, 0, 0)>(vb), h0 = tr_read<v_rd_off(D0, 0, 1)>(vb), l1 = tr_read<v_rd_off(D0, 1, 0)>(vb), h1 = tr_read<v_rd_off(D0, 1, 1)>(vb);
    const s16x4 l2 = tr_read<v_rd_off(D0, 2, 0)>(vb), h2 = tr_read<v_rd_off(D0, 2, 1)>(vb), l3 = tr_read<v_rd_off(D0, 3, 0)>(vb), h3 = tr_read<v_rd_off(D0, 3, 1)>(vb);
    asm volatile("s_waitcnt lgkmcnt(0)" ::: "memory"); SBAR();
#define PK(L, H) (bf16x8){L[0], L[1], L[2], L[3], H[0], H[1], H[2], H[3]}
    od = __builtin_amdgcn_mfma_f32_32x32x16_bf16(pa0, PK(l0, h0), od, 0, 0, 0);
    od = __builtin_amdgcn_mfma_f32_32x32x16_bf16(pa1, PK(l1, h1), od, 0, 0, 0);
    od = __builtin_amdgcn_mfma_f32_32x32x16_bf16(pa2, PK(l2, h2), od, 0, 0, 0);
    od = __builtin_amdgcn_mfma_f32_32x32x16_bf16(pa3, PK(l3, h3), od, 0, 0, 0);
#undef PK
}
__device__ __forceinline__ void pv_d0(f32x16* o, int vb, bf16x8 pa0, bf16x8 pa1, bf16x8 pa2, bf16x8 pa3) {
    pv_one<0>(o[0], vb, pa0, pa1, pa2, pa3); pv_one<1>(o[1], vb, pa0, pa1, pa2, pa3); pv_one<2>(o[2], vb, pa0, pa1, pa2, pa3); pv_one<3>(o[3], vb, pa0, pa1, pa2, pa3);
}
__device__ __forceinline__ void attn_unit(const bf16* __restrict__ QKV, int h, int jb, int q, int dsti, LAS unsigned char* lds, unsigned* __restrict__ PART, float* __restrict__ LSE, int tid) {
    const int wid = tid >> 6, lane = tid & 63, r32 = lane & 31, hi = lane >> 5;
    LAS unsigned char* V_lds = lds + OFF_V; LAS unsigned char* K_lds = lds + OFF_K;
    LAS float* ws = (LAS float*)(lds + OFF_WS) + wid * 64; LAS float* li_l = ws; LAS float* al_l = ws + 32;
    LAS int* dst_l = (LAS int*)(lds + OFF_DST) + wid * 32;
    const LAS float* bt = (const LAS float*)(lds + OFF_BT);
    const bf16* Kh = QKV + (size_t)(jb * BLK) * LDK + DM + h * HD; const bf16* Vh = Kh + DM;
    float m_reg = -1e30f, l_reg = 0; f32x16 o[4] = {}; bf16x8 qr[8];
    const bf16* Qw = QKV + (size_t)q * LDK + h * HD + hi * 8;
#pragma unroll
    for (int d0 = 0; d0 < 8; ++d0) qr[d0] = *reinterpret_cast<const bf16x8*>(Qw + d0 * 16);
    if (hi == 0) dst_l[r32] = dsti;
    const LAS float* bp0 = bt + (q - jb * BLK - 4 * hi + 256 - 59);
    const int sr = tid >> 4, sc = (tid & 15) * 8, vst0 = v_st(sr, sc), vst1 = v_st(32 + sr, sc);
    const int vb0 = (int)(uintptr_t)V_lds + v_rd_base(lane);
    struct { bf16x8 vs0, vs1, ks0, ks1; } sr_[2];
#define SLOAD(i, k0) do { sr_[i].vs0 = *reinterpret_cast<const bf16x8*>(&Vh[(size_t)((k0) + sr) * LDK + sc]); sr_[i].vs1 = *reinterpret_cast<const bf16x8*>(&Vh[(size_t)((k0) + 32 + sr) * LDK + sc]); \
    sr_[i].ks0 = *reinterpret_cast<const bf16x8*>(&Kh[(size_t)((k0) + sr) * LDK + sc]); sr_[i].ks1 = *reinterpret_cast<const bf16x8*>(&Kh[(size_t)((k0) + 32 + sr) * LDK + sc]); } while (0)
#define SWRITE(b, i) do { *(LAS bf16x8*)(V_lds + (b) * SHM_V + vst0) = sr_[i].vs0; *(LAS bf16x8*)(V_lds + (b) * SHM_V + vst1) = sr_[i].vs1; const int kc = sc * 2; \
    *(LAS bf16x8*)(K_lds + (b) * SHM_K + KSWZ(sr, kc)) = sr_[i].ks0; *(LAS bf16x8*)(K_lds + (b) * SHM_K + KSWZ(32 + sr, kc)) = sr_[i].ks1; } while (0)
#define SWAIT() asm volatile("s_waitcnt vmcnt(4)" ::: "memory")
#define RESC(a) do { if (__any((a) < 1.f)) { if (hi == 0) al_l[r32] = (a); asm volatile("s_waitcnt lgkmcnt(0)" ::: "memory"); \
    _Pragma("unroll") for (int d = 0; d < 4; ++d) _Pragma("unroll") for (int r = 0; r < 16; ++r) o[d][r] *= al_l[crow(r, hi)]; } } while (0)
    f32x16 pA0, pA1, pB0, pB1; float alA, alB; bf16x8 pa0, pa1, pa2, pa3;
    SLOAD(0, 0); asm volatile("s_waitcnt vmcnt(0)" ::: "memory"); SWRITE(0, 0); __syncthreads();
    qkt(pA0, pA1, K_lds, qr, r32, hi); partialSM(pA0, pA1, bp0, m_reg, alA);
    SLOAD(1, KVBLK); SLOAD(0, 2 * KVBLK);
    SWAIT(); SWRITE(1, 1); __syncthreads();
    SBAR(); qkt(pB0, pB1, K_lds + SHM_K, qr, r32, hi);
    finishSM(pA0, pA1, alA, l_reg, pa0, pa1, pa2, pa3); SBAR();
    SLOAD(1, 3 * KVBLK); SBAR();
    pv_d0(o, vb0, pa0, pa1, pa2, pa3); partialSM(pB0, pB1, bp0 - 64, m_reg, alB);
    __syncthreads(); SWAIT(); SWRITE(0, 0);
    RESC(alB); __syncthreads();
    SBAR(); qkt(pA0, pA1, K_lds, qr, r32, hi);
    finishSM(pB0, pB1, alB, l_reg, pa0, pa1, pa2, pa3); SBAR();
    pv_d0(o, vb0 + SHM_V, pa0, pa1, pa2, pa3); partialSM(pA0, pA1, bp0 - 128, m_reg, alA);
    __syncthreads(); asm volatile("s_waitcnt vmcnt(0)" ::: "memory"); SWRITE(1, 1);
    RESC(alA); __syncthreads();
    SBAR(); qkt(pB0, pB1, K_lds + SHM_K, qr, r32, hi);
    finishSM(pA0, pA1, alA, l_reg, pa0, pa1, pa2, pa3); SBAR();
    pv_d0(o, vb0, pa0, pa1, pa2, pa3); partialSM(pB0, pB1, bp0 - 192, m_reg, alB);
    RESC(alB);
    finishSM(pB0, pB1, alB, l_reg, pa0, pa1, pa2, pa3); SBAR();
    pv_d0(o, vb0 + SHM_V, pa0, pa1, pa2, pa3);
    if (hi == 0) { li_l[r32] = l_reg; if (dsti >= 0) LSE[dsti] = m_reg + __builtin_amdgcn_logf(l_reg); }
    asm volatile("s_waitcnt lgkmcnt(0)" ::: "memory");
#pragma unroll
    for (int r = 0; r < 16; ++r) { const int row = crow(r, hi); const float rl = __builtin_amdgcn_rcpf(li_l[row]); const int ds = dst_l[row];
        if (ds >= 0) { unsigned* pp = PART + (size_t)ds * 64 + r32; pp[0] = cvtpk(o[0][r] * rl, o[1][r] * rl); pp[32] = cvtpk(o[2][r] * rl, o[3][r] * rl); } }
    __syncthreads();
#undef SLOAD
#undef SWRITE
#undef SWAIT
#undef RESC
}
}
__device__ __forceinline__ void phase_attn_mfma(const Args& A, Frame& F, int ja) {
    int tid = F.wave * 64 + lane_id_v(); asm volatile("" : "+v"(tid));
    const unsigned* cnt = (const unsigned*)(F.ctl + CW_CNT + ja * 512); const unsigned* list = (const unsigned*)(F.ws + WS_LIST);
    LAS unsigned char* lds = F.lds + RING_OFF;
    LAS unsigned* pre = (LAS unsigned*)(lds + at::OFF_PRE);
    LAS unsigned* cl = (LAS unsigned*)(lds + at::OFF_CL);
    for (int i = tid; i < 512; i += NWAVES * 64) cl[i] = __hip_atomic_load(cnt + i, RLX_AGENT);
    __syncthreads();
    {
        const int g0 = 2 * tid, h0 = g0 >> 6, x0 = g0 & 63;
        const unsigned n0 = x0 < 32 ? (cl[h0 * 32 + x0] + 255u) >> 8 : 1u, n1 = (x0 + 1) < 32 ? (cl[h0 * 32 + x0 + 1] + 255u) >> 8 : 1u;
        unsigned v = n0 + n1; const int ln = tid & 63;
#pragma unroll
        for (int o = 1; o < 64; o <<= 1) { const unsigned t = __shfl_up(v, o); if (ln >= o) v += t; }
        LAS unsigned* wt = (LAS unsigned*)(lds + at::OFF_WT);
        if (ln == 63) wt[tid >> 6] = v;
        __syncthreads();
        unsigned base = 0;
        for (int w = 0; w < (tid >> 6); ++w) base += wt[w];
        const unsigned excl = base + v - (n0 + n1);
        pre[g0] = excl; pre[g0 + 1] = excl + n0;
        if (tid == NWAVES * 64 - 1) pre[1024] = base + v;
    }
    __syncthreads();
    const unsigned U = pre[1024];
    const unsigned u0 = (unsigned)(((unsigned long long)F.bid * U) / (unsigned)F.G), u1 = (unsigned)(((unsigned long long)(F.bid + 1) * U) / (unsigned)F.G);
    int cur_h = -1;
    const int wave = tid >> 6, r32 = tid & 31;
    for (unsigned u = u0; u < u1; ++u) {
        int lo = 0, hi_ = 1024;
        while (hi_ - lo > 1) { const int mid = (lo + hi_) >> 1; if (pre[mid] <= u) lo = mid; else hi_ = mid; }
        const int g = lo, h = g >> 6, x = g & 63, tile = (int)(u - pre[g]);
        if (h != cur_h) { __syncthreads(); const float* bsrc = (const float*)(F.ws + WS_BIAS) + h * BIAS_LD; LAS float* btl = (LAS float*)(lds + at::OFF_BT);
            {
                const int wv_ = __builtin_amdgcn_readfirstlane(tid >> 6), ln_ = tid & 63;
#pragma unroll
                for (int j = 0; j < 4; ++j) __builtin_amdgcn_global_load_lds((const unsigned*)(bsrc + (j * 8 + wv_) * 256 + ln_ * 4), (LAS unsigned*)((LAS unsigned char*)btl + (j * 8 + wv_) * 1024), 16, 0, 0);
                if (wv_ == 0) __builtin_amdgcn_global_load_lds((const unsigned*)(bsrc + 32 * 256 + ln_ * 4), (LAS unsigned*)((LAS unsigned char*)btl + 32 * 1024), 16, 0, 0); }
            cur_h = h; }
        int q, dsti, jb;
        if (x < 32) { jb = x; const int n = (int)cl[h * 32 + x]; const int e = tile * 256 + wave * 32 + r32; const unsigned ent = list[(size_t)(h * 32 + x) * 8192 + (e < n ? e : n - 1)];
            q = (int)(ent >> 2); dsti = e < n ? (q * NH + h) * 4 + (int)(ent & 3u) : -1; }
        else { jb = x - 32; q = jb * BLK + wave * 32 + r32; dsti = (q * NH + h) * 4 + 3; }
        at::attn_unit((const bf16*)(F.ws + WS_QKV), h, jb, q, dsti, lds, (unsigned*)(F.ws + WS_HID), (float*)(F.ws + WS_LSE), tid);
    }
}
template <bool OWN>
__device__ __forceinline__ void attn_phase(const Args& A, Frame& F, int ja) {
    using namespace at;
    int tid = F.wave * 64 + lane_id_v(); asm volatile("" : "+v"(tid));
    const int wid = tid >> 6, lane = tid & 63, r32 = lane & 31, hi = lane >> 5;
    const bf16* __restrict__ QKV = (const bf16*)(F.ws + WS_QKV);
    const unsigned* cnt = (const unsigned*)(F.ctl + CW_CNT + ja * 512); const unsigned* list = (const unsigned*)(F.ws + WS_LIST);
    unsigned* __restrict__ PART = (unsigned*)(F.ws + WS_HID); float* __restrict__ LSE = (float*)(F.ws + WS_LSE); bf16* __restrict__ AO = (bf16*)(F.ws + WS_AO);
    LAS unsigned char* lds = F.lds + RING_OFF;
    LAS unsigned char* V_lds = lds + OFF_V; LAS unsigned char* K_lds = lds + OFF_K;
    LAS float* ws = (LAS float*)(lds + OFF_WS) + wid * 64; LAS float* li_l = ws; LAS float* al_l = ws + 32;
    LAS int* dst_l = (LAS int*)(lds + OFF_DST) + wid * 32;
    LAS float* btl = (LAS float*)(lds + OFF_BT);
    LAS unsigned* pre = (LAS unsigned*)(lds + OFF_PRE);
    LAS unsigned* cl = (LAS unsigned*)(lds + OFF_CL);
    unsigned u0, u1;
    if (!OWN) {
        const unsigned n0 = (__hip_atomic_load(cnt + tid, RLX_AGENT));
        cl[tid] = n0;
        unsigned v = (n0 + 255u) >> 8; const unsigned mine = v;
#pragma unroll
        for (int o = 1; o < 64; o <<= 1) { const unsigned t = __shfl_up(v, o); if (lane >= o) v += t; }
        LAS unsigned* wt = (LAS unsigned*)(lds + OFF_WT);
        if (lane == 63) wt[wid] = v;
        __syncthreads();
        unsigned base = 0;
        for (int w = 0; w < wid; ++w) base += wt[w];
        pre[tid] = base + v - mine;
        if (tid == NWAVES * 64 - 1) pre[512] = base + v;
        __syncthreads();
        const unsigned U = pre[512];
        u0 = (unsigned)(((unsigned long long)F.bid * U) / (unsigned)F.G); u1 = (unsigned)(((unsigned long long)(F.bid + 1) * U) / (unsigned)F.G);
    } else { u0 = 0; u1 = (512 - F.bid + F.G - 1) / F.G; }
    const int sr = tid >> 4, sc = (tid & 15) * 8, vst0 = v_st(sr, sc), vst1 = v_st(32 + sr, sc);
    const int vb0 = (int)(uintptr_t)V_lds + v_rd_base(lane);
    struct { bf16x8 vs0, vs1, ks0, ks1; } sr_[2];
    bf16x8 qr[8];
    int h = 0, jb = 0, q = 0, dsti = -1;
#define DECODE(u_, h_, jb_, q_, d_) do { if (OWN) { const int gu = F.bid + (int)(u_) * F.G; h_ = gu >> 5; jb_ = gu & 31; q_ = jb_ * BLK + wid * 32 + r32; d_ = 0; } \
    else { int lo = 0, hi_ = 512; while (hi_ - lo > 1) { const int mid = (lo + hi_) >> 1; if (pre[mid] <= (u_)) lo = mid; else hi_ = mid; } \
        h_ = lo >> 5; jb_ = lo & 31; const int n_ = (int)cl[lo], e_ = (int)((u_) - pre[lo]) * 256 + wid * 32 + r32; \
        const unsigned ent_ = list[(size_t)lo * 8192 + (e_ < n_ ? e_ : n_ - 1)]; q_ = (int)(ent_ >> 2); d_ = e_ < n_ ? (q_ * NH + h_) * 4 + (int)(ent_ & 3u) : -1; } } while (0)
#define KVPTR(h_, jb_) (QKV + (size_t)((jb_) * BLK) * LDK + DM + (h_) * HD)
#define SLOAD(i, kp, k0) do { const bf16* kp_ = (kp); sr_[i].vs0 = *reinterpret_cast<const bf16x8*>(&kp_[DM + (size_t)((k0) + sr) * LDK + sc]); sr_[i].vs1 = *reinterpret_cast<const bf16x8*>(&kp_[DM + (size_t)((k0) + 32 + sr) * LDK + sc]); \
    sr_[i].ks0 = *reinterpret_cast<const bf16x8*>(&kp_[(size_t)((k0) + sr) * LDK + sc]); sr_[i].ks1 = *reinterpret_cast<const bf16x8*>(&kp_[(size_t)((k0) + 32 + sr) * LDK + sc]); } while (0)
#define QLOAD(h_, q_) do { const bf16* Qw_ = QKV + (size_t)(q_) * LDK + (h_) * HD + hi * 8; _Pragma("unroll") for (int d0 = 0; d0 < 8; ++d0) qr[d0] = *reinterpret_cast<const bf16x8*>(Qw_ + d0 * 16); } while (0)
#define SWRITE(b, i) do { *(LAS bf16x8*)(V_lds + (b) * SHM_V + vst0) = sr_[i].vs0; *(LAS bf16x8*)(V_lds + (b) * SHM_V + vst1) = sr_[i].vs1; const int kc = sc * 2; \
    *(LAS bf16x8*)(K_lds + (b) * SHM_K + KSWZ(sr, kc)) = sr_[i].ks0; *(LAS bf16x8*)(K_lds + (b) * SHM_K + KSWZ(32 + sr, kc)) = sr_[i].ks1; } while (0)
#define SWAIT() asm volatile("s_waitcnt vmcnt(4)" ::: "memory")
#define RESC(a) do { if (__any((a) < 1.f)) { if (hi == 0) al_l[r32] = (a); asm volatile("s_waitcnt lgkmcnt(0)" ::: "memory"); \
    _Pragma("unroll") for (int d = 0; d < 4; ++d) _Pragma("unroll") for (int r = 0; r < 16; ++r) o[d][r] *= al_l[crow(r, hi)]; } } while (0)
    if (u0 < u1) { DECODE(u0, h, jb, q, dsti); }
    int cur_h = -1;
    for (unsigned u = u0; u < u1; ++u) {
        if (h != cur_h) { const float* bsrc = (const float*)(F.ws + WS_BIAS) + h * BIAS_LD;
            {
                const int wv_ = __builtin_amdgcn_readfirstlane(tid >> 6), ln_ = tid & 63;
#pragma unroll
                for (int j = 0; j < 4; ++j) __builtin_amdgcn_global_load_lds((const unsigned*)(bsrc + (j * 8 + wv_) * 256 + ln_ * 4), (LAS unsigned*)((LAS unsigned char*)btl + (j * 8 + wv_) * 1024), 16, 0, 0);
                if (wv_ == 0) __builtin_amdgcn_global_load_lds((const unsigned*)(bsrc + 32 * 256 + ln_ * 4), (LAS unsigned*)((LAS unsigned char*)btl + 32 * 1024), 16, 0, 0); }
            cur_h = h; }
        const bf16* Kp = KVPTR(h, jb); QLOAD(h, q); SLOAD(0, Kp, 0);
        float m_reg = -1e30f, l_reg = 0; f32x16 o[4] = {};
        if (hi == 0) dst_l[r32] = dsti;
        const LAS float* bp0 = btl + (q - jb * BLK - 4 * hi + 256 - 59);
        f32x16 pA0, pA1, pB0, pB1; float alA, alB; bf16x8 pa0, pa1, pa2, pa3;
        asm volatile("s_waitcnt vmcnt(0)" ::: "memory"); SWRITE(0, 0); __syncthreads();
        qkt(pA0, pA1, K_lds, qr, r32, hi); partialSM(pA0, pA1, bp0, m_reg, alA);
        SLOAD(1, Kp, KVBLK); SLOAD(0, Kp, 2 * KVBLK);
        SWAIT(); SWRITE(1, 1); __syncthreads();
        SBAR(); qkt(pB0, pB1, K_lds + SHM_K, qr, r32, hi);
        finishSM(pA0, pA1, alA, l_reg, pa0, pa1, pa2, pa3); SBAR();
        SLOAD(1, Kp, 3 * KVBLK); SBAR();
        pv_d0(o, vb0, pa0, pa1, pa2, pa3); partialSM(pB0, pB1, bp0 - 64, m_reg, alB);
        __syncthreads(); SWAIT(); SWRITE(0, 0);
        RESC(alB); __syncthreads();
        SBAR(); qkt(pA0, pA1, K_lds, qr, r32, hi);
        finishSM(pB0, pB1, alB, l_reg, pa0, pa1, pa2, pa3); SBAR();
        pv_d0(o, vb0 + SHM_V, pa0, pa1, pa2, pa3); partialSM(pA0, pA1, bp0 - 128, m_reg, alA);
        __syncthreads(); asm volatile("s_waitcnt vmcnt(0)" ::: "memory"); SWRITE(1, 1);
        RESC(alA); __syncthreads();
        SBAR(); qkt(pB0, pB1, K_lds + SHM_K, qr, r32, hi); SBAR();
        int hn = h, jbn = jb, qn = q, dn = -1;
        if (u + 1 < u1) { DECODE(u + 1, hn, jbn, qn, dn); }
        SBAR();
        finishSM(pA0, pA1, alA, l_reg, pa0, pa1, pa2, pa3); SBAR();
        pv_d0(o, vb0, pa0, pa1, pa2, pa3); partialSM(pB0, pB1, bp0 - 192, m_reg, alB);

        RESC(alB);
        finishSM(pB0, pB1, alB, l_reg, pa0, pa1, pa2, pa3); SBAR();
        pv_d0(o, vb0 + SHM_V, pa0, pa1, pa2, pa3);
        asm volatile("s_waitcnt vmcnt(0)" ::: "memory");
        if (!OWN) {
            if (hi == 0) { li_l[r32] = l_reg; if (dsti >= 0) LSE[dsti] = m_reg + __builtin_amdgcn_logf(l_reg); }
            asm volatile("s_waitcnt lgkmcnt(0)" ::: "memory");
#pragma unroll
            for (int r = 0; r < 16; ++r) { const int row = crow(r, hi); const float rl = __builtin_amdgcn_rcpf(li_l[row]); const int ds = dst_l[row];
                if (ds >= 0) { unsigned* pp = PART + (size_t)ds * 64 + r32; pp[0] = cvtpk(o[0][r] * rl, o[1][r] * rl); pp[32] = cvtpk(o[2][r] * rl, o[3][r] * rl); } }
        } else {
            if (hi == 0) { li_l[r32] = l_reg; al_l[r32] = m_reg; }
            asm volatile("s_waitcnt lgkmcnt(0)" ::: "memory");
#pragma unroll
            for (int hf = 0; hf < 2; ++hf) {
                float wo[8], w0[8], w1[8], w2[8];
                {   f32x4 ls[8];
#pragma unroll
                    for (int rr = 0; rr < 8; ++rr) { const int row = crow(hf * 8 + rr, hi); ls[rr] = *(const f32x4*)(LSE + ((size_t)(jb * BLK + wid * 32 + row) * NH + h) * 4); }
#pragma unroll
                    for (int rr = 0; rr < 8; ++rr) { const int row = crow(hf * 8 + rr, hi); const float lrow = li_l[row], lown = al_l[row] + __builtin_amdgcn_logf(lrow);
                        const float M = fmaxf(fmaxf(lown, ls[rr][0]), fmaxf(ls[rr][1], ls[rr][2]));
                        const float eo = __builtin_amdgcn_exp2f(lown - M), e0 = __builtin_amdgcn_exp2f(ls[rr][0] - M), e1 = __builtin_amdgcn_exp2f(ls[rr][1] - M), e2 = __builtin_amdgcn_exp2f(ls[rr][2] - M);
                        const float iw = __builtin_amdgcn_rcpf((eo + e0) + (e1 + e2));
                        wo[rr] = eo * iw * __builtin_amdgcn_rcpf(lrow); w0[rr] = e0 * iw; w1[rr] = e1 * iw; w2[rr] = e2 * iw; } }
#pragma unroll
                for (int g4 = 0; g4 < 2; ++g4) {
                    unsigned pu[4][3][2];
#pragma unroll
                    for (int r4 = 0; r4 < 4; ++r4) { const int rr = g4 * 4 + r4, row = crow(hf * 8 + rr, hi); const unsigned* pp = PART + ((size_t)(jb * BLK + wid * 32 + row) * NH + h) * 256 + r32;
                        pu[r4][0][0] = w0[rr] > 0.f ? pp[0] : 0u; pu[r4][0][1] = w0[rr] > 0.f ? pp[32] : 0u;
                        pu[r4][1][0] = w1[rr] > 0.f ? pp[64] : 0u; pu[r4][1][1] = w1[rr] > 0.f ? pp[96] : 0u;
                        pu[r4][2][0] = w2[rr] > 0.f ? pp[128] : 0u; pu[r4][2][1] = w2[rr] > 0.f ? pp[160] : 0u; }
#pragma unroll
                    for (int r4 = 0; r4 < 4; ++r4) { const int rr = g4 * 4 + r4, r = hf * 8 + rr, row = crow(r, hi);
                        float a0 = o[0][r] * wo[rr], a1 = o[1][r] * wo[rr], a2 = o[2][r] * wo[rr], a3 = o[3][r] * wo[rr];
                        a0 += w0[rr] * bflo(pu[r4][0][0]) + w1[rr] * bflo(pu[r4][1][0]) + w2[rr] * bflo(pu[r4][2][0]);
                        a1 += w0[rr] * bfhi(pu[r4][0][0]) + w1[rr] * bfhi(pu[r4][1][0]) + w2[rr] * bfhi(pu[r4][2][0]);
                        a2 += w0[rr] * bflo(pu[r4][0][1]) + w1[rr] * bflo(pu[r4][1][1]) + w2[rr] * bflo(pu[r4][2][1]);
                        a3 += w0[rr] * bfhi(pu[r4][0][1]) + w1[rr] * bfhi(pu[r4][1][1]) + w2[rr] * bfhi(pu[r4][2][1]);
                        bf16* op = AO + (size_t)(jb * BLK + wid * 32 + row) * DM + h * HD + r32;
                        op[0] = (bf16)(cvtpk(a0, a0) & 0xffffu); op[32] = (bf16)(cvtpk(a1, a1) & 0xffffu); op[64] = (bf16)(cvtpk(a2, a2) & 0xffffu); op[96] = (bf16)(cvtpk(a3, a3) & 0xffffu); }
                }
            }
        }
        __syncthreads();
        h = hn; jb = jbn; q = qn; dsti = dn;
    }
#undef DECODE
#undef KVPTR
#undef SLOAD
#undef QLOAD
#undef SWRITE
#undef SWAIT
#undef RESC
}
namespace at3 {
using namespace at;
constexpr int O_K = 0, O_V = 65536, O_BT = 131072, O_WS = O_BT + BIAS_LD * 2, O_PRE = O_WS + 8 * 384, O_CL = O_PRE + 516 * 4, O_WT = O_CL + 512 * 4, O_END = O_WT + 64;
static_assert(O_END <= RING_BYTES, "attention LDS map");
__device__ __forceinline__ void sm_tile(f32x16& p0, f32x16& p1, const LAS unsigned short* bp, float& m_reg, float& l_reg, f32x16 (&o)[4], bf16x8& pa0, bf16x8& pa1, bf16x8& pa2, bf16x8& pa3, LAS float* al_l, int r32, int hi) {
    constexpr float C = 0.088388347648318440f * 1.4426950408889634f;
#pragma unroll
    for (int r = 0; r < 16; ++r) p0[r] = fmaf(p0[r], C, __builtin_bit_cast(float, (unsigned)bp[59 - ((r & 3) + 8 * (r >> 2))] << 16));
#pragma unroll
    for (int r = 0; r < 16; ++r) p1[r] = fmaf(p1[r], C, __builtin_bit_cast(float, (unsigned)bp[27 - ((r & 3) + 8 * (r >> 2))] << 16));
    float pmax = p0[0];
#pragma unroll
    for (int r = 1; r < 16; ++r) pmax = fmaxf(pmax, p0[r]);
#pragma unroll
    for (int r = 0; r < 16; ++r) pmax = fmaxf(pmax, p1[r]);
    { auto rr = __builtin_amdgcn_permlane32_swap(__float_as_uint(pmax), __float_as_uint(pmax), false, false); pmax = fmaxf(__uint_as_float(rr[0]), __uint_as_float(rr[1])); }
    float mn = m_reg, alpha = 1.f;
    if (!__all(pmax <= m_reg + 8.0f)) { const bool up = pmax > m_reg + 8.0f;
        mn = up ? pmax : m_reg; alpha = up ? __builtin_amdgcn_exp2f(m_reg - mn) : 1.f; m_reg = mn; }
#pragma unroll
    for (int r = 0; r < 16; ++r) p0[r] = __builtin_amdgcn_exp2f(p0[r] - mn);
#pragma unroll
    for (int r = 0; r < 16; ++r) p1[r] = __builtin_amdgcn_exp2f(p1[r] - mn);
    float ps = 0;
#pragma unroll
    for (int r = 0; r < 16; ++r) ps += p0[r];
#pragma unroll
    for (int r = 0; r < 16; ++r) ps += p1[r];
    { auto rr = __builtin_amdgcn_permlane32_swap(__float_as_uint(ps), __float_as_uint(ps), false, false); ps = __uint_as_float(rr[0]) + __uint_as_float(rr[1]); }
    l_reg = l_reg * alpha + ps;
#define PK4(P, BASE, OUT) do { unsigned a0 = cvtpk(P[BASE + 0], P[BASE + 1]), a1 = cvtpk(P[BASE + 2], P[BASE + 3]);   \
    unsigned b0 = cvtpk(P[BASE + 4], P[BASE + 5]), b1 = cvtpk(P[BASE + 6], P[BASE + 7]);                              \
    auto r0 = __builtin_amdgcn_permlane32_swap(a0, b0, false, false); auto r1 = __builtin_amdgcn_permlane32_swap(a1, b1, false, false); \
    u32x4 w = {r0[0], r1[0], r0[1], r1[1]}; OUT = *reinterpret_cast<bf16x8*>(&w); } while (0)
    PK4(p0, 0, pa0); PK4(p0, 8, pa1); PK4(p1, 0, pa2); PK4(p1, 8, pa3);
#undef PK4
    if (__any(alpha < 1.f)) { if (hi == 0) al_l[r32] = alpha; asm volatile("s_waitcnt lgkmcnt(0)" ::: "memory");
#pragma unroll
        for (int d = 0; d < 4; ++d)
#pragma unroll
            for (int r = 0; r < 16; ++r) o[d][r] *= al_l[crow(r, hi)]; }
}
__device__ __forceinline__ void load_kv_block(const bf16* __restrict__ QKV, int h, int jb, LAS unsigned char* lds, int tid) {
    const bf16* Kp = QKV + (size_t)(jb * BLK) * LDK + DM + h * HD;
    bf16x8 kv[8], vv[8];
#pragma unroll
    for (int i = 0; i < 8; ++i) { const int p = tid + 512 * i, row = p >> 4, c16 = p & 15; kv[i] = *reinterpret_cast<const bf16x8*>(Kp + (size_t)row * LDK + c16 * 8); vv[i] = *reinterpret_cast<const bf16x8*>(Kp + DM + (size_t)row * LDK + c16 * 8); }
#pragma unroll
    for (int i = 0; i < 8; ++i) { const int p = tid + 512 * i, row = p >> 4, c16 = p & 15, t = row >> 6, rl = row & 63;
        *(LAS bf16x8*)(lds + O_K + t * 16384 + KSWZ(rl, c16 * 16)) = kv[i]; *(LAS bf16x8*)(lds + O_V + t * 16384 + v_st(rl, c16 * 8)) = vv[i]; }
}
}
template <bool OWN>
__device__ __forceinline__ void attn_phase3(const Args& A, Frame& F, int ja) {
    using namespace at3;
    int tid = F.wave * 64 + lane_id_v(); asm volatile("" : "+v"(tid));
    const int wid = __builtin_amdgcn_readfirstlane(tid >> 6), lane = tid & 63, r32 = lane & 31, hi = lane >> 5;
    const bf16* __restrict__ QKV = (const bf16*)(F.ws + WS_QKV);
    const unsigned* cnt = (const unsigned*)(F.ctl + CW_CNT + ja * 512); const unsigned* list = (const unsigned*)(F.ws + WS_LIST);
    unsigned* __restrict__ PART = (unsigned*)(F.ws + WS_HID); float* __restrict__ LSE = (float*)(F.ws + WS_LSE); bf16* __restrict__ AO = (bf16*)(F.ws + WS_AO);
    LAS unsigned char* lds = F.lds + RING_OFF;
    LAS float* li_l = (LAS float*)(lds + O_WS + wid * 384); LAS float* al_l = li_l + 32; LAS int* dst_l = (LAS int*)(li_l + 64);
    LAS unsigned short* btl = (LAS unsigned short*)(lds + O_BT);
    LAS unsigned* pre = (LAS unsigned*)(lds + O_PRE); LAS unsigned* cl = (LAS unsigned*)(lds + O_CL);
    const int vb0 = (int)(uintptr_t)(lds + O_V) + v_rd_base(lane);
    unsigned s0 = 0, s1 = 0;
    if (!OWN) {
        const unsigned n0 = __hip_atomic_load(cnt + tid, RLX_AGENT); cl[tid] = n0;
        unsigned v = (n0 + 31u) >> 5; const unsigned mine = v;
#pragma unroll
        for (int o = 1; o < 64; o <<= 1) { const unsigned t = __shfl_up(v, o); if (lane >= o) v += t; }
        LAS unsigned* wt = (LAS unsigned*)(lds + O_WT);
        if (lane == 63) wt[wid] = v;
        __syncthreads();
        unsigned base = 0;
        for (int w = 0; w < wid; ++w) base += wt[w];
        pre[tid] = base + v - mine;
        if (tid == NWAVES * 64 - 1) pre[512] = base + v;
        __syncthreads();
        const unsigned ST = pre[512];
        s0 = (unsigned)(((unsigned long long)F.bid * ST) / (unsigned)F.G); s1 = (unsigned)(((unsigned long long)(F.bid + 1) * ST) / (unsigned)F.G);
    } else { s0 = 0; s1 = (512 - F.bid + F.G - 1) / F.G; }
    int cur_h = -1;
    while (s0 < s1) {
        int h, jb; unsigned seg_end, gbase = 0; int n_g = 0, g = 0;
        if (!OWN) { int lo = 0, hi_ = 512; while (hi_ - lo > 1) { const int mid = (lo + hi_) >> 1; if (pre[mid] <= s0) lo = mid; else hi_ = mid; }
            g = lo; h = g >> 5; jb = g & 31; gbase = pre[g]; n_g = (int)cl[g]; const unsigned ge = pre[g + 1]; seg_end = ge < s1 ? ge : s1; }
        else { const int gu = F.bid + (int)s0 * F.G; h = gu & 15; jb = gu >> 4; seg_end = s0 + 1; }
        __syncthreads();
        if (h != cur_h) { const float* bsrc = (const float*)(F.ws + WS_BIAS) + h * BIAS_LD;
            {
                const int ln_ = tid & 63;
#pragma unroll
                for (int j = 0; j < 4; ++j) __builtin_amdgcn_global_load_lds((const unsigned*)(bsrc + (j * 8 + wid) * 256 + ln_ * 4), (LAS unsigned*)(lds + O_K + (j * 8 + wid) * 1024), 16, 0, 0);
                if (wid == 0) __builtin_amdgcn_global_load_lds((const unsigned*)(bsrc + 32 * 256 + ln_ * 4), (LAS unsigned*)(lds + O_K + 32 * 1024), 16, 0, 0);
                asm volatile("s_waitcnt vmcnt(0)" ::: "memory"); __syncthreads();
                for (int i = tid; i < BIAS_LD; i += NWAVES * 64) btl[i] = (unsigned short)f2bf(((const LAS float*)(lds + O_K))[i]);
                __syncthreads(); }
            cur_h = h; }
        load_kv_block(QKV, h, jb, lds, tid);
        __syncthreads();
        const unsigned st_first = OWN ? 0u : s0 + (unsigned)wid, st_step = 8u;
        for (unsigned st = st_first; OWN ? st < 1u : st < seg_end; st += st_step) {
            int q, dsti, nt;
            if (!OWN) { const int e = (int)(st - gbase) * 32 + r32; const unsigned ent = list[(size_t)g * 8192 + (e < n_g ? e : n_g - 1)];
                q = (int)(ent >> 2); dsti = e < n_g ? (q * NH + h) * 4 + (int)(ent & 3u) : -1; nt = 4; }
            else { const int sub = wid < 4 ? 7 - wid : wid - 4; q = jb * BLK + sub * 32 + r32; dsti = 0; nt = (sub >> 1) + 1; }
            bf16x8 qr[8];
            { const bf16* Qw = QKV + (size_t)q * LDK + h * HD + hi * 8;
#pragma unroll
              for (int d0 = 0; d0 < 8; ++d0) qr[d0] = *reinterpret_cast<const bf16x8*>(Qw + d0 * 16); }
            if (!OWN) { if (hi == 0) dst_l[r32] = dsti; }
            const LAS unsigned short* bp0 = btl + (q - jb * BLK - 4 * hi + 256 - 59);
            float m_reg = -1e30f, l_reg = 0; f32x16 o[4] = {};
#pragma unroll 1
            for (int t = 0; t < nt; ++t) {
                f32x16 p0, p1; bf16x8 pa0, pa1, pa2, pa3;
                qkt(p0, p1, lds + O_K + t * 16384, qr, r32, hi);
                sm_tile(p0, p1, bp0 - 64 * t, m_reg, l_reg, o, pa0, pa1, pa2, pa3, al_l, r32, hi);
                pv_d0(o, vb0 + t * 16384, pa0, pa1, pa2, pa3);
            }
            if (!OWN) {
                if (hi == 0) { li_l[r32] = l_reg; if (dsti >= 0) LSE[dsti] = m_reg + __builtin_amdgcn_logf(l_reg); }
                asm volatile("s_waitcnt lgkmcnt(0)" ::: "memory");
#pragma unroll
                for (int r = 0; r < 16; ++r) { const int row = crow(r, hi); const float rl = __builtin_amdgcn_rcpf(li_l[row]); const int ds = dst_l[row];
                    if (ds >= 0) { unsigned* pp = PART + (size_t)ds * 64 + r32; pp[0] = cvtpk(o[0][r] * rl, o[1][r] * rl); pp[32] = cvtpk(o[2][r] * rl, o[3][r] * rl); } }
            } else {
                const int sub = wid < 4 ? 7 - wid : wid - 4, rowb = jb * BLK + sub * 32;
                if (hi == 0) { li_l[r32] = l_reg; al_l[r32] = m_reg; }
                asm volatile("s_waitcnt lgkmcnt(0)" ::: "memory");
#pragma unroll
                for (int hf = 0; hf < 2; ++hf) {
                    f32x4 ls[8]; unsigned pu[8][6];
#pragma unroll
                    for (int rr = 0; rr < 8; ++rr) { const int row = crow(hf * 8 + rr, hi); const size_t e = (size_t)(rowb + row) * NH + h;
                        ls[rr] = *(const f32x4*)(LSE + e * 4); const unsigned* pp = PART + e * 256 + r32;
                        pu[rr][0] = pp[0]; pu[rr][1] = pp[32]; pu[rr][2] = pp[64]; pu[rr][3] = pp[96]; pu[rr][4] = pp[128]; pu[rr][5] = pp[160]; }
#pragma unroll
                    for (int rr = 0; rr < 8; ++rr) { const int r = hf * 8 + rr, row = crow(r, hi); const float lrow = li_l[row], lown = al_l[row] + __builtin_amdgcn_logf(lrow);
                        const float M = fmaxf(fmaxf(lown, ls[rr][0]), fmaxf(ls[rr][1], ls[rr][2]));
                        const float eo = __builtin_amdgcn_exp2f(lown - M), e0 = __builtin_amdgcn_exp2f(ls[rr][0] - M), e1 = __builtin_amdgcn_exp2f(ls[rr][1] - M), e2 = __builtin_amdgcn_exp2f(ls[rr][2] - M);
                        const float iw = __builtin_amdgcn_rcpf((eo + e0) + (e1 + e2));
                        const float wo = eo * iw * __builtin_amdgcn_rcpf(lrow), w0 = e0 * iw, w1 = e1 * iw, w2 = e2 * iw;
                        const unsigned q00 = w0 > 0.f ? pu[rr][0] : 0u, q01 = w0 > 0.f ? pu[rr][1] : 0u, q10 = w1 > 0.f ? pu[rr][2] : 0u, q11 = w1 > 0.f ? pu[rr][3] : 0u, q20 = w2 > 0.f ? pu[rr][4] : 0u, q21 = w2 > 0.f ? pu[rr][5] : 0u;
                        const float a0 = o[0][r] * wo + (w0 * bflo(q00) + w1 * bflo(q10) + w2 * bflo(q20));
                        const float a1 = o[1][r] * wo + (w0 * bfhi(q00) + w1 * bfhi(q10) + w2 * bfhi(q20));
                        const float a2 = o[2][r] * wo + (w0 * bflo(q01) + w1 * bflo(q11) + w2 * bflo(q21));
                        const float a3 = o[3][r] * wo + (w0 * bfhi(q01) + w1 * bfhi(q11) + w2 * bfhi(q21));
                        bf16* op = AO + (size_t)(rowb + row) * DM + h * HD + r32;
                        op[0] = (bf16)(cvtpk(a0, a0) & 0xffffu); op[32] = (bf16)(cvtpk(a1, a1) & 0xffffu); op[64] = (bf16)(cvtpk(a2, a2) & 0xffffu); op[96] = (bf16)(cvtpk(a3, a3) & 0xffffu); }
                }
            }
        }
        s0 = seg_end;
    }
}
#define TOP3_INS2(x_, j_) do { const float x__ = (x_); const int j__ = (j_); \
    const bool b0 = x__ > v0 || (x__ == v0 && (unsigned)j__ < (unsigned)i0), b1 = x__ > v1 || (x__ == v1 && (unsigned)j__ < (unsigned)i1), b2 = x__ > v2 || (x__ == v2 && (unsigned)j__ < (unsigned)i2); \
    v2 = b1 ? v1 : (b2 ? x__ : v2); i2 = b1 ? i1 : (b2 ? j__ : i2); v1 = b0 ? v0 : (b1 ? x__ : v1); i1 = b0 ? i0 : (b1 ? j__ : i1); v0 = b0 ? x__ : v0; i0 = b0 ? j__ : i0; } while (0)
__device__ __forceinline__ void phase_gate2(const Args& A, Frame& F, int ja) {
    using namespace at;
    int tid = F.wave * 64 + lane_id_v(); asm volatile("" : "+v"(tid));
    const int lane = tid & 63, wave = tid >> 6, r32 = lane & 31, hi = lane >> 5;
    const bf16* QKV = (const bf16*)(F.ws + WS_QKV); const float* KMP = (const float*)(F.ws + WS_KMP);
    unsigned* cnt = (unsigned*)(F.ctl + CW_CNT + ja * 512); unsigned* list = (unsigned*)(F.ws + WS_LIST); float* LSE = (float*)(F.ws + WS_LSE);
    LAS unsigned* lc = (LAS unsigned*)(F.lds + RING_OFF);
    for (int u = F.bid; u < 512; u += F.G) {
        const int h = u & 15, c = u >> 4;
        __syncthreads();
        if (tid < 64) lc[tid] = 0u;
        __syncthreads();
        const int q = c * 256 + wave * 32 + r32;
        int i0 = -1, i1 = -1, i2 = -1;
        if (c > 0) {
            bf16x8 kh[8], kl[8], qr[8];
            const bf16* Qw = QKV + (size_t)q * NQKV + h * HD + hi * 8;
#pragma unroll
            for (int d0 = 0; d0 < 8; ++d0) qr[d0] = *reinterpret_cast<const bf16x8*>(Qw + d0 * 16);
#pragma unroll
            for (int d0 = 0; d0 < 8; ++d0) { const float* p0 = KMP + (size_t)r32 * 2048 + h * HD + d0 * 16 + hi * 8; const float* p1 = p0 + (size_t)32 * 2048;
                const f32x4 a0 = *(const f32x4*)p0 + *(const f32x4*)p1, a1 = *(const f32x4*)(p0 + 4) + *(const f32x4*)(p1 + 4);
                float v[8] = {a0[0], a0[1], a0[2], a0[3], a1[0], a1[1], a1[2], a1[3]}; unsigned hh[4], ll[4];
#pragma unroll
                for (int e = 0; e < 4; ++e) { const float x0 = v[2 * e] * (1.0f / 256.0f), x1 = v[2 * e + 1] * (1.0f / 256.0f); const unsigned ph = cvtpk(x0, x1); hh[e] = ph;
                    ll[e] = cvtpk(x0 - bflo(ph), x1 - bfhi(ph)); }
                u32x4 wh = {hh[0], hh[1], hh[2], hh[3]}, wl_ = {ll[0], ll[1], ll[2], ll[3]};
                kh[d0] = *reinterpret_cast<bf16x8*>(&wh); kl[d0] = *reinterpret_cast<bf16x8*>(&wl_); }
            f32x16 Gt = {};
#pragma unroll
            for (int d0 = 0; d0 < 8; ++d0) { Gt = __builtin_amdgcn_mfma_f32_32x32x16_bf16(kh[d0], qr[d0], Gt, 0, 0, 0); Gt = __builtin_amdgcn_mfma_f32_32x32x16_bf16(kl[d0], qr[d0], Gt, 0, 0, 0); }
            float v0 = -INFINITY, v1 = -INFINITY, v2 = -INFINITY;
#pragma unroll
            for (int r = 0; r < 16; ++r) { const int jb = crow(r, hi); if (jb < c) TOP3_INS2(Gt[r], jb); }
            const float pv0 = __shfl_xor(v0, 32), pv1 = __shfl_xor(v1, 32), pv2 = __shfl_xor(v2, 32);
            const int pi0 = __shfl_xor(i0, 32), pi1 = __shfl_xor(i1, 32), pi2 = __shfl_xor(i2, 32);
            if (pi0 >= 0) TOP3_INS2(pv0, pi0);
            if (pi1 >= 0) TOP3_INS2(pv1, pi1);
            if (pi2 >= 0) TOP3_INS2(pv2, pi2);
        }
        unsigned lp0 = 0, lp1 = 0, lp2 = 0;
        if (hi == 0) { if (i0 >= 0) lp0 = atomicAdd((unsigned*)(lc + i0), 1u); if (i1 >= 0) lp1 = atomicAdd((unsigned*)(lc + i1), 1u); if (i2 >= 0) lp2 = atomicAdd((unsigned*)(lc + i2), 1u); }
        __syncthreads();
        if (tid < 32) { const unsigned n = lc[tid]; lc[32 + tid] = n ? atomicAdd(&cnt[h * 32 + tid], n) : 0u; }
        __syncthreads();
        if (hi == 0) {
#define EMIT_PICK(k_, sj_, lp_) do { if ((sj_) >= 0) list[(size_t)(h * 32 + (sj_)) * 8192 + lc[32 + (sj_)] + (lp_)] = ((unsigned)q << 2) | (unsigned)(k_); \
                else LSE[((size_t)q * NH + h) * 4 + (k_)] = -INFINITY; } while (0)
            EMIT_PICK(0, i0, lp0); EMIT_PICK(1, i1, lp1); EMIT_PICK(2, i2, lp2);
#undef EMIT_PICK
        }
    }
}
__device__ __forceinline__ void phase_combine(const Args& A, Frame& F) {
    int tid = F.wave * 64 + lane_id_v(); asm volatile("" : "+v"(tid)); const int lane = tid & 63, wave = __builtin_amdgcn_readfirstlane(tid >> 6); (void)lane; (void)wave;
    const unsigned* PART = (const unsigned*)(F.ws + WS_HID); const float* LSE = (const float*)(F.ws + WS_LSE); bf16* AO = (bf16*)(F.ws + WS_AO);
    const int gw = F.bid * NWAVES + wave, NGW = F.G * NWAVES, l = lane;
    for (int e = gw; e < S * NH; e += NGW) {
        const f32x4 ls = *(const f32x4*)(LSE + (size_t)e * 4);
        const float M = fmaxf(fmaxf(ls[0], ls[1]), fmaxf(ls[2], ls[3]));
        float o0 = 0.f, o1 = 0.f, W = 0.f;
#pragma unroll
        for (int k = 0; k < 4; ++k) { const float w = __builtin_amdgcn_exp2f(ls[k] - M);
            if (w > 0.f) { const unsigned u = PART[((size_t)e * 4 + k) * 64 + l]; o0 += w * bflo(u); o1 += w * bfhi(u); W += w; } }
        const float inv = 1.0f / W; const int q = e >> 4, h = e & 15, c0 = 64 * (l >> 5) + (l & 31);
        bf16* op = AO + (size_t)q * DM + h * HD;
        op[c0] = (bf16)f2bf(o0 * inv); op[c0 + 32] = (bf16)f2bf(o1 * inv);
    }
}
__device__ __forceinline__ float sigmoidf_(float x) { return 1.0f / (1.0f + __expf(-x)); }
__device__ __forceinline__ void phase_rec_ab(const Args& A, Frame& F, int jr) {
    int tid = F.wave * 64 + lane_id_v(); asm volatile("" : "+v"(tid)); const int lane = tid & 63, wave = __builtin_amdgcn_readfirstlane(tid >> 6); (void)lane; (void)wave;
    const bf16* XR = (const bf16*)(F.ws + WS_QKV);
    const float* cw = A.in[8] + (size_t)jr * 4 * DM; const float* cb = A.in[9] + (size_t)jr * DM;
    const float* wrg = A.in[10] + (size_t)jr * 16 * 128 * 128; const float* brg = A.in[11] + (size_t)jr * DM;
    const float* wig = A.in[12] + (size_t)jr * 16 * 128 * 128; const float* big = A.in[13] + (size_t)jr * DM; const float* lam = A.in[14] + (size_t)jr * DM;
    float* SA = (float*)(F.ws + WS_HID); float* SB = SA + (size_t)S * DM;
    LAS float* xc = (LAS float*)(F.lds + RING_OFF);
    for (int item = F.bid; item < 256 * 16; item += F.G) {
        const int tt = item >> 4, n = item & 15;
        for (int i = tid; i < 4096; i += NWAVES * 64) { const int r = i >> 7, cc = i & 127, t = tt * 32 + r, c = n * 128 + cc;
            float a = cb[c];
#pragma unroll
            for (int jj = 0; jj < 4; ++jj) { const int ts = t - 3 + jj; if (ts >= 0) a += bf2f(XR[(size_t)ts * DM + c]) * cw[jj * DM + c]; }
            xc[i] = a; }
        __syncthreads();
        const int cc = tid & 127, rg = tid >> 7, c = n * 128 + cc;
        float ar[8], ai[8];
#pragma unroll
        for (int i = 0; i < 8; ++i) { ar[i] = 0.f; ai[i] = 0.f; }
        const float* wr_ = wrg + (size_t)n * 128 * 128 + cc; const float* wi_ = wig + (size_t)n * 128 * 128 + cc;
        for (int k = 0; k < 128; ++k) { const float a = wr_[k * 128], b = wi_[k * 128];
#pragma unroll
            for (int i = 0; i < 8; ++i) { const float x = xc[(rg + 4 * i) * 128 + k]; ar[i] += x * a; ai[i] += x * b; } }
        const float lm = lam[c]; const float lsg = (fminf(lm, 0.f) - log1pf(__expf(-fabsf(lm)))) * 8.0f;
        const float b_r = brg[c], b_i = big[c];
#pragma unroll
        for (int i = 0; i < 8; ++i) { const int r = rg + 4 * i; const size_t o = (size_t)(tt * 32 + r) * DM + c;
            const float rr = sigmoidf_(ar[i] + b_r), ii = sigmoidf_(ai[i] + b_i), la = rr * lsg;
            SA[o] = __expf(la); SB[o] = sqrtf(-expm1f(2.0f * la)) * (ii * xc[r * 128 + cc]); }
        __syncthreads();
    }
}
__device__ __forceinline__ void phase_rec_ab2(const Args& A, Frame& F, int jr) {
    using namespace at;
    int tid = F.wave * 64 + lane_id_v(); asm volatile("" : "+v"(tid));
    const int lane = tid & 63, wave = tid >> 6, r32 = lane & 31, hi = lane >> 5;
    const bf16* XR = (const bf16*)(F.ws + WS_QKV);
    const float* cw = A.in[8] + (size_t)jr * 4 * DM; const float* cb = A.in[9] + (size_t)jr * DM;
    const float* brg = A.in[11] + (size_t)jr * DM; const float* big = A.in[13] + (size_t)jr * DM; const float* lam = A.in[14] + (size_t)jr * DM;
    const bf16* WG = (const bf16*)(F.ws + WS_WG) + (size_t)jr * 2 * 16 * 128 * 128;
    unsigned* SAB = (unsigned*)(F.ws + WS_HID);
    LAS unsigned char* xcl = F.lds + RING_OFF;
    LAS unsigned char* wl = F.lds + RING_OFF + 65536;
    LAS f32x2* comp = (LAS f32x2*)(F.lds + RING_OFF + 131072);
    int cur_n = -1;
    for (int u = F.bid; u < 512; u += F.G) {
        const int n = u & 15, tt = u >> 4;
        __syncthreads();
        if (n != cur_n) { cur_n = n;
#pragma unroll
            for (int i = 0; i < 8; ++i) { const int p = tid + i * 512, g = p >> 11, ch = (p >> 4) & 127, kc = p & 15;
                *(LAS v4u*)(wl + g * 32768 + KSWZ(ch, kc * 16)) = *(const v4u*)(WG + ((size_t)(g * 16 + n) * 128 + ch) * 128 + kc * 8); } }
        {
            const int chg = tid & 15, c0 = n * 128 + chg * 8;
            float w[4][8], b8[8];
#pragma unroll
            for (int jj = 0; jj < 4; ++jj) { const f32x4 x0 = *(const f32x4*)(cw + jj * DM + c0), x1 = *(const f32x4*)(cw + jj * DM + c0 + 4);
                w[jj][0] = x0[0]; w[jj][1] = x0[1]; w[jj][2] = x0[2]; w[jj][3] = x0[3]; w[jj][4] = x1[0]; w[jj][5] = x1[1]; w[jj][6] = x1[2]; w[jj][7] = x1[3]; }
            { const f32x4 x0 = *(const f32x4*)(cb + c0), x1 = *(const f32x4*)(cb + c0 + 4); b8[0] = x0[0]; b8[1] = x0[1]; b8[2] = x0[2]; b8[3] = x0[3]; b8[4] = x1[0]; b8[5] = x1[1]; b8[6] = x1[2]; b8[7] = x1[3]; }
#pragma unroll 4
            for (int ps = 0; ps < 8; ++ps) { const int rl = (tid >> 4) + 32 * ps, t = tt * 256 + rl;
                float acc[8];
#pragma unroll
                for (int e = 0; e < 8; ++e) acc[e] = b8[e];
#pragma unroll
                for (int jj = 0; jj < 4; ++jj) { const int ts = t - 3 + jj;
                    if (ts >= 0) { const v4u xv = *(const v4u*)(XR + (size_t)ts * DM + c0);
                        acc[0] += bflo(xv.x) * w[jj][0]; acc[1] += bfhi(xv.x) * w[jj][1]; acc[2] += bflo(xv.y) * w[jj][2]; acc[3] += bfhi(xv.y) * w[jj][3];
                        acc[4] += bflo(xv.z) * w[jj][4]; acc[5] += bfhi(xv.z) * w[jj][5]; acc[6] += bflo(xv.w) * w[jj][6]; acc[7] += bfhi(xv.w) * w[jj][7]; } }
                v4u o; o.x = cvtpk(acc[0], acc[1]); o.y = cvtpk(acc[2], acc[3]); o.z = cvtpk(acc[4], acc[5]); o.w = cvtpk(acc[6], acc[7]);
                *(LAS v4u*)(xcl + KSWZ(rl, chg * 16)) = o; }
        }
        __syncthreads();
        bf16x8 xf[8];
#pragma unroll
        for (int d0 = 0; d0 < 8; ++d0) xf[d0] = *(const LAS bf16x8*)(xcl + KSWZ(wave * 32 + r32, (d0 * 16 + hi * 8) * 2));
#pragma unroll 1
        for (int ct = 0; ct < 4; ++ct) {
            f32x16 aR = {}, aI = {};
#pragma unroll
            for (int d0 = 0; d0 < 8; ++d0) { const int cbo = (d0 * 16 + hi * 8) * 2;
                const bf16x8 wr_ = *(const LAS bf16x8*)(wl + KSWZ(ct * 32 + r32, cbo)), wi_ = *(const LAS bf16x8*)(wl + 32768 + KSWZ(ct * 32 + r32, cbo));
                aR = __builtin_amdgcn_mfma_f32_32x32x16_bf16(xf[d0], wr_, aR, 0, 0, 0);
                aI = __builtin_amdgcn_mfma_f32_32x32x16_bf16(xf[d0], wi_, aI, 0, 0, 0); }
            const int chl = ct * 32 + r32, ch = n * 128 + chl;
            const float lm = lam[ch], b_r = brg[ch], b_i = big[ch];
            const float lsg2 = (fminf(lm, 0.f) - log1pf(__expf(-fabsf(lm)))) * (8.0f * 1.4426950408889634f);
            float sA[4], sH[4];
#pragma unroll
            for (int r = 0; r < 16; ++r) { const int tl = wave * 32 + crow(r, hi);
                const float xcv = bf2f(*(const LAS unsigned short*)(xcl + KSWZ(tl, chl * 2)));
                const float rr = __builtin_amdgcn_rcpf(1.0f + __builtin_amdgcn_exp2f(-1.4426950408889634f * (aR[r] + b_r)));
                const float ii = __builtin_amdgcn_rcpf(1.0f + __builtin_amdgcn_exp2f(-1.4426950408889634f * (aI[r] + b_i)));
                const float la2 = rr * lsg2;
                const float av = __builtin_amdgcn_exp2f(la2);
                const float x2 = la2 * (2.0f * 0.6931471805599453f);
                const float ser = -x2 * (1.0f + x2 * (0.5f + x2 * (0.16666667f + x2 * 0.041666668f)));
                const float om = x2 > -0.1f ? ser : 1.0f - av * av;
                const size_t o = (size_t)(tt * 256 + tl) * DM + ch;
                const float bv = __builtin_amdgcn_sqrtf(om) * (ii * xcv);
                SAB[o] = cvtpk(la2, bv);
                const int sg = r >> 2; if ((r & 3) == 0) { sA[sg] = av; sH[sg] = bv; } else { sH[sg] = av * sH[sg] + bv; sA[sg] *= av; } }
            float cA = 1.f, cH = 0.f;
#pragma unroll
            for (int sg = 0; sg < 4; ++sg) { const float pA = __shfl_xor(sA[sg], 32), pH = __shfl_xor(sH[sg], 32);
                const float fA = hi ? pA : sA[sg], fH = hi ? pH : sH[sg], gA = hi ? sA[sg] : pA, gH = hi ? sH[sg] : pH;
                cH = fA * cH + fH; cA *= fA; cH = gA * cH + gH; cA *= gA; }
            if (hi == 0) comp[wave * 128 + chl] = (f32x2){cA, cH};
        }
        __syncthreads();
        { const int k = tid >> 7, chl = tid & 127; const f32x2 c0 = comp[(2 * k) * 128 + chl], c1 = comp[(2 * k + 1) * 128 + chl];
          float* CA = (float*)(F.ws + WS_CARRY); float* CH = CA + 128 * DM; const size_t o = (size_t)(tt * 4 + k) * DM + n * 128 + chl;
          CA[o] = c0.x * c1.x; CH[o] = c1.x * c0.y + c1.y; }
    }
}
__device__ __forceinline__ void phase_rec_tot(const Args& A, Frame& F) {
    int tid = F.wave * 64 + lane_id_v(); asm volatile("" : "+v"(tid)); const int lane = tid & 63, wave = __builtin_amdgcn_readfirstlane(tid >> 6); (void)lane; (void)wave;
    const float* SA = (const float*)(F.ws + WS_HID); const float* SB = SA + (size_t)S * DM; float* CA = (float*)(F.ws + WS_CARRY); float* CH = CA + 128 * DM;
    for (int i = F.bid * (NWAVES * 64) + tid; i < 128 * 1024; i += F.G * NWAVES * 64) { const int ch = i >> 10, c = (i & 1023) * 2;
        f32x2 A = (f32x2){1.f, 1.f}, H = (f32x2){0.f, 0.f};
#pragma unroll 8
        for (int r = 0; r < 64; ++r) { const size_t o = (size_t)(ch * 64 + r) * DM + c; const f32x2 a = *(const f32x2*)(SA + o), b = *(const f32x2*)(SB + o); H = a * H + b; A = A * a; }
        *(f32x2*)(CA + ch * DM + c) = A; *(f32x2*)(CH + ch * DM + c) = H; }
}
__device__ __forceinline__ void phase_rec_scan(const Args& A, Frame& F) {
    int tid = F.wave * 64 + lane_id_v(); asm volatile("" : "+v"(tid));
    const unsigned* SAB = (const unsigned*)(F.ws + WS_HID); const float* CA = (const float*)(F.ws + WS_CARRY); const float* CH = CA + 128 * DM;
    const bf16* GG = (const bf16*)(F.ws + WS_QKV + 32 * MiB); bf16* AO = (bf16*)(F.ws + WS_AO);
    for (int i = F.bid * (NWAVES * 64) + tid; i < 128 * 1024; i += F.G * NWAVES * 64) { const int ch = i >> 10, c = (i & 1023) * 2;
        f32x2 H = (f32x2){0.f, 0.f};
        int k = 0;
        for (; k + 16 <= ch; k += 16) { f32x2 a[16], b[16];
#pragma unroll
            for (int j = 0; j < 16; ++j) { a[j] = *(const f32x2*)(CA + (k + j) * DM + c); b[j] = *(const f32x2*)(CH + (k + j) * DM + c); }
#pragma unroll
            for (int j = 0; j < 16; ++j) H = a[j] * H + b[j]; }
        if (k + 8 <= ch) { f32x2 a[8], b[8];
#pragma unroll
            for (int j = 0; j < 8; ++j) { a[j] = *(const f32x2*)(CA + (k + j) * DM + c); b[j] = *(const f32x2*)(CH + (k + j) * DM + c); }
#pragma unroll
            for (int j = 0; j < 8; ++j) H = a[j] * H + b[j];
            k += 8; }
        for (; k < ch; ++k) { const f32x2 a = *(const f32x2*)(CA + k * DM + c), b = *(const f32x2*)(CH + k * DM + c); H = a * H + b; }
#pragma unroll 1
        for (int r0 = 0; r0 < 64; r0 += 32) { v2u x[32]; unsigned g[32];
#pragma unroll
            for (int j = 0; j < 32; ++j) { const size_t o = (size_t)(ch * 64 + r0 + j) * DM + c; x[j] = __builtin_nontemporal_load((const v2u*)(SAB + o)); g[j] = *(const unsigned*)(GG + o); }
#pragma unroll
            for (int j = 0; j < 32; ++j) { const size_t o = (size_t)(ch * 64 + r0 + j) * DM + c;
                const f32x2 a = (f32x2){__builtin_amdgcn_exp2f(bflo(x[j].x)), __builtin_amdgcn_exp2f(bflo(x[j].y))}, b = (f32x2){bfhi(x[j].x), bfhi(x[j].y)};
                H = a * H + b; *(unsigned*)(AO + o) = pk2(H.x * bflo(g[j]), H.y * bfhi(g[j])); } }
    }
}
__device__ __forceinline__ int dq_layer(int li) {
    int l = 0, seen = -1;
#pragma unroll
    for (int b = 0; b < 4; ++b) if ((DQ_MASK >> b) & 1) { ++seen; if (seen == li) l = b; }
    return l;
}
__device__ __forceinline__ void wq_rows(const Args& A, Frame& F) {
    int tid = F.wave * 64 + lane_id_v(); asm volatile("" : "+v"(tid)); const int lane = tid & 63, wave = __builtin_amdgcn_readfirstlane(tid >> 6);
    const int gw = F.bid * NWAVES + wave, NGW = F.G * NWAVES;
    float* SWb = (float*)(F.ws + WS_SW);
    constexpr int NL = ((DQ_MASK >> 0) & 1) + ((DQ_MASK >> 1) & 1) + ((DQ_MASK >> 2) & 1) + ((DQ_MASK >> 3) & 1);
    for (int r0 = gw; r0 < NL * DM; r0 += 2 * NGW) {
        v4u x[2][16];
#pragma unroll
        for (int h = 0; h < 2; ++h) { const int rr = r0 + h * NGW < NL * DM ? r0 + h * NGW : r0; const int li = rr / DM, n = rr - li * DM, l = dq_layer(li);
            const bf16* src = (const bf16*)(F.ws + WS_W2) + (size_t)l * DM * FF + (size_t)n * FF;
#pragma unroll
            for (int j = 0; j < 16; ++j) x[h][j] = ((const GAS v4u*)src + lane)[64 * j]; }
#pragma unroll
        for (int h = 0; h < 2; ++h) { const int rr = r0 + h * NGW; if (rr >= NL * DM) break; const int li = rr / DM, n = rr - li * DM, l = dq_layer(li);
            unsigned char* dst = F.ws + WS_W1 + WS_W2Q_OFF * MiB + (size_t)l * DM * FF + (size_t)n * FF;
            float am = 0.f;
#pragma unroll
            for (int j = 0; j < 16; ++j)
#pragma unroll
                for (int e = 0; e < 4; ++e) am = fmaxf(am, fmaxf(fabsf(bflo(x[h][j][e])), fabsf(bfhi(x[h][j][e]))));
            am = wave_max(am);
            const float inv = am > 1e-30f ? 127.0f / am : 0.f; float cs = 0.f;
#pragma unroll
            for (int j = 0; j < 16; ++j) { float r[8];
#pragma unroll
                for (int e = 0; e < 4; ++e) { r[2 * e] = __builtin_rintf(bflo(x[h][j][e]) * inv); r[2 * e + 1] = __builtin_rintf(bfhi(x[h][j][e]) * inv); cs += r[2 * e] + r[2 * e + 1]; }
                v2u o; o.x = pack_i8x4(r[0], r[1], r[2], r[3]); o.y = pack_i8x4(r[4], r[5], r[6], r[7]);
                ((GAS v2u*)dst + lane)[64 * j] = o; }
            cs = wave_sum(cs);
            if (lane == 0) { SWb[SW_T2 + l * DM + n] = am * (1.0f / 127.0f); SWb[SW_CS2 + l * DM + n] = cs; } }
    }
    for (int r0 = gw; r0 < NL * FF; r0 += 4 * NGW) {
        v4u a[4], b2[4]; float stp[4];
#pragma unroll
        for (int h = 0; h < 4; ++h) { const int rr = r0 + h * NGW < NL * FF ? r0 + h * NGW : r0; const int li = rr / FF, n = rr - li * FF, l = dq_layer(li);
            const unsigned char* src = F.ws + WS_W1 + (size_t)l * FF * DM + (size_t)n * DM;
            a[h] = ((const GAS v4u*)src + lane)[0]; b2[h] = ((const GAS v4u*)src + lane)[64]; stp[h] = SWb[SW_W1 + l * FF + n]; }
#pragma unroll
        for (int h = 0; h < 4; ++h) { const int rr = r0 + h * NGW; if (rr >= NL * FF) break; const int li = rr / FF, n = rr - li * FF, l = dq_layer(li);
            int acc = 0;
#pragma unroll
            for (int e = 0; e < 4; ++e) { const int w0 = (int)a[h][e], w1 = (int)b2[h][e];
#pragma unroll
                for (int sh = 0; sh < 4; ++sh) { const int q0 = (w0 << (24 - 8 * sh)) >> 24, q1 = (w1 << (24 - 8 * sh)) >> 24; acc += q0 * q0 + q1 * q1; } }
            const float tot = wave_sum((float)acc);
            if (lane == 0) SWb[SW_SS + l * FF + n] = tot * stp[h] * stp[h]; }
    }
}
__device__ __forceinline__ void hidden_step(Frame& F, int l) {
    if (F.bid == 0) { float* SWb = (float*)(F.ws + WS_SW); int tid = F.wave * 64 + lane_id_v(); asm volatile("" : "+v"(tid)); const int lane = tid & 63;
        float v[16];
#pragma unroll
        for (int j = 0; j < 16; ++j) v[j] = SWb[SW_SS + l * FF + tid + 512 * j];
        float s = 0.f;
#pragma unroll
        for (int j = 0; j < 16; ++j) s += v[j];
        s = wave_sum(s);
        LAS float* red = (LAS float*)(F.lds + RING_OFF);
        if (lane == 0) red[F.wave] = s;
        __syncthreads();
        if (tid == 0) { float t = 0.f;
#pragma unroll
            for (int w = 0; w < 8; ++w) t += red[w];
            const float C = 21.16f * t * (1.0f / 8192.0f);
            SWb[SW_CL + 2 * l] = 254.0f / C; SWb[SW_CL + 2 * l + 1] = C * (1.0f / 254.0f); }
        __syncthreads(); }
}
__device__ __forceinline__ void phase_quant(const Args& A, Frame& F, int need_q) {
    int tid = F.wave * 64 + lane_id_v(); asm volatile("" : "+v"(tid)); const int lane = tid & 63, wave = __builtin_amdgcn_readfirstlane(tid >> 6);
    const bf16* XB = (const bf16*)(F.ws + WS_XB); unsigned char* XQ = F.ws + WS_XQ; float* frow = (float*)(F.ws + WS_FROW);
    const int nk = pass_nrows(F, wave);
    for (int k0 = 0; k0 < nk; k0 += 4) {
        v4u x[4][4];
#pragma unroll
        for (int r = 0; r < 4; ++r) { const int m = pass_row(F, wave, k0 + r < nk ? k0 + r : k0);
#pragma unroll
            for (int j = 0; j < 4; ++j) x[r][j] = ((const GAS v4u*)(XB + (size_t)m * DM) + lane)[64 * j]; }
#pragma unroll
        for (int r = 0; r < 4; ++r) { const int m = k0 + r < nk ? pass_row(F, wave, k0 + r) : S; float s = 0.f, am = 0.f;
#pragma unroll
            for (int j = 0; j < 4; ++j) {
#pragma unroll
                for (int e = 0; e < 4; ++e) { const float a0 = bflo(x[r][j][e]), a1 = bfhi(x[r][j][e]); s += a0 * a0 + a1 * a1; am = fmaxf(am, fmaxf(fabsf(a0), fabsf(a1))); } }
            s = wave_sum(s); am = wave_max(am);
            const float inv = am > 1e-30f ? 127.0f / am : 0.f;
            if (m < S) {
                if (need_q) {
#pragma unroll
                for (int j = 0; j < 4; ++j) { v2u o; o.x = pack_i8x4(bflo(x[r][j].x) * inv, bfhi(x[r][j].x) * inv, bflo(x[r][j].y) * inv, bfhi(x[r][j].y) * inv);
                    o.y = pack_i8x4(bflo(x[r][j].z) * inv, bfhi(x[r][j].z) * inv, bflo(x[r][j].w) * inv, bfhi(x[r][j].w) * inv);
                    ((GAS v2u*)(XQ + (size_t)m * DM) + lane)[64 * j] = o; } }
                if (lane == 0) { const float rstd = __builtin_amdgcn_rsqf(s * (1.0f / 2048.0f) + 1e-6f); frow[m] = am * (1.0f / 127.0f) * rstd; ((float*)(F.ws + WS_RSTD))[m] = rstd; } } }
    }
}
__device__ __forceinline__ void phase_final(const Args& A, Frame& F) {
    int tid = F.wave * 64 + lane_id_v(); asm volatile("" : "+v"(tid)); const int lane = tid & 63, wave = __builtin_amdgcn_readfirstlane(tid >> 6);
    const bf16* XB = (const bf16*)(F.ws + WS_XB); const float* gf = A.in[4];
    const int nk = pass_nrows(F, wave);
    f32x4 g0[4], g1[4];
#pragma unroll
    for (int j = 0; j < 4; ++j) { g0[j] = *(const f32x4*)(gf + j * 512 + lane * 8); g1[j] = *(const f32x4*)(gf + j * 512 + lane * 8 + 4); }
    for (int k0 = 0; k0 < nk; k0 += 2) {
        const bool two = k0 + 1 < nk; const int m0 = pass_row(F, wave, k0), m1 = two ? pass_row(F, wave, k0 + 1) : m0;
        v4u xa[4], xb[4];
#pragma unroll
        for (int j = 0; j < 4; ++j) { xa[j] = ((const GAS v4u*)(XB + (size_t)m0 * DM) + lane)[64 * j]; xb[j] = two ? ((const GAS v4u*)(XB + (size_t)m1 * DM) + lane)[64 * j] : xa[j]; }
        float s0 = 0.f, s1 = 0.f;
#pragma unroll
        for (int j = 0; j < 4; ++j) {
#pragma unroll
            for (int e = 0; e < 4; ++e) { const float a0 = bflo(xa[j][e]), a1 = bfhi(xa[j][e]), b0 = bflo(xb[j][e]), b1 = bfhi(xb[j][e]); s0 += a0 * a0 + a1 * a1; s1 += b0 * b0 + b1 * b1; } }
        s0 = wave_sum(s0); s1 = wave_sum(s1);
        const float r0 = __builtin_amdgcn_rsqf(s0 * (1.0f / 2048.0f) + 1e-6f), r1 = __builtin_amdgcn_rsqf(s1 * (1.0f / 2048.0f) + 1e-6f);
        GAS f32x4* o0 = (GAS f32x4*)(A.out + (size_t)m0 * DM) + 2 * lane; GAS f32x4* o1 = (GAS f32x4*)(A.out + (size_t)m1 * DM) + 2 * lane;
#pragma unroll
        for (int j = 0; j < 4; ++j) { const f32x4 a = (f32x4){bflo(xa[j].x), bfhi(xa[j].x), bflo(xa[j].y), bfhi(xa[j].y)}, b = (f32x4){bflo(xa[j].z), bfhi(xa[j].z), bflo(xa[j].w), bfhi(xa[j].w)};
            __builtin_nontemporal_store(a * r0 * g0[j], &o0[128 * j]); __builtin_nontemporal_store(b * r0 * g1[j], &o0[128 * j + 1]); }
        if (two) {
#pragma unroll
            for (int j = 0; j < 4; ++j) { const f32x4 a = (f32x4){bflo(xb[j].x), bfhi(xb[j].x), bflo(xb[j].y), bfhi(xb[j].y)}, b = (f32x4){bflo(xb[j].z), bfhi(xb[j].z), bflo(xb[j].w), bfhi(xb[j].w)};
                __builtin_nontemporal_store(a * r1 * g0[j], &o1[128 * j]); __builtin_nontemporal_store(b * r1 * g1[j], &o1[128 * j + 1]); } }
    }
}
__global__ void __launch_bounds__(NWAVES * 64, 2) mega_fwd(Args A) {
    extern __shared__ __attribute__((aligned(16))) unsigned char lds[];
    Frame F;
    F.lds = (LAS unsigned char*)lds; F.ldsg = lds;
    F.MISC = (volatile LAS unsigned*)(F.lds + MISC_OFF);
    F.tid = threadIdx.x; F.lane = F.tid & 63; F.wave = __builtin_amdgcn_readfirstlane(F.tid >> 6);
    F.G = gridDim.x; F.bid = blockIdx.x;
    F.ws = A.ws; F.ctl = (gu32*)(A.ws + WS_CTL);
    for (int u = F.tid; u < (LDS_BYTES - LDSCTL_OFF) / 4; u += NWAVES * 64) ((LAS unsigned*)(F.lds + LDSCTL_OFF))[u] = 0u;
    __syncthreads();
    XcdBarrier bar; bar.bar = (unsigned*)(F.ctl + CW_BAR); bar.x = 0; bar.st = nullptr;
    if (!MK_PER_PHASE) bar = xcd_barrier_post((unsigned*)(F.ctl + CW_BAR), F.MISC + 8);
    const int lo = A.ph_lo, hi = A.ph_hi;
#define IN(k) (lo <= (k) && (k) < hi)
#define SEAM(k) do { if (IN(k) && IN((k) + 1)) xcd_barrier(bar); } while (0)

    if (IN(0) && DBG(0)) { for (int rp = 0; rp < NREP(0); ++rp) { p0_prologue(A, F); if (rp + 1 < NREP(0)) xcd_barrier(bar); } } SEAM(0);
    for (int ls = 0; ls < 2 * DEPTH; ++ls) {
        const int l = ls >> 1, st = ls & 1, jm = l >> 1, rec = l & 1;
        const int p1 = 1 + 7 * l + (st ? 5 : 0), p2 = p1 + (st ? 1 : 4);
        if (IN(p1) && DBG(1)) {
            if (ls > 0) { phase_quant(A, F, (st || !rec) ? 1 : 0); if (ls == 1 && DQ_MASK) wq_rows(A, F); if (st && ((DQ_MASK >> l) & 1)) hidden_step(F, l); xcd_barrier(bar); }
            if (!st && rec) {
                pg8::Gemm g{(const bf16*)(F.ws + WS_XB), (const bf16*)(F.ws + WS_WIN) + (size_t)jm * 2 * DM * DM, S, 2 * DM, DM, F.wave};
                pg8::FrowOrder So; So.init(S, 2 * DM, F.G, F.bid); So.frow = (const float*)(F.ws + WS_RSTD); So.tab = F.lds + 135168;
                pg8::EpiScaleT<false> E{(bf16*)(F.ws + WS_QKV), DM, F.lds + 135168, nullptr, (bf16*)(F.ws + WS_QKV + 32 * MiB), 1, nullptr, nullptr};
                pg8::gemm_phase<pg8::EpiScaleT<false>, pg8::FrowOrder, true, true, false>(F.lds + RING_OFF, g, So, E);
            } else {
            const unsigned char* Bq; const float* sc; int N, mode; bf16* O; int ldc;
            if (st) { Bq = F.ws + WS_W1 + (size_t)l * FF * DM; sc = (const float*)(F.ws + WS_SW) + SW_W1 + l * FF; N = FF; mode = ((DQ_MASK >> l) & 1) ? 3 : 2; O = (bf16*)(F.ws + WS_HID); ldc = FF; }
            else { Bq = F.ws + WS_WQKV + (size_t)jm * NQKV * DM; sc = (const float*)(F.ws + WS_SW) + SW_QKV + jm * NQKV; N = NQKV; mode = 0; O = (bf16*)(F.ws + WS_QKV); ldc = NQKV; }
            pg8::Gemm g{(const bf16*)(F.ws + WS_XQ), (const bf16*)Bq, S, N, DM / 2, F.wave};
            pg8::FrowOrder So; So.init(S, N, F.G, F.bid); So.frow = (const float*)(F.ws + WS_FROW); So.tab = F.lds + 135168;
            pg8::EpiScaleT<true> E{O, ldc, F.lds + 135168, (float*)(F.ws + WS_KMP), (bf16*)(F.ws + WS_QKV + 32 * MiB), mode, sc, (const float*)(F.ws + WS_SW) + SW_CL + 2 * l};
            for (int rp = 0; rp < NREP(1); ++rp) { pg8::gemm_phase<pg8::EpiScaleT<true>, pg8::FrowOrder, true, true, true>(F.lds + RING_OFF, g, So, E); if (rp + 1 < NREP(1)) xcd_barrier(bar); } } }
        SEAM(p1);
        if (!st) {
            if (!rec) {
                if (IN(p1 + 1) && DBG(2)) phase_gate2(A, F, jm);
                SEAM(p1 + 1);
                if (IN(p1 + 2) && DBG(3)) { for (int rp = 0; rp < NREP(3); ++rp) { attn_phase<false>(A, F, jm); if (rp + 1 < NREP(3)) xcd_barrier(bar); } }
                SEAM(p1 + 2);
                if (IN(p1 + 3) && DBG(4)) { for (int rp = 0; rp < NREP(4); ++rp) { attn_phase3<true>(A, F, jm); if (rp + 1 < NREP(4)) xcd_barrier(bar); } }
                SEAM(p1 + 3);
            } else {
                if (IN(p1 + 1) && DBG(6)) { for (int rp = 0; rp < NREP(6); ++rp) { phase_rec_ab2(A, F, jm); if (rp + 1 < NREP(6)) xcd_barrier(bar); } }
                SEAM(p1 + 1);
                                if (IN(p1 + 3) && DBG(8)) { for (int rp = 0; rp < NREP(8); ++rp) { phase_rec_scan(A, F); if (rp + 1 < NREP(8)) xcd_barrier(bar); } }
                SEAM(p1 + 3);
            }
        }
        if (IN(p2) && DBG(9) && st && ((DQ_MASK >> l) & 1)) {
            pg8::Gemm g{(const bf16*)(F.ws + WS_HID), (const bf16*)(F.ws + WS_W1 + WS_W2Q_OFF * MiB + (size_t)l * DM * FF), S, DM, FF / 2, F.wave}; pg8::StaticOrder So; So.init(S, DM, F.G, F.bid);
            pg8::EpiResQ8 E{(bf16*)(F.ws + WS_XB), (const float*)(F.ws + WS_SW) + SW_T2 + l * DM, (const float*)(F.ws + WS_SW) + SW_CS2 + l * DM, (const float*)(F.ws + WS_SW) + SW_CL + 2 * l};
            pg8::gemm_phase<pg8::EpiResQ8, pg8::StaticOrder, true, true, true>(F.lds + RING_OFF, g, So, E); }
        else if (IN(p2) && DBG(9)) {
            const bf16* Ap; const bf16* Bt; int K;
            if (st) { Ap = (const bf16*)(F.ws + WS_HID); Bt = (const bf16*)(F.ws + WS_W2) + (size_t)l * DM * FF; K = FF; }
            else { Ap = (const bf16*)(F.ws + WS_AO); Bt = (const bf16*)(F.ws + (rec ? WS_WOUT : WS_WO)) + (size_t)jm * DM * DM; K = DM; }
            pg8::Gemm g{Ap, Bt, S, DM, K, F.wave}; pg8::StaticOrder So; So.init(S, DM, F.G, F.bid);
            pg8::EpiRes E{(bf16*)(F.ws + WS_XB)};
            pg8::gemm_phase<pg8::EpiRes, pg8::StaticOrder, true, true>(F.lds + RING_OFF, g, So, E); }
        SEAM(p2);
    }
    if (IN(NPHASE - 1) && DBG(12)) { for (int rp = 0; rp < NREP(12); ++rp) { phase_final(A, F); if (rp + 1 < NREP(12)) xcd_barrier(bar); } }
#undef IN
#undef SEAM
}

extern "C" void kernel_launch(void* const* d_in, const int* in_sizes, int n_in, void* d_out, int out_size, void* d_ws, size_t ws_size, hipStream_t stream) {
    static int grid = 0;
    if (grid == 0) {
        if (n_in != 18 || in_sizes[0] != S * DM || out_size != S * DM || ws_size < WS_END) { fprintf(stderr, "kernel_launch: shape mismatch n_in %d in0 %d out %d ws %zu (need %zu)\n", n_in, n_in > 0 ? in_sizes[0] : -1, out_size, ws_size, (size_t)WS_END); grid = -1; return; }
        int dev = 0, cus = 0, per_cu = 0;
        if (hipGetDevice(&dev) != hipSuccess || hipDeviceGetAttribute(&cus, hipDeviceAttributeMultiprocessorCount, dev) != hipSuccess) { grid = -1; return; }
        if (hipFuncSetAttribute((const void*)mega_fwd, hipFuncAttributeMaxDynamicSharedMemorySize, LDS_BYTES) != hipSuccess) { fprintf(stderr, "kernel_launch: hipFuncSetAttribute failed\n"); grid = -1; return; }
        if (hipOccupancyMaxActiveBlocksPerMultiprocessor(&per_cu, (const void*)mega_fwd, NWAVES * 64, LDS_BYTES) != hipSuccess || per_cu < 1) fprintf(stderr, "kernel_launch: occupancy query says %d\n", per_cu);
        (void)hipGetLastError();
        grid = cus;
    }
    if (grid < 0) return;
    if (hipMemsetAsync((char*)d_ws + WS_CTL, 0, CTL_ZERO_BYTES, stream) != hipSuccess) { fprintf(stderr, "kernel_launch: memset failed\n"); return; }
    Args a{};
    for (int i = 0; i < 18; ++i) a.in[i] = (const float*)d_in[i];
    a.out = (float*)d_out; a.ws = (unsigned char*)d_ws;
#if MK_PER_PHASE
    for (int p = 0; p < NPHASE; ++p) { a.ph_lo = p; a.ph_hi = p + 1; hipLaunchKernelGGL(mega_fwd, dim3(grid), dim3(NWAVES * 64), LDS_BYTES, stream, a); }
#else
    a.ph_lo = 0; a.ph_hi = NPHASE; hipLaunchKernelGGL(mega_fwd, dim3(grid), dim3(NWAVES * 64), LDS_BYTES, stream, a);
#endif
    const hipError_t le = hipPeekAtLastError();
    if (le != hipSuccess) fprintf(stderr, "kernel_launch: launch failed: %s\n", hipGetErrorName(le));
}
```

```cpp
#include <hip/hip_runtime.h>
#include <cstdio>
#include <cstdint>
#include <cmath>
__device__ __forceinline__ int lane_id_v() { int l; asm volatile("v_mbcnt_lo_u32_b32 %0, -1, 0\n\tv_mbcnt_hi_u32_b32 %0, -1, %0" : "=v"(l)); return l; }
namespace pg8 {
#define PG8_LAS __attribute__((address_space(3)))
typedef unsigned short bf16_t;
typedef short bf16x8 __attribute__((ext_vector_type(8)));
typedef float f32x4 __attribute__((ext_vector_type(4)));
typedef unsigned u32x4 __attribute__((ext_vector_type(4)));
typedef int i32x4 __attribute__((ext_vector_type(4)));
template <bool I8> struct AccT { typedef f32x4 type; };
template <> struct AccT<true> { typedef i32x4 type; };
__device__ __forceinline__ f32x4 mma_op(bf16x8 a, bf16x8 b, f32x4 c) { return __builtin_amdgcn_mfma_f32_16x16x32_bf16(a, b, c, 0, 0, 0); }
__device__ __forceinline__ i32x4 mma_op(bf16x8 a, bf16x8 b, i32x4 c) { return __builtin_amdgcn_mfma_i32_16x16x64_i8(__builtin_bit_cast(i32x4, a), __builtin_bit_cast(i32x4, b), c, 0, 0, 0); }
constexpr int BM = 256, BK = 64, HALF = 128, HTB = HALF * BK * 2  , STAGE_BYTES = 8 * HTB, NXCD = 8, WGM = 8;

__host__ __device__ __forceinline__ int lds_byte(int r, int c) { const int st = (r >> 4) * 2 + (c >> 5), rr = r & 15, cc = c & 31, ob = rr * 64 + cc * 2; return st * 1024 + (ob ^ (((ob >> 9) & 1) << 5)); }
__host__ __device__ __forceinline__ void stage_rc(int b, int& R, int& C) { const int st = b / 1024, sb = b % 1024, swz = sb ^ (((sb >> 9) & 1) << 5); R = (st >> 1) * 16 + swz / 64; C = (st & 1) * 32 + (swz % 64) / 2; }
__host__ __device__ __forceinline__ int perm32(int rho) { const int n = rho >> 4, i = rho & 15; return 8 * (i >> 2) + 4 * n + (i & 3); }

struct Unit { int pm, pn, seq; };
struct Gemm { const bf16_t* A; const bf16_t* Bt; int M, N, K; int wave; };

struct StaticOrder {
    int nM, nN, nwg, G, c;
    __host__ __device__ void init(int M, int N, int G_, int c_) { nM = M / BM; nN = N / BM; nwg = nM * nN; G = G_; c = c_; }
    __host__ __device__ bool next(int i, Unit& u) const {
        const long L = (long)i * G + c; if (L >= nwg) return false;
        int wgid = (int)L; { const int q = nwg / NXCD, r = nwg % NXCD, xcd = wgid % NXCD, off = wgid / NXCD; wgid = (xcd < r ? xcd * (q + 1) : r * (q + 1) + (xcd - r) * q) + off; }
        const int nig = WGM * nN, gid = wgid / nig, fm = gid * WGM, gsz = (nM - fm) < WGM ? (nM - fm) : WGM;
        u.pm = fm + ((wgid % nig) % gsz); u.pn = (wgid % nig) / gsz; u.seq = i; return true;
    }
    __device__ __forceinline__ void a_ready(const Unit&) const {}
    __device__ __forceinline__ void done(const Unit&) const {}
};

__device__ __forceinline__ unsigned cvt_pk_bf16(float lo, float hi) { unsigned r; asm volatile("v_cvt_pk_bf16_f32 %0, %1, %2" : "=v"(r) : "v"(lo), "v"(hi)); return r; }
struct FrowOrder : StaticOrder {
    const float* frow; PG8_LAS unsigned char* tab;
    __device__ __forceinline__ void a_ready(const Unit& u) const {
        const int lane = lane_id_v();
        __builtin_amdgcn_global_load_lds((const unsigned*)(frow + (size_t)u.pm * BM + lane * 4), (PG8_LAS unsigned*)(tab + (u.seq & 1) * 1024), 16, 0, 0);
    }
};
constexpr float RMS_EPS = 1e-6f;
typedef float f32x2_ __attribute__((ext_vector_type(2)));
__device__ __forceinline__ float gelu_tanh(float x) {
    const float u = 0.7978845608028654f * (x + 0.044715f * x * x * x);
    const float e = __builtin_amdgcn_exp2f(-2.0f * 1.4426950408889634f * u);
    return x * __builtin_amdgcn_rcpf(1.0f + e);
}
template <bool I8>
struct EpiScaleT {
    static constexpr bool PERM = true, AFTER_DRAIN = false;
    bf16_t* O; int ldc; const PG8_LAS unsigned char* tab; float* kmp; bf16_t* O2; int mode; const float* scol; const float* hq;
    __device__ __forceinline__ void operator()(const typename AccT<I8>::type (&acc)[2][2][4][2], const Unit& u, int wr, int wc, int fr, int fq) const {
        const int row0 = u.pm * BM + wr * 64 + fr;
        f32x4 sc[2][2];
#pragma unroll
        for (int bj = 0; bj < 2; ++bj)
#pragma unroll
            for (int n = 0; n < 2; ++n) { if constexpr (I8) sc[bj][n] = *(const f32x4*)(scol + u.pn * BM + bj * HALF + wc * 32 + 8 * fq + 4 * n); else sc[bj][n] = (f32x4){1.f, 1.f, 1.f, 1.f}; }
        float rs[2][4];
#pragma unroll
        for (int ai = 0; ai < 2; ++ai)
#pragma unroll
            for (int m = 0; m < 4; ++m) rs[ai][m] = *(const PG8_LAS float*)(tab + (u.seq & 1) * 1024 + (wr * 64 + fr + ai * HALF + m * 16) * 4);
        int colt = u.pn * BM; bf16_t* base = O; int am = mode >= 2 ? 2 : 0; const float hqi = mode == 3 ? hq[0] : 0.f;
        if (mode == 1 && colt >= 2048) { colt -= 2048; base = O2; am = 1; }
        const int col0 = colt + wc * 32 + 8 * fq;
#pragma unroll
        for (int ai = 0; ai < 2; ++ai)
#pragma unroll
            for (int m = 0; m < 4; ++m) { bf16_t* rowp = base + (size_t)(row0 + ai * HALF + m * 16) * ldc + col0; const float r = rs[ai][m];
#pragma unroll
                for (int bj = 0; bj < 2; ++bj) { f32x4 v0 = __builtin_convertvector(acc[ai][bj][m][0], f32x4) * (sc[bj][0] * r), v1 = __builtin_convertvector(acc[ai][bj][m][1], f32x4) * (sc[bj][1] * r);
                    if (am == 1) {
#pragma unroll
                        for (int e = 0; e < 4; ++e) { v0[e] = gelu_tanh(v0[e]); v1[e] = gelu_tanh(v1[e]); } }
                    else if (am == 2) {
#pragma unroll
                        for (int e = 0; e < 4; ++e) { const float a0 = fmaxf(v0[e], 0.f), a1 = fmaxf(v1[e], 0.f); v0[e] = a0 * a0; v1[e] = a1 * a1; } }
                    u32x4 w; w.x = cvt_pk_bf16(v0[0], v0[1]); w.y = cvt_pk_bf16(v0[2], v0[3]); w.z = cvt_pk_bf16(v1[0], v1[1]); w.w = cvt_pk_bf16(v1[2], v1[3]);
                    if (mode == 3) {
                        int q[8];
#pragma unroll
                        for (int e = 0; e < 4; ++e) { q[e] = (int)__builtin_rintf(fminf(v0[e] * hqi, 254.0f)) - 127; q[4 + e] = (int)__builtin_rintf(fminf(v1[e] * hqi, 254.0f)) - 127; }
                        f32x2_ wq; wq.x = __builtin_bit_cast(float, ((unsigned)q[0] & 255u) | (((unsigned)q[1] & 255u) << 8) | (((unsigned)q[2] & 255u) << 16) | ((unsigned)q[3] << 24));
                        wq.y = __builtin_bit_cast(float, ((unsigned)q[4] & 255u) | (((unsigned)q[5] & 255u) << 8) | (((unsigned)q[6] & 255u) << 16) | ((unsigned)q[7] << 24));
                        *(f32x2_*)((unsigned char*)O + (size_t)(row0 + ai * HALF + m * 16) * 8192 + col0 + bj * HALF) = wq; }
                    else if (am == 2) __builtin_nontemporal_store(w, (u32x4*)(rowp + bj * HALF)); else *(u32x4*)(rowp + bj * HALF) = w; } }
        if (mode == 0 && u.pn >= 8 && u.pn < 16) {
            float* kp = kmp + ((size_t)wr * 32 + u.pm) * 2048 + (u.pn - 8) * BM + wc * 32 + 8 * fq;
#pragma unroll
            for (int bj = 0; bj < 2; ++bj)
#pragma unroll
                for (int n = 0; n < 2; ++n) { f32x4 s = (f32x4){0.f, 0.f, 0.f, 0.f};
#pragma unroll
                    for (int ai = 0; ai < 2; ++ai)
#pragma unroll
                        for (int m = 0; m < 4; ++m) s += __builtin_convertvector(acc[ai][bj][m][n], f32x4) * rs[ai][m];
                    s *= sc[bj][n];
#pragma unroll
                    for (int e = 0; e < 4; ++e) { float t = s[e]; t += __shfl_xor(t, 1); t += __shfl_xor(t, 2); t += __shfl_xor(t, 4); t += __shfl_xor(t, 8); s[e] = t; }
                    if (fr == 0) *(f32x4*)(kp + bj * HALF + 4 * n) = s; } }
    }
};
struct EpiRes {
    static constexpr bool PERM = true, AFTER_DRAIN = false;
    bf16_t* XB;
    __device__ __forceinline__ void operator()(const f32x4 (&acc)[2][2][4][2], const Unit& u, int wr, int wc, int fr, int fq) const {
        const int row0 = u.pm * BM + wr * 64 + fr, col0 = u.pn * BM + wc * 32 + 8 * fq;
        asm volatile("" ::: "memory"); __builtin_amdgcn_sched_barrier(0);
        u32x4 xin[2][4][2];
#pragma unroll
        for (int ai = 0; ai < 2; ++ai)
#pragma unroll
            for (int m = 0; m < 4; ++m)
#pragma unroll
                for (int bj = 0; bj < 2; ++bj) xin[ai][m][bj] = *(const u32x4*)(XB + (size_t)(row0 + ai * HALF + m * 16) * 2048 + col0 + bj * HALF);
        asm volatile("" ::: "memory"); __builtin_amdgcn_sched_barrier(0);
#pragma unroll
        for (int ai = 0; ai < 2; ++ai)
#pragma unroll
            for (int m = 0; m < 4; ++m) { const int r = row0 + ai * HALF + m * 16;
#pragma unroll
                for (int bj = 0; bj < 2; ++bj) { bf16_t* xp = XB + (size_t)r * 2048 + col0 + bj * HALF; const u32x4 xo = xin[ai][m][bj];
                    f32x4 x0, x1;
                    x0[0] = __builtin_bit_cast(float, xo.x << 16); x0[1] = __builtin_bit_cast(float, xo.x & 0xffff0000u); x0[2] = __builtin_bit_cast(float, xo.y << 16); x0[3] = __builtin_bit_cast(float, xo.y & 0xffff0000u);
                    x1[0] = __builtin_bit_cast(float, xo.z << 16); x1[1] = __builtin_bit_cast(float, xo.z & 0xffff0000u); x1[2] = __builtin_bit_cast(float, xo.w << 16); x1[3] = __builtin_bit_cast(float, xo.w & 0xffff0000u);
                    x0 += acc[ai][bj][m][0]; x1 += acc[ai][bj][m][1];
                    u32x4 w; w.x = cvt_pk_bf16(x0[0], x0[1]); w.y = cvt_pk_bf16(x0[2], x0[3]); w.z = cvt_pk_bf16(x1[0], x1[1]); w.w = cvt_pk_bf16(x1[2], x1[3]);
                    *(u32x4*)xp = w; } }
    }
};
struct EpiResQ8 {
    static constexpr bool PERM = true, AFTER_DRAIN = false;
    bf16_t* XB; const float* t2; const float* cs2; const float* hq;
    __device__ __forceinline__ void operator()(const i32x4 (&acc)[2][2][4][2], const Unit& u, int wr, int wc, int fr, int fq) const {
        const int row0 = u.pm * BM + wr * 64 + fr, col0 = u.pn * BM + wc * 32 + 8 * fq;
        const float step = hq[1];
        f32x4 sc[2][2], cc[2][2];
#pragma unroll
        for (int bj = 0; bj < 2; ++bj)
#pragma unroll
            for (int n = 0; n < 2; ++n) { sc[bj][n] = *(const f32x4*)(t2 + col0 + bj * HALF + 4 * n) * step; cc[bj][n] = *(const f32x4*)(cs2 + col0 + bj * HALF + 4 * n) * 127.0f; }
        asm volatile("" ::: "memory"); __builtin_amdgcn_sched_barrier(0);
#pragma unroll
        for (int ai = 0; ai < 2; ++ai) {
            u32x4 xin[4][2];
#pragma unroll
            for (int m = 0; m < 4; ++m)
#pragma unroll
                for (int bj = 0; bj < 2; ++bj) xin[m][bj] = *(const u32x4*)(XB + (size_t)(row0 + ai * HALF + m * 16) * 2048 + col0 + bj * HALF);
            asm volatile("" ::: "memory"); __builtin_amdgcn_sched_barrier(0);
#pragma unroll
            for (int m = 0; m < 4; ++m) { const int r = row0 + ai * HALF + m * 16;
#pragma unroll
                for (int bj = 0; bj < 2; ++bj) { bf16_t* xp = XB + (size_t)r * 2048 + col0 + bj * HALF; const u32x4 xo = xin[m][bj];
                    f32x4 x0, x1;
                    x0[0] = __builtin_bit_cast(float, xo.x << 16); x0[1] = __builtin_bit_cast(float, xo.x & 0xffff0000u); x0[2] = __builtin_bit_cast(float, xo.y << 16); x0[3] = __builtin_bit_cast(float, xo.y & 0xffff0000u);
                    x1[0] = __builtin_bit_cast(float, xo.z << 16); x1[1] = __builtin_bit_cast(float, xo.z & 0xffff0000u); x1[2] = __builtin_bit_cast(float, xo.w << 16); x1[3] = __builtin_bit_cast(float, xo.w & 0xffff0000u);
                    x0 += (__builtin_convertvector(acc[ai][bj][m][0], f32x4) + cc[bj][0]) * sc[bj][0]; x1 += (__builtin_convertvector(acc[ai][bj][m][1], f32x4) + cc[bj][1]) * sc[bj][1];
                    u32x4 w; w.x = cvt_pk_bf16(x0[0], x0[1]); w.y = cvt_pk_bf16(x0[2], x0[3]); w.z = cvt_pk_bf16(x1[0], x1[1]); w.w = cvt_pk_bf16(x1[2], x1[3]);
                    *(u32x4*)xp = w; } }
            asm volatile("" ::: "memory"); __builtin_amdgcn_sched_barrier(0); }
    }
};
template <class Epi, class Sched, bool ALIGN_EPI = false, bool SP2 = false, bool I8 = false>
__device__ __forceinline__ void gemm_phase(PG8_LAS unsigned char* lds, const Gemm g, const Sched& S, const Epi& E) {
    int tid_ = g.wave * 64 + lane_id_v(); asm volatile("" : "+v"(tid_));
    const int tid = tid_, wid = __builtin_amdgcn_readfirstlane(tid >> 6), lane = tid & 63, wr = wid >> 2, wc = wid & 3, fr = lane & 15, fq = lane >> 4;
    const int K = g.K, nt = K / BK;
    unsigned voffA[2], voffB[2];
#pragma unroll
    for (int i = 0; i < 2; ++i) { int R, C; stage_rc(tid * 16 + i * 8192, R, C); const int Rb = Epi::PERM ? ((R & ~31) + perm32(R & 31)) : R;
        voffA[i] = (unsigned)(R * K + C) * 2u; voffB[i] = (unsigned)(Rb * K + C) * 2u; }
    const size_t kstep = (size_t)(BK * 2);
    const size_t hstep = (size_t)HALF * K * 2;
    const size_t tstep = 2 * hstep;
    const unsigned ldsw = (unsigned)wid * 1024u;
    const int aoff = lds_byte(wr * 64 + fr, fq * 8), boff = lds_byte(wc * 32 + fr, fq * 8);
#define PG8_SA(b, h) (((b) * 2 + (h)) * HTB)
#define PG8_SB(b, h) ((4 + (b) * 2 + (h)) * HTB)
#define PG8_STAGE(bufoff, gbase, voff) do { _Pragma("unroll") for (int _i = 0; _i < 2; ++_i) \
        __builtin_amdgcn_global_load_lds((const unsigned*)((const char*)(gbase) + (voff)[_i]), (PG8_LAS unsigned*)(lds + (bufoff) + ldsw + _i * 8192), 16, 0, 0); } while (0)
#define PG8_LDA(dst, b, h) do { _Pragma("unroll") for (int m = 0; m < 4; ++m) _Pragma("unroll") for (int k = 0; k < 2; ++k) dst[m][k] = *(const PG8_LAS bf16x8*)(lds + PG8_SA(b, h) + aoff + m * 2048 + k * 1024); } while (0)
#define PG8_LDB(dst, b, h) do { _Pragma("unroll") for (int n = 0; n < 2; ++n) _Pragma("unroll") for (int k = 0; k < 2; ++k) dst[n][k] = *(const PG8_LAS bf16x8*)(lds + PG8_SB(b, h) + boff + n * 2048 + k * 1024); } while (0)
#define PG8_MMA(ai, bj, At, Bt) do { __builtin_amdgcn_s_setprio(1); _Pragma("unroll") for (int m = 0; m < 4; ++m) _Pragma("unroll") for (int n = 0; n < 2; ++n) _Pragma("unroll") for (int k = 0; k < 2; ++k) \
        acc[ai][bj][m][n] = mma_op(Bt[n][k], At[m][k], acc[ai][bj][m][n]); __builtin_amdgcn_s_setprio(0); } while (0)
#define PG8_WAIT_V(n) asm volatile("s_waitcnt vmcnt(" #n ")" ::: "memory")
#define PG8_WAIT_L(n) asm volatile("s_waitcnt lgkmcnt(" #n ")" ::: "memory")
#define PG8_BAR __builtin_amdgcn_s_barrier()
#define PG8_SCHED __builtin_amdgcn_sched_barrier(0)
    Unit cur, nxt; int ui = 0;
    if (!S.next(0, cur)) return;
    typedef typename AccT<I8>::type acc_t;
    acc_t acc[2][2][4][2];
#pragma unroll
    for (int a = 0; a < 2; ++a)
#pragma unroll
        for (int b = 0; b < 2; ++b)
#pragma unroll
            for (int m = 0; m < 4; ++m)
#pragma unroll
                for (int n = 0; n < 2; ++n) acc[a][b][m][n] = acc_t{};
    bf16x8 At[4][2], B0[2][2], B1[2][2];
    const char* cA = (const char*)g.A + (size_t)cur.pm * tstep; const char* cB = (const char*)g.Bt + (size_t)cur.pn * tstep;
    S.a_ready(cur);
    if constexpr (SP2) {
        PG8_STAGE(PG8_SB(0, 0), cB, voffB); PG8_STAGE(PG8_SB(0, 1), cB + hstep, voffB); PG8_STAGE(PG8_SA(0, 0), cA, voffA); PG8_STAGE(PG8_SA(0, 1), cA + hstep, voffA);
        if (wr == 1) PG8_BAR;
        PG8_WAIT_V(2); PG8_BAR;
        PG8_STAGE(PG8_SB(1, 0), cB + kstep, voffB); PG8_STAGE(PG8_SB(1, 1), cB + hstep + kstep, voffB);
        PG8_WAIT_V(4); PG8_BAR;
    } else {
        PG8_STAGE(PG8_SB(0, 0), cB, voffB); PG8_STAGE(PG8_SA(0, 0), cA, voffA); PG8_STAGE(PG8_SB(0, 1), cB + hstep, voffB); PG8_STAGE(PG8_SA(0, 1), cA + hstep, voffA);
        if (wr == 1) PG8_BAR;
        PG8_WAIT_V(4); PG8_BAR;
        PG8_STAGE(PG8_SB(1, 0), cB + kstep, voffB); PG8_STAGE(PG8_SA(1, 0), cA + kstep, voffA); PG8_STAGE(PG8_SB(1, 1), cB + hstep + kstep, voffB);
        PG8_WAIT_V(6); PG8_BAR;
    }
    for (;;) {
        const bool has_next = S.next(ui + 1, nxt);
        const char* nA = has_next ? (const char*)g.A + (size_t)nxt.pm * tstep : cA; const char* nB = has_next ? (const char*)g.Bt + (size_t)nxt.pn * tstep : cB;
        for (int t = 0; t < nt; t += 2) {
            const bool last = (t == nt - 2);
            const char* a1 = cA + (size_t)(t + 1) * kstep;
            const char* a2 = last ? nA : cA + (size_t)(t + 2) * kstep; const char* b2 = last ? nB : cB + (size_t)(t + 2) * kstep;
            const char* a3 = a2 + kstep; const char* b3 = b2 + kstep; (void)a3;
            if (last && has_next) S.a_ready(nxt);
            if constexpr (SP2) {
            PG8_LDB(B0, 0, 0); PG8_LDB(B1, 0, 1); PG8_SCHED; PG8_LDA(At, 0, 0); PG8_STAGE(PG8_SA(1, 0), a1, voffA); PG8_STAGE(PG8_SA(1, 1), a1 + hstep, voffA);
            PG8_WAIT_V(8); PG8_WAIT_L(0); PG8_BAR; PG8_MMA(0, 0, At, B0); PG8_MMA(0, 1, At, B1); PG8_BAR; PG8_SCHED;
            PG8_LDA(At, 0, 1); PG8_STAGE(PG8_SB(0, 0), b2, voffB); PG8_STAGE(PG8_SB(0, 1), b2 + hstep, voffB);
            PG8_WAIT_V(6); PG8_WAIT_L(0); PG8_BAR; PG8_MMA(1, 0, At, B0); PG8_MMA(1, 1, At, B1); PG8_BAR; PG8_SCHED;
            PG8_LDB(B0, 1, 0); PG8_LDB(B1, 1, 1); PG8_SCHED; PG8_LDA(At, 1, 0); PG8_STAGE(PG8_SA(0, 0), a2, voffA); PG8_STAGE(PG8_SA(0, 1), a2 + hstep, voffA);
            PG8_WAIT_V(8); PG8_WAIT_L(0); PG8_BAR; PG8_MMA(0, 0, At, B0); PG8_MMA(0, 1, At, B1); PG8_BAR; PG8_SCHED;
            PG8_LDA(At, 1, 1); PG8_STAGE(PG8_SB(1, 0), b3, voffB); PG8_STAGE(PG8_SB(1, 1), b3 + hstep, voffB);
            PG8_WAIT_V(6); PG8_WAIT_L(0); PG8_BAR; PG8_MMA(1, 0, At, B0); PG8_MMA(1, 1, At, B1); PG8_BAR; PG8_SCHED;
            } else {
            PG8_LDB(B0, 0, 0); PG8_SCHED; PG8_LDA(At, 0, 0); PG8_STAGE(PG8_SA(1, 1), a1 + hstep, voffA);
            PG8_WAIT_L(8); PG8_BAR; PG8_WAIT_L(0); PG8_MMA(0, 0, At, B0); PG8_BAR; PG8_SCHED;
            PG8_LDB(B1, 0, 1); PG8_STAGE(PG8_SB(0, 0), b2, voffB);
            PG8_BAR; PG8_WAIT_L(0); PG8_MMA(0, 1, At, B1); PG8_BAR;
            PG8_LDA(At, 0, 1); PG8_STAGE(PG8_SA(0, 0), a2, voffA);
            PG8_BAR; PG8_WAIT_L(0); PG8_MMA(1, 0, At, B0); PG8_BAR; PG8_SCHED;
            PG8_STAGE(PG8_SB(0, 1), b2 + hstep, voffB);
            PG8_WAIT_V(6); PG8_BAR; PG8_MMA(1, 1, At, B1); PG8_BAR;
            PG8_LDB(B0, 1, 0); PG8_SCHED; PG8_LDA(At, 1, 0); PG8_STAGE(PG8_SA(0, 1), a2 + hstep, voffA);
            PG8_WAIT_L(8); PG8_BAR; PG8_WAIT_L(0); PG8_MMA(0, 0, At, B0); PG8_BAR; PG8_SCHED;
            PG8_LDB(B1, 1, 1); PG8_STAGE(PG8_SB(1, 0), b3, voffB);
            PG8_BAR; PG8_WAIT_L(0); PG8_MMA(0, 1, At, B1); PG8_BAR;
            PG8_LDA(At, 1, 1); PG8_STAGE(PG8_SA(1, 0), a3, voffA);
            PG8_BAR; PG8_WAIT_L(0); PG8_MMA(1, 0, At, B0); PG8_BAR; PG8_SCHED;
            PG8_STAGE(PG8_SB(1, 1), b3 + hstep, voffB);
            PG8_WAIT_V(6); PG8_BAR; PG8_MMA(1, 1, At, B1); PG8_BAR;
            }
        }
        if constexpr (ALIGN_EPI) { if (wr == 0) PG8_BAR; }
        if constexpr (!Epi::AFTER_DRAIN) { E(acc, cur, wr, wc, fr, fq); S.done(cur); }
        if (!has_next) break;
#pragma unroll
        for (int a = 0; a < 2; ++a)
#pragma unroll
            for (int b = 0; b < 2; ++b)
#pragma unroll
                for (int m = 0; m < 4; ++m)
#pragma unroll
                    for (int n = 0; n < 2; ++n) acc[a][b][m][n] = acc_t{};
        cur = nxt; cA = nA; cB = nB; ++ui;
        if constexpr (ALIGN_EPI) { if (wr == 1) PG8_BAR; }
    }
    PG8_WAIT_V(0);
    if constexpr (!ALIGN_EPI) { if (wr == 0) PG8_BAR; }
    PG8_BAR;
    if constexpr (Epi::AFTER_DRAIN) { E.fused(acc, cur, wr, wc, fr, fq, lds, wid, lane); S.done(cur); }
#undef PG8_SA
#undef PG8_SB
#undef PG8_STAGE
#undef PG8_LDA
#undef PG8_LDB
#undef PG8_MMA
#undef PG8_WAIT_V
#undef PG8_WAIT_L
#undef PG8_BAR
#undef PG8_SCHED
}
}
constexpr int NWAVES = 8;
constexpr int S = 8192, DM = 2048, NH = 16, HD = 128, FF = 8192, NBLK = 32, BLK = 256, DEPTH = 4;
constexpr int NQKV = 3 * DM;
constexpr int BIAS_LD = 8448;
constexpr int NPHASE = 30;
#ifndef DBG_MASK
#define DBG_MASK 0xffff
#endif
#define DBG(b) ((DBG_MASK >> (b)) & 1)
#ifndef REP_MASK
#define REP_MASK 0
#endif
#define NREP(b) (((REP_MASK >> (b)) & 1) ? 2 : 1)
#ifndef MK_PER_PHASE
#define MK_PER_PHASE 0
#endif
constexpr size_t MiB = 1u << 20;
constexpr size_t WS_CTL = 0, CTL_ZERO_BYTES = 1 * MiB;
constexpr size_t WS_WQKV = 2 * MiB;
constexpr size_t WS_WO   = WS_WQKV + 48 * MiB;
constexpr size_t WS_WIN  = WS_WO + 16 * MiB;
constexpr size_t WS_WOUT = WS_WIN + 32 * MiB;
constexpr size_t WS_W1   = WS_WOUT + 16 * MiB;
constexpr size_t WS_W2   = WS_W1 + 128 * MiB;
constexpr size_t WS_X    = WS_W2 + 128 * MiB;
constexpr size_t WS_XQ   = WS_X;
constexpr size_t WS_FROW = WS_X + 16 * MiB;
constexpr size_t WS_RSTD = WS_FROW + 65536;
constexpr size_t WS_SW   = WS_X + 17 * MiB;
constexpr int SW_QKV = 0, SW_WIN = 2 * 6144, SW_W1 = SW_WIN + 2 * 4096;
constexpr int SW_T2 = 65536, SW_CS2 = SW_T2 + 4 * 2048, SW_SS = SW_CS2 + 4 * 2048, SW_CL = SW_SS + 4 * 8192;
#ifndef DQ_MASK
#define DQ_MASK 14
#endif
static_assert((DQ_MASK & 1) == 0 && DQ_MASK < 16, "layer 0's hidden step would be needed in the phase that computes the column norms");
constexpr size_t WS_W2Q_OFF = 64;
constexpr size_t WS_XB   = WS_X + 64 * MiB;
constexpr size_t WS_QKV  = WS_XB + 32 * MiB;
constexpr size_t WS_AO   = WS_QKV + 96 * MiB;
constexpr size_t WS_HID  = WS_AO + 32 * MiB;
constexpr size_t WS_SSQ  = WS_HID + 128 * MiB;
constexpr size_t WS_KMP  = WS_SSQ + 9 * MiB;
constexpr size_t WS_LSE  = WS_KMP + 1 * MiB;
constexpr size_t WS_LIST = WS_LSE + 2 * MiB;
constexpr size_t WS_BIAS = WS_LIST + 16 * MiB;
constexpr size_t WS_CARRY = WS_BIAS + 1 * MiB;
constexpr size_t WS_WG   = WS_CARRY + 2 * MiB;
constexpr size_t WS_END  = WS_WG + 2 * MiB;
constexpr int CW_TMO = 0, CW_CODE = 1;
constexpr int CW_BAR = 4096;
constexpr int CW_CNT = 16384;
constexpr int RING_OFF = 0, RING_BYTES = 155392;
constexpr int LDSCTL_OFF = RING_BYTES, MISC_OFF = LDSCTL_OFF + 320;
constexpr int LDS_BYTES = 157696;
#define GAS __attribute__((address_space(1)))
#define LAS __attribute__((address_space(3)))
typedef unsigned short bf16;
typedef unsigned v4u __attribute__((ext_vector_type(4)));
typedef float f32x4 __attribute__((ext_vector_type(4)));
typedef short bf16x8 __attribute__((ext_vector_type(8)));
typedef GAS unsigned gu32;
typedef GAS unsigned long long gu64;
#define RLX_AGENT __ATOMIC_RELAXED, __HIP_MEMORY_SCOPE_AGENT
#define LDS_WAIT() asm volatile("s_waitcnt lgkmcnt(0)" ::: "memory")
#define VM_WAIT() asm volatile("s_waitcnt vmcnt(0)" ::: "memory")
__device__ __forceinline__ unsigned long long rt() { return __builtin_amdgcn_s_memrealtime(); }
__device__ __forceinline__ unsigned f2bf(float f) { unsigned u = __builtin_bit_cast(unsigned, f); return (u + 0x7fffu + ((u >> 16) & 1u)) >> 16; }
__device__ __forceinline__ unsigned pk2(float lo, float hi) { return f2bf(lo) | (f2bf(hi) << 16); }

#define XB_TMO      128
#define XB_XCNT(j)  (256  + 64 * (j))
#define XB_XSUB(j)  (1280 + 64 * (j))
#define XB_XGEN(j)  (2304 + 64 * (j))
#define XB_TOP      3328
#define XB_TOPGEN   3392
#define XCD_BAR_WORDS 3456
#define XB_SPIN_CAP (1u << 22)

__device__ __forceinline__ unsigned xb_ld(unsigned* p)              { return __hip_atomic_load(p, __ATOMIC_RELAXED, __HIP_MEMORY_SCOPE_AGENT); }
__device__ __forceinline__ unsigned xb_add(unsigned* p, unsigned v) { return __hip_atomic_fetch_add(p, v, __ATOMIC_RELAXED, __HIP_MEMORY_SCOPE_AGENT); }
__device__ __forceinline__ unsigned xb_xcc_id() { return (unsigned)__builtin_amdgcn_s_getreg((3 << 11) | 20) & 0xFu; }
#define XB_SPIN(cond, bar) do { unsigned _sp = 0; while (cond) { __builtin_amdgcn_s_sleep(1); \
    if ((++_sp & 255u) == 0u) { if (xb_ld(&(bar)[XB_TMO])) break; if (_sp > XB_SPIN_CAP) { atomicAdd(&(bar)[XB_TMO], 1u); break; } } } } while (0)

struct XcdBarrier {
    unsigned* bar; unsigned x;
    volatile LAS unsigned* st;
};

__device__ __forceinline__ XcdBarrier xcd_barrier_post(unsigned* bar, volatile LAS unsigned* st) {
    XcdBarrier b; b.bar = bar; b.x = xb_xcc_id(); b.st = st;
    if (threadIdx.x == 0) (void)xb_add(&bar[XB_XCNT(b.x)], 1u);
    return b;
}
__device__ __forceinline__ void xcd_barrier_complete(unsigned* bar, unsigned x, unsigned& nloc, unsigned& nx) {
    const unsigned G = gridDim.x * gridDim.y * gridDim.z;
    unsigned sum, cnt, mine, sp = 0u;
    for (;;) {
        sum = 0u; cnt = 0u; mine = 0u;
#pragma unroll
        for (unsigned j = 0; j < 16; ++j) { const unsigned c = xb_ld(&bar[XB_XCNT(j)]); sum += c; cnt += (c > 0u) ? 1u : 0u; mine = (j == x) ? c : mine; }
        if (sum == G) break;
        __builtin_amdgcn_s_sleep(1);
        if ((++sp & 255u) == 0u) { if (xb_ld(&bar[XB_TMO])) break; if (sp > XB_SPIN_CAP) { atomicAdd(&bar[XB_TMO], 1u); break; } }
    }
    nloc = mine > 0u ? mine : 1u; nx = cnt > 0u ? cnt : 1u;
}

__device__ __forceinline__ void xcd_barrier(const XcdBarrier& b) {
    asm volatile("s_waitcnt vmcnt(0)" ::: "memory");
    __syncthreads();
    if (threadIdx.x == 0) {
        unsigned* bar = b.bar;
        __builtin_amdgcn_s_waitcnt(0);
        unsigned nloc = b.st[0], nx = b.st[1];
        if (nloc == 0u) { xcd_barrier_complete(bar, b.x, nloc, nx); b.st[0] = nloc; b.st[1] = nx; }
        const unsigned old = xb_add(&bar[XB_XSUB(b.x)], 1u);
        const unsigned gen = old / nloc;
        if (old + 1u == (gen + 1u) * nloc) {
            __builtin_amdgcn_fence(__ATOMIC_RELEASE, "agent");
            asm volatile("s_waitcnt vmcnt(0)" ::: "memory");
            const unsigned og = xb_add(&bar[XB_TOP], 1u);
            const unsigned tg = og / nx;
            if (og + 1u == (tg + 1u) * nx) xb_add(&bar[XB_TOPGEN], 1u);
            else XB_SPIN(xb_ld(&bar[XB_TOPGEN]) == tg, bar);
            __builtin_amdgcn_fence(__ATOMIC_ACQUIRE, "agent");
            xb_add(&bar[XB_XGEN(b.x)], 1u);
            asm volatile("s_waitcnt vmcnt(0)" ::: "memory");
        } else {
            XB_SPIN(xb_ld(&bar[XB_XGEN(b.x)]) == gen, bar);
            __builtin_amdgcn_fence(__ATOMIC_ACQUIRE, "agent");
            asm volatile("s_waitcnt vmcnt(0)" ::: "memory");
        }
    }
    __syncthreads();
}
typedef unsigned short bf16;
typedef unsigned v4u __attribute__((ext_vector_type(4)));
typedef unsigned v2u __attribute__((ext_vector_type(2)));
typedef float f32x2 __attribute__((ext_vector_type(2)));
__device__ __forceinline__ float bf2f(unsigned short b) { return __builtin_bit_cast(float, (unsigned)b << 16); }
__device__ __forceinline__ float bflo(unsigned u) { return __builtin_bit_cast(float, u << 16); }
__device__ __forceinline__ float bfhi(unsigned u) { return __builtin_bit_cast(float, u & 0xffff0000u); }
__device__ __forceinline__ float wave_sum(float v) {
#pragma unroll
    for (int o = 1; o < 64; o <<= 1) v += __shfl_xor(v, o);
    return v;
}
__device__ __forceinline__ float wave_max(float v) {
#pragma unroll
    for (int o = 1; o < 64; o <<= 1) v = fmaxf(v, __shfl_xor(v, o));
    return v;
}
struct Args { const float* in[18]; float* out; unsigned char* ws; int ph_lo, ph_hi; };
struct Frame {
    LAS unsigned char* lds; unsigned char* ldsg;
    volatile LAS unsigned* MISC;
    gu32* ctl;
    int tid, lane, wave, G, bid;
    unsigned char* ws;
};
__device__ __forceinline__ int pass_row(const Frame& F, int wave, int k) {
    return F.G == 256 ? (8 * ((F.bid % 8) / 2) + (F.bid / 8) % 8) * 256 + ((F.bid % 2) * 4 + F.bid / 64) * 32 + wave * 4 + k : (F.bid * NWAVES + wave) + k * (F.G * NWAVES); }
__device__ __forceinline__ int pass_nrows(const Frame& F, int wave) { const int gw = F.bid * NWAVES + wave, NGW = F.G * NWAVES; return F.G == 256 ? 4 : (gw < S ? (S - gw + NGW - 1) / NGW : 0); }

struct TrItem { const float* W; bf16* WT; const float* gain; int K, N, item; };
__device__ __forceinline__ void tr_load(const TrItem& t, int lane, f32x4 (&v)[16]) {
    const int nb = t.N >> 6, kb = t.item / nb, nbi = t.item - kb * nb, k0 = kb * 64, n0 = nbi * 64;
#pragma unroll
    for (int i = 0; i < 16; ++i) v[i] = __builtin_nontemporal_load((const f32x4*)(t.W + (size_t)(k0 + 4 * i + (lane >> 4)) * t.N + n0 + (lane & 15) * 4));
}
__device__ __forceinline__ void tr_store(const TrItem& t, int lane, const f32x4 (&v)[16], LAS float* scr) {
    const int nb = t.N >> 6, kb = t.item / nb, nbi = t.item - kb * nb, k0 = kb * 64, n0 = nbi * 64;
#pragma unroll
    for (int i = 0; i < 16; ++i) { LAS float* s = scr + (4 * i + (lane >> 4)) * 65 + (lane & 15) * 4; s[0] = v[i][0]; s[1] = v[i][1]; s[2] = v[i][2]; s[3] = v[i][3]; }
    LDS_WAIT(); asm volatile("" ::: "memory");
    const int c = lane & 7;
    float g[8];
#pragma unroll
    for (int i = 0; i < 8; ++i) g[i] = t.gain ? t.gain[k0 + 8 * c + i] : 1.0f;
#pragma unroll
    for (int j = 0; j < 8; ++j) { const int n = (lane >> 3) + 8 * j; const LAS float* s = scr + (8 * c) * 65 + n;
        v4u o; o.x = pk2(s[0 * 65] * g[0], s[1 * 65] * g[1]); o.y = pk2(s[2 * 65] * g[2], s[3 * 65] * g[3]); o.z = pk2(s[4 * 65] * g[4], s[5 * 65] * g[5]); o.w = pk2(s[6 * 65] * g[6], s[7 * 65] * g[7]);
        *(GAS v4u*)(t.WT + (size_t)(n0 + n) * t.K + k0 + 8 * c) = o; }
    LDS_WAIT(); asm volatile("" ::: "memory");
}
__device__ __forceinline__ int t5_bucket(int d) {
    if (d < 16) return d;
    const unsigned d2 = (unsigned)d * (unsigned)d; const int msb = 31 - __builtin_clz(d2);
    const int b = 16 + msb - 8; return b > 31 ? 31 : b;
}
__device__ __forceinline__ unsigned pack_i8x4(float a, float b, float c, float d) {
    const int ia = (int)__builtin_rintf(a), ib = (int)__builtin_rintf(b), ic = (int)__builtin_rintf(c), id = (int)__builtin_rintf(d);
    return ((unsigned)ia & 255u) | (((unsigned)ib & 255u) << 8) | (((unsigned)ic & 255u) << 16) | ((unsigned)id << 24);
}
__device__ __forceinline__ void st_ld(const float* W, int N, int k0, int n0, int lane, f32x4 (&v)[16]) {
    const float* p = W + (size_t)(k0 + (lane >> 4)) * N + n0 + (lane & 15) * 4; asm volatile("" : "+v"(p));
#pragma unroll
    for (int i = 0; i < 16; ++i) { v[i] = __builtin_nontemporal_load((const f32x4*)p); p += (size_t)4 * N; }
}
typedef _Float16 h16x2 __attribute__((ext_vector_type(2)));
__device__ __forceinline__ unsigned hpk(float a, float b) { return __builtin_bit_cast(unsigned, __builtin_amdgcn_cvt_pkrtz(a, b)); }
__device__ __forceinline__ float hlo(unsigned u) { return (float)__builtin_bit_cast(h16x2, u)[0]; }
__device__ __forceinline__ float hhi(unsigned u) { return (float)__builtin_bit_cast(h16x2, u)[1]; }
__device__ __forceinline__ void st_pk(const f32x4 (&v)[16], int k0, const LAS float* gl, int lane, unsigned (&h)[32], f32x4& cm) {
#pragma unroll
    for (int i = 0; i < 16; ++i) { const float g = gl[k0 + 4 * i + (lane >> 4)];
        const unsigned p0 = hpk(v[i][0] * g, v[i][1] * g), p1 = hpk(v[i][2] * g, v[i][3] * g); h[2 * i] = p0; h[2 * i + 1] = p1;
        cm[0] = fmaxf(cm[0], fabsf(hlo(p0))); cm[1] = fmaxf(cm[1], fabsf(hhi(p0))); cm[2] = fmaxf(cm[2], fabsf(hlo(p1))); cm[3] = fmaxf(cm[3], fabsf(hhi(p1))); }
    asm volatile("" ::: "memory"); __builtin_amdgcn_sched_barrier(0);
}
__device__ __forceinline__ void st_quant(const unsigned (&h)[32], f32x4 inv4, int k0, int n0, int lane, LAS float* scr, unsigned char* WQ) {
#pragma unroll
    for (int i = 0; i < 16; ++i) { LAS float* sp = scr + (4 * i + (lane >> 4)) * 65 + (lane & 15) * 4;
        sp[0] = hlo(h[2 * i]) * inv4[0]; sp[1] = hhi(h[2 * i]) * inv4[1]; sp[2] = hlo(h[2 * i + 1]) * inv4[2]; sp[3] = hhi(h[2 * i + 1]) * inv4[3]; }
    LDS_WAIT(); asm volatile("" ::: "memory");
    const int c = lane & 7;
#pragma unroll
    for (int j = 0; j < 8; ++j) { const int n = (lane >> 3) + 8 * j; const LAS float* sp = scr + (8 * c) * 65 + n;
        v2u o; o.x = pack_i8x4(sp[0 * 65], sp[1 * 65], sp[2 * 65], sp[3 * 65]); o.y = pack_i8x4(sp[4 * 65], sp[5 * 65], sp[6 * 65], sp[7 * 65]);
        *(GAS v2u*)(WQ + (size_t)(n0 + n) * DM + k0 + 8 * c) = o;
        if (j & 1) { asm volatile("" ::: "memory"); __builtin_amdgcn_sched_barrier(0); } }
    LDS_WAIT(); asm volatile("" ::: "memory");
}
__device__ __forceinline__ void p0_strips(const Args& A, Frame& F) {
    int tid = F.wave * 64 + lane_id_v(); asm volatile("" : "+v"(tid)); const int lane = tid & 63, wave = __builtin_amdgcn_readfirstlane(tid >> 6); (void)lane; (void)wave;
    LAS float* scr = (LAS float*)(F.lds + RING_OFF + wave * 16640);
    LAS float* cmx = (LAS float*)(F.lds + RING_OFF + 133120);
    LAS float* gl = (LAS float*)(F.lds + RING_OFF + 137216);
    const int gw = F.bid * NWAVES + wave, NGW = F.G * NWAVES;
    const float* mixn = A.in[2]; const float* mlpn = A.in[3];
    float* SWb = (float*)(F.ws + WS_SW);
    constexpr int NS_QKV = 2 * 96, NS_1 = 4 * 128, NSTRIP = NS_QKV + NS_1;
    struct SD { const float* W; const float* gain; unsigned char* WQ; float* SW; int N, n0; };
    auto dec = [&](int si) -> SD { SD d;
        if (si < NS_QKV) { const int j = si / 96, c = si - j * 96; d.W = A.in[5] + (size_t)j * DM * NQKV; d.gain = mixn + (2 * j) * DM; d.WQ = F.ws + WS_WQKV + (size_t)j * NQKV * DM; d.SW = SWb + SW_QKV + j * NQKV; d.N = NQKV; d.n0 = c * 64; }
        else { const int r = si - NS_QKV, l = r >> 7, c = r & 127; d.W = A.in[16] + (size_t)l * DM * FF; d.gain = mlpn + l * DM; d.WQ = F.ws + WS_W1 + (size_t)l * FF * DM; d.SW = SWb + SW_W1 + l * FF; d.N = FF; d.n0 = c * 64; }
        return d; };
    const int kb = wave * 256;
    int sp = 0;
    f32x4 v[16];
    if (F.bid < NSTRIP) { const SD d0 = dec(F.bid); st_ld(d0.W, d0.N, kb, d0.n0, lane, v); }
    for (int si = F.bid; si < NSTRIP; si += F.G, sp ^= 1) {
        const SD d = dec(si);
        __syncthreads();
#pragma unroll
        for (int i = 0; i < 4; ++i) gl[tid + 512 * i] = d.gain[tid + 512 * i];
        __syncthreads();
        unsigned hb[4][32]; f32x4 cm = (f32x4){0.f, 0.f, 0.f, 0.f};
        st_pk(v, kb, gl, lane, hb[0], cm);
#pragma unroll
        for (int t = 1; t < 4; ++t) { st_ld(d.W, d.N, kb + 64 * t, d.n0, lane, v); st_pk(v, kb + 64 * t, gl, lane, hb[t], cm); }
#pragma unroll
        for (int e = 0; e < 4; ++e) { float t = cm[e]; t = fmaxf(t, __shfl_xor(t, 16)); t = fmaxf(t, __shfl_xor(t, 32)); cm[e] = t; }
        if (lane < 16) *(LAS f32x4*)(cmx + (sp * 8 + wave) * 64 + lane * 4) = cm;
#pragma unroll
        for (int t = 0; t < 4; ++t)
#pragma unroll
            for (int k = 0; k < 32; ++k) asm volatile("" : "+v"(hb[t][k]));
        __syncthreads();
        f32x4 mx = *(const LAS f32x4*)(cmx + (sp * 8) * 64 + (lane & 15) * 4);
#pragma unroll
        for (int w = 1; w < 8; ++w) { const f32x4 t = *(const LAS f32x4*)(cmx + (sp * 8 + w) * 64 + (lane & 15) * 4);
#pragma unroll
            for (int e = 0; e < 4; ++e) mx[e] = fmaxf(mx[e], t[e]); }
        f32x4 inv4;
#pragma unroll
        for (int e = 0; e < 4; ++e) inv4[e] = mx[e] > 1e-30f ? 127.0f / mx[e] : 0.f;
        if (wave == 0 && lane < 16) *(f32x4*)(d.SW + d.n0 + lane * 4) = mx * (1.0f / 127.0f);
        st_quant(hb[0], inv4, kb, d.n0, lane, scr, d.WQ);
        if (si + F.G < NSTRIP) { const SD dn = dec(si + F.G); st_ld(dn.W, dn.N, kb, dn.n0, lane, v); }
#pragma unroll
        for (int t = 1; t < 4; ++t) st_quant(hb[t], inv4, kb + 64 * t, d.n0, lane, scr, d.WQ);
    }
}
__device__ __forceinline__ void p0_tiles(const Args& A, Frame& F) {
    int tid = F.wave * 64 + lane_id_v(); asm volatile("" : "+v"(tid)); const int lane = tid & 63, wave = __builtin_amdgcn_readfirstlane(tid >> 6); (void)lane; (void)wave;
    LAS float* scr = (LAS float*)(F.lds + RING_OFF + wave * 16640);
    const int gw = F.bid * NWAVES + wave, NGW = F.G * NWAVES; (void)gw; (void)NGW; (void)scr;
    constexpr int NSTRIP = 2 * 96 + 4 * 128;
    constexpr int T_O = 32 * 32, T_2 = 128 * 32, T_IN = 32 * 64;
    constexpr int NB = 4 * T_O + 4 * T_2 + 256 + 2 * T_IN;
    auto decode = [&](int it) -> TrItem {
        int r = it; TrItem t;
        if (r >= 4 * T_O + 4 * T_2 + 256) { r -= 4 * T_O + 4 * T_2 + 256; const int j = r / T_IN; r -= j * T_IN;
            t.W = A.in[7] + (size_t)j * DM * 2 * DM; t.WT = (bf16*)(F.ws + WS_WIN) + (size_t)j * 2 * DM * DM; t.gain = A.in[2] + (2 * j + 1) * DM; t.K = DM; t.N = 2 * DM; t.item = r; return t; }
        if (r >= 4 * T_O + 4 * T_2) { r -= 4 * T_O + 4 * T_2; const int blk = r >> 2, jg = blk >> 4, j = jg >> 1, g = jg & 1, n = blk & 15;
            t.W = A.in[g ? 12 : 10] + ((size_t)j * 16 + n) * 16384; t.WT = (bf16*)(F.ws + WS_WG) + (((size_t)j * 2 + g) * 16 + n) * 16384; t.gain = nullptr; t.K = 128; t.N = 128; t.item = r & 3; return t; }
        if (r < 4 * T_O) { const int jj = r / T_O, j = jj & 1; r -= jj * T_O;
            if (jj < 2) { t.W = A.in[6] + (size_t)j * DM * DM; t.WT = (bf16*)(F.ws + WS_WO) + (size_t)j * DM * DM; }
            else { t.W = A.in[15] + (size_t)j * DM * DM; t.WT = (bf16*)(F.ws + WS_WOUT) + (size_t)j * DM * DM; }
            t.gain = nullptr; t.K = DM; t.N = DM; t.item = r; return t; }
        r -= 4 * T_O;
        const int l = r / T_2; r -= l * T_2;
        t.W = A.in[17] + (size_t)l * FF * DM; t.WT = (bf16*)(F.ws + WS_W2) + (size_t)l * DM * FF; t.gain = nullptr; t.K = FF; t.N = DM; t.item = r; return t;
    };
    {
        constexpr int SW_ = 32;
        const int per = (NSTRIP * SW_ + NB + F.G - 1) / F.G;
        int start = 0, cnt = 0;
        for (int b2 = 0; b2 <= F.bid; ++b2) { const int ns = b2 < NSTRIP ? (NSTRIP - b2 + F.G - 1) / F.G : 0; int q = per - SW_ * ns; q = q < 0 ? 0 : q; if (b2 < F.bid) start += q; else cnt = q; }
        int tot = start;
        for (int b2 = F.bid; b2 < F.G; ++b2) { const int ns = b2 < NSTRIP ? (NSTRIP - b2 + F.G - 1) / F.G : 0; int q = per - SW_ * ns; tot += q < 0 ? 0 : q; }
        int end = start + cnt; if (end > NB) end = NB; if (start > NB) start = NB;
        f32x4 va[16], vb[16];
        for (int pass = 0; pass < 2; ++pass) {
            const int first = pass == 0 ? start + wave : (tot < NB ? tot + gw : NB), lim = pass == 0 ? end : NB, step = pass == 0 ? NWAVES : NGW;
            if (first >= lim) continue;
            TrItem cur = decode(first); tr_load(cur, lane, va);
            for (int it = first; it < lim; it += 2 * step) {
                const bool h1 = it + step < lim; TrItem n1 = cur; if (h1) { n1 = decode(it + step); tr_load(n1, lane, vb); }
                tr_store(cur, lane, va, scr);
                if (!h1) break;
                const bool h2 = it + 2 * step < lim; if (h2) { cur = decode(it + 2 * step); tr_load(cur, lane, va); }
                tr_store(n1, lane, vb, scr);
                if (!h2) break;
            }
        }
    }
}
__device__ __forceinline__ void p0_x(const Args& A, Frame& F) {
    int tid = F.wave * 64 + lane_id_v(); asm volatile("" : "+v"(tid)); const int lane = tid & 63, wave = __builtin_amdgcn_readfirstlane(tid >> 6); (void)lane; (void)wave;
    LAS float* scr = (LAS float*)(F.lds + RING_OFF + wave * 16640);
    const int gw = F.bid * NWAVES + wave, NGW = F.G * NWAVES; (void)gw; (void)NGW; (void)scr;
    { const float* x = A.in[0]; bf16* XB = (bf16*)(F.ws + WS_XB); unsigned char* XQ = F.ws + WS_XQ; float* frow = (float*)(F.ws + WS_FROW);
      const int nk = pass_nrows(F, wave);
      for (int k0 = 0; k0 < nk; k0 += 4) {
          f32x4 v[4][8];
#pragma unroll
          for (int r = 0; r < 4; ++r) { const int m = pass_row(F, wave, k0 + r < nk ? k0 + r : k0); const GAS f32x4* xr = (const GAS f32x4*)(x + (size_t)m * DM) + lane;
#pragma unroll
              for (int j = 0; j < 8; ++j) v[r][j] = xr[64 * j]; }
#pragma unroll
          for (int r = 0; r < 4; ++r) { if (k0 + r >= nk) break; const int m = pass_row(F, wave, k0 + r);
              GAS v2u* xb = (GAS v2u*)(XB + (size_t)m * DM) + lane; GAS unsigned* xq = (GAS unsigned*)(XQ + (size_t)m * DM) + lane; float s = 0.f, am = 0.f;
#pragma unroll
              for (int j = 0; j < 8; ++j) { s += (v[r][j].x * v[r][j].x + v[r][j].y * v[r][j].y) + (v[r][j].z * v[r][j].z + v[r][j].w * v[r][j].w); am = fmaxf(fmaxf(am, fmaxf(fabsf(v[r][j].x), fabsf(v[r][j].y))), fmaxf(fabsf(v[r][j].z), fabsf(v[r][j].w)));
                  v2u o; o.x = pk2(v[r][j].x, v[r][j].y); o.y = pk2(v[r][j].z, v[r][j].w); xb[64 * j] = o; }
              s = wave_sum(s); am = wave_max(am);
              const float inv = am > 1e-30f ? 127.0f / am : 0.f;
#pragma unroll
              for (int j = 0; j < 8; ++j) xq[64 * j] = pack_i8x4(v[r][j].x * inv, v[r][j].y * inv, v[r][j].z * inv, v[r][j].w * inv);
              if (lane == 0) { const float rstd = __builtin_amdgcn_rsqf(s * (1.0f / 2048.0f) + 1e-6f); frow[m] = am * (1.0f / 127.0f) * rstd; ((float*)(F.ws + WS_RSTD))[m] = rstd; } } } }
    { const float* rb = A.in[1]; float* bt = (float*)(F.ws + WS_BIAS);
      for (int i = F.bid * (NWAVES * 64) + tid; i < NH * BIAS_LD; i += F.G * NWAVES * 64) { const int h = i / BIAS_LD, d = i - h * BIAS_LD - 256;
          bt[i] = d < 0 ? -INFINITY : rb[t5_bucket(d) * NH + h] * 1.4426950408889634f; } }
}
__device__ __forceinline__ void p0_prologue(const Args& A, Frame& F) { p0_strips(A, F); p0_tiles(A, F); p0_x(A, F); }
#define TOP3_INS(x_, j_) do { const float x__ = (x_); const int j__ = (j_); const bool b0 = x__ > v0, b1 = x__ > v1, b2 = x__ > v2; \
    v2 = b1 ? v1 : (b2 ? x__ : v2); i2 = b1 ? i1 : (b2 ? j__ : i2); v1 = b0 ? v0 : (b1 ? x__ : v1); i1 = b0 ? i0 : (b1 ? j__ : i1); v0 = b0 ? x__ : v0; i0 = b0 ? j__ : i0; } while (0)
namespace at {
using bf16x8 = __attribute__((ext_vector_type(8))) short;
using s16x4  = __attribute__((ext_vector_type(4))) short;
using f32x16 = __attribute__((ext_vector_type(16))) float;
using u32x4  = __attribute__((ext_vector_type(4))) unsigned;
constexpr int KVBLK = 64, LDK = NQKV;
constexpr int SHM_V = KVBLK * 128 * 2, SHM_K = KVBLK * 128 * 2;
constexpr int OFF_V = 0, OFF_K = 2 * SHM_V, OFF_WS = OFF_K + 2 * SHM_K, OFF_DST = OFF_WS + 8 * 256, OFF_BT = OFF_DST + 8 * 128, OFF_PRE = OFF_BT + BIAS_LD * 4, OFF_CL = OFF_PRE + 1032 * 4, OFF_WT = OFF_CL + 512 * 4, OFF_END = OFF_WT + 64;
static_assert(OFF_END <= RING_BYTES, "attention LDS map");
#define KSWZ(row, colB) ((row) * 256 + ((colB) ^ (((row) & 7) << 4)))
#define SBAR() __builtin_amdgcn_sched_barrier(0)
__device__ __forceinline__ int crow(int r, int hi) { return (r & 3) + 8 * (r >> 2) + 4 * hi; }
__device__ __forceinline__ unsigned cvtpk(float lo, float hi) { unsigned r; asm volatile("v_cvt_pk_bf16_f32 %0, %1, %2" : "=v"(r) : "v"(lo), "v"(hi)); return r; }
__device__ __forceinline__ void partialSM(f32x16& p0, f32x16& p1, const LAS float* bp, float& m_reg, float& alpha) {
    constexpr float C = 0.088388347648318440f * 1.4426950408889634f;
#pragma unroll
    for (int r = 0; r < 16; ++r) p0[r] = fmaf(p0[r], C, bp[59 - ((r & 3) + 8 * (r >> 2))]);
#pragma unroll
    for (int r = 0; r < 16; ++r) p1[r] = fmaf(p1[r], C, bp[27 - ((r & 3) + 8 * (r >> 2))]);
    float pmax = p0[0];
#pragma unroll
    for (int r = 1; r < 16; ++r) pmax = fmaxf(pmax, p0[r]);
#pragma unroll
    for (int r = 0; r < 16; ++r) pmax = fmaxf(pmax, p1[r]);
    { auto rr = __builtin_amdgcn_permlane32_swap(__float_as_uint(pmax), __float_as_uint(pmax), false, false); pmax = fmaxf(__uint_as_float(rr[0]), __uint_as_float(rr[1])); }
    float mn = m_reg; alpha = 1.f;
    if (!__all(pmax <= m_reg + 8.0f)) { const bool up = pmax > m_reg + 8.0f;
        mn = up ? pmax : m_reg; alpha = up ? __builtin_amdgcn_exp2f(m_reg - mn) : 1.f; m_reg = mn; }
#pragma unroll
    for (int r = 0; r < 16; ++r) p0[r] -= mn;
#pragma unroll
    for (int r = 0; r < 16; ++r) p1[r] -= mn;
#pragma unroll
    for (int r = 0; r < 16; ++r) p0[r] = __builtin_amdgcn_exp2f(p0[r]);
}
__device__ __forceinline__ void finishSM(f32x16& p0, f32x16& p1, float alpha, float& l_reg, bf16x8& pa0, bf16x8& pa1, bf16x8& pa2, bf16x8& pa3) {
#pragma unroll
    for (int r = 0; r < 16; ++r) p1[r] = __builtin_amdgcn_exp2f(p1[r]);
    float ps = 0;
#pragma unroll
    for (int r = 0; r < 16; ++r) ps += p0[r];
#pragma unroll
    for (int r = 0; r < 16; ++r) ps += p1[r];
    { auto rr = __builtin_amdgcn_permlane32_swap(__float_as_uint(ps), __float_as_uint(ps), false, false); ps = __uint_as_float(rr[0]) + __uint_as_float(rr[1]); }
    l_reg = l_reg * alpha + ps;
#define PK4(P, BASE, OUT) do { unsigned a0 = cvtpk(P[BASE + 0], P[BASE + 1]), a1 = cvtpk(P[BASE + 2], P[BASE + 3]);   \
    unsigned b0 = cvtpk(P[BASE + 4], P[BASE + 5]), b1 = cvtpk(P[BASE + 6], P[BASE + 7]);                              \
    auto r0 = __builtin_amdgcn_permlane32_swap(a0, b0, false, false); auto r1 = __builtin_amdgcn_permlane32_swap(a1, b1, false, false); \
    u32x4 w = {r0[0], r1[0], r0[1], r1[1]}; OUT = *reinterpret_cast<bf16x8*>(&w); } while (0)
    PK4(p0, 0, pa0); PK4(p0, 8, pa1); PK4(p1, 0, pa2); PK4(p1, 8, pa3);
#undef PK4
}
__device__ __forceinline__ void qkt(f32x16& p0, f32x16& p1, const LAS unsigned char* Ks, const bf16x8* qr, int r32, int hi) {
    p0 = f32x16{}; p1 = f32x16{};
#pragma unroll
    for (int d0 = 0; d0 < 8; ++d0) { const int cb = (d0 * 16 + hi * 8) * 2;
        const bf16x8 b0 = *reinterpret_cast<const LAS bf16x8*>(Ks + KSWZ(r32, cb));
        const bf16x8 b1 = *reinterpret_cast<const LAS bf16x8*>(Ks + KSWZ(32 + r32, cb));
        p0 = __builtin_amdgcn_mfma_f32_32x32x16_bf16(b0, qr[d0], p0, 0, 0, 0);
        p1 = __builtin_amdgcn_mfma_f32_32x32x16_bf16(b1, qr[d0], p1, 0, 0, 0); }
}
__device__ __forceinline__ int v_st(int k, int c) { const int kk = (k & ~0xC) | ((k & 4) << 1) | ((k & 8) >> 1); return ((kk >> 3) * 4 + (c >> 5)) * 512 + ((kk & 7) * 32 + (c & 31)) * 2; }
__device__ __forceinline__ int v_rd_base(int lane) { return ((lane & 3) << 3) | (((lane >> 2) & 3) << 6) | (((lane >> 4) & 1) << 5) | (((lane >> 5) & 1) << 8); }
constexpr int v_rd_off(int d0, int ks, int half) { return d0 * 512 + ks * 4096 + half * 2048; }
template <int OFF> __device__ __forceinline__ s16x4 tr_read(int vb) { s16x4 r; asm volatile("ds_read_b64_tr_b16 %0, %1 offset:%2" : "=&v"(r) : "v"(vb), "i"(OFF) : "memory"); return r; }
template <int D0> __device__ __forceinline__ void pv_one(f32x16& od, int vb, bf16x8 pa0, bf16x8 pa1, bf16x8 pa2, bf16x8 pa3) {
    const s16x4 l0 = tr_read<v_rd_off(D0, 0, 0)>(vb), h0 = tr_read<v_rd_off(D0, 0, 1)>(vb), l1 = tr_read<v_rd_off(D0, 1, 0)>(vb), h1 = tr_read<v_rd_off(D0, 1, 1)>(vb);
    const s16x4 l2 = tr_read<v_rd_off(D0, 2, 0)>(vb), h2 = tr_read<v_rd_off(D0, 2, 1)>(vb), l3 = tr_read<v_rd_off(D0, 3, 0)>(vb), h3 = tr_read<v_rd_off(D0, 3, 1)>(vb);
    asm volatile("s_waitcnt lgkmcnt(0)" ::: "memory"); SBAR();
#define PK(L, H) (bf16x8){L[0], L[1], L[2], L[3], H[0], H[1], H[2], H[3]}
    od = __builtin_amdgcn_mfma_f32_32x32x16_bf16(pa0, PK(l0, h0), od, 0, 0, 0);
    od = __builtin_amdgcn_mfma_f32_32x32x16_bf16(pa1, PK(l1, h1), od, 0, 0, 0);
    od = __builtin_amdgcn_mfma_f32_32x32x16_bf16(pa2, PK(l2, h2), od, 0, 0, 0);
    od = __builtin_amdgcn_mfma_f32_32x32x16_bf16(pa3, PK(l3, h3), od, 0, 0, 0);
#undef PK
}
__device__ __forceinline__ void pv_d0(f32x16* o, int vb, bf16x8 pa0, bf16x8 pa1, bf16x8 pa2, bf16x8 pa3) {
    pv_one<0>(o[0], vb, pa0, pa1, pa2, pa3); pv_one<1>(o[1], vb, pa0, pa1, pa2, pa3); pv_one<2>(o[2], vb, pa0, pa1, pa2, pa3); pv_one<3>(o[3], vb, pa0, pa1, pa2, pa3);
}
}
template <bool OWN>
__device__ __forceinline__ void attn_phase(const Args& A, Frame& F, int ja) {
    using namespace at;
    int tid = F.wave * 64 + lane_id_v(); asm volatile("" : "+v"(tid));
    const int wid = tid >> 6, lane = tid & 63, r32 = lane & 31, hi = lane >> 5;
    const bf16* __restrict__ QKV = (const bf16*)(F.ws + WS_QKV);
    const unsigned* cnt = (const unsigned*)(F.ctl + CW_CNT + ja * 512); const unsigned* list = (const unsigned*)(F.ws + WS_LIST);
    unsigned* __restrict__ PART = (unsigned*)(F.ws + WS_HID); float* __restrict__ LSE = (float*)(F.ws + WS_LSE); bf16* __restrict__ AO = (bf16*)(F.ws + WS_AO);
    LAS unsigned char* lds = F.lds + RING_OFF;
    LAS unsigned char* V_lds = lds + OFF_V; LAS unsigned char* K_lds = lds + OFF_K;
    LAS float* ws = (LAS float*)(lds + OFF_WS) + wid * 64; LAS float* li_l = ws; LAS float* al_l = ws + 32;
    LAS int* dst_l = (LAS int*)(lds + OFF_DST) + wid * 32;
    LAS float* btl = (LAS float*)(lds + OFF_BT);
    LAS unsigned* pre = (LAS unsigned*)(lds + OFF_PRE);
    LAS unsigned* cl = (LAS unsigned*)(lds + OFF_CL);
    unsigned u0, u1;
    if (!OWN) {
        const unsigned n0 = (__hip_atomic_load(cnt + tid, RLX_AGENT));
        cl[tid] = n0;
        unsigned v = (n0 + 255u) >> 8; const unsigned mine = v;
#pragma unroll
        for (int o = 1; o < 64; o <<= 1) { const unsigned t = __shfl_up(v, o); if (lane >= o) v += t; }
        LAS unsigned* wt = (LAS unsigned*)(lds + OFF_WT);
        if (lane == 63) wt[wid] = v;
        __syncthreads();
        unsigned base = 0;
        for (int w = 0; w < wid; ++w) base += wt[w];
        pre[tid] = base + v - mine;
        if (tid == NWAVES * 64 - 1) pre[512] = base + v;
        __syncthreads();
        const unsigned U = pre[512];
        u0 = (unsigned)(((unsigned long long)F.bid * U) / (unsigned)F.G); u1 = (unsigned)(((unsigned long long)(F.bid + 1) * U) / (unsigned)F.G);
    } else { u0 = 0; u1 = (512 - F.bid + F.G - 1) / F.G; }
    const int sr = tid >> 4, sc = (tid & 15) * 8, vst0 = v_st(sr, sc), vst1 = v_st(32 + sr, sc);
    const int vb0 = (int)(uintptr_t)V_lds + v_rd_base(lane);
    struct { bf16x8 vs0, vs1, ks0, ks1; } sr_[2];
    bf16x8 qr[8];
    int h = 0, jb = 0, q = 0, dsti = -1;
#define DECODE(u_, h_, jb_, q_, d_) do { if (OWN) { const int gu = F.bid + (int)(u_) * F.G; h_ = gu >> 5; jb_ = gu & 31; q_ = jb_ * BLK + wid * 32 + r32; d_ = 0; } \
    else { int lo = 0, hi_ = 512; while (hi_ - lo > 1) { const int mid = (lo + hi_) >> 1; if (pre[mid] <= (u_)) lo = mid; else hi_ = mid; } \
        h_ = lo >> 5; jb_ = lo & 31; const int n_ = (int)cl[lo], e_ = (int)((u_) - pre[lo]) * 256 + wid * 32 + r32; \
        const unsigned ent_ = list[(size_t)lo * 8192 + (e_ < n_ ? e_ : n_ - 1)]; q_ = (int)(ent_ >> 2); d_ = e_ < n_ ? (q_ * NH + h_) * 4 + (int)(ent_ & 3u) : -1; } } while (0)
#define KVPTR(h_, jb_) (QKV + (size_t)((jb_) * BLK) * LDK + DM + (h_) * HD)
#define SLOAD(i, kp, k0) do { const bf16* kp_ = (kp); sr_[i].vs0 = *reinterpret_cast<const bf16x8*>(&kp_[DM + (size_t)((k0) + sr) * LDK + sc]); sr_[i].vs1 = *reinterpret_cast<const bf16x8*>(&kp_[DM + (size_t)((k0) + 32 + sr) * LDK + sc]); \
    sr_[i].ks0 = *reinterpret_cast<const bf16x8*>(&kp_[(size_t)((k0) + sr) * LDK + sc]); sr_[i].ks1 = *reinterpret_cast<const bf16x8*>(&kp_[(size_t)((k0) + 32 + sr) * LDK + sc]); } while (0)
#define QLOAD(h_, q_) do { const bf16* Qw_ = QKV + (size_t)(q_) * LDK + (h_) * HD + hi * 8; _Pragma("unroll") for (int d0 = 0; d0 < 8; ++d0) qr[d0] = *reinterpret_cast<const bf16x8*>(Qw_ + d0 * 16); } while (0)
#define SWRITE(b, i) do { *(LAS bf16x8*)(V_lds + (b) * SHM_V + vst0) = sr_[i].vs0; *(LAS bf16x8*)(V_lds + (b) * SHM_V + vst1) = sr_[i].vs1; const int kc = sc * 2; \
    *(LAS bf16x8*)(K_lds + (b) * SHM_K + KSWZ(sr, kc)) = sr_[i].ks0; *(LAS bf16x8*)(K_lds + (b) * SHM_K + KSWZ(32 + sr, kc)) = sr_[i].ks1; } while (0)
#define SWAIT() asm volatile("s_waitcnt vmcnt(4)" ::: "memory")
#define RESC(a) do { if (__any((a) < 1.f)) { if (hi == 0) al_l[r32] = (a); asm volatile("s_waitcnt lgkmcnt(0)" ::: "memory"); \
    _Pragma("unroll") for (int d = 0; d < 4; ++d) _Pragma("unroll") for (int r = 0; r < 16; ++r) o[d][r] *= al_l[crow(r, hi)]; } } while (0)
    if (u0 < u1) { DECODE(u0, h, jb, q, dsti); }
    int cur_h = -1;
    for (unsigned u = u0; u < u1; ++u) {
        if (h != cur_h) { const float* bsrc = (const float*)(F.ws + WS_BIAS) + h * BIAS_LD;
            {
                const int wv_ = __builtin_amdgcn_readfirstlane(tid >> 6), ln_ = tid & 63;
#pragma unroll
                for (int j = 0; j < 4; ++j) __builtin_amdgcn_global_load_lds((const unsigned*)(bsrc + (j * 8 + wv_) * 256 + ln_ * 4), (LAS unsigned*)((LAS unsigned char*)btl + (j * 8 + wv_) * 1024), 16, 0, 0);
                if (wv_ == 0) __builtin_amdgcn_global_load_lds((const unsigned*)(bsrc + 32 * 256 + ln_ * 4), (LAS unsigned*)((LAS unsigned char*)btl + 32 * 1024), 16, 0, 0); }
            cur_h = h; }
        const bf16* Kp = KVPTR(h, jb); QLOAD(h, q); SLOAD(0, Kp, 0);
        float m_reg = -1e30f, l_reg = 0; f32x16 o[4] = {};
        if (hi == 0) dst_l[r32] = dsti;
        const LAS float* bp0 = btl + (q - jb * BLK - 4 * hi + 256 - 59);
        f32x16 pA0, pA1, pB0, pB1; float alA, alB; bf16x8 pa0, pa1, pa2, pa3;
        asm volatile("s_waitcnt vmcnt(0)" ::: "memory"); SWRITE(0, 0); __syncthreads();
        qkt(pA0, pA1, K_lds, qr, r32, hi); partialSM(pA0, pA1, bp0, m_reg, alA);
        SLOAD(1, Kp, KVBLK); SLOAD(0, Kp, 2 * KVBLK);
        SWAIT(); SWRITE(1, 1); __syncthreads();
        SBAR(); qkt(pB0, pB1, K_lds + SHM_K, qr, r32, hi);
        finishSM(pA0, pA1, alA, l_reg, pa0, pa1, pa2, pa3); SBAR();
        SLOAD(1, Kp, 3 * KVBLK); SBAR();
        pv_d0(o, vb0, pa0, pa1, pa2, pa3); partialSM(pB0, pB1, bp0 - 64, m_reg, alB);
        __syncthreads(); SWAIT(); SWRITE(0, 0);
        RESC(alB); __syncthreads();
        SBAR(); qkt(pA0, pA1, K_lds, qr, r32, hi);
        finishSM(pB0, pB1, alB, l_reg, pa0, pa1, pa2, pa3); SBAR();
        pv_d0(o, vb0 + SHM_V, pa0, pa1, pa2, pa3); partialSM(pA0, pA1, bp0 - 128, m_reg, alA);
        __syncthreads(); asm volatile("s_waitcnt vmcnt(0)" ::: "memory"); SWRITE(1, 1);
        RESC(alA); __syncthreads();
        SBAR(); qkt(pB0, pB1, K_lds + SHM_K, qr, r32, hi); SBAR();
        int hn = h, jbn = jb, qn = q, dn = -1;
        if (u + 1 < u1) { DECODE(u + 1, hn, jbn, qn, dn); }
        SBAR();
        finishSM(pA0, pA1, alA, l_reg, pa0, pa1, pa2, pa3); SBAR();
        pv_d0(o, vb0, pa0, pa1, pa2, pa3); partialSM(pB0, pB1, bp0 - 192, m_reg, alB);

        RESC(alB);
        finishSM(pB0, pB1, alB, l_reg, pa0, pa1, pa2, pa3); SBAR();
        pv_d0(o, vb0 + SHM_V, pa0, pa1, pa2, pa3);
        asm volatile("s_waitcnt vmcnt(0)" ::: "memory");
        if (!OWN) {
            if (hi == 0) { li_l[r32] = l_reg; if (dsti >= 0) LSE[dsti] = m_reg + __builtin_amdgcn_logf(l_reg); }
            asm volatile("s_waitcnt lgkmcnt(0)" ::: "memory");
#pragma unroll
            for (int r = 0; r < 16; ++r) { const int row = crow(r, hi); const float rl = __builtin_amdgcn_rcpf(li_l[row]); const int ds = dst_l[row];
                if (ds >= 0) { unsigned* pp = PART + (size_t)ds * 64 + r32; pp[0] = cvtpk(o[0][r] * rl, o[1][r] * rl); pp[32] = cvtpk(o[2][r] * rl, o[3][r] * rl); } }
        } else {
            if (hi == 0) { li_l[r32] = l_reg; al_l[r32] = m_reg; }
            asm volatile("s_waitcnt lgkmcnt(0)" ::: "memory");
#pragma unroll
            for (int hf = 0; hf < 2; ++hf) {
                float wo[8], w0[8], w1[8], w2[8];
                {   f32x4 ls[8];
#pragma unroll
                    for (int rr = 0; rr < 8; ++rr) { const int row = crow(hf * 8 + rr, hi); ls[rr] = *(const f32x4*)(LSE + ((size_t)(jb * BLK + wid * 32 + row) * NH + h) * 4); }
#pragma unroll
                    for (int rr = 0; rr < 8; ++rr) { const int row = crow(hf * 8 + rr, hi); const float lrow = li_l[row], lown = al_l[row] + __builtin_amdgcn_logf(lrow);
                        const float M = fmaxf(fmaxf(lown, ls[rr][0]), fmaxf(ls[rr][1], ls[rr][2]));
                        const float eo = __builtin_amdgcn_exp2f(lown - M), e0 = __builtin_amdgcn_exp2f(ls[rr][0] - M), e1 = __builtin_amdgcn_exp2f(ls[rr][1] - M), e2 = __builtin_amdgcn_exp2f(ls[rr][2] - M);
                        const float iw = __builtin_amdgcn_rcpf((eo + e0) + (e1 + e2));
                        wo[rr] = eo * iw * __builtin_amdgcn_rcpf(lrow); w0[rr] = e0 * iw; w1[rr] = e1 * iw; w2[rr] = e2 * iw; } }
#pragma unroll
                for (int g4 = 0; g4 < 2; ++g4) {
                    unsigned pu[4][3][2];
#pragma unroll
                    for (int r4 = 0; r4 < 4; ++r4) { const int rr = g4 * 4 + r4, row = crow(hf * 8 + rr, hi); const unsigned* pp = PART + ((size_t)(jb * BLK + wid * 32 + row) * NH + h) * 256 + r32;
                        pu[r4][0][0] = w0[rr] > 0.f ? pp[0] : 0u; pu[r4][0][1] = w0[rr] > 0.f ? pp[32] : 0u;
                        pu[r4][1][0] = w1[rr] > 0.f ? pp[64] : 0u; pu[r4][1][1] = w1[rr] > 0.f ? pp[96] : 0u;
                        pu[r4][2][0] = w2[rr] > 0.f ? pp[128] : 0u; pu[r4][2][1] = w2[rr] > 0.f ? pp[160] : 0u; }
#pragma unroll
                    for (int r4 = 0; r4 < 4; ++r4) { const int rr = g4 * 4 + r4, r = hf * 8 + rr, row = crow(r, hi);
                        float a0 = o[0][r] * wo[rr], a1 = o[1][r] * wo[rr], a2 = o[2][r] * wo[rr], a3 = o[3][r] * wo[rr];
                        a0 += w0[rr] * bflo(pu[r4][0][0]) + w1[rr] * bflo(pu[r4][1][0]) + w2[rr] * bflo(pu[r4][2][0]);
                        a1 += w0[rr] * bfhi(pu[r4][0][0]) + w1[rr] * bfhi(pu[r4][1][0]) + w2[rr] * bfhi(pu[r4][2][0]);
                        a2 += w0[rr] * bflo(pu[r4][0][1]) + w1[rr] * bflo(pu[r4][1][1]) + w2[rr] * bflo(pu[r4][2][1]);
                        a3 += w0[rr] * bfhi(pu[r4][0][1]) + w1[rr] * bfhi(pu[r4][1][1]) + w2[rr] * bfhi(pu[r4][2][1]);
                        bf16* op = AO + (size_t)(jb * BLK + wid * 32 + row) * DM + h * HD + r32;
                        op[0] = (bf16)(cvtpk(a0, a0) & 0xffffu); op[32] = (bf16)(cvtpk(a1, a1) & 0xffffu); op[64] = (bf16)(cvtpk(a2, a2) & 0xffffu); op[96] = (bf16)(cvtpk(a3, a3) & 0xffffu); }
                }
            }
        }
        __syncthreads();
        h = hn; jb = jbn; q = qn; dsti = dn;
    }
#undef DECODE
#undef KVPTR
#undef SLOAD
#undef QLOAD
#undef SWRITE
#undef SWAIT
#undef RESC
}
namespace at3 {
using namespace at;
constexpr int O_K = 0, O_V = 65536, O_BT = 131072, O_WS = O_BT + BIAS_LD * 2, O_PRE = O_WS + 8 * 384, O_CL = O_PRE + 516 * 4, O_WT = O_CL + 512 * 4, O_END = O_WT + 64;
static_assert(O_END <= RING_BYTES, "attention LDS map");
__device__ __forceinline__ void sm_tile(f32x16& p0, f32x16& p1, const LAS unsigned short* bp, float& m_reg, float& l_reg, f32x16 (&o)[4], bf16x8& pa0, bf16x8& pa1, bf16x8& pa2, bf16x8& pa3, LAS float* al_l, int r32, int hi) {
    constexpr float C = 0.088388347648318440f * 1.4426950408889634f;
#pragma unroll
    for (int r = 0; r < 16; ++r) p0[r] = fmaf(p0[r], C, __builtin_bit_cast(float, (unsigned)bp[59 - ((r & 3) + 8 * (r >> 2))] << 16));
#pragma unroll
    for (int r = 0; r < 16; ++r) p1[r] = fmaf(p1[r], C, __builtin_bit_cast(float, (unsigned)bp[27 - ((r & 3) + 8 * (r >> 2))] << 16));
    float pmax = p0[0];
#pragma unroll
    for (int r = 1; r < 16; ++r) pmax = fmaxf(pmax, p0[r]);
#pragma unroll
    for (int r = 0; r < 16; ++r) pmax = fmaxf(pmax, p1[r]);
    { auto rr = __builtin_amdgcn_permlane32_swap(__float_as_uint(pmax), __float_as_uint(pmax), false, false); pmax = fmaxf(__uint_as_float(rr[0]), __uint_as_float(rr[1])); }
    float mn = m_reg, alpha = 1.f;
    if (!__all(pmax <= m_reg + 8.0f)) { const bool up = pmax > m_reg + 8.0f;
        mn = up ? pmax : m_reg; alpha = up ? __builtin_amdgcn_exp2f(m_reg - mn) : 1.f; m_reg = mn; }
#pragma unroll
    for (int r = 0; r < 16; ++r) p0[r] = __builtin_amdgcn_exp2f(p0[r] - mn);
#pragma unroll
    for (int r = 0; r < 16; ++r) p1[r] = __builtin_amdgcn_exp2f(p1[r] - mn);
    float ps = 0;
#pragma unroll
    for (int r = 0; r < 16; ++r) ps += p0[r];
#pragma unroll
    for (int r = 0; r < 16; ++r) ps += p1[r];
    { auto rr = __builtin_amdgcn_permlane32_swap(__float_as_uint(ps), __float_as_uint(ps), false, false); ps = __uint_as_float(rr[0]) + __uint_as_float(rr[1]); }
    l_reg = l_reg * alpha + ps;
#define PK4(P, BASE, OUT) do { unsigned a0 = cvtpk(P[BASE + 0], P[BASE + 1]), a1 = cvtpk(P[BASE + 2], P[BASE + 3]);   \
    unsigned b0 = cvtpk(P[BASE + 4], P[BASE + 5]), b1 = cvtpk(P[BASE + 6], P[BASE + 7]);                              \
    auto r0 = __builtin_amdgcn_permlane32_swap(a0, b0, false, false); auto r1 = __builtin_amdgcn_permlane32_swap(a1, b1, false, false); \
    u32x4 w = {r0[0], r1[0], r0[1], r1[1]}; OUT = *reinterpret_cast<bf16x8*>(&w); } while (0)
    PK4(p0, 0, pa0); PK4(p0, 8, pa1); PK4(p1, 0, pa2); PK4(p1, 8, pa3);
#undef PK4
    if (__any(alpha < 1.f)) { if (hi == 0) al_l[r32] = alpha; asm volatile("s_waitcnt lgkmcnt(0)" ::: "memory");
#pragma unroll
        for (int d = 0; d < 4; ++d)
#pragma unroll
            for (int r = 0; r < 16; ++r) o[d][r] *= al_l[crow(r, hi)]; }
}
__device__ __forceinline__ void load_kv_block(const bf16* __restrict__ QKV, int h, int jb, LAS unsigned char* lds, int tid) {
    const bf16* Kp = QKV + (size_t)(jb * BLK) * LDK + DM + h * HD;
    bf16x8 kv[8], vv[8];
#pragma unroll
    for (int i = 0; i < 8; ++i) { const int p = tid + 512 * i, row = p >> 4, c16 = p & 15; kv[i] = *reinterpret_cast<const bf16x8*>(Kp + (size_t)row * LDK + c16 * 8); vv[i] = *reinterpret_cast<const bf16x8*>(Kp + DM + (size_t)row * LDK + c16 * 8); }
#pragma unroll
    for (int i = 0; i < 8; ++i) { const int p = tid + 512 * i, row = p >> 4, c16 = p & 15, t = row >> 6, rl = row & 63;
        *(LAS bf16x8*)(lds + O_K + t * 16384 + KSWZ(rl, c16 * 16)) = kv[i]; *(LAS bf16x8*)(lds + O_V + t * 16384 + v_st(rl, c16 * 8)) = vv[i]; }
}
}
template <bool OWN>
__device__ __forceinline__ void attn_phase3(const Args& A, Frame& F, int ja) {
    using namespace at3;
    int tid = F.wave * 64 + lane_id_v(); asm volatile("" : "+v"(tid));
    const int wid = __builtin_amdgcn_readfirstlane(tid >> 6), lane = tid & 63, r32 = lane & 31, hi = lane >> 5;
    const bf16* __restrict__ QKV = (const bf16*)(F.ws + WS_QKV);
    const unsigned* cnt = (const unsigned*)(F.ctl + CW_CNT + ja * 512); const unsigned* list = (const unsigned*)(F.ws + WS_LIST);
    unsigned* __restrict__ PART = (unsigned*)(F.ws + WS_HID); float* __restrict__ LSE = (float*)(F.ws + WS_LSE); bf16* __restrict__ AO = (bf16*)(F.ws + WS_AO);
    LAS unsigned char* lds = F.lds + RING_OFF;
    LAS float* li_l = (LAS float*)(lds + O_WS + wid * 384); LAS float* al_l = li_l + 32; LAS int* dst_l = (LAS int*)(li_l + 64);
    LAS unsigned short* btl = (LAS unsigned short*)(lds + O_BT);
    LAS unsigned* pre = (LAS unsigned*)(lds + O_PRE); LAS unsigned* cl = (LAS unsigned*)(lds + O_CL);
    const int vb0 = (int)(uintptr_t)(lds + O_V) + v_rd_base(lane);
    unsigned s0 = 0, s1 = 0;
    if (!OWN) {
        const unsigned n0 = __hip_atomic_load(cnt + tid, RLX_AGENT); cl[tid] = n0;
        unsigned v = (n0 + 31u) >> 5; const unsigned mine = v;
#pragma unroll
        for (int o = 1; o < 64; o <<= 1) { const unsigned t = __shfl_up(v, o); if (lane >= o) v += t; }
        LAS unsigned* wt = (LAS unsigned*)(lds + O_WT);
        if (lane == 63) wt[wid] = v;
        __syncthreads();
        unsigned base = 0;
        for (int w = 0; w < wid; ++w) base += wt[w];
        pre[tid] = base + v - mine;
        if (tid == NWAVES * 64 - 1) pre[512] = base + v;
        __syncthreads();
        const unsigned ST = pre[512];
        s0 = (unsigned)(((unsigned long long)F.bid * ST) / (unsigned)F.G); s1 = (unsigned)(((unsigned long long)(F.bid + 1) * ST) / (unsigned)F.G);
    } else { s0 = 0; s1 = (512 - F.bid + F.G - 1) / F.G; }
    int cur_h = -1;
    while (s0 < s1) {
        int h, jb; unsigned seg_end, gbase = 0; int n_g = 0, g = 0;
        if (!OWN) { int lo = 0, hi_ = 512; while (hi_ - lo > 1) { const int mid = (lo + hi_) >> 1; if (pre[mid] <= s0) lo = mid; else hi_ = mid; }
            g = lo; h = g >> 5; jb = g & 31; gbase = pre[g]; n_g = (int)cl[g]; const unsigned ge = pre[g + 1]; seg_end = ge < s1 ? ge : s1; }
        else { const int gu = F.bid + (int)s0 * F.G; h = gu & 15; jb = gu >> 4; seg_end = s0 + 1; }
        __syncthreads();
        if (h != cur_h) { const float* bsrc = (const float*)(F.ws + WS_BIAS) + h * BIAS_LD;
            {
                const int ln_ = tid & 63;
#pragma unroll
                for (int j = 0; j < 4; ++j) __builtin_amdgcn_global_load_lds((const unsigned*)(bsrc + (j * 8 + wid) * 256 + ln_ * 4), (LAS unsigned*)(lds + O_K + (j * 8 + wid) * 1024), 16, 0, 0);
                if (wid == 0) __builtin_amdgcn_global_load_lds((const unsigned*)(bsrc + 32 * 256 + ln_ * 4), (LAS unsigned*)(lds + O_K + 32 * 1024), 16, 0, 0);
                asm volatile("s_waitcnt vmcnt(0)" ::: "memory"); __syncthreads();
                for (int i = tid; i < BIAS_LD; i += NWAVES * 64) btl[i] = (unsigned short)f2bf(((const LAS float*)(lds + O_K))[i]);
                __syncthreads(); }
            cur_h = h; }
        load_kv_block(QKV, h, jb, lds, tid);
        __syncthreads();
        const unsigned st_first = OWN ? 0u : s0 + (unsigned)wid, st_step = 8u;
        for (unsigned st = st_first; OWN ? st < 1u : st < seg_end; st += st_step) {
            int q, dsti, nt;
            if (!OWN) { const int e = (int)(st - gbase) * 32 + r32; const unsigned ent = list[(size_t)g * 8192 + (e < n_g ? e : n_g - 1)];
                q = (int)(ent >> 2); dsti = e < n_g ? (q * NH + h) * 4 + (int)(ent & 3u) : -1; nt = 4; }
            else { const int sub = wid < 4 ? 7 - wid : wid - 4; q = jb * BLK + sub * 32 + r32; dsti = 0; nt = (sub >> 1) + 1; }
            bf16x8 qr[8];
            { const bf16* Qw = QKV + (size_t)q * LDK + h * HD + hi * 8;
#pragma unroll
              for (int d0 = 0; d0 < 8; ++d0) qr[d0] = *reinterpret_cast<const bf16x8*>(Qw + d0 * 16); }
            if (!OWN) { if (hi == 0) dst_l[r32] = dsti; }
            const LAS unsigned short* bp0 = btl + (q - jb * BLK - 4 * hi + 256 - 59);
            float m_reg = -1e30f, l_reg = 0; f32x16 o[4] = {};
#pragma unroll 1
            for (int t = 0; t < nt; ++t) {
                f32x16 p0, p1; bf16x8 pa0, pa1, pa2, pa3;
                qkt(p0, p1, lds + O_K + t * 16384, qr, r32, hi);
                sm_tile(p0, p1, bp0 - 64 * t, m_reg, l_reg, o, pa0, pa1, pa2, pa3, al_l, r32, hi);
                pv_d0(o, vb0 + t * 16384, pa0, pa1, pa2, pa3);
            }
            if (!OWN) {
                if (hi == 0) { li_l[r32] = l_reg; if (dsti >= 0) LSE[dsti] = m_reg + __builtin_amdgcn_logf(l_reg); }
                asm volatile("s_waitcnt lgkmcnt(0)" ::: "memory");
#pragma unroll
                for (int r = 0; r < 16; ++r) { const int row = crow(r, hi); const float rl = __builtin_amdgcn_rcpf(li_l[row]); const int ds = dst_l[row];
                    if (ds >= 0) { unsigned* pp = PART + (size_t)ds * 64 + r32; pp[0] = cvtpk(o[0][r] * rl, o[1][r] * rl); pp[32] = cvtpk(o[2][r] * rl, o[3][r] * rl); } }
            } else {
                const int sub = wid < 4 ? 7 - wid : wid - 4, rowb = jb * BLK + sub * 32;
                if (hi == 0) { li_l[r32] = l_reg; al_l[r32] = m_reg; }
                asm volatile("s_waitcnt lgkmcnt(0)" ::: "memory");
#pragma unroll
                for (int hf = 0; hf < 2; ++hf) {
                    f32x4 ls[8]; unsigned pu[8][6];
#pragma unroll
                    for (int rr = 0; rr < 8; ++rr) { const int row = crow(hf * 8 + rr, hi); const size_t e = (size_t)(rowb + row) * NH + h;
                        ls[rr] = *(const f32x4*)(LSE + e * 4); const unsigned* pp = PART + e * 256 + r32;
                        pu[rr][0] = pp[0]; pu[rr][1] = pp[32]; pu[rr][2] = pp[64]; pu[rr][3] = pp[96]; pu[rr][4] = pp[128]; pu[rr][5] = pp[160]; }
#pragma unroll
                    for (int rr = 0; rr < 8; ++rr) { const int r = hf * 8 + rr, row = crow(r, hi); const float lrow = li_l[row], lown = al_l[row] + __builtin_amdgcn_logf(lrow);
                        const float M = fmaxf(fmaxf(lown, ls[rr][0]), fmaxf(ls[rr][1], ls[rr][2]));
                        const float eo = __builtin_amdgcn_exp2f(lown - M), e0 = __builtin_amdgcn_exp2f(ls[rr][0] - M), e1 = __builtin_amdgcn_exp2f(ls[rr][1] - M), e2 = __builtin_amdgcn_exp2f(ls[rr][2] - M);
                        const float iw = __builtin_amdgcn_rcpf((eo + e0) + (e1 + e2));
                        const float wo = eo * iw * __builtin_amdgcn_rcpf(lrow), w0 = e0 * iw, w1 = e1 * iw, w2 = e2 * iw;
                        const unsigned q00 = w0 > 0.f ? pu[rr][0] : 0u, q01 = w0 > 0.f ? pu[rr][1] : 0u, q10 = w1 > 0.f ? pu[rr][2] : 0u, q11 = w1 > 0.f ? pu[rr][3] : 0u, q20 = w2 > 0.f ? pu[rr][4] : 0u, q21 = w2 > 0.f ? pu[rr][5] : 0u;
                        const float a0 = o[0][r] * wo + (w0 * bflo(q00) + w1 * bflo(q10) + w2 * bflo(q20));
                        const float a1 = o[1][r] * wo + (w0 * bfhi(q00) + w1 * bfhi(q10) + w2 * bfhi(q20));
                        const float a2 = o[2][r] * wo + (w0 * bflo(q01) + w1 * bflo(q11) + w2 * bflo(q21));
                        const float a3 = o[3][r] * wo + (w0 * bfhi(q01) + w1 * bfhi(q11) + w2 * bfhi(q21));
                        bf16* op = AO + (size_t)(rowb + row) * DM + h * HD + r32;
                        op[0] = (bf16)(cvtpk(a0, a0) & 0xffffu); op[32] = (bf16)(cvtpk(a1, a1) & 0xffffu); op[64] = (bf16)(cvtpk(a2, a2) & 0xffffu); op[96] = (bf16)(cvtpk(a3, a3) & 0xffffu); }
                }
            }
        }
        s0 = seg_end;
    }
}
#define TOP3_INS2(x_, j_) do { const float x__ = (x_); const int j__ = (j_); \
    const bool b0 = x__ > v0 || (x__ == v0 && (unsigned)j__ < (unsigned)i0), b1 = x__ > v1 || (x__ == v1 && (unsigned)j__ < (unsigned)i1), b2 = x__ > v2 || (x__ == v2 && (unsigned)j__ < (unsigned)i2); \
    v2 = b1 ? v1 : (b2 ? x__ : v2); i2 = b1 ? i1 : (b2 ? j__ : i2); v1 = b0 ? v0 : (b1 ? x__ : v1); i1 = b0 ? i0 : (b1 ? j__ : i1); v0 = b0 ? x__ : v0; i0 = b0 ? j__ : i0; } while (0)
__device__ __forceinline__ void phase_gate2(const Args& A, Frame& F, int ja) {
    using namespace at;
    int tid = F.wave * 64 + lane_id_v(); asm volatile("" : "+v"(tid));
    const int lane = tid & 63, wave = tid >> 6, r32 = lane & 31, hi = lane >> 5;
    const bf16* QKV = (const bf16*)(F.ws + WS_QKV); const float* KMP = (const float*)(F.ws + WS_KMP);
    unsigned* cnt = (unsigned*)(F.ctl + CW_CNT + ja * 512); unsigned* list = (unsigned*)(F.ws + WS_LIST); float* LSE = (float*)(F.ws + WS_LSE);
    LAS unsigned* lc = (LAS unsigned*)(F.lds + RING_OFF);
    for (int u = F.bid; u < 512; u += F.G) {
        const int h = u & 15, c = u >> 4;
        __syncthreads();
        if (tid < 64) lc[tid] = 0u;
        __syncthreads();
        const int q = c * 256 + wave * 32 + r32;
        int i0 = -1, i1 = -1, i2 = -1;
        if (c > 0) {
            bf16x8 kh[8], kl[8], qr[8];
            const bf16* Qw = QKV + (size_t)q * NQKV + h * HD + hi * 8;
#pragma unroll
            for (int d0 = 0; d0 < 8; ++d0) qr[d0] = *reinterpret_cast<const bf16x8*>(Qw + d0 * 16);
#pragma unroll
            for (int d0 = 0; d0 < 8; ++d0) { const float* p0 = KMP + (size_t)r32 * 2048 + h * HD + d0 * 16 + hi * 8; const float* p1 = p0 + (size_t)32 * 2048;
                const f32x4 a0 = *(const f32x4*)p0 + *(const f32x4*)p1, a1 = *(const f32x4*)(p0 + 4) + *(const f32x4*)(p1 + 4);
                float v[8] = {a0[0], a0[1], a0[2], a0[3], a1[0], a1[1], a1[2], a1[3]}; unsigned hh[4], ll[4];
#pragma unroll
                for (int e = 0; e < 4; ++e) { const float x0 = v[2 * e] * (1.0f / 256.0f), x1 = v[2 * e + 1] * (1.0f / 256.0f); const unsigned ph = cvtpk(x0, x1); hh[e] = ph;
                    ll[e] = cvtpk(x0 - bflo(ph), x1 - bfhi(ph)); }
                u32x4 wh = {hh[0], hh[1], hh[2], hh[3]}, wl_ = {ll[0], ll[1], ll[2], ll[3]};
                kh[d0] = *reinterpret_cast<bf16x8*>(&wh); kl[d0] = *reinterpret_cast<bf16x8*>(&wl_); }
            f32x16 Gt = {};
#pragma unroll
            for (int d0 = 0; d0 < 8; ++d0) { Gt = __builtin_amdgcn_mfma_f32_32x32x16_bf16(kh[d0], qr[d0], Gt, 0, 0, 0); Gt = __builtin_amdgcn_mfma_f32_32x32x16_bf16(kl[d0], qr[d0], Gt, 0, 0, 0); }
            float v0 = -INFINITY, v1 = -INFINITY, v2 = -INFINITY;
#pragma unroll
            for (int r = 0; r < 16; ++r) { const int jb = crow(r, hi); if (jb < c) TOP3_INS2(Gt[r], jb); }
            const float pv0 = __shfl_xor(v0, 32), pv1 = __shfl_xor(v1, 32), pv2 = __shfl_xor(v2, 32);
            const int pi0 = __shfl_xor(i0, 32), pi1 = __shfl_xor(i1, 32), pi2 = __shfl_xor(i2, 32);
            if (pi0 >= 0) TOP3_INS2(pv0, pi0);
            if (pi1 >= 0) TOP3_INS2(pv1, pi1);
            if (pi2 >= 0) TOP3_INS2(pv2, pi2);
        }
        unsigned lp0 = 0, lp1 = 0, lp2 = 0;
        if (hi == 0) { if (i0 >= 0) lp0 = atomicAdd((unsigned*)(lc + i0), 1u); if (i1 >= 0) lp1 = atomicAdd((unsigned*)(lc + i1), 1u); if (i2 >= 0) lp2 = atomicAdd((unsigned*)(lc + i2), 1u); }
        __syncthreads();
        if (tid < 32) { const unsigned n = lc[tid]; lc[32 + tid] = n ? atomicAdd(&cnt[h * 32 + tid], n) : 0u; }
        __syncthreads();
        if (hi == 0) {
#define EMIT_PICK(k_, sj_, lp_) do { if ((sj_) >= 0) list[(size_t)(h * 32 + (sj_)) * 8192 + lc[32 + (sj_)] + (lp_)] = ((unsigned)q << 2) | (unsigned)(k_); \
                else LSE[((size_t)q * NH + h) * 4 + (k_)] = -INFINITY; } while (0)
            EMIT_PICK(0, i0, lp0); EMIT_PICK(1, i1, lp1); EMIT_PICK(2, i2, lp2);
#undef EMIT_PICK
        }
    }
}
__device__ __forceinline__ void phase_rec_ab2(const Args& A, Frame& F, int jr) {
    using namespace at;
    int tid = F.wave * 64 + lane_id_v(); asm volatile("" : "+v"(tid));
    const int lane = tid & 63, wave = tid >> 6, r32 = lane & 31, hi = lane >> 5;
    const bf16* XR = (const bf16*)(F.ws + WS_QKV);
    const float* cw = A.in[8] + (size_t)jr * 4 * DM; const float* cb = A.in[9] + (size_t)jr * DM;
    const float* brg = A.in[11] + (size_t)jr * DM; const float* big = A.in[13] + (size_t)jr * DM; const float* lam = A.in[14] + (size_t)jr * DM;
    const bf16* WG = (const bf16*)(F.ws + WS_WG) + (size_t)jr * 2 * 16 * 128 * 128;
    unsigned* SAB = (unsigned*)(F.ws + WS_HID);
    LAS unsigned char* xcl = F.lds + RING_OFF;
    LAS unsigned char* wl = F.lds + RING_OFF + 65536;
    LAS f32x2* comp = (LAS f32x2*)(F.lds + RING_OFF + 131072);
    int cur_n = -1;
    for (int u = F.bid; u < 512; u += F.G) {
        const int n = u & 15, tt = u >> 4;
        __syncthreads();
        if (n != cur_n) { cur_n = n;
#pragma unroll
            for (int i = 0; i < 8; ++i) { const int p = tid + i * 512, g = p >> 11, ch = (p >> 4) & 127, kc = p & 15;
                *(LAS v4u*)(wl + g * 32768 + KSWZ(ch, kc * 16)) = *(const v4u*)(WG + ((size_t)(g * 16 + n) * 128 + ch) * 128 + kc * 8); } }
        {
            const int chg = tid & 15, c0 = n * 128 + chg * 8;
            float w[4][8], b8[8];
#pragma unroll
            for (int jj = 0; jj < 4; ++jj) { const f32x4 x0 = *(const f32x4*)(cw + jj * DM + c0), x1 = *(const f32x4*)(cw + jj * DM + c0 + 4);
                w[jj][0] = x0[0]; w[jj][1] = x0[1]; w[jj][2] = x0[2]; w[jj][3] = x0[3]; w[jj][4] = x1[0]; w[jj][5] = x1[1]; w[jj][6] = x1[2]; w[jj][7] = x1[3]; }
            { const f32x4 x0 = *(const f32x4*)(cb + c0), x1 = *(const f32x4*)(cb + c0 + 4); b8[0] = x0[0]; b8[1] = x0[1]; b8[2] = x0[2]; b8[3] = x0[3]; b8[4] = x1[0]; b8[5] = x1[1]; b8[6] = x1[2]; b8[7] = x1[3]; }
#pragma unroll 4
            for (int ps = 0; ps < 8; ++ps) { const int rl = (tid >> 4) + 32 * ps, t = tt * 256 + rl;
                float acc[8];
#pragma unroll
                for (int e = 0; e < 8; ++e) acc[e] = b8[e];
#pragma unroll
                for (int jj = 0; jj < 4; ++jj) { const int ts = t - 3 + jj;
                    if (ts >= 0) { const v4u xv = *(const v4u*)(XR + (size_t)ts * DM + c0);
                        acc[0] += bflo(xv.x) * w[jj][0]; acc[1] += bfhi(xv.x) * w[jj][1]; acc[2] += bflo(xv.y) * w[jj][2]; acc[3] += bfhi(xv.y) * w[jj][3];
                        acc[4] += bflo(xv.z) * w[jj][4]; acc[5] += bfhi(xv.z) * w[jj][5]; acc[6] += bflo(xv.w) * w[jj][6]; acc[7] += bfhi(xv.w) * w[jj][7]; } }
                v4u o; o.x = cvtpk(acc[0], acc[1]); o.y = cvtpk(acc[2], acc[3]); o.z = cvtpk(acc[4], acc[5]); o.w = cvtpk(acc[6], acc[7]);
                *(LAS v4u*)(xcl + KSWZ(rl, chg * 16)) = o; }
        }
        __syncthreads();
        bf16x8 xf[8];
#pragma unroll
        for (int d0 = 0; d0 < 8; ++d0) xf[d0] = *(const LAS bf16x8*)(xcl + KSWZ(wave * 32 + r32, (d0 * 16 + hi * 8) * 2));
#pragma unroll 1
        for (int ct = 0; ct < 4; ++ct) {
            f32x16 aR = {}, aI = {};
#pragma unroll
            for (int d0 = 0; d0 < 8; ++d0) { const int cbo = (d0 * 16 + hi * 8) * 2;
                const bf16x8 wr_ = *(const LAS bf16x8*)(wl + KSWZ(ct * 32 + r32, cbo)), wi_ = *(const LAS bf16x8*)(wl + 32768 + KSWZ(ct * 32 + r32, cbo));
                aR = __builtin_amdgcn_mfma_f32_32x32x16_bf16(xf[d0], wr_, aR, 0, 0, 0);
                aI = __builtin_amdgcn_mfma_f32_32x32x16_bf16(xf[d0], wi_, aI, 0, 0, 0); }
            const int chl = ct * 32 + r32, ch = n * 128 + chl;
            const float lm = lam[ch], b_r = brg[ch], b_i = big[ch];
            const float lsg2 = (fminf(lm, 0.f) - log1pf(__expf(-fabsf(lm)))) * (8.0f * 1.4426950408889634f);
            float sA[4], sH[4];
#pragma unroll
            for (int r = 0; r < 16; ++r) { const int tl = wave * 32 + crow(r, hi);
                const float xcv = bf2f(*(const LAS unsigned short*)(xcl + KSWZ(tl, chl * 2)));
                const float rr = __builtin_amdgcn_rcpf(1.0f + __builtin_amdgcn_exp2f(-1.4426950408889634f * (aR[r] + b_r)));
                const float ii = __builtin_amdgcn_rcpf(1.0f + __builtin_amdgcn_exp2f(-1.4426950408889634f * (aI[r] + b_i)));
                const float la2 = rr * lsg2;
                const float av = __builtin_amdgcn_exp2f(la2);
                const float x2 = la2 * (2.0f * 0.6931471805599453f);
                const float ser = -x2 * (1.0f + x2 * (0.5f + x2 * (0.16666667f + x2 * 0.041666668f)));
                const float om = x2 > -0.1f ? ser : 1.0f - av * av;
                const size_t o = (size_t)(tt * 256 + tl) * DM + ch;
                const float bv = __builtin_amdgcn_sqrtf(om) * (ii * xcv);
                SAB[o] = cvtpk(la2, bv);
                const int sg = r >> 2; if ((r & 3) == 0) { sA[sg] = av; sH[sg] = bv; } else { sH[sg] = av * sH[sg] + bv; sA[sg] *= av; } }
            float cA = 1.f, cH = 0.f;
#pragma unroll
            for (int sg = 0; sg < 4; ++sg) { const float pA = __shfl_xor(sA[sg], 32), pH = __shfl_xor(sH[sg], 32);
                const float fA = hi ? pA : sA[sg], fH = hi ? pH : sH[sg], gA = hi ? sA[sg] : pA, gH = hi ? sH[sg] : pH;
                cH = fA * cH + fH; cA *= fA; cH = gA * cH + gH; cA *= gA; }
            if (hi == 0) comp[wave * 128 + chl] = (f32x2){cA, cH};
        }
        __syncthreads();
        { const int k = tid >> 7, chl = tid & 127; const f32x2 c0 = comp[(2 * k) * 128 + chl], c1 = comp[(2 * k + 1) * 128 + chl];
          float* CA = (float*)(F.ws + WS_CARRY); float* CH = CA + 128 * DM; const size_t o = (size_t)(tt * 4 + k) * DM + n * 128 + chl;
          CA[o] = c0.x * c1.x; CH[o] = c1.x * c0.y + c1.y; }
    }
}
__device__ __forceinline__ void phase_rec_scan(const Args& A, Frame& F) {
    int tid = F.wave * 64 + lane_id_v(); asm volatile("" : "+v"(tid));
    const unsigned* SAB = (const unsigned*)(F.ws + WS_HID); const float* CA = (const float*)(F.ws + WS_CARRY); const float* CH = CA + 128 * DM;
    const bf16* GG = (const bf16*)(F.ws + WS_QKV + 32 * MiB); bf16* AO = (bf16*)(F.ws + WS_AO);
    for (int i = F.bid * (NWAVES * 64) + tid; i < 128 * 1024; i += F.G * NWAVES * 64) { const int ch = i >> 10, c = (i & 1023) * 2;
        f32x2 H = (f32x2){0.f, 0.f};
        int k = 0;
        for (; k + 16 <= ch; k += 16) { f32x2 a[16], b[16];
#pragma unroll
            for (int j = 0; j < 16; ++j) { a[j] = *(const f32x2*)(CA + (k + j) * DM + c); b[j] = *(const f32x2*)(CH + (k + j) * DM + c); }
#pragma unroll
            for (int j = 0; j < 16; ++j) H = a[j] * H + b[j]; }
        if (k + 8 <= ch) { f32x2 a[8], b[8];
#pragma unroll
            for (int j = 0; j < 8; ++j) { a[j] = *(const f32x2*)(CA + (k + j) * DM + c); b[j] = *(const f32x2*)(CH + (k + j) * DM + c); }
#pragma unroll
            for (int j = 0; j < 8; ++j) H = a[j] * H + b[j];
            k += 8; }
        for (; k < ch; ++k) { const f32x2 a = *(const f32x2*)(CA + k * DM + c), b = *(const f32x2*)(CH + k * DM + c); H = a * H + b; }
#pragma unroll 1
        for (int r0 = 0; r0 < 64; r0 += 32) { v2u x[32]; unsigned g[32];
#pragma unroll
            for (int j = 0; j < 32; ++j) { const size_t o = (size_t)(ch * 64 + r0 + j) * DM + c; x[j] = __builtin_nontemporal_load((const v2u*)(SAB + o)); g[j] = *(const unsigned*)(GG + o); }
#pragma unroll
            for (int j = 0; j < 32; ++j) { const size_t o = (size_t)(ch * 64 + r0 + j) * DM + c;
                const f32x2 a = (f32x2){__builtin_amdgcn_exp2f(bflo(x[j].x)), __builtin_amdgcn_exp2f(bflo(x[j].y))}, b = (f32x2){bfhi(x[j].x), bfhi(x[j].y)};
                H = a * H + b; *(unsigned*)(AO + o) = pk2(H.x * bflo(g[j]), H.y * bfhi(g[j])); } }
    }
}
__device__ __forceinline__ int dq_layer(int li) {
    int l = 0, seen = -1;
#pragma unroll
    for (int b = 0; b < 4; ++b) if ((DQ_MASK >> b) & 1) { ++seen; if (seen == li) l = b; }
    return l;
}
__device__ __forceinline__ void wq_rows(const Args& A, Frame& F) {
    int tid = F.wave * 64 + lane_id_v(); asm volatile("" : "+v"(tid)); const int lane = tid & 63, wave = __builtin_amdgcn_readfirstlane(tid >> 6);
    const int gw = F.bid * NWAVES + wave, NGW = F.G * NWAVES;
    float* SWb = (float*)(F.ws + WS_SW);
    constexpr int NL = ((DQ_MASK >> 0) & 1) + ((DQ_MASK >> 1) & 1) + ((DQ_MASK >> 2) & 1) + ((DQ_MASK >> 3) & 1);
    for (int r0 = gw; r0 < NL * DM; r0 += 2 * NGW) {
        v4u x[2][16];
#pragma unroll
        for (int h = 0; h < 2; ++h) { const int rr = r0 + h * NGW < NL * DM ? r0 + h * NGW : r0; const int li = rr / DM, n = rr - li * DM, l = dq_layer(li);
            const bf16* src = (const bf16*)(F.ws + WS_W2) + (size_t)l * DM * FF + (size_t)n * FF;
#pragma unroll
            for (int j = 0; j < 16; ++j) x[h][j] = ((const GAS v4u*)src + lane)[64 * j]; }
#pragma unroll
        for (int h = 0; h < 2; ++h) { const int rr = r0 + h * NGW; if (rr >= NL * DM) break; const int li = rr / DM, n = rr - li * DM, l = dq_layer(li);
            unsigned char* dst = F.ws + WS_W1 + WS_W2Q_OFF * MiB + (size_t)l * DM * FF + (size_t)n * FF;
            float am = 0.f;
#pragma unroll
            for (int j = 0; j < 16; ++j)
#pragma unroll
                for (int e = 0; e < 4; ++e) am = fmaxf(am, fmaxf(fabsf(bflo(x[h][j][e])), fabsf(bfhi(x[h][j][e]))));
            am = wave_max(am);
            const float inv = am > 1e-30f ? 127.0f / am : 0.f; float cs = 0.f;
#pragma unroll
            for (int j = 0; j < 16; ++j) { float r[8];
#pragma unroll
                for (int e = 0; e < 4; ++e) { r[2 * e] = __builtin_rintf(bflo(x[h][j][e]) * inv); r[2 * e + 1] = __builtin_rintf(bfhi(x[h][j][e]) * inv); cs += r[2 * e] + r[2 * e + 1]; }
                v2u o; o.x = pack_i8x4(r[0], r[1], r[2], r[3]); o.y = pack_i8x4(r[4], r[5], r[6], r[7]);
                ((GAS v2u*)dst + lane)[64 * j] = o; }
            cs = wave_sum(cs);
            if (lane == 0) { SWb[SW_T2 + l * DM + n] = am * (1.0f / 127.0f); SWb[SW_CS2 + l * DM + n] = cs; } }
    }
    for (int r0 = gw; r0 < NL * FF; r0 += 4 * NGW) {
        v4u a[4], b2[4]; float stp[4];
#pragma unroll
        for (int h = 0; h < 4; ++h) { const int rr = r0 + h * NGW < NL * FF ? r0 + h * NGW : r0; const int li = rr / FF, n = rr - li * FF, l = dq_layer(li);
            const unsigned char* src = F.ws + WS_W1 + (size_t)l * FF * DM + (size_t)n * DM;
            a[h] = ((const GAS v4u*)src + lane)[0]; b2[h] = ((const GAS v4u*)src + lane)[64]; stp[h] = SWb[SW_W1 + l * FF + n]; }
#pragma unroll
        for (int h = 0; h < 4; ++h) { const int rr = r0 + h * NGW; if (rr >= NL * FF) break; const int li = rr / FF, n = rr - li * FF, l = dq_layer(li);
            int acc = 0;
#pragma unroll
            for (int e = 0; e < 4; ++e) { const int w0 = (int)a[h][e], w1 = (int)b2[h][e];
#pragma unroll
                for (int sh = 0; sh < 4; ++sh) { const int q0 = (w0 << (24 - 8 * sh)) >> 24, q1 = (w1 << (24 - 8 * sh)) >> 24; acc += q0 * q0 + q1 * q1; } }
            const float tot = wave_sum((float)acc);
            if (lane == 0) SWb[SW_SS + l * FF + n] = tot * stp[h] * stp[h]; }
    }
}
__device__ __forceinline__ void hidden_step(Frame& F, int l) {
    if (F.bid == 0) { float* SWb = (float*)(F.ws + WS_SW); int tid = F.wave * 64 + lane_id_v(); asm volatile("" : "+v"(tid)); const int lane = tid & 63;
        float v[16];
#pragma unroll
        for (int j = 0; j < 16; ++j) v[j] = SWb[SW_SS + l * FF + tid + 512 * j];
        float s = 0.f;
#pragma unroll
        for (int j = 0; j < 16; ++j) s += v[j];
        s = wave_sum(s);
        LAS float* red = (LAS float*)(F.lds + RING_OFF);
        if (lane == 0) red[F.wave] = s;
        __syncthreads();
        if (tid == 0) { float t = 0.f;
#pragma unroll
            for (int w = 0; w < 8; ++w) t += red[w];
            const float C = 21.16f * t * (1.0f / 8192.0f);
            SWb[SW_CL + 2 * l] = 254.0f / C; SWb[SW_CL + 2 * l + 1] = C * (1.0f / 254.0f); }
        __syncthreads(); }
}
__device__ __forceinline__ void phase_quant(const Args& A, Frame& F, int need_q) {
    int tid = F.wave * 64 + lane_id_v(); asm volatile("" : "+v"(tid)); const int lane = tid & 63, wave = __builtin_amdgcn_readfirstlane(tid >> 6);
    const bf16* XB = (const bf16*)(F.ws + WS_XB); unsigned char* XQ = F.ws + WS_XQ; float* frow = (float*)(F.ws + WS_FROW);
    const int nk = pass_nrows(F, wave);
    for (int k0 = 0; k0 < nk; k0 += 4) {
        v4u x[4][4];
#pragma unroll
        for (int r = 0; r < 4; ++r) { const int m = pass_row(F, wave, k0 + r < nk ? k0 + r : k0);
#pragma unroll
            for (int j = 0; j < 4; ++j) x[r][j] = ((const GAS v4u*)(XB + (size_t)m * DM) + lane)[64 * j]; }
#pragma unroll
        for (int r = 0; r < 4; ++r) { const int m = k0 + r < nk ? pass_row(F, wave, k0 + r) : S; float s = 0.f, am = 0.f;
#pragma unroll
            for (int j = 0; j < 4; ++j) {
#pragma unroll
                for (int e = 0; e < 4; ++e) { const float a0 = bflo(x[r][j][e]), a1 = bfhi(x[r][j][e]); s += a0 * a0 + a1 * a1; am = fmaxf(am, fmaxf(fabsf(a0), fabsf(a1))); } }
            s = wave_sum(s); am = wave_max(am);
            const float inv = am > 1e-30f ? 127.0f / am : 0.f;
            if (m < S) {
                if (need_q) {
#pragma unroll
                for (int j = 0; j < 4; ++j) { v2u o; o.x = pack_i8x4(bflo(x[r][j].x) * inv, bfhi(x[r][j].x) * inv, bflo(x[r][j].y) * inv, bfhi(x[r][j].y) * inv);
                    o.y = pack_i8x4(bflo(x[r][j].z) * inv, bfhi(x[r][j].z) * inv, bflo(x[r][j].w) * inv, bfhi(x[r][j].w) * inv);
                    ((GAS v2u*)(XQ + (size_t)m * DM) + lane)[64 * j] = o; } }
                if (lane == 0) { const float rstd = __builtin_amdgcn_rsqf(s * (1.0f / 2048.0f) + 1e-6f); frow[m] = am * (1.0f / 127.0f) * rstd; ((float*)(F.ws + WS_RSTD))[m] = rstd; } } }
    }
}
__device__ __forceinline__ void phase_final(const Args& A, Frame& F) {
    int tid = F.wave * 64 + lane_id_v(); asm volatile("" : "+v"(tid)); const int lane = tid & 63, wave = __builtin_amdgcn_readfirstlane(tid >> 6);
    const bf16* XB = (const bf16*)(F.ws + WS_XB); const float* gf = A.in[4];
    const int nk = pass_nrows(F, wave);
    f32x4 g0[4], g1[4];
#pragma unroll
    for (int j = 0; j < 4; ++j) { g0[j] = *(const f32x4*)(gf + j * 512 + lane * 8); g1[j] = *(const f32x4*)(gf + j * 512 + lane * 8 + 4); }
    for (int k0 = 0; k0 < nk; k0 += 2) {
        const bool two = k0 + 1 < nk; const int m0 = pass_row(F, wave, k0), m1 = two ? pass_row(F, wave, k0 + 1) : m0;
        v4u xa[4], xb[4];
#pragma unroll
        for (int j = 0; j < 4; ++j) { xa[j] = ((const GAS v4u*)(XB + (size_t)m0 * DM) + lane)[64 * j]; xb[j] = two ? ((const GAS v4u*)(XB + (size_t)m1 * DM) + lane)[64 * j] : xa[j]; }
        float s0 = 0.f, s1 = 0.f;
#pragma unroll
        for (int j = 0; j < 4; ++j) {
#pragma unroll
            for (int e = 0; e < 4; ++e) { const float a0 = bflo(xa[j][e]), a1 = bfhi(xa[j][e]), b0 = bflo(xb[j][e]), b1 = bfhi(xb[j][e]); s0 += a0 * a0 + a1 * a1; s1 += b0 * b0 + b1 * b1; } }
        s0 = wave_sum(s0); s1 = wave_sum(s1);
        const float r0 = __builtin_amdgcn_rsqf(s0 * (1.0f / 2048.0f) + 1e-6f), r1 = __builtin_amdgcn_rsqf(s1 * (1.0f / 2048.0f) + 1e-6f);
        GAS f32x4* o0 = (GAS f32x4*)(A.out + (size_t)m0 * DM) + 2 * lane; GAS f32x4* o1 = (GAS f32x4*)(A.out + (size_t)m1 * DM) + 2 * lane;
#pragma unroll
        for (int j = 0; j < 4; ++j) { const f32x4 a = (f32x4){bflo(xa[j].x), bfhi(xa[j].x), bflo(xa[j].y), bfhi(xa[j].y)}, b = (f32x4){bflo(xa[j].z), bfhi(xa[j].z), bflo(xa[j].w), bfhi(xa[j].w)};
            __builtin_nontemporal_store(a * r0 * g0[j], &o0[128 * j]); __builtin_nontemporal_store(b * r0 * g1[j], &o0[128 * j + 1]); }
        if (two) {
#pragma unroll
            for (int j = 0; j < 4; ++j) { const f32x4 a = (f32x4){bflo(xb[j].x), bfhi(xb[j].x), bflo(xb[j].y), bfhi(xb[j].y)}, b = (f32x4){bflo(xb[j].z), bfhi(xb[j].z), bflo(xb[j].w), bfhi(xb[j].w)};
                __builtin_nontemporal_store(a * r1 * g0[j], &o1[128 * j]); __builtin_nontemporal_store(b * r1 * g1[j], &o1[128 * j + 1]); } }
    }
}
__global__ void __launch_bounds__(NWAVES * 64, 2) mega_fwd(Args A) {
    extern __shared__ __attribute__((aligned(16))) unsigned char lds[];
    Frame F;
    F.lds = (LAS unsigned char*)lds; F.ldsg = lds;
    F.MISC = (volatile LAS unsigned*)(F.lds + MISC_OFF);
    F.tid = threadIdx.x; F.lane = F.tid & 63; F.wave = __builtin_amdgcn_readfirstlane(F.tid >> 6);
    F.G = gridDim.x; F.bid = blockIdx.x;
    F.ws = A.ws; F.ctl = (gu32*)(A.ws + WS_CTL);
    for (int u = F.tid; u < (LDS_BYTES - LDSCTL_OFF) / 4; u += NWAVES * 64) ((LAS unsigned*)(F.lds + LDSCTL_OFF))[u] = 0u;
    __syncthreads();
    XcdBarrier bar; bar.bar = (unsigned*)(F.ctl + CW_BAR); bar.x = 0; bar.st = nullptr;
    if (!MK_PER_PHASE) bar = xcd_barrier_post((unsigned*)(F.ctl + CW_BAR), F.MISC + 8);
    const int lo = A.ph_lo, hi = A.ph_hi;
#define IN(k) (lo <= (k) && (k) < hi)
#define SEAM(k) do { if (IN(k) && IN((k) + 1)) xcd_barrier(bar); } while (0)

    if (IN(0) && DBG(0)) { for (int rp = 0; rp < NREP(0); ++rp) { p0_prologue(A, F); if (rp + 1 < NREP(0)) xcd_barrier(bar); } } SEAM(0);
    for (int ls = 0; ls < 2 * DEPTH; ++ls) {
        const int l = ls >> 1, st = ls & 1, jm = l >> 1, rec = l & 1;
        const int p1 = 1 + 7 * l + (st ? 5 : 0), p2 = p1 + (st ? 1 : 4);
        if (IN(p1) && DBG(1)) {
            if (ls > 0) { phase_quant(A, F, (st || !rec) ? 1 : 0); if (ls == 1 && DQ_MASK) wq_rows(A, F); if (st && ((DQ_MASK >> l) & 1)) hidden_step(F, l); xcd_barrier(bar); }
            if (!st && rec) {
                pg8::Gemm g{(const bf16*)(F.ws + WS_XB), (const bf16*)(F.ws + WS_WIN) + (size_t)jm * 2 * DM * DM, S, 2 * DM, DM, F.wave};
                pg8::FrowOrder So; So.init(S, 2 * DM, F.G, F.bid); So.frow = (const float*)(F.ws + WS_RSTD); So.tab = F.lds + 135168;
                pg8::EpiScaleT<false> E{(bf16*)(F.ws + WS_QKV), DM, F.lds + 135168, nullptr, (bf16*)(F.ws + WS_QKV + 32 * MiB), 1, nullptr, nullptr};
                pg8::gemm_phase<pg8::EpiScaleT<false>, pg8::FrowOrder, true, true, false>(F.lds + RING_OFF, g, So, E);
            } else {
            const unsigned char* Bq; const float* sc; int N, mode; bf16* O; int ldc;
            if (st) { Bq = F.ws + WS_W1 + (size_t)l * FF * DM; sc = (const float*)(F.ws + WS_SW) + SW_W1 + l * FF; N = FF; mode = ((DQ_MASK >> l) & 1) ? 3 : 2; O = (bf16*)(F.ws + WS_HID); ldc = FF; }
            else { Bq = F.ws + WS_WQKV + (size_t)jm * NQKV * DM; sc = (const float*)(F.ws + WS_SW) + SW_QKV + jm * NQKV; N = NQKV; mode = 0; O = (bf16*)(F.ws + WS_QKV); ldc = NQKV; }
            pg8::Gemm g{(const bf16*)(F.ws + WS_XQ), (const bf16*)Bq, S, N, DM / 2, F.wave};
            pg8::FrowOrder So; So.init(S, N, F.G, F.bid); So.frow = (const float*)(F.ws + WS_FROW); So.tab = F.lds + 135168;
            pg8::EpiScaleT<true> E{O, ldc, F.lds + 135168, (float*)(F.ws + WS_KMP), (bf16*)(F.ws + WS_QKV + 32 * MiB), mode, sc, (const float*)(F.ws + WS_SW) + SW_CL + 2 * l};
            for (int rp = 0; rp < NREP(1); ++rp) { pg8::gemm_phase<pg8::EpiScaleT<true>, pg8::FrowOrder, true, true, true>(F.lds + RING_OFF, g, So, E); if (rp + 1 < NREP(1)) xcd_barrier(bar); } } }
        SEAM(p1);
        if (!st) {
            if (!rec) {
                if (IN(p1 + 1) && DBG(2)) phase_gate2(A, F, jm);
                SEAM(p1 + 1);
                if (IN(p1 + 2) && DBG(3)) { for (int rp = 0; rp < NREP(3); ++rp) { attn_phase<false>(A, F, jm); if (rp + 1 < NREP(3)) xcd_barrier(bar); } }
                SEAM(p1 + 2);
                if (IN(p1 + 3) && DBG(4)) { for (int rp = 0; rp < NREP(4); ++rp) { attn_phase3<true>(A, F, jm); if (rp + 1 < NREP(4)) xcd_barrier(bar); } }
                SEAM(p1 + 3);
            } else {
                if (IN(p1 + 1) && DBG(6)) { for (int rp = 0; rp < NREP(6); ++rp) { phase_rec_ab2(A, F, jm); if (rp + 1 < NREP(6)) xcd_barrier(bar); } }
                SEAM(p1 + 1);
                                if (IN(p1 + 3) && DBG(8)) { for (int rp = 0; rp < NREP(8); ++rp) { phase_rec_scan(A, F); if (rp + 1 < NREP(8)) xcd_barrier(bar); } }
                SEAM(p1 + 3);
            }
        }
        if (IN(p2) && DBG(9) && st && ((DQ_MASK >> l) & 1)) {
            pg8::Gemm g{(const bf16*)(F.ws + WS_HID), (const bf16*)(F.ws + WS_W1 + WS_W2Q_OFF * MiB + (size_t)l * DM * FF), S, DM, FF / 2, F.wave}; pg8::StaticOrder So; So.init(S, DM, F.G, F.bid);
            pg8::EpiResQ8 E{(bf16*)(F.ws + WS_XB), (const float*)(F.ws + WS_SW) + SW_T2 + l * DM, (const float*)(F.ws + WS_SW) + SW_CS2 + l * DM, (const float*)(F.ws + WS_SW) + SW_CL + 2 * l};
            pg8::gemm_phase<pg8::EpiResQ8, pg8::StaticOrder, true, true, true>(F.lds + RING_OFF, g, So, E); }
        else if (IN(p2) && DBG(9)) {
            const bf16* Ap; const bf16* Bt; int K;
            if (st) { Ap = (const bf16*)(F.ws + WS_HID); Bt = (const bf16*)(F.ws + WS_W2) + (size_t)l * DM * FF; K = FF; }
            else { Ap = (const bf16*)(F.ws + WS_AO); Bt = (const bf16*)(F.ws + (rec ? WS_WOUT : WS_WO)) + (size_t)jm * DM * DM; K = DM; }
            pg8::Gemm g{Ap, Bt, S, DM, K, F.wave}; pg8::StaticOrder So; So.init(S, DM, F.G, F.bid);
            pg8::EpiRes E{(bf16*)(F.ws + WS_XB)};
            pg8::gemm_phase<pg8::EpiRes, pg8::StaticOrder, true, true>(F.lds + RING_OFF, g, So, E); }
        SEAM(p2);
    }
    if (IN(NPHASE - 1) && DBG(12)) { for (int rp = 0; rp < NREP(12); ++rp) { phase_final(A, F); if (rp + 1 < NREP(12)) xcd_barrier(bar); } }
#undef IN
#undef SEAM
}

extern "C" void kernel_launch(void* const* d_in, const int* in_sizes, int n_in, void* d_out, int out_size, void* d_ws, size_t ws_size, hipStream_t stream) {
    static int grid = 0;
    if (grid == 0) {
        if (n_in != 18 || in_sizes[0] != S * DM || out_size != S * DM || ws_size < WS_END) { fprintf(stderr, "kernel_launch: shape mismatch n_in %d in0 %d out %d ws %zu (need %zu)\n", n_in, n_in > 0 ? in_sizes[0] : -1, out_size, ws_size, (size_t)WS_END); grid = -1; return; }
        int dev = 0, cus = 0, per_cu = 0;
        if (hipGetDevice(&dev) != hipSuccess || hipDeviceGetAttribute(&cus, hipDeviceAttributeMultiprocessorCount, dev) != hipSuccess) { grid = -1; return; }
        if (hipFuncSetAttribute((const void*)mega_fwd, hipFuncAttributeMaxDynamicSharedMemorySize, LDS_BYTES) != hipSuccess) { fprintf(stderr, "kernel_launch: hipFuncSetAttribute failed\n"); grid = -1; return; }
        if (hipOccupancyMaxActiveBlocksPerMultiprocessor(&per_cu, (const void*)mega_fwd, NWAVES * 64, LDS_BYTES) != hipSuccess || per_cu < 1) fprintf(stderr, "kernel_launch: occupancy query says %d\n", per_cu);
        (void)hipGetLastError();
        grid = cus;
    }
    if (grid < 0) return;
    if (hipMemsetAsync((char*)d_ws + WS_CTL, 0, CTL_ZERO_BYTES, stream) != hipSuccess) { fprintf(stderr, "kernel_launch: memset failed\n"); return; }
    Args a{};
    for (int i = 0; i < 18; ++i) a.in[i] = (const float*)d_in[i];
    a.out = (float*)d_out; a.ws = (unsigned char*)d_ws;
#if MK_PER_PHASE
    for (int p = 0; p < NPHASE; ++p) { a.ph_lo = p; a.ph_hi = p + 1; hipLaunchKernelGGL(mega_fwd, dim3(grid), dim3(NWAVES * 64), LDS_BYTES, stream, a); }
#else
    a.ph_lo = 0; a.ph_hi = NPHASE; hipLaunchKernelGGL(mega_fwd, dim3(grid), dim3(NWAVES * 64), LDS_BYTES, stream, a);
#endif
    const hipError_t le = hipPeekAtLastError();
    if (le != hipSuccess) fprintf(stderr, "kernel_launch: launch failed: %s\n", hipGetErrorName(le));
}
```
